# Optimizing an MI355X kernel written in HIP

```python
import math
import jax, jax.numpy as jnp
from jax import lax
import numpy as np

D_MODEL = 2048
BATCH = 8
SEQ = 2048
DEPTH = 1

GRID_W = 64
CTX_LEN = 256
D_MIX = D_MODEL
S5_W = D_MIX // 2
HY_W = D_MIX - S5_W
D_IN = S5_W + 3 * HY_W
S5_H = 16
S5_GROUPS = S5_W // S5_H
S5_P = 64
S5_DT_MIN = 1e-3
S5_DT_MAX = 1e-1
S5_RE_MAX = -1e-4
HY_BANDS = 16
HY_EMB = 2 * HY_BANDS + 1
HY_ORDER = 64
HY_FAST_DECAY = 0.3
HY_SLOW_DECAY = 1.5
HY_TARGET = 1e-2
N_EXPERTS = 32
TOP_K = 4
D_FF = D_MODEL
SWIGLU_LIMIT = 7.0
SWIGLU_ALPHA = 1.702
MOE_BLOCK = 256
N_MOD = 6
EPS = 1e-6

kernel_name = "hybrid_s5_hyena_moe_dit_block"


def rmsnorm(x, g):
    xf = x.astype(jnp.float32)
    y = xf * lax.rsqrt(jnp.mean(xf * xf, axis=-1, keepdims=True) + EPS)
    return (y * g.astype(jnp.float32)).astype(x.dtype)


def modulate(h, shift, scale):
    return h * (1 + scale) + shift


def short_conv_seq(u, w, b):
    up = jnp.pad(u, ((0, 0), (1, 1), (0, 0)))
    return up[:, :-2] * w[0] + up[:, 1:-1] * w[1] + up[:, 2:] * w[2] + b


def short_conv_grid(u, w, b):
    n, length, ch = u.shape
    rows = length // GRID_W
    g = u.reshape(n * rows, GRID_W, ch)
    return short_conv_seq(g, w, b).reshape(n, length, ch)


def hyena_filter(length, w1, b1, w2, b2, w3, b3, w4, freq, deltas):
    f32 = jnp.float32
    t = jnp.linspace(0.0, 1.0, length, dtype=f32)[:, None]
    bands = jnp.linspace(1e-4, HY_BANDS - 1, HY_BANDS, dtype=f32)
    ang = (2 * math.pi / length) * jnp.arange(length, dtype=f32)[:, None] * bands
    z = jnp.concatenate([t, jnp.cos(ang), -jnp.sin(ang)], axis=-1)
    fr = freq.astype(f32)
    h = jnp.sin(fr * (z @ w1.astype(f32) + b1.astype(f32)))
    h = jnp.sin(fr * (h @ w2.astype(f32) + b2.astype(f32)))
    h = jnp.sin(fr * (h @ w3.astype(f32) + b3.astype(f32)))
    h = (h @ w4.astype(f32)) * jnp.exp(-t * jnp.abs(deltas.astype(f32)))
    h_fwd = h[:, :HY_W]
    h_bwd = h[:length - 1, HY_W:]
    norm = jnp.sum(jnp.abs(h_fwd), axis=0) + jnp.sum(jnp.abs(h_bwd), axis=0)
    k = jnp.concatenate([h_fwd, jnp.zeros((1, HY_W), f32), h_bwd[::-1]], axis=0)
    return k / norm


def long_conv(u, k):
    length = u.shape[1]
    n = 2 * length
    uf = jnp.fft.rfft(u.astype(jnp.float32), n=n, axis=1)
    kf = jnp.fft.rfft(k, n=n, axis=0)
    return jnp.fft.irfft(uf * kf, n=n, axis=1)[:, :length]


def hyena_mixer(p, conv_fn, conv_w, conv_b, w1, b1, w2, b2, w3, b3, w4, freq, deltas, d_skip):
    z = conv_fn(p, conv_w, conv_b)
    v, x1, x0 = jnp.split(z, 3, axis=-1)
    k = hyena_filter(p.shape[1], w1, b1, w2, b2, w3, b3, w4, freq, deltas)
    v = v * x1
    v = long_conv(v, k).astype(p.dtype) + v * d_skip
    return v * x0


def _diag_combine(left, right):
    a_l, b_l = left
    a_r, b_r = right
    return a_l * a_r, a_r * b_l + b_r


def diag_scan(lam_bar, bu, reverse):
    a = jnp.broadcast_to(lam_bar, (bu.shape[0], 1) + lam_bar.shape)
    _, states = lax.associative_scan(_diag_combine, (a, bu), reverse=reverse, axis=0)
    return states


def s5_readout(y, w_glu, b_glu, dtype):
    nb, length = y.shape[:2]
    y = jax.nn.gelu(y.reshape(nb, length, S5_W), approximate=False)
    y = y * jax.nn.sigmoid(y @ w_glu.astype(jnp.float32) + b_glu.astype(jnp.float32))
    return y.astype(dtype)


def s5_mixer(u_lat, u_ctx, lam_re, lam_im, log_step, b_re, b_im, c_re, c_im, d_skip,
             w_glu, b_glu, with_ctx_out):
    f32 = jnp.float32
    nb, l_lat, _ = u_lat.shape
    l_ctx = u_ctx.shape[1]
    ul = u_lat.astype(f32).reshape(nb, l_lat, S5_GROUPS, S5_H)
    uc = u_ctx.astype(f32).reshape(nb, l_ctx, S5_GROUPS, S5_H)
    dsk = d_skip.astype(f32).reshape(S5_GROUPS, S5_H)
    y_lat = ul * dsk
    y_ctx = uc * dsk if with_ctx_out else None
    for direction in range(2):
        reverse = direction == 1
        lam = lax.complex(jnp.minimum(lam_re[direction].astype(f32), S5_RE_MAX),
                          lam_im[direction].astype(f32))
        lam_bar = jnp.exp(lam * jnp.exp(log_step[direction].astype(f32)))
        b_bar = ((lam_bar - 1) / lam)[..., None] * lax.complex(
            b_re[direction].astype(f32), b_im[direction].astype(f32))
        c_mat = lax.complex(c_re[direction].astype(f32), c_im[direction].astype(f32))
        st_ctx = diag_scan(lam_bar, jnp.einsum('blgh,gph->lbgp', uc, b_bar), reverse)
        s0 = st_ctx[0] if reverse else st_ctx[-1]
        bu_lat = jnp.einsum('blgh,gph->lbgp', ul, b_bar)
        first = l_lat - 1 if reverse else 0
        bu_lat = bu_lat.at[first].add(lam_bar * s0)
        st_lat = diag_scan(lam_bar, bu_lat, reverse)
        y_lat = y_lat + jnp.einsum('lbgp,ghp->blgh', st_lat, c_mat).real
        if with_ctx_out:
            y_ctx = y_ctx + jnp.einsum('lbgp,ghp->blgh', st_ctx, c_mat).real
    out_lat = s5_readout(y_lat, w_glu, b_glu, u_lat.dtype)
    out_ctx = s5_readout(y_ctx, w_glu, b_glu, u_ctx.dtype) if with_ctx_out else None
    return out_lat, out_ctx


def moe_ffn(h, w_router, b_router, w_gate_up, b_gate_up, w_down, b_down):
    lead = h.shape[:-1]
    d = h.shape[-1]
    t = h.reshape(-1, d)
    n_tok = t.shape[0]
    logits = (t @ w_router + b_router).astype(jnp.float32)
    top_val, top_idx = lax.top_k(logits, TOP_K)
    gate = jax.nn.softmax(top_val, axis=-1)
    flat_e = top_idx.reshape(-1)
    n_assign = n_tok * TOP_K
    order = jnp.argsort(flat_e)
    sorted_e = flat_e[order]
    tok = order // TOP_K
    counts = jnp.bincount(flat_e, length=N_EXPERTS)
    padded = (counts + MOE_BLOCK - 1) // MOE_BLOCK * MOE_BLOCK
    pad_end = jnp.cumsum(padded)
    pad_start = pad_end - padded
    start = jnp.cumsum(counts) - counts
    dest = pad_start[sorted_e] + jnp.arange(n_assign) - start[sorted_e]
    n_blocks = -(-n_assign // MOE_BLOCK) + N_EXPERTS
    src = jnp.full((n_blocks * MOE_BLOCK,), n_tok, jnp.int32).at[dest].set(tok)
    t_pad = jnp.concatenate([t, jnp.zeros((1, d), t.dtype)], axis=0)
    xb = t_pad[src].reshape(n_blocks, MOE_BLOCK, d)
    blk_e = jnp.minimum(jnp.searchsorted(pad_end, jnp.arange(n_blocks) * MOE_BLOCK, side='right'),
                        N_EXPERTS - 1)

    def expert_block(args):
        xblk, e = args
        gu = xblk @ w_gate_up[e] + b_gate_up[e]
        g, u = jnp.split(gu, 2, axis=-1)
        g = jnp.minimum(g, SWIGLU_LIMIT)
        u = jnp.clip(u, -SWIGLU_LIMIT, SWIGLU_LIMIT)
        return ((u + 1) * (g * jax.nn.sigmoid(SWIGLU_ALPHA * g))) @ w_down[e] + b_down[e]

    yb = lax.map(expert_block, (xb, blk_e)).reshape(-1, d)
    y = yb[dest] * gate.reshape(-1)[order][:, None].astype(yb.dtype)
    return jax.ops.segment_sum(y, tok, num_segments=n_tok).reshape(lead + (d,))


def setup_inputs(seed: int = 0) -> dict:
    key = jax.random.key(seed)
    keys = iter(jax.random.split(key, 48))
    f32 = jnp.float32

    def normal(shape, scale):
        return scale * jax.random.normal(next(keys), shape, f32)

    def gain(shape):
        return 1.0 + normal(shape, 0.05)

    s5_shape = (DEPTH, 2, S5_GROUPS, S5_P)
    n_idx = jnp.arange(S5_P, dtype=f32)
    decay_base = jnp.linspace(math.log(HY_TARGET) / HY_FAST_DECAY,
                              math.log(HY_TARGET) / HY_SLOW_DECAY, HY_W, dtype=f32)
    return {
        'x': normal((BATCH, SEQ, D_MODEL), 1.0),
        'c': normal((BATCH, D_MODEL), 1.0),
        'ctx': normal((BATCH, CTX_LEN, D_MODEL), 1.0),
        'c_ctx': normal((D_MODEL,), 1.0),
        'w_ada': normal((DEPTH, D_MODEL, N_MOD * D_MODEL), 0.5 * D_MODEL ** -0.5),
        'b_ada': normal((DEPTH, N_MOD * D_MODEL), 0.02),
        'g_norm1': gain((DEPTH, D_MODEL)),
        'g_norm2': gain((DEPTH, D_MODEL)),
        'w_in': normal((DEPTH, D_MODEL, D_IN), D_MODEL ** -0.5),
        's5_lam_re': -0.5 + normal(s5_shape, 0.02),
        's5_lam_im': math.pi * n_idx + normal(s5_shape, 0.02),
        's5_log_step': jax.random.uniform(next(keys), s5_shape, f32,
                                          math.log(S5_DT_MIN), math.log(S5_DT_MAX)),
        's5_b_re': normal((DEPTH, 2, S5_GROUPS, S5_P, S5_H), (2 * S5_H) ** -0.5),
        's5_b_im': normal((DEPTH, 2, S5_GROUPS, S5_P, S5_H), (2 * S5_H) ** -0.5),
        's5_c_re': normal((DEPTH, 2, S5_GROUPS, S5_H, S5_P), S5_P ** -0.5),
        's5_c_im': normal((DEPTH, 2, S5_GROUPS, S5_H, S5_P), S5_P ** -0.5),
        's5_d': normal((DEPTH, S5_W), 1.0),
        's5_w_glu': normal((DEPTH, S5_W, S5_W), S5_W ** -0.5),
        's5_b_glu': normal((DEPTH, S5_W), 0.02),
        'hy_conv_w': normal((DEPTH, 3, 3 * HY_W), 3 ** -0.5),
        'hy_conv_b': normal((DEPTH, 3 * HY_W), 0.02),
        'hy_w1': normal((DEPTH, HY_EMB, HY_ORDER), HY_EMB ** -0.5),
        'hy_b1': normal((DEPTH, HY_ORDER), 0.1),
        'hy_w2': normal((DEPTH, HY_ORDER, HY_ORDER), HY_ORDER ** -0.5),
        'hy_b2': normal((DEPTH, HY_ORDER), 0.1),
        'hy_w3': normal((DEPTH, HY_ORDER, HY_ORDER), HY_ORDER ** -0.5),
        'hy_b3': normal((DEPTH, HY_ORDER), 0.1),
        'hy_w4': normal((DEPTH, HY_ORDER, 2 * HY_W), HY_ORDER ** -0.5),
        'hy_freq': gain((DEPTH, HY_ORDER)),
        'hy_deltas': jnp.concatenate([decay_base, decay_base]) + normal((DEPTH, 2 * HY_W), 0.01),
        'hy_d': normal((DEPTH, HY_W), 1.0),
        'w_out': normal((DEPTH, D_MIX, D_MODEL), D_MIX ** -0.5),
        'w_router': normal((DEPTH, D_MODEL, N_EXPERTS), D_MODEL ** -0.5),
        'b_router': normal((DEPTH, N_EXPERTS), 0.01),
        'w_gate_up': normal((DEPTH, N_EXPERTS, D_MODEL, 2 * D_FF), D_MODEL ** -0.5),
        'b_gate_up': normal((DEPTH, N_EXPERTS, 2 * D_FF), 0.02),
        'w_down': normal((DEPTH, N_EXPERTS, D_FF, D_MODEL), D_FF ** -0.5),
        'b_down': normal((DEPTH, N_EXPERTS, D_MODEL), 0.02),
        'g_final': gain((D_MODEL,)),
    }


def reference(x, c, ctx, c_ctx, w_ada, b_ada, g_norm1, g_norm2, w_in,
              s5_lam_re, s5_lam_im, s5_log_step, s5_b_re, s5_b_im, s5_c_re, s5_c_im,
              s5_d, s5_w_glu, s5_b_glu,
              hy_conv_w, hy_conv_b, hy_w1, hy_b1, hy_w2, hy_b2, hy_w3, hy_b3, hy_w4,
              hy_freq, hy_deltas, hy_d,
              w_out, w_router, b_router, w_gate_up, b_gate_up, w_down, b_down, g_final):
    for l in range(DEPTH):
        last = l == DEPTH - 1
        mod_x = jax.nn.silu(c) @ w_ada[l] + b_ada[l]
        mod_c = jax.nn.silu(c_ctx) @ w_ada[l] + b_ada[l]
        sh1, sc1, ga1, sh2, sc2, ga2 = jnp.split(mod_x[:, None, :], N_MOD, axis=-1)
        csh1, csc1, cga1, csh2, csc2, cga2 = jnp.split(mod_c, N_MOD, axis=-1)

        p_lat = modulate(rmsnorm(x, g_norm1[l]), sh1, sc1) @ w_in[l]
        w_in_ctx = w_in[l] if not last else w_in[l][:, :S5_W]
        p_ctx = modulate(rmsnorm(ctx, g_norm1[l]), csh1, csc1) @ w_in_ctx
        y_s5_lat, y_s5_ctx = s5_mixer(
            p_lat[..., :S5_W], p_ctx[..., :S5_W],
            s5_lam_re[l], s5_lam_im[l], s5_log_step[l], s5_b_re[l], s5_b_im[l],
            s5_c_re[l], s5_c_im[l], s5_d[l], s5_w_glu[l], s5_b_glu[l],
            with_ctx_out=not last)
        hy_prm = (hy_conv_w[l], hy_conv_b[l], hy_w1[l], hy_b1[l], hy_w2[l], hy_b2[l],
                  hy_w3[l], hy_b3[l], hy_w4[l], hy_freq[l], hy_deltas[l], hy_d[l])
        y_hy_lat = hyena_mixer(p_lat[..., S5_W:], short_conv_grid, *hy_prm)
        x = x + ga1 * (jnp.concatenate([y_s5_lat, y_hy_lat], axis=-1) @ w_out[l])
        if not last:
            y_hy_ctx = hyena_mixer(p_ctx[..., S5_W:], short_conv_seq, *hy_prm)
            ctx = ctx + cga1 * (jnp.concatenate([y_s5_ctx, y_hy_ctx], axis=-1) @ w_out[l])

        moe_prm = (w_router[l], b_router[l], w_gate_up[l], b_gate_up[l], w_down[l], b_down[l])
        x = x + ga2 * moe_ffn(modulate(rmsnorm(x, g_norm2[l]), sh2, sc2), *moe_prm)
        if not last:
            ctx = ctx + cga2 * moe_ffn(modulate(rmsnorm(ctx, g_norm2[l]), csh2, csc2), *moe_prm)
    return rmsnorm(x, g_final)
```

```cpp
#include <hip/hip_runtime.h>
#include <cstdio>
#include <cstdint>

#ifndef MK_SPLIT
#define MK_SPLIT 0
#endif

#define GAS __attribute__((address_space(1)))
#define LAS __attribute__((address_space(3)))
typedef unsigned short bf16_t;
typedef short bf16x8 __attribute__((ext_vector_type(8)));
typedef float f32x4 __attribute__((ext_vector_type(4)));
typedef float f32x16 __attribute__((ext_vector_type(16)));
typedef unsigned u32x4 __attribute__((ext_vector_type(4)));
typedef unsigned u32x2 __attribute__((ext_vector_type(2)));

constexpr int NWAVES = 8, NTHR = 512;
constexpr int D = 2048, NB = 8, SEQ = 2048, M = NB * SEQ, CTXL = 256, MC = NB * CTXL, MT = M + MC;
constexpr int DIN = 4096, S5W = 1024, HYW = 1024, NG = 64;
constexpr int NE = 32, DFF = 2048;
constexpr int NPHASE = 11;
constexpr int SEG = 288;

constexpr size_t MiB = 1u << 20;
constexpr size_t WS_CTL = 0, CTL_ZERO_BYTES = 512 * 1024;
constexpr int CW_TMO = 0, CW_BAR = 4096, CW_CNT = 8192, CW_HNORM = 12288, CW_MOD = 16384;
constexpr size_t WS_LAM = 1 * MiB, WS_LAML = WS_LAM + 64 * 1024, WS_S5B = WS_LAM + 128 * 1024, WS_S5C = WS_LAM + 640 * 1024;
constexpr size_t WS_HRAW = 4 * MiB, WS_RG = 20 * MiB, WS_WIN = 28 * MiB, WS_WGLU = 44 * MiB, WS_WOUT = 46 * MiB;
constexpr size_t WS_PK = 54 * MiB, WS_GATE = WS_PK + 256 * 1024, WS_ROWL = 55 * MiB;
constexpr size_t WS_A1 = 64 * MiB, WS_P = 136 * MiB, WS_YS5 = 280 * MiB, WS_VT = 344 * MiB, WS_LCT = 376 * MiB, WS_YG = 408 * MiB;
constexpr size_t WS_YCAT = 440 * MiB, WS_X1 = 504 * MiB, WS_A2 = 632 * MiB, WS_WGU = 704 * MiB, WS_WDN = 1216 * MiB;
constexpr size_t WS_H = 1472 * MiB, WS_YD = 1760 * MiB, WS_END = 2048 * MiB;
constexpr int HROWS = 73728;

constexpr int RING_BYTES = 131072, LDSCTL_OFF = RING_BYTES, LDS_BYTES = 147456;
constexpr int LW_BAR = 8, LW_TST = 64, LW_CNT = 128;

__device__ __forceinline__ unsigned f2bf(float f) { unsigned u = __builtin_bit_cast(unsigned, f); return (u + 0x7fffu + ((u >> 16) & 1u)) >> 16; }
__device__ __forceinline__ unsigned pk2(float lo, float hi) { return f2bf(lo) | (f2bf(hi) << 16); }
__device__ __forceinline__ float bflo(unsigned w) { return __builtin_bit_cast(float, w << 16); }
__device__ __forceinline__ float bfhi(unsigned w) { return __builtin_bit_cast(float, w & 0xffff0000u); }
__device__ __forceinline__ float bf1(bf16_t b) { return __builtin_bit_cast(float, (unsigned)b << 16); }
__device__ __forceinline__ float wave_sum(float v) {
#pragma unroll
    for (int o = 1; o < 64; o <<= 1) v += __shfl_xor(v, o);
    return v;
}
#define LDS_WAIT() asm volatile("s_waitcnt lgkmcnt(0)" ::: "memory")
#define VM_WAIT() asm volatile("s_waitcnt vmcnt(0)" ::: "memory")

#define XB_TMO      128
#define XB_XCNT(j)  (256  + 64 * (j))
#define XB_XSUB(j)  (1280 + 64 * (j))
#define XB_XGEN(j)  (2304 + 64 * (j))
#define XB_TOP      3328
#define XB_TOPGEN   3392
#define XCD_BAR_WORDS 3456
#define XB_SPIN_CAP (1u << 18)
__device__ __forceinline__ unsigned xb_ld(unsigned* p)              { return __hip_atomic_load(p, __ATOMIC_RELAXED, __HIP_MEMORY_SCOPE_AGENT); }
__device__ __forceinline__ unsigned xb_add(unsigned* p, unsigned v) { return __hip_atomic_fetch_add(p, v, __ATOMIC_RELAXED, __HIP_MEMORY_SCOPE_AGENT); }
__device__ __forceinline__ unsigned xb_xcc_id() { return (unsigned)__builtin_amdgcn_s_getreg((3 << 11) | 20) & 0xFu; }
#define XB_SPIN(cond, bar) do { unsigned _sp = 0; while (cond) { __builtin_amdgcn_s_sleep(1); \
    if ((++_sp & 255u) == 0u) { if (xb_ld(&(bar)[XB_TMO])) break; if (_sp > XB_SPIN_CAP) { atomicAdd(&(bar)[XB_TMO], 1u); break; } } } } while (0)
struct XcdBarrier { unsigned* bar; unsigned x; volatile LAS unsigned* st; };
__device__ __forceinline__ XcdBarrier xcd_barrier_post(unsigned* bar, volatile LAS unsigned* st) {
    XcdBarrier b; b.bar = bar; b.x = xb_xcc_id(); b.st = st;
    if (threadIdx.x == 0) (void)xb_add(&bar[XB_XCNT(b.x)], 1u);
    return b;
}
__device__ __forceinline__ void xcd_barrier_complete(unsigned* bar, unsigned x, unsigned& nloc, unsigned& nx) {
    const unsigned G = gridDim.x * gridDim.y * gridDim.z;
    unsigned sum, cnt, mine, sp = 0u;
    for (;;) {
        sum = 0u; cnt = 0u; mine = 0u;
#pragma unroll
        for (unsigned j = 0; j < 16; ++j) { const unsigned c = xb_ld(&bar[XB_XCNT(j)]); sum += c; cnt += (c > 0u) ? 1u : 0u; mine = (j == x) ? c : mine; }
        if (sum == G) break;
        __builtin_amdgcn_s_sleep(1);
        if ((++sp & 255u) == 0u) { if (xb_ld(&bar[XB_TMO])) break; if (sp > XB_SPIN_CAP) { atomicAdd(&bar[XB_TMO], 1u); break; } }
    }
    nloc = mine > 0u ? mine : 1u; nx = cnt > 0u ? cnt : 1u;
}
__device__ __forceinline__ void xcd_barrier(const XcdBarrier& b) {
    asm volatile("s_waitcnt vmcnt(0)" ::: "memory");
    __syncthreads();
    if (threadIdx.x == 0) {
        unsigned* bar = b.bar;
        __builtin_amdgcn_s_waitcnt(0);
        unsigned nloc = b.st[0], nx = b.st[1];
        if (nloc == 0u) { xcd_barrier_complete(bar, b.x, nloc, nx); b.st[0] = nloc; b.st[1] = nx; }
        const unsigned old = xb_add(&bar[XB_XSUB(b.x)], 1u);
        const unsigned gen = old / nloc;
        if (old + 1u == (gen + 1u) * nloc) {
            __builtin_amdgcn_fence(__ATOMIC_RELEASE, "agent");
            asm volatile("s_waitcnt vmcnt(0)" ::: "memory");
            const unsigned og = xb_add(&bar[XB_TOP], 1u);
            const unsigned tg = og / nx;
            if (og + 1u == (tg + 1u) * nx) xb_add(&bar[XB_TOPGEN], 1u);
            else XB_SPIN(xb_ld(&bar[XB_TOPGEN]) == tg, bar);
            __builtin_amdgcn_fence(__ATOMIC_ACQUIRE, "agent");
            xb_add(&bar[XB_XGEN(b.x)], 1u);
            asm volatile("s_waitcnt vmcnt(0)" ::: "memory");
        } else {
            XB_SPIN(xb_ld(&bar[XB_XGEN(b.x)]) == gen, bar);
            __builtin_amdgcn_fence(__ATOMIC_ACQUIRE, "agent");
            asm volatile("s_waitcnt vmcnt(0)" ::: "memory");
        }
    }
    __syncthreads();
}

struct Args { const float* in[39]; float* out; unsigned char* ws; int ph_lo, ph_hi; };

namespace pg8 {
constexpr int BM = 256, BK = 64, HALF = 128, HTB = HALF * BK * 2, STAGE_BYTES = 8 * HTB, NXCD = 8, WGM = 8;
__device__ __forceinline__ int lds_byte(int r, int c) { const int st = (r >> 4) * 2 + (c >> 5), rr = r & 15, cc = c & 31, ob = rr * 64 + cc * 2; return st * 1024 + (ob ^ (((ob >> 9) & 1) << 5)); }
__device__ __forceinline__ void stage_rc(int b, int& R, int& C) { const int st = b / 1024, sb = b % 1024, swz = sb ^ (((sb >> 9) & 1) << 5); R = (st >> 1) * 16 + swz / 64; C = (st & 1) * 32 + (swz % 64) / 2; }
__device__ __forceinline__ int perm32(int rho) { const int n = rho >> 4, i = rho & 15; return 8 * (i >> 2) + 4 * n + (i & 3); }
struct Unit { int pm, pn, e; };
__device__ __forceinline__ unsigned cvt_pk_bf16(float lo, float hi) { unsigned r; asm volatile("v_cvt_pk_bf16_f32 %0, %1, %2" : "=v"(r) : "v"(lo), "v"(hi)); return r; }

__device__ __forceinline__ void tile_of(long L, int nM, int nN, int& pm, int& pn) {
    const int nwg = nM * nN; int wgid = (int)L;
    { const int q = nwg / NXCD, r = nwg % NXCD, xcd = wgid % NXCD, off = wgid / NXCD; wgid = (xcd < r ? xcd * (q + 1) : r * (q + 1) + (xcd - r) * q) + off; }
    const int nig = WGM * nN, gid = wgid / nig, fm = gid * WGM, gsz = (nM - fm) < WGM ? (nM - fm) : WGM;
    pm = fm + ((wgid % nig) % gsz); pn = (wgid % nig) / gsz;
}

struct DenseSched {
    const bf16_t* A; const bf16_t* Bt; int K, nM, nN, G, c, xM0, xnM, xnN;
    __device__ __forceinline__ bool next(int i, Unit& u) const {
        const long L = (long)i * G + c; const int nwg = nM * nN;
        if (L < nwg) { tile_of(L, nM, nN, u.pm, u.pn); u.e = 0; return true; }
        const long r = L - nwg; if (r >= (long)xnM * xnN) return false;
        u.pm = xM0 + (int)(r % xnM); u.pn = (int)(r / xnM); u.e = 0; return true;
    }
    __device__ __forceinline__ const char* abase(const Unit& u) const { return (const char*)A + (size_t)u.pm * BM * K * 2; }
    __device__ __forceinline__ const char* bbase(const Unit& u) const { return (const char*)Bt + (size_t)u.pn * BM * K * 2; }
    __device__ __forceinline__ void rows(const Unit&, unsigned (&va)[2][2], const int (&R)[2], const int (&C)[2]) const {
#pragma unroll
        for (int h = 0; h < 2; ++h)
#pragma unroll
            for (int i = 0; i < 2; ++i) va[h][i] = (unsigned)((h * HALF + R[i]) * K + C[i]) * 2u;
    }
};
template <bool GATHER> struct MoeSched {
    const bf16_t* A; const bf16_t* Bt; int K, nN, G, c; size_t estride;
    const LAS int* tst; const LAS int* cnts; const int* rowlist;
    __device__ __forceinline__ bool next(int i, Unit& u) const {
        const int TM = tst[NE]; const long L = (long)i * G + c; if (L >= (long)TM * nN) return false;
        tile_of(L, TM, nN, u.pm, u.pn);
        int e = 0;
#pragma unroll 1
        for (int j = 1; j < NE; ++j) e += (tst[j] <= u.pm) ? 1 : 0;
        u.e = e; return true;
    }
    __device__ __forceinline__ const char* abase(const Unit& u) const { return GATHER ? (const char*)A : (const char*)A + (size_t)u.pm * BM * K * 2; }
    __device__ __forceinline__ const char* bbase(const Unit& u) const { return (const char*)Bt + ((size_t)u.e * estride + (size_t)u.pn * BM * K) * 2; }
    __device__ __forceinline__ void rows(const Unit& u, unsigned (&va)[2][2], const int (&R)[2], const int (&C)[2]) const {
        if (GATHER) {
            const int n = cnts[u.e], lt = u.pm - tst[u.e];
#pragma unroll
            for (int h = 0; h < 2; ++h)
#pragma unroll
                for (int i = 0; i < 2; ++i) { int slot = lt * BM + h * HALF + R[i]; slot = slot < n ? slot : 0; const int tok = rowlist[u.e * M + slot]; va[h][i] = (unsigned)(tok * K + C[i]) * 2u; }
        } else {
#pragma unroll
            for (int h = 0; h < 2; ++h)
#pragma unroll
                for (int i = 0; i < 2; ++i) va[h][i] = (unsigned)((h * HALF + R[i]) * K + C[i]) * 2u;
        }
    }
};

template <class Epi, class Sched>
__device__ __forceinline__ void gemm_phase(LAS unsigned char* lds, const int K, const Sched& S, const Epi& E) {
    const int tid = threadIdx.x, wid = __builtin_amdgcn_readfirstlane(tid >> 6), lane = tid & 63, wr = wid >> 2, wc = wid & 3, fr = lane & 15, fq = lane >> 4;
    const int nt = K / BK;
    unsigned voffB[2]; int Rr[2], Cc[2];
#pragma unroll
    for (int i = 0; i < 2; ++i) { int R, C; stage_rc(tid * 16 + i * 8192, R, C); Rr[i] = R; Cc[i] = C; const int Rb = Epi::PERM ? ((R & ~31) + perm32(R & 31)) : R; voffB[i] = (unsigned)(Rb * K + C) * 2u; }
    const size_t kstep = (size_t)(BK * 2);
    const size_t hstep = (size_t)HALF * K * 2;
    const unsigned ldsw = (unsigned)wid * 1024u;
    const int aoff = lds_byte(wr * 64 + fr, fq * 8), boff = lds_byte(wc * 32 + fr, fq * 8);
#define PG8_SA(b, h) (((b) * 2 + (h)) * HTB)
#define PG8_SB(b, h) ((4 + (b) * 2 + (h)) * HTB)
#define PG8_STAGE(bufoff, gbase, voff) do { _Pragma("unroll") for (int _i = 0; _i < 2; ++_i) \
        __builtin_amdgcn_global_load_lds((const unsigned*)((const char*)(gbase) + (voff)[_i]), (LAS unsigned*)(lds + (bufoff) + ldsw + _i * 8192), 16, 0, 0); } while (0)
#define PG8_LDA(dst, b, h) do { _Pragma("unroll") for (int m = 0; m < 4; ++m) _Pragma("unroll") for (int k = 0; k < 2; ++k) dst[m][k] = *(const LAS bf16x8*)(lds + PG8_SA(b, h) + aoff + m * 2048 + k * 1024); } while (0)
#define PG8_LDB(dst, b, h) do { _Pragma("unroll") for (int n = 0; n < 2; ++n) _Pragma("unroll") for (int k = 0; k < 2; ++k) dst[n][k] = *(const LAS bf16x8*)(lds + PG8_SB(b, h) + boff + n * 2048 + k * 1024); } while (0)
#define PG8_MMA(ai, bj, At, Bt) do { __builtin_amdgcn_s_setprio(1); _Pragma("unroll") for (int m = 0; m < 4; ++m) _Pragma("unroll") for (int n = 0; n < 2; ++n) _Pragma("unroll") for (int k = 0; k < 2; ++k) \
        acc[ai][bj][m][n] = __builtin_amdgcn_mfma_f32_16x16x32_bf16(Bt[n][k], At[m][k], acc[ai][bj][m][n], 0, 0, 0); __builtin_amdgcn_s_setprio(0); } while (0)
#define PG8_WAIT_V(n) asm volatile("s_waitcnt vmcnt(" #n ")" ::: "memory")
#define PG8_WAIT_L(n) asm volatile("s_waitcnt lgkmcnt(" #n ")" ::: "memory")
#define PG8_BAR __builtin_amdgcn_s_barrier()
#define PG8_SCHED __builtin_amdgcn_sched_barrier(0)
    Unit cur, nxt; int ui = 0;
    if (!S.next(0, cur)) return;
    f32x4 acc[2][2][4][2];
#pragma unroll
    for (int a = 0; a < 2; ++a)
#pragma unroll
        for (int b = 0; b < 2; ++b)
#pragma unroll
            for (int m = 0; m < 4; ++m)
#pragma unroll
                for (int n = 0; n < 2; ++n) acc[a][b][m][n] = (f32x4){0.f, 0.f, 0.f, 0.f};
    bf16x8 At[4][2], B0[2][2], B1[2][2];
    unsigned vaC[2][2], vaN[2][2];
    S.rows(cur, vaC, Rr, Cc);
    const char* cA = S.abase(cur); const char* cB = S.bbase(cur);
    PG8_STAGE(PG8_SB(0, 0), cB, voffB); PG8_STAGE(PG8_SA(0, 0), cA, vaC[0]); PG8_STAGE(PG8_SB(0, 1), cB + hstep, voffB); PG8_STAGE(PG8_SA(0, 1), cA, vaC[1]);
    if (wr == 1) PG8_BAR;
    PG8_WAIT_V(4); PG8_BAR;
    PG8_STAGE(PG8_SB(1, 0), cB + kstep, voffB); PG8_STAGE(PG8_SA(1, 0), cA + kstep, vaC[0]); PG8_STAGE(PG8_SB(1, 1), cB + hstep + kstep, voffB);
    PG8_WAIT_V(6); PG8_BAR;
    for (;;) {
        const bool has_next = S.next(ui + 1, nxt);
        const char* nA = has_next ? S.abase(nxt) : cA; const char* nB = has_next ? S.bbase(nxt) : cB;
#pragma unroll
        for (int h = 0; h < 2; ++h)
#pragma unroll
            for (int i = 0; i < 2; ++i) vaN[h][i] = vaC[h][i];
        for (int t = 0; t < nt; t += 2) {
            const bool last = (t == nt - 2);
            const char* a1 = cA + (size_t)(t + 1) * kstep;
            const char* a2 = last ? nA : cA + (size_t)(t + 2) * kstep; const char* b2 = last ? nB : cB + (size_t)(t + 2) * kstep;
            const char* a3 = a2 + kstep; const char* b3 = b2 + kstep;
            if (last && has_next) S.rows(nxt, vaN, Rr, Cc);
            unsigned v2[2][2];
#pragma unroll
            for (int h = 0; h < 2; ++h)
#pragma unroll
                for (int i = 0; i < 2; ++i) v2[h][i] = last ? vaN[h][i] : vaC[h][i];
            PG8_LDB(B0, 0, 0); PG8_SCHED; PG8_LDA(At, 0, 0); PG8_STAGE(PG8_SA(1, 1), a1, vaC[1]);
            PG8_WAIT_L(8); PG8_BAR; PG8_WAIT_L(0); PG8_MMA(0, 0, At, B0); PG8_BAR; PG8_SCHED;
            PG8_LDB(B1, 0, 1); PG8_STAGE(PG8_SB(0, 0), b2, voffB);
            PG8_BAR; PG8_WAIT_L(0); PG8_MMA(0, 1, At, B1); PG8_BAR;
            PG8_LDA(At, 0, 1); PG8_STAGE(PG8_SA(0, 0), a2, v2[0]);
            PG8_BAR; PG8_WAIT_L(0); PG8_MMA(1, 0, At, B0); PG8_BAR; PG8_SCHED;
            PG8_STAGE(PG8_SB(0, 1), b2 + hstep, voffB);
            PG8_WAIT_V(6); PG8_BAR; PG8_MMA(1, 1, At, B1); PG8_BAR;
            PG8_LDB(B0, 1, 0); PG8_SCHED; PG8_LDA(At, 1, 0); PG8_STAGE(PG8_SA(0, 1), a2, v2[1]);
            PG8_WAIT_L(8); PG8_BAR; PG8_WAIT_L(0); PG8_MMA(0, 0, At, B0); PG8_BAR; PG8_SCHED;
            PG8_LDB(B1, 1, 1); PG8_STAGE(PG8_SB(1, 0), b3, voffB);
            PG8_BAR; PG8_WAIT_L(0); PG8_MMA(0, 1, At, B1); PG8_BAR;
            PG8_LDA(At, 1, 1); PG8_STAGE(PG8_SA(1, 0), a3, v2[0]);
            PG8_BAR; PG8_WAIT_L(0); PG8_MMA(1, 0, At, B0); PG8_BAR; PG8_SCHED;
            PG8_STAGE(PG8_SB(1, 1), b3 + hstep, voffB);
            PG8_WAIT_V(6); PG8_BAR; PG8_MMA(1, 1, At, B1); PG8_BAR;
        }
        E(acc, cur, wr, wc, fr, fq);
        if (!has_next) break;
#pragma unroll
        for (int a = 0; a < 2; ++a)
#pragma unroll
            for (int b = 0; b < 2; ++b)
#pragma unroll
                for (int m = 0; m < 4; ++m)
#pragma unroll
                    for (int n = 0; n < 2; ++n) acc[a][b][m][n] = (f32x4){0.f, 0.f, 0.f, 0.f};
        cur = nxt; cA = nA; cB = nB; ++ui;
#pragma unroll
        for (int h = 0; h < 2; ++h)
#pragma unroll
            for (int i = 0; i < 2; ++i) vaC[h][i] = vaN[h][i];
    }
    PG8_WAIT_V(0);
    if (wr == 0) PG8_BAR;
    PG8_BAR;
#undef PG8_SA
#undef PG8_SB
#undef PG8_STAGE
#undef PG8_LDA
#undef PG8_LDB
#undef PG8_MMA
#undef PG8_WAIT_V
#undef PG8_WAIT_L
#undef PG8_BAR
#undef PG8_SCHED
}

struct EpiStoreBf16 {
    static constexpr bool PERM = true;
    bf16_t* O; int ldc; const float* bias; int bias_estride;
    __device__ __forceinline__ void operator()(const f32x4 (&acc)[2][2][4][2], const Unit& u, int wr, int wc, int fr, int fq) const {
        const int row0 = u.pm * BM + wr * 64 + fr, col0 = u.pn * BM + wc * 32 + 8 * fq;
        f32x4 bv[2][2];
#pragma unroll
        for (int bj = 0; bj < 2; ++bj)
#pragma unroll
            for (int n = 0; n < 2; ++n) bv[bj][n] = bias ? *(const f32x4*)(bias + (size_t)u.e * bias_estride + col0 + bj * HALF + 4 * n) : (f32x4){0.f, 0.f, 0.f, 0.f};
#pragma unroll
        for (int ai = 0; ai < 2; ++ai)
#pragma unroll
            for (int m = 0; m < 4; ++m) { bf16_t* rowp = O + (size_t)(row0 + ai * HALF + m * 16) * ldc + col0;
#pragma unroll
                for (int bj = 0; bj < 2; ++bj) { const f32x4 v0 = acc[ai][bj][m][0] + bv[bj][0], v1 = acc[ai][bj][m][1] + bv[bj][1];
                    u32x4 w; w.x = cvt_pk_bf16(v0[0], v0[1]); w.y = cvt_pk_bf16(v0[2], v0[3]); w.z = cvt_pk_bf16(v1[0], v1[1]); w.w = cvt_pk_bf16(v1[2], v1[3]);
                    *(u32x4*)(rowp + bj * HALF) = w; } }
    }
};
struct EpiGlu {
    static constexpr bool PERM = true;
    const bf16_t* Yg; bf16_t* O; const float* bias;
    __device__ __forceinline__ void operator()(const f32x4 (&acc)[2][2][4][2], const Unit& u, int wr, int wc, int fr, int fq) const {
        const int row0 = u.pm * BM + wr * 64 + fr, col0 = u.pn * BM + wc * 32 + 8 * fq;
        f32x4 bv[2][2];
#pragma unroll
        for (int bj = 0; bj < 2; ++bj)
#pragma unroll
            for (int n = 0; n < 2; ++n) bv[bj][n] = *(const f32x4*)(bias + col0 + bj * HALF + 4 * n);
#pragma unroll
        for (int ai = 0; ai < 2; ++ai)
#pragma unroll
            for (int m = 0; m < 4; ++m) { const size_t r = (size_t)(row0 + ai * HALF + m * 16);
#pragma unroll
                for (int bj = 0; bj < 2; ++bj) { const f32x4 v0 = acc[ai][bj][m][0] + bv[bj][0], v1 = acc[ai][bj][m][1] + bv[bj][1];
                    const u32x4 y = *(const u32x4*)(Yg + r * S5W + col0 + bj * HALF);
                    float o[8];
                    o[0] = bflo(y.x) / (1.f + __expf(-v0[0])); o[1] = bfhi(y.x) / (1.f + __expf(-v0[1])); o[2] = bflo(y.y) / (1.f + __expf(-v0[2])); o[3] = bfhi(y.y) / (1.f + __expf(-v0[3]));
                    o[4] = bflo(y.z) / (1.f + __expf(-v1[0])); o[5] = bfhi(y.z) / (1.f + __expf(-v1[1])); o[6] = bflo(y.w) / (1.f + __expf(-v1[2])); o[7] = bfhi(y.w) / (1.f + __expf(-v1[3]));
                    u32x4 w; w.x = cvt_pk_bf16(o[0], o[1]); w.y = cvt_pk_bf16(o[2], o[3]); w.z = cvt_pk_bf16(o[4], o[5]); w.w = cvt_pk_bf16(o[6], o[7]);
                    *(u32x4*)(O + r * D + col0 + bj * HALF) = w; } }
    }
};
struct EpiResid {
    static constexpr bool PERM = false;
    const float* X; float* O; const float* mod; const float* bada;
    __device__ __forceinline__ void operator()(const f32x4 (&acc)[2][2][4][2], const Unit& u, int wr, int wc, int fr, int fq) const {
        const int row0 = u.pm * BM + wr * 64 + fr, col0 = u.pn * BM + wc * 32 + 4 * fq, b = u.pm >> 3;
        f32x4 gv[2][2];
#pragma unroll
        for (int bj = 0; bj < 2; ++bj)
#pragma unroll
            for (int n = 0; n < 2; ++n) { const int c = col0 + bj * HALF + n * 16; gv[bj][n] = *(const f32x4*)(mod + (size_t)b * 12288 + 2 * D + c) + *(const f32x4*)(bada + 2 * D + c); }
#pragma unroll
        for (int ai = 0; ai < 2; ++ai)
#pragma unroll
            for (int m = 0; m < 4; ++m) { const size_t off = (size_t)(row0 + ai * HALF + m * 16) * D + col0;
#pragma unroll
                for (int bj = 0; bj < 2; ++bj)
#pragma unroll
                    for (int n = 0; n < 2; ++n) { const f32x4 xv = *(const f32x4*)(X + off + bj * HALF + n * 16); *(f32x4*)(O + off + bj * HALF + n * 16) = xv + gv[bj][n] * acc[ai][bj][m][n]; } }
    }
};
struct EpiSwiglu {
    static constexpr bool PERM = true;
    bf16_t* O; const float* bias;
    __device__ __forceinline__ void operator()(const f32x4 (&acc)[2][2][4][2], const Unit& u, int wr, int wc, int fr, int fq) const {
        const int row0 = u.pm * BM + wr * 64 + fr, j0 = wc * 32 + 8 * fq, cb = u.pn * HALF + j0;
        f32x4 bg[2], bu[2];
#pragma unroll
        for (int n = 0; n < 2; ++n) { bg[n] = *(const f32x4*)(bias + (size_t)u.e * 4096 + cb + 4 * n); bu[n] = *(const f32x4*)(bias + (size_t)u.e * 4096 + 2048 + cb + 4 * n); }
#pragma unroll
        for (int ai = 0; ai < 2; ++ai)
#pragma unroll
            for (int m = 0; m < 4; ++m) { float o[8];
#pragma unroll
                for (int n = 0; n < 2; ++n)
#pragma unroll
                    for (int e = 0; e < 4; ++e) { float g = acc[ai][0][m][n][e] + bg[n][e], uu = acc[ai][1][m][n][e] + bu[n][e];
                        g = fminf(g, 7.0f); uu = fminf(fmaxf(uu, -7.0f), 7.0f);
                        o[4 * n + e] = (uu + 1.0f) * (g / (1.0f + __expf(-1.702f * g))); }
                u32x4 w; w.x = cvt_pk_bf16(o[0], o[1]); w.y = cvt_pk_bf16(o[2], o[3]); w.z = cvt_pk_bf16(o[4], o[5]); w.w = cvt_pk_bf16(o[6], o[7]);
                *(u32x4*)(O + (size_t)(row0 + ai * HALF + m * 16) * DFF + cb) = w; }
    }
};
}

#define FI __device__ __forceinline__

FI void transpose_item(const float* W, int K, int N, bf16_t* WT, int row_off, LAS float* scr, int kb, int nb, int lane) {
    const int k0 = 64 * kb, n0 = 32 * nb;
#pragma unroll 8
    for (int i = 0; i < 32; ++i) { const int kk = 2 * i + (lane >> 5); scr[kk * 33 + (lane & 31)] = W[(size_t)(k0 + kk) * N + n0 + (lane & 31)]; }
    LDS_WAIT(); asm volatile("" ::: "memory");
    const int c = lane & 7;
#pragma unroll
    for (int j = 0; j < 4; ++j) { const int n = (lane >> 3) + 8 * j; const LAS float* s = scr + (8 * c) * 33 + n;
        u32x4 o; o.x = pk2(s[0 * 33], s[1 * 33]); o.y = pk2(s[2 * 33], s[3 * 33]); o.z = pk2(s[4 * 33], s[5 * 33]); o.w = pk2(s[6 * 33], s[7 * 33]);
        *(u32x4*)(WT + (size_t)(row_off + n0 + n) * K + k0 + 8 * c) = o; }
    LDS_WAIT(); asm volatile("" ::: "memory");
}

FI void p0_run(const Args& A, LAS unsigned char* lds, int tid, int lane, int wave, int vcu, int G) {
    unsigned char* ws = A.ws;
    float* ctlf = (float*)(ws + WS_CTL);
    float* mod = ctlf + CW_MOD; float* hnorm = ctlf + CW_HNORM;
    {
        LAS float* sl = (LAS float*)lds;
        const float* c = A.in[1]; const float* cc = A.in[3];
        for (int i = tid; i < 9 * D; i += NTHR) { const float v = i < 8 * D ? c[i] : cc[i - 8 * D]; sl[i] = v / (1.f + __expf(-v)); }
        __syncthreads();
        const float* wada = A.in[4];
        for (int it = vcu * NWAVES + wave; it < 1536; it += G * NWAVES) {
            const int cg = it % 48, kc = it / 48, n0 = cg * 256 + 4 * lane, k0 = kc * 64;
            f32x4 acc[9];
#pragma unroll
            for (int r = 0; r < 9; ++r) acc[r] = (f32x4){0.f, 0.f, 0.f, 0.f};
#pragma unroll 8
            for (int kk = 0; kk < 64; ++kk) { const f32x4 w = *(const f32x4*)(wada + (size_t)(k0 + kk) * 12288 + n0);
#pragma unroll
                for (int r = 0; r < 9; ++r) { const float s = sl[r * D + k0 + kk]; acc[r] += w * s; } }
#pragma unroll
            for (int r = 0; r < 9; ++r)
#pragma unroll
                for (int e = 0; e < 4; ++e) unsafeAtomicAdd(mod + r * 12288 + n0 + e, acc[r][e]);
        }
        __syncthreads();
    }
    {
        LAS float* L = (LAS float*)lds;
        LAS float *w1s = L, *w2s = L + 2112, *w3s = L + 6208, *b1s = L + 10304, *b2s = L + 10368, *b3s = L + 10432, *fqs = L + 10496, *zs = L + 10560, *h1 = L + 10824, *h2 = L + 11336, *h3 = L + 11848;
        for (int i = tid; i < 33 * 64; i += NTHR) w1s[i] = A.in[21][i];
        for (int i = tid; i < 4096; i += NTHR) { w2s[i] = A.in[23][i]; w3s[i] = A.in[25][i]; }
        if (tid < 64) { b1s[tid] = A.in[22][tid]; b2s[tid] = A.in[24][tid]; b3s[tid] = A.in[26][tid]; fqs[tid] = A.in[28][tid]; }
        __syncthreads();
        const float* w4 = A.in[27]; const float* dl = A.in[29]; float* hraw = (float*)(ws + WS_HRAW);
        for (int item = vcu; item < 256; item += G) {
            const int l0 = item * 8;
            if (tid < 264) { const int r = tid / 33, i = tid % 33, l = l0 + r; float z;
                if (i == 0) z = (float)l / 2047.0f;
                else { const int j = (i - 1) & 15; const float band = 1e-4f + (float)j * ((15.0f - 1e-4f) / 15.0f); const float ang = (6.283185307179586f / 2048.0f) * (float)l * band; z = (i <= 16) ? cosf(ang) : -sinf(ang); }
                zs[tid] = z; }
            __syncthreads();
            const int r = tid >> 6, o = tid & 63;
            { float s = b1s[o]; for (int i = 0; i < 33; ++i) s += zs[r * 33 + i] * w1s[i * 64 + o]; h1[r * 64 + o] = sinf(fqs[o] * s); }
            __syncthreads();
            { float s = b2s[o]; for (int i = 0; i < 64; ++i) s += h1[r * 64 + i] * w2s[i * 64 + o]; h2[r * 64 + o] = sinf(fqs[o] * s); }
            __syncthreads();
            { float s = b3s[o]; for (int i = 0; i < 64; ++i) s += h2[r * 64 + i] * w3s[i * 64 + o]; h3[r * 64 + o] = sinf(fqs[o] * s); }
            __syncthreads();
            f32x4 acc[8];
#pragma unroll
            for (int q = 0; q < 8; ++q) acc[q] = (f32x4){0.f, 0.f, 0.f, 0.f};
#pragma unroll 4
            for (int i = 0; i < 64; ++i) { const f32x4 w = *(const f32x4*)(w4 + (size_t)i * 2048 + 4 * tid);
#pragma unroll
                for (int q = 0; q < 8; ++q) acc[q] += w * h3[q * 64 + i]; }
            const f32x4 dv = *(const f32x4*)(dl + 4 * tid);
            f32x4 asum = (f32x4){0.f, 0.f, 0.f, 0.f};
#pragma unroll
            for (int q = 0; q < 8; ++q) { const int l = l0 + q; const float t = (float)l / 2047.0f; f32x4 v;
#pragma unroll
                for (int e = 0; e < 4; ++e) v[e] = acc[q][e] * expf(-t * fabsf(dv[e]));
                *(f32x4*)(hraw + (size_t)l * 2048 + 4 * tid) = v;
                if (!(l == 2047 && 4 * tid >= 1024)) {
#pragma unroll
                    for (int e = 0; e < 4; ++e) asum[e] += fabsf(v[e]); } }
#pragma unroll
            for (int e = 0; e < 4; ++e) unsafeAtomicAdd(hnorm + 4 * tid + e, asum[e]);
            __syncthreads();
        }
    }
    {
        const float *lre = A.in[9], *lim = A.in[10], *lst = A.in[11], *bre = A.in[12], *bim = A.in[13], *cre = A.in[14], *cim = A.in[15];
        float* LAM = (float*)(ws + WS_LAM); float* LAML = (float*)(ws + WS_LAML); bf16_t* SB = (bf16_t*)(ws + WS_S5B); bf16_t* SC = (bf16_t*)(ws + WS_S5C);
        for (int idx = vcu * NTHR + tid; idx < 2 * 64 * 4 * 64; idx += G * NTHR) {
            const int ln = idx & 63, T = (idx >> 6) & 3, g = (idx >> 8) & 63, d = idx >> 14;
            {
                const int n = ln & 31, hq = ln >> 5, p = n + 32 * (T >> 1), part = T & 1;
                const int q = (d * 64 + g) * 64 + p;
                const float lr = fminf(lre[q], -1e-4f), li = lim[q], dt = expf(lst[q]), zr = lr * dt, zi = li * dt, er = expf(zr), br = er * cosf(zi), bi = er * sinf(zi);
                const float den = lr * lr + li * li, cr = ((br - 1.f) * lr + bi * li) / den, ci = (bi * lr - (br - 1.f) * li) / den;
                float v[8];
#pragma unroll
                for (int j = 0; j < 8; ++j) { const int h = 8 * hq + j; const float xr = bre[(size_t)q * 16 + h], xi = bim[(size_t)q * 16 + h]; v[j] = part ? (cr * xi + ci * xr) : (cr * xr - ci * xi); }
                u32x4 w; w.x = pk2(v[0], v[1]); w.y = pk2(v[2], v[3]); w.z = pk2(v[4], v[5]); w.w = pk2(v[6], v[7]);
                *(u32x4*)(SB + (size_t)idx * 8) = w;
                if (part == 0 && hq == 0) { LAM[q * 2] = br; LAM[q * 2 + 1] = bi; const float eL = expf((float)SEG * zr), aL = (float)SEG * zi; LAML[q * 2] = eL * cosf(aL); LAML[q * 2 + 1] = eL * sinf(aL); }
            }
            {
                const int hc = ln & 15, qq = ln >> 4; float v[8];
#pragma unroll
                for (int j = 0; j < 8; ++j) { const int k = 32 * T + 8 * qq + j, n = k >> 2, TT = k & 3, p = n + 32 * (TT >> 1), part = TT & 1; const size_t ci = ((size_t)(d * 64 + g) * 16 + hc) * 64 + p; v[j] = part ? -cim[ci] : cre[ci]; }
                u32x4 w; w.x = pk2(v[0], v[1]); w.y = pk2(v[2], v[3]); w.z = pk2(v[4], v[5]); w.w = pk2(v[6], v[7]);
                *(u32x4*)(SC + (size_t)idx * 8) = w;
            }
        }
    }
    {
        __syncthreads();
        LAS float* scr = (LAS float*)(lds + wave * 16384);
        const int gw = vcu * NWAVES + wave, NGW = G * NWAVES;
        constexpr int I_IN = 32 * 128, I_GLU = 16 * 32, I_OUT = 32 * 64, I_GU = 32 * 32 * 128, I_DN = 32 * 32 * 64;
        constexpr int NITEMS = I_IN + I_GLU + I_OUT + I_GU + I_DN;
        for (int it = gw; it < NITEMS; it += NGW) {
            int r = it;
            if (r < I_IN) { transpose_item(A.in[8], D, DIN, (bf16_t*)(ws + WS_WIN), 0, scr, r / 128, r % 128, lane); continue; } r -= I_IN;
            if (r < I_GLU) { transpose_item(A.in[17], S5W, S5W, (bf16_t*)(ws + WS_WGLU), 0, scr, r / 32, r % 32, lane); continue; } r -= I_GLU;
            if (r < I_OUT) { transpose_item(A.in[31], D, D, (bf16_t*)(ws + WS_WOUT), 0, scr, r / 64, r % 64, lane); continue; } r -= I_OUT;
            if (r < I_GU) { const int e = r / 4096, q = r % 4096, kb = q / 128, nb = q % 128, n0 = 32 * nb;
                const int isU = n0 / 2048, pn = (n0 % 2048) / 128, j = n0 % 128, rowmap = 256 * pn + 128 * isU + j;
                transpose_item(A.in[34] + (size_t)e * D * 4096, D, 4096, (bf16_t*)(ws + WS_WGU) + (size_t)e * 4096 * D, rowmap - n0, scr, kb, nb, lane); continue; } r -= I_GU;
            { const int e = r / 2048, q = r % 2048; transpose_item(A.in[36] + (size_t)e * DFF * D, DFF, D, (bf16_t*)(ws + WS_WDN) + (size_t)e * D * DFF, 0, scr, q / 64, q % 64, lane); }
        }
    }
}

FI void p1_run(const Args& A, int tid, int lane, int wave, int vcu, int G) {
    unsigned char* ws = A.ws;
    const float* mod = (const float*)(ws + WS_CTL) + CW_MOD; const float* hnorm = (const float*)(ws + WS_CTL) + CW_HNORM;
    const float* bada = A.in[5]; const float* g1 = A.in[6];
    bf16_t* A1 = (bf16_t*)(ws + WS_A1);
    const int gw = vcu * NWAVES + wave, NGW = G * NWAVES;
    for (int m = gw; m < MT; m += NGW) {
        const float* src = m < M ? A.in[0] + (size_t)m * D : A.in[2] + (size_t)(m - M) * D;
        const int mr = m < M ? m / SEQ : 8;
        f32x4 v[8]; float ss = 0.f;
#pragma unroll
        for (int j = 0; j < 8; ++j) { v[j] = *(const f32x4*)(src + 4 * lane + 256 * j); ss += (v[j].x * v[j].x + v[j].y * v[j].y) + (v[j].z * v[j].z + v[j].w * v[j].w); }
        const float rstd = rsqrtf(wave_sum(ss) * (1.0f / D) + 1e-6f);
#pragma unroll
        for (int j = 0; j < 8; ++j) { const int c = 4 * lane + 256 * j;
            const f32x4 gv = *(const f32x4*)(g1 + c);
            const f32x4 sh = *(const f32x4*)(mod + (size_t)mr * 12288 + c) + *(const f32x4*)(bada + c);
            const f32x4 sc = *(const f32x4*)(mod + (size_t)mr * 12288 + D + c) + *(const f32x4*)(bada + D + c);
            const f32x4 h = v[j] * rstd * gv * (sc + 1.0f) + sh;
            u32x2 w; w.x = pk2(h.x, h.y); w.y = pk2(h.z, h.w);
            *(u32x2*)(A1 + (size_t)m * D + c) = w; }
    }
    const float* hraw = (const float*)(ws + WS_HRAW); bf16_t* Rg = (bf16_t*)(ws + WS_RG);
    for (int it = gw; it < 512 * 16; it += NGW) {
        const int ib = it >> 4, c = (it & 15) * 64 + lane;
        const float inv = 1.0f / (hnorm[c] + hnorm[HYW + c]);
        float v[8];
#pragma unroll
        for (int jj = 0; jj < 8; ++jj) { const int i = 8 * ib + jj; float x;
            if (i <= 2047) x = hraw[(size_t)(2047 - i) * 2048 + c]; else if (i <= 4094) x = hraw[(size_t)(i - 2048) * 2048 + HYW + c]; else x = 0.f;
            v[jj] = x * inv; }
        u32x4 w; w.x = pk2(v[0], v[1]); w.y = pk2(v[2], v[3]); w.z = pk2(v[4], v[5]); w.w = pk2(v[6], v[7]);
        *(u32x4*)(Rg + (size_t)c * 4096 + 8 * ib) = w;
    }
}

FI void s5_unit(const Args& A, LAS unsigned char* lds, int unit, int lane, int wave) {
    unsigned char* ws = A.ws;
    const int d = unit & 1, g = (unit >> 1) & 63, bp = unit >> 7, dg = d * 64 + g;
    const bf16_t* P = (const bf16_t*)(ws + WS_P); bf16_t* Ys = (bf16_t*)(ws + WS_YS5);
    bf16x8 Bf[4], Cf[4];
#pragma unroll
    for (int T = 0; T < 4; ++T) { Bf[T] = *(const bf16x8*)((const bf16_t*)(ws + WS_S5B) + ((size_t)(dg * 4 + T) * 64 + lane) * 8); Cf[T] = *(const bf16x8*)((const bf16_t*)(ws + WS_S5C) + ((size_t)(dg * 4 + T) * 64 + lane) * 8); }
    const int n = lane & 31, hh = lane >> 5;
    const float* LAM = (const float*)(ws + WS_LAM) + (size_t)dg * 128; const float* LAML = (const float*)(ws + WS_LAML) + (size_t)dg * 128;
    const float lr0 = LAM[n * 2], li0 = LAM[n * 2 + 1], lr1 = LAM[(n + 32) * 2], li1 = LAM[(n + 32) * 2 + 1];
    const int r = lane & 31, bsel = (r >> 2) & 1, tau = (r & 3) + 4 * (r >> 3), b = 2 * bp + bsel, kofs = g * 16 + 8 * (lane >> 5);
    const int seg0 = wave * SEG;
    auto rowp = [&](int pos) -> const bf16_t* {
        int row; if (pos < CTXL) { const int tc = d ? (CTXL - 1 - pos) : pos; row = M + b * CTXL + tc; } else { const int q = pos - CTXL; const int tl = d ? (SEQ - 1 - q) : q; row = b * SEQ + tl; }
        return P + (size_t)row * DIN + kofs; };
    const f32x16 z16 = {0.f, 0.f, 0.f, 0.f, 0.f, 0.f, 0.f, 0.f, 0.f, 0.f, 0.f, 0.f, 0.f, 0.f, 0.f, 0.f};
    float xr0 = 0.f, xi0 = 0.f, xr1 = 0.f, xi1 = 0.f;
    {
        bf16x8 aC = *(const bf16x8*)rowp(seg0 + tau), aN = aC;
#pragma unroll 1
        for (int st = 0; st < SEG / 16; ++st) {
            if (st + 1 < SEG / 16) aN = *(const bf16x8*)rowp(seg0 + 16 * (st + 1) + tau);
            const f32x16 c0 = __builtin_amdgcn_mfma_f32_32x32x16_bf16(aC, Bf[0], z16, 0, 0, 0), c1 = __builtin_amdgcn_mfma_f32_32x32x16_bf16(aC, Bf[1], z16, 0, 0, 0);
            const f32x16 c2 = __builtin_amdgcn_mfma_f32_32x32x16_bf16(aC, Bf[2], z16, 0, 0, 0), c3 = __builtin_amdgcn_mfma_f32_32x32x16_bf16(aC, Bf[3], z16, 0, 0, 0);
#pragma unroll
            for (int tt = 0; tt < 16; ++tt) {
                const float nr0 = lr0 * xr0 - li0 * xi0 + c0[tt], ni0 = lr0 * xi0 + li0 * xr0 + c1[tt]; xr0 = nr0; xi0 = ni0;
                const float nr1 = lr1 * xr1 - li1 * xi1 + c2[tt], ni1 = lr1 * xi1 + li1 * xr1 + c3[tt]; xr1 = nr1; xi1 = ni1; }
            aC = aN;
        }
    }
    LAS float* Es = (LAS float*)(lds + 8 * 8704);
    *(LAS f32x4*)(Es + (wave * 64 + lane) * 4) = (f32x4){xr0, xi0, xr1, xi1};
    __syncthreads();
    {
        const float Lr0 = LAML[n * 2], Li0 = LAML[n * 2 + 1], Lr1 = LAML[(n + 32) * 2], Li1 = LAML[(n + 32) * 2 + 1];
        xr0 = 0.f; xi0 = 0.f; xr1 = 0.f; xi1 = 0.f;
#pragma unroll 1
        for (int w = 0; w < wave; ++w) { const f32x4 e = *(LAS f32x4*)(Es + (w * 64 + lane) * 4);
            const float nr0 = Lr0 * xr0 - Li0 * xi0 + e.x, ni0 = Lr0 * xi0 + Li0 * xr0 + e.y; xr0 = nr0; xi0 = ni0;
            const float nr1 = Lr1 * xr1 - Li1 * xi1 + e.z, ni1 = Lr1 * xi1 + Li1 * xr1 + e.w; xr1 = nr1; xi1 = ni1; }
    }
    {
        LAS unsigned char* Xs = lds + wave * 8704;
        bf16x8 aC = *(const bf16x8*)rowp(seg0 + tau), aN = aC;
#pragma unroll 1
        for (int st = 0; st < SEG / 16; ++st) {
            const int pos0 = seg0 + 16 * st;
            if (st + 1 < SEG / 16) aN = *(const bf16x8*)rowp(pos0 + 16 + tau);
            f32x16 c0 = __builtin_amdgcn_mfma_f32_32x32x16_bf16(aC, Bf[0], z16, 0, 0, 0), c1 = __builtin_amdgcn_mfma_f32_32x32x16_bf16(aC, Bf[1], z16, 0, 0, 0);
            f32x16 c2 = __builtin_amdgcn_mfma_f32_32x32x16_bf16(aC, Bf[2], z16, 0, 0, 0), c3 = __builtin_amdgcn_mfma_f32_32x32x16_bf16(aC, Bf[3], z16, 0, 0, 0);
#pragma unroll
            for (int tt = 0; tt < 16; ++tt) {
                const float nr0 = lr0 * xr0 - li0 * xi0 + c0[tt], ni0 = lr0 * xi0 + li0 * xr0 + c1[tt]; xr0 = nr0; xi0 = ni0; c0[tt] = nr0; c1[tt] = ni0;
                const float nr1 = lr1 * xr1 - li1 * xi1 + c2[tt], ni1 = lr1 * xi1 + li1 * xr1 + c3[tt]; xr1 = nr1; xi1 = ni1; c2[tt] = nr1; c3[tt] = ni1; }
            if (pos0 >= CTXL) {
#pragma unroll
                for (int tt = 0; tt < 16; ++tt) { u32x2 w; w.x = pk2(c0[tt], c1[tt]); w.y = pk2(c2[tt], c3[tt]); *(LAS u32x2*)(Xs + (hh * 16 + tt) * 272 + 8 * n) = w; }
                LDS_WAIT();
#pragma unroll
                for (int bt = 0; bt < 2; ++bt) {
                    f32x4 y = (f32x4){0.f, 0.f, 0.f, 0.f};
#pragma unroll
                    for (int ks = 0; ks < 4; ++ks) { const bf16x8 xf = *(const LAS bf16x8*)(Xs + (bt * 16 + (lane & 15)) * 272 + (32 * ks + 8 * (lane >> 4)) * 2); y = __builtin_amdgcn_mfma_f32_16x16x32_bf16(Cf[ks], xf, y, 0, 0, 0); }
                    const int q = pos0 + (lane & 15) - CTXL, tl = d ? (SEQ - 1 - q) : q, bb = 2 * bp + bt;
                    u32x2 w; w.x = pk2(y[0], y[1]); w.y = pk2(y[2], y[3]);
                    *(u32x2*)(Ys + ((size_t)(d * M + bb * SEQ + tl)) * S5W + g * 16 + 4 * (lane >> 4)) = w;
                }
                LDS_WAIT();
            }
            aC = aN;
        }
    }
    __syncthreads();
}

FI void h1_item(const Args& A, LAS unsigned char* lds, int item, int tid) {
    unsigned char* ws = A.ws;
    const bf16_t* P = (const bf16_t*)(ws + WS_P); bf16_t* Vt = (bf16_t*)(ws + WS_VT);
    const int gr = item >> 3, cg = item & 7, b = gr >> 5, t0 = (gr & 31) * 64, c0 = cg * 128;
    for (int idx = tid; idx < 2 * 64 * 16; idx += NTHR) { const int ch = idx >> 10, rem = idx & 1023, row = rem >> 4, sg = rem & 15;
        const u32x4 v = *(const u32x4*)(P + (size_t)(b * SEQ + t0 + row) * DIN + S5W + ch * HYW + c0 + sg * 8);
        *(LAS u32x4*)(lds + ch * 16896 + (row + 1) * 256 + sg * 16) = v; }
    if (tid < 64) { const int ch = tid >> 5, rr = (tid >> 4) & 1, sg = tid & 15; *(LAS u32x4*)(lds + ch * 16896 + (rr ? 65 : 0) * 256 + sg * 16) = (u32x4){0u, 0u, 0u, 0u}; }
    __syncthreads();
    const int c = tid & 127, tq = tid >> 7, cc = c0 + c;
    const float* cw = A.in[19]; const float* cb = A.in[20];
    const float w0v = cw[cc], w1v = cw[3072 + cc], w2v = cw[6144 + cc], bv = cb[cc];
    const float w0x = cw[HYW + cc], w1x = cw[3072 + HYW + cc], w2x = cw[6144 + HYW + cc], bx = cb[HYW + cc];
    const LAS bf16_t* Vs = (const LAS bf16_t*)lds; const LAS bf16_t* Xs = (const LAS bf16_t*)(lds + 16896);
    float o[16];
#pragma unroll
    for (int i = 0; i < 16; ++i) { const int t = tq * 16 + i;
        const float v = w0v * bf1(Vs[t * 128 + c]) + w1v * bf1(Vs[(t + 1) * 128 + c]) + w2v * bf1(Vs[(t + 2) * 128 + c]) + bv;
        const float x = w0x * bf1(Xs[t * 128 + c]) + w1x * bf1(Xs[(t + 1) * 128 + c]) + w2x * bf1(Xs[(t + 2) * 128 + c]) + bx;
        o[i] = v * x; }
    bf16_t* dst = Vt + ((size_t)(cc * NB + b) * SEQ + t0 + tq * 16);
    u32x4 w0; w0.x = pk2(o[0], o[1]); w0.y = pk2(o[2], o[3]); w0.z = pk2(o[4], o[5]); w0.w = pk2(o[6], o[7]);
    u32x4 w1; w1.x = pk2(o[8], o[9]); w1.y = pk2(o[10], o[11]); w1.z = pk2(o[12], o[13]); w1.w = pk2(o[14], o[15]);
    *(u32x4*)dst = w0; *(u32x4*)(dst + 8) = w1;
    __syncthreads();
}

constexpr int RT_STRIDE = 8208, VS_OFF = 8 * RT_STRIDE, VS_STRIDE = 4112;
FI void longconv_channel(const Args& A, LAS unsigned char* lds, int c, int tid, int lane, int wave) {
    unsigned char* ws = A.ws;
    const bf16_t* Rg = (const bf16_t*)(ws + WS_RG) + (size_t)c * 4096; const bf16_t* Vt = (const bf16_t*)(ws + WS_VT) + (size_t)c * NB * SEQ; bf16_t* LC = (bf16_t*)(ws + WS_LCT) + (size_t)c * NB * SEQ;
    for (int i = tid; i < VS_OFF / 16; i += NTHR) *(LAS u32x4*)(lds + i * 16) = (u32x4){0u, 0u, 0u, 0u};
    for (int i = tid; i < NB * SEQ / 8; i += NTHR) { const int bb = i >> 8, s8 = i & 255; *(LAS u32x4*)(lds + VS_OFF + bb * VS_STRIDE + s8 * 16) = *(const u32x4*)(Vt + (size_t)bb * SEQ + s8 * 8); }
    __syncthreads();
    for (int i = tid; i < 4096; i += NTHR) { const bf16_t v = Rg[i];
#pragma unroll
        for (int r = 0; r < 8; ++r) *(LAS bf16_t*)(lds + r * RT_STRIDE + (i + r) * 2) = v; }
    __syncthreads();
    const int a = lane & 15, q = lane >> 4, r = (a + 1) & 7;
    const LAS unsigned char* vb = lds + VS_OFF + (lane & 7) * VS_STRIDE + 16 * q;
#pragma unroll 1
    for (int grp = 0; grp < 2; ++grp) {
        const int i0 = wave * 16 + grp * 8;
        const LAS unsigned char* rb = lds + r * RT_STRIDE + 2 * (2047 - 16 * (i0 + 7) - a + 8 * q + r);
        f32x4 acc[8];
#pragma unroll
        for (int ii = 0; ii < 8; ++ii) acc[ii] = (f32x4){0.f, 0.f, 0.f, 0.f};
#pragma unroll 2
        for (int j = 0; j < 64; ++j) {
            const bf16x8 bfr = *(const LAS bf16x8*)(vb + 64 * j);
#pragma unroll
            for (int ii = 0; ii < 8; ++ii) { const bf16x8 afr = *(const LAS bf16x8*)(rb + 32 * (7 - ii) + 64 * j); acc[ii] = __builtin_amdgcn_mfma_f32_16x16x32_bf16(afr, bfr, acc[ii], 0, 0, 0); }
        }
        if (a < 8) {
#pragma unroll
            for (int ii = 0; ii < 8; ++ii) { u32x2 w; w.x = pk2(acc[ii][0], acc[ii][1]); w.y = pk2(acc[ii][2], acc[ii][3]); *(u32x2*)(LC + (size_t)a * SEQ + 16 * (i0 + ii) + 4 * q) = w; }
        }
    }
    __syncthreads();
}

FI void s5_combine(const Args& A, int gtid, int gthreads) {
    unsigned char* ws = A.ws;
    const bf16_t* P = (const bf16_t*)(ws + WS_P); const bf16_t* Ys = (const bf16_t*)(ws + WS_YS5); bf16_t* Yg = (bf16_t*)(ws + WS_YG); const float* dsk = A.in[16];
    for (int idx = gtid; idx < M * 128; idx += gthreads) {
        const int row = idx >> 7, c8 = (idx & 127) * 8;
        const u32x4 u = *(const u32x4*)(P + (size_t)row * DIN + c8), yf = *(const u32x4*)(Ys + (size_t)row * S5W + c8), yb = *(const u32x4*)(Ys + (size_t)(M + row) * S5W + c8);
        const f32x4 d0 = *(const f32x4*)(dsk + c8), d1 = *(const f32x4*)(dsk + c8 + 4);
        float y[8];
        y[0] = bflo(u.x) * d0.x + bflo(yf.x) + bflo(yb.x); y[1] = bfhi(u.x) * d0.y + bfhi(yf.x) + bfhi(yb.x);
        y[2] = bflo(u.y) * d0.z + bflo(yf.y) + bflo(yb.y); y[3] = bfhi(u.y) * d0.w + bfhi(yf.y) + bfhi(yb.y);
        y[4] = bflo(u.z) * d1.x + bflo(yf.z) + bflo(yb.z); y[5] = bfhi(u.z) * d1.y + bfhi(yf.z) + bfhi(yb.z);
        y[6] = bflo(u.w) * d1.z + bflo(yf.w) + bflo(yb.w); y[7] = bfhi(u.w) * d1.w + bfhi(yf.w) + bfhi(yb.w);
#pragma unroll
        for (int e = 0; e < 8; ++e) y[e] = 0.5f * y[e] * (1.0f + erff(y[e] * 0.70710678118654752f));
        u32x4 w; w.x = pk2(y[0], y[1]); w.y = pk2(y[2], y[3]); w.z = pk2(y[4], y[5]); w.w = pk2(y[6], y[7]);
        *(u32x4*)(Yg + (size_t)row * S5W + c8) = w;
    }
}

FI void h3_item(const Args& A, LAS unsigned char* lds, int item, int tid) {
    unsigned char* ws = A.ws;
    const bf16_t* P = (const bf16_t*)(ws + WS_P); const bf16_t* LC = (const bf16_t*)(ws + WS_LCT); bf16_t* Yc = (bf16_t*)(ws + WS_YCAT);
    const int gr = item >> 3, cg = item & 7, b = gr >> 5, t0 = (gr & 31) * 64, c0 = cg * 128;
    for (int idx = tid; idx < 3 * 64 * 16; idx += NTHR) { const int ch = idx >> 10, rem = idx & 1023, row = rem >> 4, sg = rem & 15;
        const u32x4 v = *(const u32x4*)(P + (size_t)(b * SEQ + t0 + row) * DIN + S5W + ch * HYW + c0 + sg * 8);
        *(LAS u32x4*)(lds + ch * 16896 + (row + 1) * 256 + sg * 16) = v; }
    if (tid < 96) { const int ch = tid >> 5, rr = (tid >> 4) & 1, sg = tid & 15; *(LAS u32x4*)(lds + ch * 16896 + (rr ? 65 : 0) * 256 + sg * 16) = (u32x4){0u, 0u, 0u, 0u}; }
    LAS bf16_t* Ls = (LAS bf16_t*)(lds + 3 * 16896);
    for (int idx = tid; idx < 128 * 8; idx += NTHR) { const int c = idx >> 3, pc = idx & 7;
        const u32x4 v = *(const u32x4*)(LC + (size_t)((c0 + c) * NB + b) * SEQ + t0 + pc * 8);
        const unsigned wv[4] = {v.x, v.y, v.z, v.w};
#pragma unroll
        for (int e = 0; e < 4; ++e) { Ls[(pc * 8 + 2 * e) * 128 + c] = (bf16_t)(wv[e] & 0xffffu); Ls[(pc * 8 + 2 * e + 1) * 128 + c] = (bf16_t)(wv[e] >> 16); } }
    __syncthreads();
    const int c = tid & 127, tq = tid >> 7, cc = c0 + c;
    const float* cw = A.in[19]; const float* cb = A.in[20];
    const float w0v = cw[cc], w1v = cw[3072 + cc], w2v = cw[6144 + cc], bv = cb[cc];
    const float w0x = cw[HYW + cc], w1x = cw[3072 + HYW + cc], w2x = cw[6144 + HYW + cc], bx = cb[HYW + cc];
    const float w0z = cw[2 * HYW + cc], w1z = cw[3072 + 2 * HYW + cc], w2z = cw[6144 + 2 * HYW + cc], bz = cb[2 * HYW + cc];
    const float dd = A.in[30][cc];
    const LAS bf16_t* Vs = (const LAS bf16_t*)lds; const LAS bf16_t* Xs = (const LAS bf16_t*)(lds + 16896); const LAS bf16_t* Zs = (const LAS bf16_t*)(lds + 2 * 16896);
#pragma unroll 4
    for (int i = 0; i < 16; ++i) { const int t = tq * 16 + i;
        const float v = w0v * bf1(Vs[t * 128 + c]) + w1v * bf1(Vs[(t + 1) * 128 + c]) + w2v * bf1(Vs[(t + 2) * 128 + c]) + bv;
        const float x = w0x * bf1(Xs[t * 128 + c]) + w1x * bf1(Xs[(t + 1) * 128 + c]) + w2x * bf1(Xs[(t + 2) * 128 + c]) + bx;
        const float z = w0z * bf1(Zs[t * 128 + c]) + w1z * bf1(Zs[(t + 1) * 128 + c]) + w2z * bf1(Zs[(t + 2) * 128 + c]) + bz;
        const float vg = v * x, y = (bf1(Ls[t * 128 + c]) + vg * dd) * z;
        Yc[(size_t)(b * SEQ + t0 + t) * D + S5W + cc] = (bf16_t)f2bf(y); }
    __syncthreads();
}

FI void p7_run(const Args& A, LAS unsigned char* lds, int lane, int wave, int vcu, int G) {
    unsigned char* ws = A.ws;
    const float* x1 = (const float*)(ws + WS_X1); bf16_t* A2 = (bf16_t*)(ws + WS_A2);
    const float* mod = (const float*)(ws + WS_CTL) + CW_MOD; const float* bada = A.in[5]; const float* g2 = A.in[7];
    const float* wrt = A.in[32]; const float* brt = A.in[33];
    int* cnt = (int*)(ws + WS_CTL) + CW_CNT; int* rowl = (int*)(ws + WS_ROWL); int* pk = (int*)(ws + WS_PK); float* gate = (float*)(ws + WS_GATE);
    LAS float* hb = (LAS float*)(lds + wave * 8192);
    const int e = lane & 31, kh = lane >> 5;
    for (int it = vcu; it < M / 64; it += G) {
        const int rbase = it * 64 + wave * 8, b = rbase / SEQ;
        float rstd[8];
#pragma unroll
        for (int r = 0; r < 8; ++r) { float ss = 0.f;
#pragma unroll
            for (int j = 0; j < 8; ++j) { const f32x4 v = *(const f32x4*)(x1 + (size_t)(rbase + r) * D + 4 * lane + 256 * j); ss += (v.x * v.x + v.y * v.y) + (v.z * v.z + v.w * v.w); }
            rstd[r] = rsqrtf(wave_sum(ss) * (1.0f / D) + 1e-6f); }
        float lg[8];
#pragma unroll
        for (int r = 0; r < 8; ++r) lg[r] = 0.f;
#pragma unroll 1
        for (int kc = 0; kc < 8; ++kc) {
            const int col = kc * 256 + 4 * lane;
            const f32x4 gv = *(const f32x4*)(g2 + col);
            const f32x4 sh = *(const f32x4*)(mod + (size_t)b * 12288 + 3 * D + col) + *(const f32x4*)(bada + 3 * D + col);
            const f32x4 sc = *(const f32x4*)(mod + (size_t)b * 12288 + 4 * D + col) + *(const f32x4*)(bada + 4 * D + col) + 1.0f;
#pragma unroll
            for (int r = 0; r < 8; ++r) { const f32x4 xv = *(const f32x4*)(x1 + (size_t)(rbase + r) * D + col);
                const f32x4 h = xv * rstd[r] * gv * sc + sh;
                u32x2 w; w.x = pk2(h.x, h.y); w.y = pk2(h.z, h.w); *(u32x2*)(A2 + (size_t)(rbase + r) * D + col) = w;
                *(LAS f32x4*)(hb + r * 256 + 4 * lane) = h; }
            LDS_WAIT();
            const float* wp = wrt + (size_t)(kc * 256 + kh * 128) * NE + e;
#pragma unroll 2
            for (int jj = 0; jj < 128; jj += 4) {
                const float w0 = wp[(jj + 0) * NE], w1 = wp[(jj + 1) * NE], w2 = wp[(jj + 2) * NE], w3 = wp[(jj + 3) * NE];
#pragma unroll
                for (int r = 0; r < 8; ++r) { const f32x4 hv = *(const LAS f32x4*)(hb + r * 256 + kh * 128 + jj); lg[r] += (hv.x * w0 + hv.y * w1) + (hv.z * w2 + hv.w * w3); }
            }
            LDS_WAIT();
        }
        const float be = brt[e];
#pragma unroll
        for (int r = 0; r < 8; ++r) {
            float v = lg[r] + __shfl_xor(lg[r], 32) + be;
            float tv[4]; int ti[4];
#pragma unroll
            for (int k = 0; k < 4; ++k) { float bvv = v; int bi = e;
#pragma unroll
                for (int o = 16; o >= 1; o >>= 1) { const float ov = __shfl_xor(bvv, o); const int oi = __shfl_xor(bi, o); if (ov > bvv || (ov == bvv && oi < bi)) { bvv = ov; bi = oi; } }
                tv[k] = bvv; ti[k] = bi; if (e == bi) v = -3.0e38f; }
            const float e1 = __expf(tv[1] - tv[0]), e2 = __expf(tv[2] - tv[0]), e3 = __expf(tv[3] - tv[0]), inv = 1.0f / (1.0f + e1 + e2 + e3);
            if (lane < 4) { const int ex = lane == 0 ? ti[0] : lane == 1 ? ti[1] : lane == 2 ? ti[2] : ti[3];
                const float gx = (lane == 0 ? 1.0f : lane == 1 ? e1 : lane == 2 ? e2 : e3) * inv;
                const int row = rbase + r, slot = atomicAdd(cnt + ex, 1);
                rowl[ex * M + slot] = row; pk[row * 4 + lane] = ex * M + slot; gate[row * 4 + lane] = gx; }
        }
    }
}

FI void moe_table(const Args& A, LAS unsigned char* lds, int tid) {
    const int* cnt = (const int*)(A.ws + WS_CTL) + CW_CNT;
    LAS int* tw = (LAS int*)(lds + LDSCTL_OFF);
    if (tid < 64) { const int n = tid < NE ? cnt[tid] : 0; int p = (n + 255) >> 8;
#pragma unroll
        for (int o = 1; o < 32; o <<= 1) { const int q = __shfl_up(p, o); if ((tid & 63) >= o) p += q; }
        if (tid < NE) { tw[LW_TST + tid + 1] = p; tw[LW_CNT + tid] = n; } if (tid == 0) tw[LW_TST] = 0; }
    __syncthreads();
}

FI void p10_run(const Args& A, LAS unsigned char* lds, int lane, int wave, int vcu, int G) {
    unsigned char* ws = A.ws;
    const float* x1 = (const float*)(ws + WS_X1); const bf16_t* Yd = (const bf16_t*)(ws + WS_YD);
    const float* mod = (const float*)(ws + WS_CTL) + CW_MOD; const float* bada = A.in[5]; const float* gf = A.in[38];
    const int* pk = (const int*)(ws + WS_PK); const float* gate = (const float*)(ws + WS_GATE);
    const LAS int* tst = (const LAS int*)(lds + LDSCTL_OFF) + LW_TST;
    const int gw = vcu * NWAVES + wave, NGW = G * NWAVES;
    for (int row = gw; row < M; row += NGW) {
        const int b = row / SEQ; size_t hr[4]; float gk[4];
#pragma unroll
        for (int k = 0; k < 4; ++k) { const int p = pk[row * 4 + k], ex = p / M, slot = p % M; hr[k] = (size_t)(tst[ex] * 256 + slot) * D; gk[k] = gate[row * 4 + k]; }
        f32x4 x2[8]; float ss = 0.f;
#pragma unroll
        for (int j = 0; j < 8; ++j) { const int col = 4 * lane + 256 * j;
            f32x4 s = (f32x4){0.f, 0.f, 0.f, 0.f};
#pragma unroll
            for (int k = 0; k < 4; ++k) { const u32x2 y = *(const u32x2*)(Yd + hr[k] + col); s += (f32x4){bflo(y.x), bfhi(y.x), bflo(y.y), bfhi(y.y)} * gk[k]; }
            const f32x4 ga = *(const f32x4*)(mod + (size_t)b * 12288 + 5 * D + col) + *(const f32x4*)(bada + 5 * D + col);
            x2[j] = *(const f32x4*)(x1 + (size_t)row * D + col) + ga * s;
            ss += (x2[j].x * x2[j].x + x2[j].y * x2[j].y) + (x2[j].z * x2[j].z + x2[j].w * x2[j].w); }
        const float rstd = rsqrtf(wave_sum(ss) * (1.0f / D) + 1e-6f);
#pragma unroll
        for (int j = 0; j < 8; ++j) { const int col = 4 * lane + 256 * j; *(f32x4*)(A.out + (size_t)row * D + col) = x2[j] * rstd * *(const f32x4*)(gf + col); }
    }
}

__global__ void __launch_bounds__(NTHR, 2) fwd_kernel(Args args) {
    extern __shared__ __attribute__((aligned(16))) unsigned char lds_raw[];
    LAS unsigned char* lds = (LAS unsigned char*)lds_raw;
    const int tid = threadIdx.x, lane = tid & 63, wave = __builtin_amdgcn_readfirstlane(tid >> 6);
    const int G = gridDim.x; const int bx = blockIdx.x; const int vcu = (G % 8 == 0) ? (bx % 8) * (G / 8) + bx / 8 : bx;
    unsigned char* ws = args.ws;
    for (int u = tid; u < (LDS_BYTES - LDSCTL_OFF) / 4; u += NTHR) ((LAS unsigned*)(lds + LDSCTL_OFF))[u] = 0u;
    __syncthreads();
    XcdBarrier bar; bar.bar = (unsigned*)(ws + WS_CTL) + CW_BAR; bar.x = 0; bar.st = nullptr;
#if !MK_SPLIT
    bar = xcd_barrier_post((unsigned*)(ws + WS_CTL) + CW_BAR, (volatile LAS unsigned*)(lds + LDSCTL_OFF) + LW_BAR);
#endif
    const int lo = args.ph_lo, hi = args.ph_hi;
#define IN(k) (lo <= (k) && (k) < hi)
#if MK_SPLIT
#define SEAM(k) do { } while (0)
#else
#define SEAM(k) do { if (IN(k) && IN((k) + 1)) xcd_barrier(bar); } while (0)
#endif
    const float* modp = (const float*)(ws + WS_CTL) + CW_MOD;

    if (IN(0)) { p0_run(args, lds, tid, lane, wave, vcu, G); } SEAM(0);
    if (IN(1)) { p1_run(args, tid, lane, wave, vcu, G); } SEAM(1);
    if (IN(2)) {
        pg8::DenseSched S{(const bf16_t*)(ws + WS_A1), (const bf16_t*)(ws + WS_WIN), D, M / 256, DIN / 256, G, bx, M / 256, MC / 256, S5W / 256};
        pg8::EpiStoreBf16 E{(bf16_t*)(ws + WS_P), DIN, nullptr, 0};
        pg8::gemm_phase(lds, D, S, E);
    } SEAM(2);
    if (IN(3)) {
        for (int u = vcu; u < 512; u += G) s5_unit(args, lds, u, lane, wave);
        for (int it = vcu; it < 2048; it += G) h1_item(args, lds, it, tid);
    } SEAM(3);
    if (IN(4)) {
        s5_combine(args, vcu * NTHR + tid, G * NTHR);
        for (int c = vcu; c < HYW; c += G) longconv_channel(args, lds, c, tid, lane, wave);
    } SEAM(4);
    if (IN(5)) {
        for (int it = vcu; it < 2048; it += G) h3_item(args, lds, it, tid);
        pg8::DenseSched S{(const bf16_t*)(ws + WS_YG), (const bf16_t*)(ws + WS_WGLU), S5W, M / 256, S5W / 256, G, bx, 0, 0, 0};
        pg8::EpiGlu E{(const bf16_t*)(ws + WS_YG), (bf16_t*)(ws + WS_YCAT), args.in[18]};
        pg8::gemm_phase(lds, S5W, S, E);
    } SEAM(5);
    if (IN(6)) {
        pg8::DenseSched S{(const bf16_t*)(ws + WS_YCAT), (const bf16_t*)(ws + WS_WOUT), D, M / 256, D / 256, G, bx, 0, 0, 0};
        pg8::EpiResid E{args.in[0], (float*)(ws + WS_X1), modp, args.in[5]};
        pg8::gemm_phase(lds, D, S, E);
    } SEAM(6);
    if (IN(7)) { p7_run(args, lds, lane, wave, vcu, G); } SEAM(7);
    if (IN(8)) {
        moe_table(args, lds, tid);
        pg8::MoeSched<true> S{(const bf16_t*)(ws + WS_A2), (const bf16_t*)(ws + WS_WGU), D, 16, G, bx, (size_t)4096 * D,
                              (const LAS int*)(lds + LDSCTL_OFF) + LW_TST, (const LAS int*)(lds + LDSCTL_OFF) + LW_CNT, (const int*)(ws + WS_ROWL)};
        pg8::EpiSwiglu E{(bf16_t*)(ws + WS_H), args.in[35]};
        pg8::gemm_phase(lds, D, S, E);
    } SEAM(8);
    if (IN(9)) {
        moe_table(args, lds, tid);
        pg8::MoeSched<false> S{(const bf16_t*)(ws + WS_H), (const bf16_t*)(ws + WS_WDN), DFF, 8, G, bx, (size_t)D * DFF,
                               (const LAS int*)(lds + LDSCTL_OFF) + LW_TST, (const LAS int*)(lds + LDSCTL_OFF) + LW_CNT, (const int*)(ws + WS_ROWL)};
        pg8::EpiStoreBf16 E{(bf16_t*)(ws + WS_YD), D, args.in[37], D};
        pg8::gemm_phase(lds, DFF, S, E);
    } SEAM(9);
    if (IN(10)) { moe_table(args, lds, tid); p10_run(args, lds, lane, wave, vcu, G); }
#undef IN
#undef SEAM
}

extern "C" void kernel_launch(void* const* d_in, const int* in_sizes, int n_in, void* d_out, int out_size, void* d_ws, size_t ws_size, hipStream_t stream) {
    static int grid = 0;
    if (grid == 0) {
        if (n_in != 39 || out_size != M * D || ws_size < WS_END) { fprintf(stderr, "kernel_launch: unexpected problem (n_in %d, out %d, ws %zu)\n", n_in, out_size, ws_size); grid = -1; return; }
        int dev = 0, cus = 0, per_cu = 0;
        if (hipGetDevice(&dev) != hipSuccess || hipDeviceGetAttribute(&cus, hipDeviceAttributeMultiprocessorCount, dev) != hipSuccess) { grid = -1; return; }
        if (hipFuncSetAttribute((const void*)fwd_kernel, hipFuncAttributeMaxDynamicSharedMemorySize, LDS_BYTES) != hipSuccess) { fprintf(stderr, "kernel_launch: hipFuncSetAttribute failed\n"); grid = -1; return; }
        if (hipOccupancyMaxActiveBlocksPerMultiprocessor(&per_cu, (const void*)fwd_kernel, NTHR, LDS_BYTES) != hipSuccess || per_cu < 1) fprintf(stderr, "kernel_launch: occupancy query says %d\n", per_cu);
        (void)hipGetLastError();
        grid = cus;
    }
    if (grid < 0) return;
    (void)in_sizes;
    if (hipMemsetAsync((char*)d_ws + WS_CTL, 0, CTL_ZERO_BYTES, stream) != hipSuccess) { fprintf(stderr, "kernel_launch: memset failed\n"); return; }
    Args a{};
    for (int i = 0; i < 39; ++i) a.in[i] = (const float*)d_in[i];
    a.out = (float*)d_out; a.ws = (unsigned char*)d_ws;
#if MK_SPLIT
    for (int p = 0; p < NPHASE; ++p) { a.ph_lo = p; a.ph_hi = p + 1; hipLaunchKernelGGL(fwd_kernel, dim3(grid), dim3(NTHR), LDS_BYTES, stream, a); }
#else
    a.ph_lo = 0; a.ph_hi = NPHASE;
    hipLaunchKernelGGL(fwd_kernel, dim3(grid), dim3(NTHR), LDS_BYTES, stream, a);
#endif
    const hipError_t le = hipPeekAtLastError();
    if (le != hipSuccess) fprintf(stderr, "kernel_launch: launch failed: %s\n", hipGetErrorName(le));
}
```

```cpp
#include <hip/hip_runtime.h>
#include <cstdio>
#include <cstdint>

#ifndef MK_SPLIT
#define MK_SPLIT 0
#endif

#ifndef REP0D
#define REP0D 1
#endif
#ifndef REP2
#define REP2 1
#endif
#ifndef REP3
#define REP3 1
#endif
#ifndef REP4
#define REP4 1
#endif
#ifndef REP6
#define REP6 1
#endif
#ifndef REP8
#define REP8 1
#endif
#ifndef REP9
#define REP9 1
#endif
#define GAS __attribute__((address_space(1)))
#define LAS __attribute__((address_space(3)))
typedef unsigned short bf16_t;
typedef short bf16x8 __attribute__((ext_vector_type(8)));
typedef float f32x4 __attribute__((ext_vector_type(4)));
typedef float f32x16 __attribute__((ext_vector_type(16)));
typedef unsigned u32x4 __attribute__((ext_vector_type(4)));
typedef unsigned u32x2 __attribute__((ext_vector_type(2)));

constexpr int NWAVES = 8, NTHR = 512;
constexpr int D = 2048, NB = 8, SEQ = 2048, M = NB * SEQ, CTXL = 256, MC = NB * CTXL, MT = M + MC;
constexpr int DIN = 4096, S5W = 1024, HYW = 1024, NG = 64;
constexpr int NE = 32, DFF = 2048;
constexpr int NPHASE = 11;
constexpr float WSCALE = 64.0f;
constexpr int SEG = 288;

constexpr size_t MiB = 1u << 20;
constexpr size_t WS_CTL = 0, CTL_ZERO_BYTES = 1024 * 1024;
constexpr int CW_TMO = 0, CW_BAR = 4096, CW_CNT = 8192, CW_HNORM = 12288, CW_MOD = 16384;
constexpr size_t WS_LAM = 1 * MiB, WS_LAML = WS_LAM + 64 * 1024, WS_S5B = WS_LAM + 128 * 1024, WS_S5C = WS_LAM + 640 * 1024;
constexpr size_t WS_HRAW = 4 * MiB, WS_RG = 20 * MiB, WS_WIN = 28 * MiB, WS_WGLU = 44 * MiB, WS_WOUT = 46 * MiB;
constexpr size_t WS_PK = 54 * MiB, WS_GATE = WS_PK + 256 * 1024, WS_ROWL = 55 * MiB, WS_MODF = 58 * MiB;
constexpr size_t WS_A1 = 64 * MiB, WS_P = 136 * MiB, WS_YS5 = 280 * MiB, WS_VT = 344 * MiB, WS_LCT = 376 * MiB, WS_YG = 408 * MiB;
constexpr size_t WS_YCAT = 440 * MiB, WS_X1 = 504 * MiB, WS_A2 = 632 * MiB, WS_WGU = 704 * MiB, WS_WDN = 1216 * MiB;
constexpr size_t WS_H = 1472 * MiB, WS_YD = 1760 * MiB, WS_END = 2048 * MiB;
constexpr int HROWS = 73728;

constexpr int RING_BYTES = 131072, LDSCTL_OFF = RING_BYTES, LDS_BYTES = 147456;
constexpr int LW_BAR = 8, LW_TST = 64, LW_CNT = 128;

__device__ __forceinline__ unsigned f2bf(float f) { unsigned u = __builtin_bit_cast(unsigned, f); return (u + 0x7fffu + ((u >> 16) & 1u)) >> 16; }
__device__ __forceinline__ unsigned pk2(float lo, float hi) { return f2bf(lo) | (f2bf(hi) << 16); }
__device__ __forceinline__ float bflo(unsigned w) { return __builtin_bit_cast(float, w << 16); }
__device__ __forceinline__ float bfhi(unsigned w) { return __builtin_bit_cast(float, w & 0xffff0000u); }
__device__ __forceinline__ float bf1(bf16_t b) { return __builtin_bit_cast(float, (unsigned)b << 16); }
__device__ __forceinline__ unsigned pk4_fp8(float a, float b, float c, float d) { int w = __builtin_amdgcn_cvt_pk_fp8_f32(a, b, 0, false); w = __builtin_amdgcn_cvt_pk_fp8_f32(c, d, w, true); return (unsigned)w; }
constexpr float FIX_SCALE = 4294967296.0f;
__device__ __forceinline__ void fix_add(unsigned long long* p, float v) { atomicAdd(p, (unsigned long long)__float2ll_rn(v * FIX_SCALE)); }
__device__ __forceinline__ float fix_get(const unsigned long long* p) { return (float)((double)(long long)(*p) * (1.0 / 4294967296.0)); }
__device__ __forceinline__ float wave_sum(float v) {
#pragma unroll
    for (int o = 1; o < 64; o <<= 1) v += __shfl_xor(v, o);
    return v;
}
#define LDS_WAIT() asm volatile("s_waitcnt lgkmcnt(0)" ::: "memory")
#define VM_WAIT() asm volatile("s_waitcnt vmcnt(0)" ::: "memory")

#define XB_TMO      128
#define XB_XCNT(j)  (256  + 64 * (j))
#define XB_XSUB(j)  (1280 + 64 * (j))
#define XB_XGEN(j)  (2304 + 64 * (j))
#define XB_TOP      3328
#define XB_TOPGEN   3392
#define XCD_BAR_WORDS 3456
#define XB_SPIN_CAP (1u << 18)
__device__ __forceinline__ unsigned xb_ld(unsigned* p)              { return __hip_atomic_load(p, __ATOMIC_RELAXED, __HIP_MEMORY_SCOPE_AGENT); }
__device__ __forceinline__ unsigned xb_add(unsigned* p, unsigned v) { return __hip_atomic_fetch_add(p, v, __ATOMIC_RELAXED, __HIP_MEMORY_SCOPE_AGENT); }
__device__ __forceinline__ unsigned xb_xcc_id() { return (unsigned)__builtin_amdgcn_s_getreg((3 << 11) | 20) & 0xFu; }
#define XB_SPIN(cond, bar) do { unsigned _sp = 0; while (cond) { __builtin_amdgcn_s_sleep(1); \
    if ((++_sp & 255u) == 0u) { if (xb_ld(&(bar)[XB_TMO])) break; if (_sp > XB_SPIN_CAP) { atomicAdd(&(bar)[XB_TMO], 1u); break; } } } } while (0)
struct XcdBarrier { unsigned* bar; unsigned x; volatile LAS unsigned* st; };
__device__ __forceinline__ XcdBarrier xcd_barrier_post(unsigned* bar, volatile LAS unsigned* st) {
    XcdBarrier b; b.bar = bar; b.x = xb_xcc_id(); b.st = st;
    if (threadIdx.x == 0) (void)xb_add(&bar[XB_XCNT(b.x)], 1u);
    return b;
}
__device__ __forceinline__ void xcd_barrier_complete(unsigned* bar, unsigned x, unsigned& nloc, unsigned& nx) {
    const unsigned G = gridDim.x * gridDim.y * gridDim.z;
    unsigned sum, cnt, mine, sp = 0u;
    for (;;) {
        sum = 0u; cnt = 0u; mine = 0u;
#pragma unroll
        for (unsigned j = 0; j < 16; ++j) { const unsigned c = xb_ld(&bar[XB_XCNT(j)]); sum += c; cnt += (c > 0u) ? 1u : 0u; mine = (j == x) ? c : mine; }
        if (sum == G) break;
        __builtin_amdgcn_s_sleep(1);
        if ((++sp & 255u) == 0u) { if (xb_ld(&bar[XB_TMO])) break; if (sp > XB_SPIN_CAP) { atomicAdd(&bar[XB_TMO], 1u); break; } }
    }
    nloc = mine > 0u ? mine : 1u; nx = cnt > 0u ? cnt : 1u;
}
__device__ __forceinline__ void xcd_barrier(const XcdBarrier& b) {
    asm volatile("s_waitcnt vmcnt(0)" ::: "memory");
    __syncthreads();
    if (threadIdx.x == 0) {
        unsigned* bar = b.bar;
        __builtin_amdgcn_s_waitcnt(0);
        unsigned nloc = b.st[0], nx = b.st[1];
        if (nloc == 0u) { xcd_barrier_complete(bar, b.x, nloc, nx); b.st[0] = nloc; b.st[1] = nx; }
        const unsigned old = xb_add(&bar[XB_XSUB(b.x)], 1u);
        const unsigned gen = old / nloc;
        if (old + 1u == (gen + 1u) * nloc) {
            __builtin_amdgcn_fence(__ATOMIC_RELEASE, "agent");
            asm volatile("s_waitcnt vmcnt(0)" ::: "memory");
            const unsigned og = xb_add(&bar[XB_TOP], 1u);
            const unsigned tg = og / nx;
            if (og + 1u == (tg + 1u) * nx) xb_add(&bar[XB_TOPGEN], 1u);
            else XB_SPIN(xb_ld(&bar[XB_TOPGEN]) == tg, bar);
            __builtin_amdgcn_fence(__ATOMIC_ACQUIRE, "agent");
            xb_add(&bar[XB_XGEN(b.x)], 1u);
            asm volatile("s_waitcnt vmcnt(0)" ::: "memory");
        } else {
            XB_SPIN(xb_ld(&bar[XB_XGEN(b.x)]) == gen, bar);
            __builtin_amdgcn_fence(__ATOMIC_ACQUIRE, "agent");
            asm volatile("s_waitcnt vmcnt(0)" ::: "memory");
        }
    }
    __syncthreads();
}

struct Args { const float* in[39]; float* out; unsigned char* ws; int ph_lo, ph_hi; };

namespace pg8 {
constexpr int BM = 256, BK = 64, HALF = 128, HTB = HALF * BK * 2, STAGE_BYTES = 8 * HTB, NXCD = 8, WGM = 8;
__device__ __forceinline__ int lds_byte(int r, int c) { const int st = (r >> 4) * 2 + (c >> 5), rr = r & 15, cc = c & 31, ob = rr * 64 + cc * 2; return st * 1024 + (ob ^ (((ob >> 9) & 1) << 5)); }
__device__ __forceinline__ void stage_rc(int b, int& R, int& C) { const int st = b / 1024, sb = b % 1024, swz = sb ^ (((sb >> 9) & 1) << 5); R = (st >> 1) * 16 + swz / 64; C = (st & 1) * 32 + (swz % 64) / 2; }
__device__ __forceinline__ int perm32(int rho) { const int n = rho >> 4, i = rho & 15; return 8 * (i >> 2) + 4 * n + (i & 3); }
struct Unit { int pm, pn, e; };
__device__ __forceinline__ unsigned cvt_pk_bf16(float lo, float hi) { unsigned r; asm volatile("v_cvt_pk_bf16_f32 %0, %1, %2" : "=v"(r) : "v"(lo), "v"(hi)); return r; }

__device__ __forceinline__ void tile_of(long L, int nM, int nN, int& pm, int& pn) {
    const int nwg = nM * nN; int wgid = (int)L;
    { const int q = nwg / NXCD, r = nwg % NXCD, xcd = wgid % NXCD, off = wgid / NXCD; wgid = (xcd < r ? xcd * (q + 1) : r * (q + 1) + (xcd - r) * q) + off; }
    const int nig = WGM * nN, gid = wgid / nig, fm = gid * WGM, gsz = (nM - fm) < WGM ? (nM - fm) : WGM;
    pm = fm + ((wgid % nig) % gsz); pn = (wgid % nig) / gsz;
}

struct DenseSched {
    const bf16_t* A; const bf16_t* Bt; int RB, nM, nN, G, c, xM0, xnM, xnN;
    __device__ __forceinline__ bool next(int i, Unit& u) const {
        const long L = (long)i * G + c; const int nwg = nM * nN;
        if (L < nwg) { tile_of(L, nM, nN, u.pm, u.pn); u.e = 0; return true; }
        const long r = L - nwg; if (r >= (long)xnM * xnN) return false;
        u.pm = xM0 + (int)(r % xnM); u.pn = (int)(r / xnM); u.e = 0; return true;
    }
    __device__ __forceinline__ const char* abase(const Unit& u) const { return (const char*)A + (size_t)u.pm * BM * RB; }
    __device__ __forceinline__ const char* bbase(const Unit& u) const { return (const char*)Bt + (size_t)u.pn * BM * RB; }
    __device__ __forceinline__ void rows(const Unit&, unsigned (&va)[2][2], const int (&R)[2], const int (&C)[2]) const {
#pragma unroll
        for (int h = 0; h < 2; ++h)
#pragma unroll
            for (int i = 0; i < 2; ++i) va[h][i] = (unsigned)((h * HALF + R[i]) * RB + 2 * C[i]);
    }
};
template <bool GATHER> struct MoeSched {
    const unsigned char* A; const unsigned char* Bt; int RB, nN, G, c; size_t estride;
    const LAS int* tst; const LAS int* cnts; const int* rowlist;
    __device__ __forceinline__ bool next(int i, Unit& u) const {
        const int TM = __builtin_amdgcn_readfirstlane(tst[NE]); const long L = (long)i * G + c; if (L >= (long)TM * nN) return false;
        tile_of(L, TM, nN, u.pm, u.pn);
        int e = 0;
#pragma unroll 1
        for (int j = 1; j < NE; ++j) e += (__builtin_amdgcn_readfirstlane(tst[j]) <= u.pm) ? 1 : 0;
        u.e = e; return true;
    }
    __device__ __forceinline__ const char* abase(const Unit& u) const { return GATHER ? (const char*)A : (const char*)A + (size_t)u.pm * BM * RB; }
    __device__ __forceinline__ const char* bbase(const Unit& u) const { return (const char*)Bt + (size_t)u.e * estride + (size_t)u.pn * BM * RB; }
    __device__ __forceinline__ void rows(const Unit& u, unsigned (&va)[2][2], const int (&R)[2], const int (&C)[2]) const {
        if (GATHER) {
            const int n = __builtin_amdgcn_readfirstlane(cnts[u.e]), lt = u.pm - __builtin_amdgcn_readfirstlane(tst[u.e]);
#pragma unroll
            for (int h = 0; h < 2; ++h)
#pragma unroll
                for (int i = 0; i < 2; ++i) { int slot = lt * BM + h * HALF + R[i]; slot = slot < n ? slot : 0; const int tok = rowlist[u.e * M + slot]; va[h][i] = (unsigned)(tok * RB + 2 * C[i]); }
        } else {
#pragma unroll
            for (int h = 0; h < 2; ++h)
#pragma unroll
                for (int i = 0; i < 2; ++i) va[h][i] = (unsigned)((h * HALF + R[i]) * RB + 2 * C[i]);
        }
    }
};

typedef int i32x4 __attribute__((ext_vector_type(4)));
typedef int i32x8 __attribute__((ext_vector_type(8)));
template <bool FP8, class Epi, class Sched>
__device__ __forceinline__ void gemm_phase(LAS unsigned char* lds, const int RB, const Sched& S, const Epi& E) {
    const int tid = threadIdx.x, wid = __builtin_amdgcn_readfirstlane(tid >> 6), lane = tid & 63, wr = wid >> 2, wc = wid & 3, fr = lane & 15, fq = lane >> 4;
    const int nt = RB / 128;
    unsigned voffB[2]; int Rr[2], Cc[2];
#pragma unroll
    for (int i = 0; i < 2; ++i) { int R, C; stage_rc(tid * 16 + i * 8192, R, C); Rr[i] = R; Cc[i] = C; const int Rb = Epi::PERM ? ((R & ~31) + perm32(R & 31)) : R; voffB[i] = (unsigned)(Rb * RB + 2 * C); }
    const size_t kstep = (size_t)(BK * 2);
    const size_t hstep = (size_t)HALF * RB;
    const unsigned ldsw = (unsigned)wid * 1024u;
    const int aoff = lds_byte(wr * 64 + fr, fq * 8), boff = lds_byte(wc * 32 + fr, fq * 8);
#define PG8_SA(b, h) (((b) * 2 + (h)) * HTB)
#define PG8_SB(b, h) ((4 + (b) * 2 + (h)) * HTB)
#define PG8_STAGE(bufoff, gbase, voff) do { _Pragma("unroll") for (int _i = 0; _i < 2; ++_i) \
        __builtin_amdgcn_global_load_lds((const unsigned*)((const char*)(gbase) + (voff)[_i]), (LAS unsigned*)(lds + (bufoff) + ldsw + _i * 8192), 16, 0, 0); } while (0)
#define PG8_LDA(dst, b, h) do { _Pragma("unroll") for (int m = 0; m < 4; ++m) _Pragma("unroll") for (int k = 0; k < 2; ++k) dst[m][k] = *(const LAS bf16x8*)(lds + PG8_SA(b, h) + aoff + m * 2048 + k * 1024); } while (0)
#define PG8_LDB(dst, b, h) do { _Pragma("unroll") for (int n = 0; n < 2; ++n) _Pragma("unroll") for (int k = 0; k < 2; ++k) dst[n][k] = *(const LAS bf16x8*)(lds + PG8_SB(b, h) + boff + n * 2048 + k * 1024); } while (0)
#define PG8_MMA(ai, bj, At, Bt) do { __builtin_amdgcn_s_setprio(1); _Pragma("unroll") for (int m = 0; m < 4; ++m) _Pragma("unroll") for (int n = 0; n < 2; ++n) { \
        if constexpr (FP8) { const i32x8 bb_ = __builtin_shufflevector(__builtin_bit_cast(i32x4, Bt[n][0]), __builtin_bit_cast(i32x4, Bt[n][1]), 0, 1, 2, 3, 4, 5, 6, 7); \
            const i32x8 aa_ = __builtin_shufflevector(__builtin_bit_cast(i32x4, At[m][0]), __builtin_bit_cast(i32x4, At[m][1]), 0, 1, 2, 3, 4, 5, 6, 7); \
            asm volatile("v_mfma_scale_f32_16x16x128_f8f6f4 %0, %1, %2, %0, %3, %3 op_sel_hi:[0,0,0]" : "+v"(acc[ai][bj][m][n]) : "v"(bb_), "v"(aa_), "v"(one_scale)); } \
        else { _Pragma("unroll") for (int k = 0; k < 2; ++k) acc[ai][bj][m][n] = __builtin_amdgcn_mfma_f32_16x16x32_bf16(Bt[n][k], At[m][k], acc[ai][bj][m][n], 0, 0, 0); } } \
        __builtin_amdgcn_s_setprio(0); } while (0)
#define PG8_WAIT_V(n) asm volatile("s_waitcnt vmcnt(" #n ")" ::: "memory")
#define PG8_WAIT_L(n) asm volatile("s_waitcnt lgkmcnt(" #n ")" ::: "memory")
#define PG8_BAR __builtin_amdgcn_s_barrier()
#define PG8_SCHED __builtin_amdgcn_sched_barrier(0)
    Unit cur, nxt; int ui = 0;
    if (!S.next(0, cur)) return;
    f32x4 acc[2][2][4][2];
#pragma unroll
    for (int a = 0; a < 2; ++a)
#pragma unroll
        for (int b = 0; b < 2; ++b)
#pragma unroll
            for (int m = 0; m < 4; ++m)
#pragma unroll
                for (int n = 0; n < 2; ++n) acc[a][b][m][n] = (f32x4){0.f, 0.f, 0.f, 0.f};
    bf16x8 At[4][2], B0[2][2], B1[2][2];
    unsigned one_scale = 0x7F7F7F7Fu; asm volatile("" : "+v"(one_scale));
    unsigned vaC[2][2], vaN[2][2];
    S.rows(cur, vaC, Rr, Cc);
    const char* cA = S.abase(cur); const char* cB = S.bbase(cur);
    PG8_STAGE(PG8_SB(0, 0), cB, voffB); PG8_STAGE(PG8_SA(0, 0), cA, vaC[0]); PG8_STAGE(PG8_SB(0, 1), cB + hstep, voffB); PG8_STAGE(PG8_SA(0, 1), cA, vaC[1]);
    if (wr == 1) PG8_BAR;
    PG8_WAIT_V(4); PG8_BAR;
    PG8_STAGE(PG8_SB(1, 0), cB + kstep, voffB); PG8_STAGE(PG8_SA(1, 0), cA + kstep, vaC[0]); PG8_STAGE(PG8_SB(1, 1), cB + hstep + kstep, voffB);
    PG8_WAIT_V(6); PG8_BAR;
    for (;;) {
        const bool has_next = S.next(ui + 1, nxt);
        const char* nA = has_next ? S.abase(nxt) : cA; const char* nB = has_next ? S.bbase(nxt) : cB;
#pragma unroll
        for (int h = 0; h < 2; ++h)
#pragma unroll
            for (int i = 0; i < 2; ++i) vaN[h][i] = vaC[h][i];
        for (int t = 0; t < nt; t += 2) {
            const bool last = (t == nt - 2);
            const char* a1 = cA + (size_t)(t + 1) * kstep;
            const char* a2 = last ? nA : cA + (size_t)(t + 2) * kstep; const char* b2 = last ? nB : cB + (size_t)(t + 2) * kstep;
            const char* a3 = a2 + kstep; const char* b3 = b2 + kstep;
            if (last && has_next) S.rows(nxt, vaN, Rr, Cc);
            unsigned v2[2][2];
#pragma unroll
            for (int h = 0; h < 2; ++h)
#pragma unroll
                for (int i = 0; i < 2; ++i) v2[h][i] = last ? vaN[h][i] : vaC[h][i];
            PG8_LDB(B0, 0, 0); PG8_SCHED; PG8_LDA(At, 0, 0); PG8_STAGE(PG8_SA(1, 1), a1, vaC[1]);
            PG8_WAIT_L(8); PG8_BAR; PG8_WAIT_L(0); PG8_MMA(0, 0, At, B0); PG8_BAR; PG8_SCHED;
            PG8_LDB(B1, 0, 1); PG8_STAGE(PG8_SB(0, 0), b2, voffB);
            PG8_BAR; PG8_WAIT_L(0); PG8_MMA(0, 1, At, B1); PG8_BAR;
            PG8_LDA(At, 0, 1); PG8_STAGE(PG8_SA(0, 0), a2, v2[0]);
            PG8_BAR; PG8_WAIT_L(0); PG8_MMA(1, 0, At, B0); PG8_BAR; PG8_SCHED;
            PG8_STAGE(PG8_SB(0, 1), b2 + hstep, voffB);
            PG8_WAIT_V(6); PG8_BAR; PG8_MMA(1, 1, At, B1); PG8_BAR;
            PG8_LDB(B0, 1, 0); PG8_SCHED; PG8_LDA(At, 1, 0); PG8_STAGE(PG8_SA(0, 1), a2, v2[1]);
            PG8_WAIT_L(8); PG8_BAR; PG8_WAIT_L(0); PG8_MMA(0, 0, At, B0); PG8_BAR; PG8_SCHED;
            PG8_LDB(B1, 1, 1); PG8_STAGE(PG8_SB(1, 0), b3, voffB);
            PG8_BAR; PG8_WAIT_L(0); PG8_MMA(0, 1, At, B1); PG8_BAR;
            PG8_LDA(At, 1, 1); PG8_STAGE(PG8_SA(1, 0), a3, v2[0]);
            PG8_BAR; PG8_WAIT_L(0); PG8_MMA(1, 0, At, B0); PG8_BAR; PG8_SCHED;
            PG8_STAGE(PG8_SB(1, 1), b3 + hstep, voffB);
            PG8_WAIT_V(6); PG8_BAR; PG8_MMA(1, 1, At, B1); PG8_BAR;
        }
        if constexpr (FP8) asm volatile("s_nop 15\n\ts_nop 15" ::: "memory");
        E(acc, cur, wr, wc, fr, fq);
        if (!has_next) break;
#pragma unroll
        for (int a = 0; a < 2; ++a)
#pragma unroll
            for (int b = 0; b < 2; ++b)
#pragma unroll
                for (int m = 0; m < 4; ++m)
#pragma unroll
                    for (int n = 0; n < 2; ++n) acc[a][b][m][n] = (f32x4){0.f, 0.f, 0.f, 0.f};
        cur = nxt; cA = nA; cB = nB; ++ui;
#pragma unroll
        for (int h = 0; h < 2; ++h)
#pragma unroll
            for (int i = 0; i < 2; ++i) vaC[h][i] = vaN[h][i];
    }
    PG8_WAIT_V(0);
    if (wr == 0) PG8_BAR;
    PG8_BAR;
#undef PG8_SA
#undef PG8_SB
#undef PG8_STAGE
#undef PG8_LDA
#undef PG8_LDB
#undef PG8_MMA
#undef PG8_WAIT_V
#undef PG8_WAIT_L
#undef PG8_BAR
#undef PG8_SCHED
}

struct EpiStoreBf16 {
    static constexpr bool PERM = true;
    bf16_t* O; int ldc; const float* bias; int bias_estride; float sc;
    __device__ __forceinline__ void operator()(const f32x4 (&acc)[2][2][4][2], const Unit& u, int wr, int wc, int fr, int fq) const {
        const int row0 = u.pm * BM + wr * 64 + fr, col0 = u.pn * BM + wc * 32 + 8 * fq;
        f32x4 bv[2][2];
#pragma unroll
        for (int bj = 0; bj < 2; ++bj)
#pragma unroll
            for (int n = 0; n < 2; ++n) bv[bj][n] = bias ? *(const f32x4*)(bias + (size_t)u.e * bias_estride + col0 + bj * HALF + 4 * n) : (f32x4){0.f, 0.f, 0.f, 0.f};
#pragma unroll
        for (int ai = 0; ai < 2; ++ai)
#pragma unroll
            for (int m = 0; m < 4; ++m) { bf16_t* rowp = O + (size_t)(row0 + ai * HALF + m * 16) * ldc + col0;
#pragma unroll
                for (int bj = 0; bj < 2; ++bj) { const f32x4 v0 = acc[ai][bj][m][0] * sc + bv[bj][0], v1 = acc[ai][bj][m][1] * sc + bv[bj][1];
                    u32x4 w; w.x = cvt_pk_bf16(v0[0], v0[1]); w.y = cvt_pk_bf16(v0[2], v0[3]); w.z = cvt_pk_bf16(v1[0], v1[1]); w.w = cvt_pk_bf16(v1[2], v1[3]);
                    *(u32x4*)(rowp + bj * HALF) = w; } }
    }
};
struct EpiGlu {
    static constexpr bool PERM = true;
    const bf16_t* Yg; bf16_t* O; const float* bias;
    __device__ __forceinline__ void operator()(const f32x4 (&acc)[2][2][4][2], const Unit& u, int wr, int wc, int fr, int fq) const {
        const int row0 = u.pm * BM + wr * 64 + fr, col0 = u.pn * BM + wc * 32 + 8 * fq;
        f32x4 bv[2][2];
#pragma unroll
        for (int bj = 0; bj < 2; ++bj)
#pragma unroll
            for (int n = 0; n < 2; ++n) bv[bj][n] = *(const f32x4*)(bias + col0 + bj * HALF + 4 * n);
#pragma unroll
        for (int ai = 0; ai < 2; ++ai)
#pragma unroll
            for (int m = 0; m < 4; ++m) { const size_t r = (size_t)(row0 + ai * HALF + m * 16);
#pragma unroll
                for (int bj = 0; bj < 2; ++bj) { const f32x4 v0 = acc[ai][bj][m][0] + bv[bj][0], v1 = acc[ai][bj][m][1] + bv[bj][1];
                    const u32x4 y = *(const u32x4*)(Yg + r * S5W + col0 + bj * HALF);
                    float o[8];
                    o[0] = bflo(y.x) / (1.f + __expf(-v0[0])); o[1] = bfhi(y.x) / (1.f + __expf(-v0[1])); o[2] = bflo(y.y) / (1.f + __expf(-v0[2])); o[3] = bfhi(y.y) / (1.f + __expf(-v0[3]));
                    o[4] = bflo(y.z) / (1.f + __expf(-v1[0])); o[5] = bfhi(y.z) / (1.f + __expf(-v1[1])); o[6] = bflo(y.w) / (1.f + __expf(-v1[2])); o[7] = bfhi(y.w) / (1.f + __expf(-v1[3]));
                    u32x4 w; w.x = cvt_pk_bf16(o[0], o[1]); w.y = cvt_pk_bf16(o[2], o[3]); w.z = cvt_pk_bf16(o[4], o[5]); w.w = cvt_pk_bf16(o[6], o[7]);
                    *(u32x4*)(O + r * D + col0 + bj * HALF) = w; } }
    }
};
struct EpiResid {
    static constexpr bool PERM = false;
    const float* X; float* O; const float* mod;
    __device__ __forceinline__ void operator()(const f32x4 (&acc)[2][2][4][2], const Unit& u, int wr, int wc, int fr, int fq) const {
        const int row0 = u.pm * BM + wr * 64 + fr, col0 = u.pn * BM + wc * 32 + 4 * fq, b = u.pm >> 3;
        f32x4 gv[2][2];
#pragma unroll
        for (int bj = 0; bj < 2; ++bj)
#pragma unroll
            for (int n = 0; n < 2; ++n) { const int c = col0 + bj * HALF + n * 16; gv[bj][n] = *(const f32x4*)(mod + (size_t)b * 12288 + 2 * D + c); }
#pragma unroll
        for (int ai = 0; ai < 2; ++ai)
#pragma unroll
            for (int m = 0; m < 4; ++m) { const size_t off = (size_t)(row0 + ai * HALF + m * 16) * D + col0;
#pragma unroll
                for (int bj = 0; bj < 2; ++bj)
#pragma unroll
                    for (int n = 0; n < 2; ++n) { const f32x4 xv = *(const f32x4*)(X + off + bj * HALF + n * 16); *(f32x4*)(O + off + bj * HALF + n * 16) = xv + gv[bj][n] * acc[ai][bj][m][n]; } }
    }
};
struct EpiSwiglu {
    static constexpr bool PERM = true;
    unsigned char* O; const float* bias; float sc;
    __device__ __forceinline__ void operator()(const f32x4 (&acc)[2][2][4][2], const Unit& u, int wr, int wc, int fr, int fq) const {
        const int row0 = u.pm * BM + wr * 64 + fr, j0 = wc * 32 + 8 * fq, cb = u.pn * HALF + j0;
        f32x4 bg[2], bu[2];
#pragma unroll
        for (int n = 0; n < 2; ++n) { bg[n] = *(const f32x4*)(bias + (size_t)u.e * 4096 + cb + 4 * n); bu[n] = *(const f32x4*)(bias + (size_t)u.e * 4096 + 2048 + cb + 4 * n); }
#pragma unroll
        for (int ai = 0; ai < 2; ++ai)
#pragma unroll
            for (int m = 0; m < 4; ++m) { float o[8];
#pragma unroll
                for (int n = 0; n < 2; ++n)
#pragma unroll
                    for (int e = 0; e < 4; ++e) { float g = acc[ai][0][m][n][e] * sc + bg[n][e], uu = acc[ai][1][m][n][e] * sc + bu[n][e];
                        g = fminf(g, 7.0f); uu = fminf(fmaxf(uu, -7.0f), 7.0f);
                        o[4 * n + e] = (uu + 1.0f) * (g / (1.0f + __expf(-1.702f * g))); }
                u32x2 w; w.x = pk4_fp8(o[0], o[1], o[2], o[3]); w.y = pk4_fp8(o[4], o[5], o[6], o[7]);
                *(u32x2*)(O + (size_t)(row0 + ai * HALF + m * 16) * DFF + cb) = w; }
    }
};
}

#define FI __device__ __forceinline__

FI void transpose_item(const float* W, int K, int N, bf16_t* WT, int row_off, LAS float* scr, int kb, int nb, int lane) {
    const int k0 = 64 * kb, n0 = 32 * nb;
#pragma unroll 8
    for (int i = 0; i < 32; ++i) { const int kk = 2 * i + (lane >> 5); scr[kk * 33 + (lane & 31)] = W[(size_t)(k0 + kk) * N + n0 + (lane & 31)]; }
    LDS_WAIT(); asm volatile("" ::: "memory");
    const int c = lane & 7;
#pragma unroll
    for (int j = 0; j < 4; ++j) { const int n = (lane >> 3) + 8 * j; const LAS float* s = scr + (8 * c) * 33 + n;
        u32x4 o; o.x = pk2(s[0 * 33], s[1 * 33]); o.y = pk2(s[2 * 33], s[3 * 33]); o.z = pk2(s[4 * 33], s[5 * 33]); o.w = pk2(s[6 * 33], s[7 * 33]);
        *(u32x4*)(WT + (size_t)(row_off + n0 + n) * K + k0 + 8 * c) = o; }
    LDS_WAIT(); asm volatile("" ::: "memory");
}

FI void transpose_item_fp8(const float* W, int K, int N, unsigned char* WT, int row_off, LAS float* scr, int kb, int nb, int lane, float scale) {
    const int k0 = 64 * kb, n0 = 32 * nb;
#pragma unroll 8
    for (int i = 0; i < 32; ++i) { const int kk = 2 * i + (lane >> 5); scr[kk * 33 + (lane & 31)] = W[(size_t)(k0 + kk) * N + n0 + (lane & 31)]; }
    LDS_WAIT(); asm volatile("" ::: "memory");
    const int n = lane & 31, hf = lane >> 5; const LAS float* s = scr + (32 * hf) * 33 + n;
    u32x4 o0, o1;
    o0.x = pk4_fp8(s[0 * 33] * scale, s[1 * 33] * scale, s[2 * 33] * scale, s[3 * 33] * scale); o0.y = pk4_fp8(s[4 * 33] * scale, s[5 * 33] * scale, s[6 * 33] * scale, s[7 * 33] * scale);
    o0.z = pk4_fp8(s[8 * 33] * scale, s[9 * 33] * scale, s[10 * 33] * scale, s[11 * 33] * scale); o0.w = pk4_fp8(s[12 * 33] * scale, s[13 * 33] * scale, s[14 * 33] * scale, s[15 * 33] * scale);
    o1.x = pk4_fp8(s[16 * 33] * scale, s[17 * 33] * scale, s[18 * 33] * scale, s[19 * 33] * scale); o1.y = pk4_fp8(s[20 * 33] * scale, s[21 * 33] * scale, s[22 * 33] * scale, s[23 * 33] * scale);
    o1.z = pk4_fp8(s[24 * 33] * scale, s[25 * 33] * scale, s[26 * 33] * scale, s[27 * 33] * scale); o1.w = pk4_fp8(s[28 * 33] * scale, s[29 * 33] * scale, s[30 * 33] * scale, s[31 * 33] * scale);
    unsigned char* dst = WT + (size_t)(row_off + n0 + n) * K + k0 + 32 * hf;
    *(u32x4*)dst = o0; *(u32x4*)(dst + 16) = o1;
    LDS_WAIT(); asm volatile("" ::: "memory");
}

FI void p0_run(const Args& A, LAS unsigned char* lds, int tid, int lane, int wave, int vcu, int G) {
    unsigned char* ws = A.ws;
    unsigned long long* mod = (unsigned long long*)((unsigned*)(ws + WS_CTL) + CW_MOD); unsigned long long* hnorm = (unsigned long long*)((unsigned*)(ws + WS_CTL) + CW_HNORM);
    {
        LAS float* sl = (LAS float*)lds;
        const float* c = A.in[1]; const float* cc = A.in[3];
        for (int i = tid; i < 9 * D; i += NTHR) { const float v = i < 8 * D ? c[i] : cc[i - 8 * D]; sl[i] = v / (1.f + __expf(-v)); }
        __syncthreads();
        const float* wada = A.in[4];
        for (int it = vcu * NWAVES + wave; it < 1536; it += G * NWAVES) {
            const int cg = it % 48, kc = it / 48, n0 = cg * 256 + 4 * lane, k0 = kc * 64;
            f32x4 acc[9];
#pragma unroll
            for (int r = 0; r < 9; ++r) acc[r] = (f32x4){0.f, 0.f, 0.f, 0.f};
#pragma unroll 8
            for (int kk = 0; kk < 64; ++kk) { const f32x4 w = *(const f32x4*)(wada + (size_t)(k0 + kk) * 12288 + n0);
#pragma unroll
                for (int r = 0; r < 9; ++r) { const float s = sl[r * D + k0 + kk]; acc[r] += w * s; } }
#pragma unroll
            for (int r = 0; r < 9; ++r)
#pragma unroll
                for (int e = 0; e < 4; ++e) fix_add(mod + r * 12288 + n0 + e, acc[r][e]);
        }
        __syncthreads();
    }
    {
        LAS float* L = (LAS float*)lds;
        LAS float *w1s = L, *w2s = L + 2112, *w3s = L + 6208, *b1s = L + 10304, *b2s = L + 10368, *b3s = L + 10432, *fqs = L + 10496, *zs = L + 10560, *h1 = L + 10824, *h2 = L + 11336, *h3 = L + 11848;
        for (int i = tid; i < 33 * 64; i += NTHR) w1s[i] = A.in[21][i];
        for (int i = tid; i < 4096; i += NTHR) { w2s[i] = A.in[23][i]; w3s[i] = A.in[25][i]; }
        if (tid < 64) { b1s[tid] = A.in[22][tid]; b2s[tid] = A.in[24][tid]; b3s[tid] = A.in[26][tid]; fqs[tid] = A.in[28][tid]; }
        __syncthreads();
        const float* w4 = A.in[27]; const float* dl = A.in[29]; float* hraw = (float*)(ws + WS_HRAW);
        for (int item = vcu; item < 256; item += G) {
            const int l0 = item * 8;
            if (tid < 264) { const int r = tid / 33, i = tid % 33, l = l0 + r; float z;
                if (i == 0) z = (float)l / 2047.0f;
                else { const int j = (i - 1) & 15; const float band = 1e-4f + (float)j * ((15.0f - 1e-4f) / 15.0f); const float ang = (6.283185307179586f / 2048.0f) * (float)l * band; z = (i <= 16) ? cosf(ang) : -sinf(ang); }
                zs[tid] = z; }
            __syncthreads();
            const int r = tid >> 6, o = tid & 63;
            { float s = b1s[o]; for (int i = 0; i < 33; ++i) s += zs[r * 33 + i] * w1s[i * 64 + o]; h1[r * 64 + o] = sinf(fqs[o] * s); }
            __syncthreads();
            { float s = b2s[o]; for (int i = 0; i < 64; ++i) s += h1[r * 64 + i] * w2s[i * 64 + o]; h2[r * 64 + o] = sinf(fqs[o] * s); }
            __syncthreads();
            { float s = b3s[o]; for (int i = 0; i < 64; ++i) s += h2[r * 64 + i] * w3s[i * 64 + o]; h3[r * 64 + o] = sinf(fqs[o] * s); }
            __syncthreads();
            f32x4 acc[8];
#pragma unroll
            for (int q = 0; q < 8; ++q) acc[q] = (f32x4){0.f, 0.f, 0.f, 0.f};
#pragma unroll 4
            for (int i = 0; i < 64; ++i) { const f32x4 w = *(const f32x4*)(w4 + (size_t)i * 2048 + 4 * tid);
#pragma unroll
                for (int q = 0; q < 8; ++q) acc[q] += w * h3[q * 64 + i]; }
            const f32x4 dv = *(const f32x4*)(dl + 4 * tid);
            f32x4 asum = (f32x4){0.f, 0.f, 0.f, 0.f};
#pragma unroll
            for (int q = 0; q < 8; ++q) { const int l = l0 + q; const float t = (float)l / 2047.0f; f32x4 v;
#pragma unroll
                for (int e = 0; e < 4; ++e) v[e] = acc[q][e] * expf(-t * fabsf(dv[e]));
                *(f32x4*)(hraw + (size_t)l * 2048 + 4 * tid) = v;
                if (!(l == 2047 && 4 * tid >= 1024)) {
#pragma unroll
                    for (int e = 0; e < 4; ++e) asum[e] += fabsf(v[e]); } }
#pragma unroll
            for (int e = 0; e < 4; ++e) fix_add(hnorm + 4 * tid + e, asum[e]);
            __syncthreads();
        }
    }
    {
        const float *lre = A.in[9], *lim = A.in[10], *lst = A.in[11], *bre = A.in[12], *bim = A.in[13], *cre = A.in[14], *cim = A.in[15];
        float* LAM = (float*)(ws + WS_LAM); float* LAML = (float*)(ws + WS_LAML); bf16_t* SB = (bf16_t*)(ws + WS_S5B); bf16_t* SC = (bf16_t*)(ws + WS_S5C);
        for (int idx = vcu * NTHR + tid; idx < 2 * 64 * 4 * 64; idx += G * NTHR) {
            const int ln = idx & 63, T = (idx >> 6) & 3, g = (idx >> 8) & 63, d = idx >> 14;
            {
                const int n = ln & 31, hq = ln >> 5, p = n + 32 * (T >> 1), part = T & 1;
                const int q = (d * 64 + g) * 64 + p;
                const float lr = fminf(lre[q], -1e-4f), li = lim[q], dt = expf(lst[q]), zr = lr * dt, zi = li * dt, er = expf(zr), br = er * cosf(zi), bi = er * sinf(zi);
                const float den = lr * lr + li * li, cr = ((br - 1.f) * lr + bi * li) / den, ci = (bi * lr - (br - 1.f) * li) / den;
                float v[8];
#pragma unroll
                for (int j = 0; j < 8; ++j) { const int h = 8 * hq + j; const float xr = bre[(size_t)q * 16 + h], xi = bim[(size_t)q * 16 + h]; v[j] = part ? (cr * xi + ci * xr) : (cr * xr - ci * xi); }
                u32x4 w; w.x = pk2(v[0], v[1]); w.y = pk2(v[2], v[3]); w.z = pk2(v[4], v[5]); w.w = pk2(v[6], v[7]);
                *(u32x4*)(SB + (size_t)idx * 8) = w;
                if (part == 0 && hq == 0) { LAM[q * 2] = br; LAM[q * 2 + 1] = bi; const float eL = expf((float)SEG * zr), aL = (float)SEG * zi; LAML[q * 2] = eL * cosf(aL); LAML[q * 2 + 1] = eL * sinf(aL); }
            }
            {
                const int hc = ln & 15, qq = ln >> 4; float v[8];
#pragma unroll
                for (int j = 0; j < 8; ++j) { const int k = 32 * T + 8 * qq + j, n = k >> 2, TT = k & 3, p = n + 32 * (TT >> 1), part = TT & 1; const size_t ci = ((size_t)(d * 64 + g) * 16 + hc) * 64 + p; v[j] = part ? -cim[ci] : cre[ci]; }
                u32x4 w; w.x = pk2(v[0], v[1]); w.y = pk2(v[2], v[3]); w.z = pk2(v[4], v[5]); w.w = pk2(v[6], v[7]);
                *(u32x4*)(SC + (size_t)idx * 8) = w;
            }
        }
    }
    {
        __syncthreads();
        LAS float* scr = (LAS float*)(lds + wave * 16384);
        const int gw = vcu * NWAVES + wave, NGW = G * NWAVES;
        constexpr int I_IN = 32 * 128, I_GLU = 16 * 32, I_OUT = 32 * 64, I_GU = 32 * 32 * 128, I_DN = 32 * 32 * 64;
        constexpr int NITEMS = I_IN + I_GLU + I_OUT + I_GU + I_DN;
        _Pragma("unroll 1") for (int rep = 0; rep < REP0D; ++rep)
        for (int it2 = gw; it2 < NITEMS / 2; it2 += NGW)
        _Pragma("unroll 1") for (int sub = 0; sub < 2; ++sub) {
            int r = 2 * it2 + sub;
            if (r < I_IN) { transpose_item(A.in[8], D, DIN, (bf16_t*)(ws + WS_WIN), 0, scr, r / 128, r % 128, lane); continue; } r -= I_IN;
            if (r < I_GLU) { transpose_item(A.in[17], S5W, S5W, (bf16_t*)(ws + WS_WGLU), 0, scr, r / 32, r % 32, lane); continue; } r -= I_GLU;
            if (r < I_OUT) { transpose_item(A.in[31], D, D, (bf16_t*)(ws + WS_WOUT), 0, scr, r / 64, r % 64, lane); continue; } r -= I_OUT;
            if (r < I_GU) { const int e = r / 4096, q = r % 4096, kb = (q >> 1) / 128 * 2 + (q & 1), nb = (q >> 1) % 128, n0 = 32 * nb;
                const int isU = n0 / 2048, pn = (n0 % 2048) / 128, j = n0 % 128, rowmap = 256 * pn + 128 * isU + j;
                transpose_item_fp8(A.in[34] + (size_t)e * D * 4096, D, 4096, ws + WS_WGU + (size_t)e * 4096 * D, rowmap - n0, scr, kb, nb, lane, WSCALE); continue; } r -= I_GU;
            { const int e = r / 2048, q = r % 2048, kb = (q >> 1) / 64 * 2 + (q & 1), nb = (q >> 1) % 64; transpose_item_fp8(A.in[36] + (size_t)e * DFF * D, DFF, D, ws + WS_WDN + (size_t)e * D * DFF, 0, scr, kb, nb, lane, WSCALE); }
        }
    }
}

FI void p1_run(const Args& A, int tid, int lane, int wave, int vcu, int G) {
    unsigned char* ws = A.ws;
    const unsigned long long* mod = (const unsigned long long*)((const unsigned*)(ws + WS_CTL) + CW_MOD); const unsigned long long* hnorm = (const unsigned long long*)((const unsigned*)(ws + WS_CTL) + CW_HNORM);
    const float* bada = A.in[5]; const float* g1 = A.in[6];
    bf16_t* A1 = (bf16_t*)(ws + WS_A1);
    const int gw = vcu * NWAVES + wave, NGW = G * NWAVES;
    { float* modf = (float*)(ws + WS_MODF); for (int i = vcu * NTHR + tid; i < 9 * 12288; i += G * NTHR) modf[i] = fix_get(mod + i) + bada[i % 12288]; }
    for (int m = gw; m < MT; m += NGW) {
        const float* src = m < M ? A.in[0] + (size_t)m * D : A.in[2] + (size_t)(m - M) * D;
        const int mr = m < M ? m / SEQ : 8;
        f32x4 v[8]; float ss = 0.f;
#pragma unroll
        for (int j = 0; j < 8; ++j) { v[j] = *(const f32x4*)(src + 4 * lane + 256 * j); ss += (v[j].x * v[j].x + v[j].y * v[j].y) + (v[j].z * v[j].z + v[j].w * v[j].w); }
        const float rstd = rsqrtf(wave_sum(ss) * (1.0f / D) + 1e-6f);
#pragma unroll
        for (int j = 0; j < 8; ++j) { const int c = 4 * lane + 256 * j;
            const f32x4 gv = *(const f32x4*)(g1 + c);
            const unsigned long long* mp = mod + (size_t)mr * 12288 + c;
            const f32x4 sh = (f32x4){fix_get(mp), fix_get(mp + 1), fix_get(mp + 2), fix_get(mp + 3)} + *(const f32x4*)(bada + c);
            const f32x4 sc = (f32x4){fix_get(mp + D), fix_get(mp + D + 1), fix_get(mp + D + 2), fix_get(mp + D + 3)} + *(const f32x4*)(bada + D + c);
            const f32x4 h = v[j] * rstd * gv * (sc + 1.0f) + sh;
            u32x2 w; w.x = pk2(h.x, h.y); w.y = pk2(h.z, h.w);
            *(u32x2*)(A1 + (size_t)m * D + c) = w; }
    }
    const float* hraw = (const float*)(ws + WS_HRAW); bf16_t* Rg = (bf16_t*)(ws + WS_RG);
    for (int it = gw; it < 512 * 16; it += NGW) {
        const int ib = it >> 4, c = (it & 15) * 64 + lane;
        const float inv = 1.0f / (fix_get(hnorm + c) + fix_get(hnorm + HYW + c));
        float v[8];
#pragma unroll
        for (int jj = 0; jj < 8; ++jj) { const int i = 8 * ib + jj; float x;
            if (i <= 2047) x = hraw[(size_t)(2047 - i) * 2048 + c]; else if (i <= 4094) x = hraw[(size_t)(i - 2048) * 2048 + HYW + c]; else x = 0.f;
            v[jj] = x * inv; }
        u32x4 w; w.x = pk2(v[0], v[1]); w.y = pk2(v[2], v[3]); w.z = pk2(v[4], v[5]); w.w = pk2(v[6], v[7]);
        *(u32x4*)(Rg + (size_t)c * 4096 + 8 * ib) = w;
    }
}

FI void s5_unit(const Args& A, LAS unsigned char* lds, int unit, int lane, int wave) {
    unsigned char* ws = A.ws;
    const int d = unit & 1, g = (unit >> 1) & 63, bp = unit >> 7, dg = d * 64 + g;
    const bf16_t* P = (const bf16_t*)(ws + WS_P); bf16_t* Ys = (bf16_t*)(ws + WS_YS5);
    bf16x8 Bf[4], Cf[4];
#pragma unroll
    for (int T = 0; T < 4; ++T) { Bf[T] = *(const bf16x8*)((const bf16_t*)(ws + WS_S5B) + ((size_t)(dg * 4 + T) * 64 + lane) * 8); Cf[T] = *(const bf16x8*)((const bf16_t*)(ws + WS_S5C) + ((size_t)(dg * 4 + T) * 64 + lane) * 8); }
    const int n = lane & 31, hh = lane >> 5;
    const float* LAM = (const float*)(ws + WS_LAM) + (size_t)dg * 128; const float* LAML = (const float*)(ws + WS_LAML) + (size_t)dg * 128;
    const float lr0 = LAM[n * 2], li0 = LAM[n * 2 + 1], lr1 = LAM[(n + 32) * 2], li1 = LAM[(n + 32) * 2 + 1];
    const int r = lane & 31, bsel = (r >> 2) & 1, tau = (r & 3) + 4 * (r >> 3), b = 2 * bp + bsel, kofs = g * 16 + 8 * (lane >> 5);
    const int seg0 = wave * SEG;
    auto rowp = [&](int pos) -> const bf16_t* {
        int row; if (pos < CTXL) { const int tc = d ? (CTXL - 1 - pos) : pos; row = M + b * CTXL + tc; } else { const int q = pos - CTXL; const int tl = d ? (SEQ - 1 - q) : q; row = b * SEQ + tl; }
        return P + (size_t)row * DIN + kofs; };
    const f32x16 z16 = {0.f, 0.f, 0.f, 0.f, 0.f, 0.f, 0.f, 0.f, 0.f, 0.f, 0.f, 0.f, 0.f, 0.f, 0.f, 0.f};
    float xr0 = 0.f, xi0 = 0.f, xr1 = 0.f, xi1 = 0.f;
    {
        bf16x8 aC = *(const bf16x8*)rowp(seg0 + tau), aN = aC;
#pragma unroll 1
        for (int st = 0; st < SEG / 16; ++st) {
            if (st + 1 < SEG / 16) aN = *(const bf16x8*)rowp(seg0 + 16 * (st + 1) + tau);
            const f32x16 c0 = __builtin_amdgcn_mfma_f32_32x32x16_bf16(aC, Bf[0], z16, 0, 0, 0), c1 = __builtin_amdgcn_mfma_f32_32x32x16_bf16(aC, Bf[1], z16, 0, 0, 0);
            const f32x16 c2 = __builtin_amdgcn_mfma_f32_32x32x16_bf16(aC, Bf[2], z16, 0, 0, 0), c3 = __builtin_amdgcn_mfma_f32_32x32x16_bf16(aC, Bf[3], z16, 0, 0, 0);
#pragma unroll
            for (int tt = 0; tt < 16; ++tt) {
                const float nr0 = lr0 * xr0 - li0 * xi0 + c0[tt], ni0 = lr0 * xi0 + li0 * xr0 + c1[tt]; xr0 = nr0; xi0 = ni0;
                const float nr1 = lr1 * xr1 - li1 * xi1 + c2[tt], ni1 = lr1 * xi1 + li1 * xr1 + c3[tt]; xr1 = nr1; xi1 = ni1; }
            aC = aN;
        }
    }
    LAS float* Es = (LAS float*)(lds + 8 * 8704);
    *(LAS f32x4*)(Es + (wave * 64 + lane) * 4) = (f32x4){xr0, xi0, xr1, xi1};
    __syncthreads();
    {
        const float Lr0 = LAML[n * 2], Li0 = LAML[n * 2 + 1], Lr1 = LAML[(n + 32) * 2], Li1 = LAML[(n + 32) * 2 + 1];
        xr0 = 0.f; xi0 = 0.f; xr1 = 0.f; xi1 = 0.f;
#pragma unroll 1
        for (int w = 0; w < wave; ++w) { const f32x4 e = *(LAS f32x4*)(Es + (w * 64 + lane) * 4);
            const float nr0 = Lr0 * xr0 - Li0 * xi0 + e.x, ni0 = Lr0 * xi0 + Li0 * xr0 + e.y; xr0 = nr0; xi0 = ni0;
            const float nr1 = Lr1 * xr1 - Li1 * xi1 + e.z, ni1 = Lr1 * xi1 + Li1 * xr1 + e.w; xr1 = nr1; xi1 = ni1; }
    }
    {
        LAS unsigned char* Xs = lds + wave * 8704;
        bf16x8 aC = *(const bf16x8*)rowp(seg0 + tau), aN = aC;
#pragma unroll 1
        for (int st = 0; st < SEG / 16; ++st) {
            const int pos0 = seg0 + 16 * st;
            if (st + 1 < SEG / 16) aN = *(const bf16x8*)rowp(pos0 + 16 + tau);
            f32x16 c0 = __builtin_amdgcn_mfma_f32_32x32x16_bf16(aC, Bf[0], z16, 0, 0, 0), c1 = __builtin_amdgcn_mfma_f32_32x32x16_bf16(aC, Bf[1], z16, 0, 0, 0);
            f32x16 c2 = __builtin_amdgcn_mfma_f32_32x32x16_bf16(aC, Bf[2], z16, 0, 0, 0), c3 = __builtin_amdgcn_mfma_f32_32x32x16_bf16(aC, Bf[3], z16, 0, 0, 0);
#pragma unroll
            for (int tt = 0; tt < 16; ++tt) {
                const float nr0 = lr0 * xr0 - li0 * xi0 + c0[tt], ni0 = lr0 * xi0 + li0 * xr0 + c1[tt]; xr0 = nr0; xi0 = ni0; c0[tt] = nr0; c1[tt] = ni0;
                const float nr1 = lr1 * xr1 - li1 * xi1 + c2[tt], ni1 = lr1 * xi1 + li1 * xr1 + c3[tt]; xr1 = nr1; xi1 = ni1; c2[tt] = nr1; c3[tt] = ni1; }
            if (pos0 >= CTXL) {
#pragma unroll
                for (int tt = 0; tt < 16; ++tt) { u32x2 w; w.x = pk2(c0[tt], c1[tt]); w.y = pk2(c2[tt], c3[tt]); *(LAS u32x2*)(Xs + (hh * 16 + tt) * 272 + 8 * n) = w; }
                LDS_WAIT();
#pragma unroll
                for (int bt = 0; bt < 2; ++bt) {
                    f32x4 y = (f32x4){0.f, 0.f, 0.f, 0.f};
#pragma unroll
                    for (int ks = 0; ks < 4; ++ks) { const bf16x8 xf = *(const LAS bf16x8*)(Xs + (bt * 16 + (lane & 15)) * 272 + (32 * ks + 8 * (lane >> 4)) * 2); y = __builtin_amdgcn_mfma_f32_16x16x32_bf16(Cf[ks], xf, y, 0, 0, 0); }
                    const int q = pos0 + (lane & 15) - CTXL, tl = d ? (SEQ - 1 - q) : q, bb = 2 * bp + bt;
                    u32x2 w; w.x = pk2(y[0], y[1]); w.y = pk2(y[2], y[3]);
                    *(u32x2*)(Ys + ((size_t)(d * M + bb * SEQ + tl)) * S5W + g * 16 + 4 * (lane >> 4)) = w;
                }
                LDS_WAIT();
            }
            aC = aN;
        }
    }
    __syncthreads();
}

FI void h1_item(const Args& A, LAS unsigned char* lds, int item, int tid) {
    unsigned char* ws = A.ws;
    const bf16_t* P = (const bf16_t*)(ws + WS_P); bf16_t* Vt = (bf16_t*)(ws + WS_VT);
    const int gr = item >> 3, cg = item & 7, b = gr >> 5, t0 = (gr & 31) * 64, c0 = cg * 128;
    for (int idx = tid; idx < 2 * 64 * 16; idx += NTHR) { const int ch = idx >> 10, rem = idx & 1023, row = rem >> 4, sg = rem & 15;
        const u32x4 v = *(const u32x4*)(P + (size_t)(b * SEQ + t0 + row) * DIN + S5W + ch * HYW + c0 + sg * 8);
        *(LAS u32x4*)(lds + ch * 16896 + (row + 1) * 256 + sg * 16) = v; }
    if (tid < 64) { const int ch = tid >> 5, rr = (tid >> 4) & 1, sg = tid & 15; *(LAS u32x4*)(lds + ch * 16896 + (rr ? 65 : 0) * 256 + sg * 16) = (u32x4){0u, 0u, 0u, 0u}; }
    __syncthreads();
    const int c = tid & 127, tq = tid >> 7, cc = c0 + c;
    const float* cw = A.in[19]; const float* cb = A.in[20];
    const float w0v = cw[cc], w1v = cw[3072 + cc], w2v = cw[6144 + cc], bv = cb[cc];
    const float w0x = cw[HYW + cc], w1x = cw[3072 + HYW + cc], w2x = cw[6144 + HYW + cc], bx = cb[HYW + cc];
    const LAS bf16_t* Vs = (const LAS bf16_t*)lds; const LAS bf16_t* Xs = (const LAS bf16_t*)(lds + 16896);
    float o[16];
#pragma unroll
    for (int i = 0; i < 16; ++i) { const int t = tq * 16 + i;
        const float v = w0v * bf1(Vs[t * 128 + c]) + w1v * bf1(Vs[(t + 1) * 128 + c]) + w2v * bf1(Vs[(t + 2) * 128 + c]) + bv;
        const float x = w0x * bf1(Xs[t * 128 + c]) + w1x * bf1(Xs[(t + 1) * 128 + c]) + w2x * bf1(Xs[(t + 2) * 128 + c]) + bx;
        o[i] = v * x; }
    bf16_t* dst = Vt + ((size_t)(cc * NB + b) * SEQ + t0 + tq * 16);
    u32x4 w0; w0.x = pk2(o[0], o[1]); w0.y = pk2(o[2], o[3]); w0.z = pk2(o[4], o[5]); w0.w = pk2(o[6], o[7]);
    u32x4 w1; w1.x = pk2(o[8], o[9]); w1.y = pk2(o[10], o[11]); w1.z = pk2(o[12], o[13]); w1.w = pk2(o[14], o[15]);
    *(u32x4*)dst = w0; *(u32x4*)(dst + 8) = w1;
    __syncthreads();
}

constexpr int RT_STRIDE = 8208, VS_OFF = 8 * RT_STRIDE, VS_STRIDE = 4112;
FI void longconv_channel(const Args& A, LAS unsigned char* lds, int c, int tid, int lane, int wave) {
    unsigned char* ws = A.ws;
    const bf16_t* Rg = (const bf16_t*)(ws + WS_RG) + (size_t)c * 4096; const bf16_t* Vt = (const bf16_t*)(ws + WS_VT) + (size_t)c * NB * SEQ; bf16_t* LC = (bf16_t*)(ws + WS_LCT) + (size_t)c * NB * SEQ;
    for (int i = tid; i < VS_OFF / 16; i += NTHR) *(LAS u32x4*)(lds + i * 16) = (u32x4){0u, 0u, 0u, 0u};
    for (int i = tid; i < NB * SEQ / 8; i += NTHR) { const int bb = i >> 8, s8 = i & 255; *(LAS u32x4*)(lds + VS_OFF + bb * VS_STRIDE + s8 * 16) = *(const u32x4*)(Vt + (size_t)bb * SEQ + s8 * 8); }
    __syncthreads();
    for (int i = tid; i < 4096; i += NTHR) { const bf16_t v = Rg[i];
#pragma unroll
        for (int r = 0; r < 8; ++r) *(LAS bf16_t*)(lds + r * RT_STRIDE + (i + r) * 2) = v; }
    __syncthreads();
    const int a = lane & 15, q = lane >> 4, r = (a + 1) & 7;
    const LAS unsigned char* vb = lds + VS_OFF + (lane & 7) * VS_STRIDE + 16 * q;
#pragma unroll 1
    for (int grp = 0; grp < 2; ++grp) {
        const int i0 = wave * 16 + grp * 8;
        const LAS unsigned char* rb = lds + r * RT_STRIDE + 2 * (2047 - 16 * (i0 + 7) - a + 8 * q + r);
        f32x4 acc[8];
#pragma unroll
        for (int ii = 0; ii < 8; ++ii) acc[ii] = (f32x4){0.f, 0.f, 0.f, 0.f};
#pragma unroll 2
        for (int j = 0; j < 64; ++j) {
            const bf16x8 bfr = *(const LAS bf16x8*)(vb + 64 * j);
#pragma unroll
            for (int ii = 0; ii < 8; ++ii) { const bf16x8 afr = *(const LAS bf16x8*)(rb + 32 * (7 - ii) + 64 * j); acc[ii] = __builtin_amdgcn_mfma_f32_16x16x32_bf16(afr, bfr, acc[ii], 0, 0, 0); }
        }
        if (a < 8) {
#pragma unroll
            for (int ii = 0; ii < 8; ++ii) { u32x2 w; w.x = pk2(acc[ii][0], acc[ii][1]); w.y = pk2(acc[ii][2], acc[ii][3]); *(u32x2*)(LC + (size_t)a * SEQ + 16 * (i0 + ii) + 4 * q) = w; }
        }
    }
    __syncthreads();
}

FI void s5_combine(const Args& A, int gtid, int gthreads) {
    unsigned char* ws = A.ws;
    const bf16_t* P = (const bf16_t*)(ws + WS_P); const bf16_t* Ys = (const bf16_t*)(ws + WS_YS5); bf16_t* Yg = (bf16_t*)(ws + WS_YG); const float* dsk = A.in[16];
    for (int idx = gtid; idx < M * 128; idx += gthreads) {
        const int row = idx >> 7, c8 = (idx & 127) * 8;
        const u32x4 u = *(const u32x4*)(P + (size_t)row * DIN + c8), yf = *(const u32x4*)(Ys + (size_t)row * S5W + c8), yb = *(const u32x4*)(Ys + (size_t)(M + row) * S5W + c8);
        const f32x4 d0 = *(const f32x4*)(dsk + c8), d1 = *(const f32x4*)(dsk + c8 + 4);
        float y[8];
        y[0] = bflo(u.x) * d0.x + bflo(yf.x) + bflo(yb.x); y[1] = bfhi(u.x) * d0.y + bfhi(yf.x) + bfhi(yb.x);
        y[2] = bflo(u.y) * d0.z + bflo(yf.y) + bflo(yb.y); y[3] = bfhi(u.y) * d0.w + bfhi(yf.y) + bfhi(yb.y);
        y[4] = bflo(u.z) * d1.x + bflo(yf.z) + bflo(yb.z); y[5] = bfhi(u.z) * d1.y + bfhi(yf.z) + bfhi(yb.z);
        y[6] = bflo(u.w) * d1.z + bflo(yf.w) + bflo(yb.w); y[7] = bfhi(u.w) * d1.w + bfhi(yf.w) + bfhi(yb.w);
#pragma unroll
        for (int e = 0; e < 8; ++e) y[e] = 0.5f * y[e] * (1.0f + erff(y[e] * 0.70710678118654752f));
        u32x4 w; w.x = pk2(y[0], y[1]); w.y = pk2(y[2], y[3]); w.z = pk2(y[4], y[5]); w.w = pk2(y[6], y[7]);
        *(u32x4*)(Yg + (size_t)row * S5W + c8) = w;
    }
}

FI void h3_item(const Args& A, LAS unsigned char* lds, int item, int tid) {
    unsigned char* ws = A.ws;
    const bf16_t* P = (const bf16_t*)(ws + WS_P); const bf16_t* LC = (const bf16_t*)(ws + WS_LCT); bf16_t* Yc = (bf16_t*)(ws + WS_YCAT);
    const int gr = item >> 3, cg = item & 7, b = gr >> 5, t0 = (gr & 31) * 64, c0 = cg * 128;
    for (int idx = tid; idx < 3 * 64 * 16; idx += NTHR) { const int ch = idx >> 10, rem = idx & 1023, row = rem >> 4, sg = rem & 15;
        const u32x4 v = *(const u32x4*)(P + (size_t)(b * SEQ + t0 + row) * DIN + S5W + ch * HYW + c0 + sg * 8);
        *(LAS u32x4*)(lds + ch * 16896 + (row + 1) * 256 + sg * 16) = v; }
    if (tid < 96) { const int ch = tid >> 5, rr = (tid >> 4) & 1, sg = tid & 15; *(LAS u32x4*)(lds + ch * 16896 + (rr ? 65 : 0) * 256 + sg * 16) = (u32x4){0u, 0u, 0u, 0u}; }
    LAS bf16_t* Ls = (LAS bf16_t*)(lds + 3 * 16896);
    for (int idx = tid; idx < 128 * 8; idx += NTHR) { const int c = idx >> 3, pc = idx & 7;
        const u32x4 v = *(const u32x4*)(LC + (size_t)((c0 + c) * NB + b) * SEQ + t0 + pc * 8);
        const unsigned wv[4] = {v.x, v.y, v.z, v.w};
#pragma unroll
        for (int e = 0; e < 4; ++e) { Ls[(pc * 8 + 2 * e) * 128 + c] = (bf16_t)(wv[e] & 0xffffu); Ls[(pc * 8 + 2 * e + 1) * 128 + c] = (bf16_t)(wv[e] >> 16); } }
    __syncthreads();
    const int c = tid & 127, tq = tid >> 7, cc = c0 + c;
    const float* cw = A.in[19]; const float* cb = A.in[20];
    const float w0v = cw[cc], w1v = cw[3072 + cc], w2v = cw[6144 + cc], bv = cb[cc];
    const float w0x = cw[HYW + cc], w1x = cw[3072 + HYW + cc], w2x = cw[6144 + HYW + cc], bx = cb[HYW + cc];
    const float w0z = cw[2 * HYW + cc], w1z = cw[3072 + 2 * HYW + cc], w2z = cw[6144 + 2 * HYW + cc], bz = cb[2 * HYW + cc];
    const float dd = A.in[30][cc];
    const LAS bf16_t* Vs = (const LAS bf16_t*)lds; const LAS bf16_t* Xs = (const LAS bf16_t*)(lds + 16896); const LAS bf16_t* Zs = (const LAS bf16_t*)(lds + 2 * 16896);
#pragma unroll 4
    for (int i = 0; i < 16; ++i) { const int t = tq * 16 + i;
        const float v = w0v * bf1(Vs[t * 128 + c]) + w1v * bf1(Vs[(t + 1) * 128 + c]) + w2v * bf1(Vs[(t + 2) * 128 + c]) + bv;
        const float x = w0x * bf1(Xs[t * 128 + c]) + w1x * bf1(Xs[(t + 1) * 128 + c]) + w2x * bf1(Xs[(t + 2) * 128 + c]) + bx;
        const float z = w0z * bf1(Zs[t * 128 + c]) + w1z * bf1(Zs[(t + 1) * 128 + c]) + w2z * bf1(Zs[(t + 2) * 128 + c]) + bz;
        const float vg = v * x, y = (bf1(Ls[t * 128 + c]) + vg * dd) * z;
        Yc[(size_t)(b * SEQ + t0 + t) * D + S5W + cc] = (bf16_t)f2bf(y); }
    __syncthreads();
}

FI void p7_run(const Args& A, LAS unsigned char* lds, int lane, int wave, int vcu, int G) {
    unsigned char* ws = A.ws;
    const float* x1 = (const float*)(ws + WS_X1); unsigned char* A2 = ws + WS_A2;
    const float* mod = (const float*)(ws + WS_MODF); const float* g2 = A.in[7];
    const float* wrt = A.in[32]; const float* brt = A.in[33];
    int* cnt = (int*)(ws + WS_CTL) + CW_CNT; int* rowl = (int*)(ws + WS_ROWL); int* pk = (int*)(ws + WS_PK); float* gate = (float*)(ws + WS_GATE);
    LAS float* hb = (LAS float*)(lds + wave * 8192);
    const int e = lane & 31, kh = lane >> 5;
    for (int it = vcu; it < M / 64; it += G) {
        const int rbase = it * 64 + wave * 8, b = rbase / SEQ;
        float rstd[8];
#pragma unroll
        for (int r = 0; r < 8; ++r) { float ss = 0.f;
#pragma unroll
            for (int j = 0; j < 8; ++j) { const f32x4 v = *(const f32x4*)(x1 + (size_t)(rbase + r) * D + 4 * lane + 256 * j); ss += (v.x * v.x + v.y * v.y) + (v.z * v.z + v.w * v.w); }
            rstd[r] = rsqrtf(wave_sum(ss) * (1.0f / D) + 1e-6f); }
        float lg[8];
#pragma unroll
        for (int r = 0; r < 8; ++r) lg[r] = 0.f;
#pragma unroll 1
        for (int kc = 0; kc < 8; ++kc) {
            const int col = kc * 256 + 4 * lane;
            const f32x4 gv = *(const f32x4*)(g2 + col);
            const f32x4 sh = *(const f32x4*)(mod + (size_t)b * 12288 + 3 * D + col);
            const f32x4 sc = *(const f32x4*)(mod + (size_t)b * 12288 + 4 * D + col) + 1.0f;
#pragma unroll
            for (int r = 0; r < 8; ++r) { const f32x4 xv = *(const f32x4*)(x1 + (size_t)(rbase + r) * D + col);
                const f32x4 h = xv * rstd[r] * gv * sc + sh;
                *(unsigned*)(A2 + (size_t)(rbase + r) * D + col) = pk4_fp8(h.x, h.y, h.z, h.w);
                *(LAS f32x4*)(hb + r * 256 + 4 * lane) = h; }
            LDS_WAIT();
            const float* wp = wrt + (size_t)(kc * 256 + kh * 128) * NE + e;
#pragma unroll 2
            for (int jj = 0; jj < 128; jj += 4) {
                const float w0 = wp[(jj + 0) * NE], w1 = wp[(jj + 1) * NE], w2 = wp[(jj + 2) * NE], w3 = wp[(jj + 3) * NE];
#pragma unroll
                for (int r = 0; r < 8; ++r) { const f32x4 hv = *(const LAS f32x4*)(hb + r * 256 + kh * 128 + jj); lg[r] += (hv.x * w0 + hv.y * w1) + (hv.z * w2 + hv.w * w3); }
            }
            LDS_WAIT();
        }
        const float be = brt[e];
#pragma unroll
        for (int r = 0; r < 8; ++r) {
            float v = lg[r] + __shfl_xor(lg[r], 32) + be;
            float tv[4]; int ti[4];
#pragma unroll
            for (int k = 0; k < 4; ++k) { float bvv = v; int bi = e;
#pragma unroll
                for (int o = 16; o >= 1; o >>= 1) { const float ov = __shfl_xor(bvv, o); const int oi = __shfl_xor(bi, o); if (ov > bvv || (ov == bvv && oi < bi)) { bvv = ov; bi = oi; } }
                tv[k] = bvv; ti[k] = bi; if (e == bi) v = -3.0e38f; }
            const float e1 = __expf(tv[1] - tv[0]), e2 = __expf(tv[2] - tv[0]), e3 = __expf(tv[3] - tv[0]), inv = 1.0f / (1.0f + e1 + e2 + e3);
            if (lane < 4) { const int ex = lane == 0 ? ti[0] : lane == 1 ? ti[1] : lane == 2 ? ti[2] : ti[3];
                const float gx = (lane == 0 ? 1.0f : lane == 1 ? e1 : lane == 2 ? e2 : e3) * inv;
                const int row = rbase + r, slot = atomicAdd(cnt + ex, 1);
                rowl[ex * M + slot] = row; pk[row * 4 + lane] = ex * M + slot; gate[row * 4 + lane] = gx; }
        }
    }
}

FI void moe_table(const Args& A, LAS unsigned char* lds, int tid) {
    const int* cnt = (const int*)(A.ws + WS_CTL) + CW_CNT;
    LAS int* tw = (LAS int*)(lds + LDSCTL_OFF);
    if (tid < 64) { const int n = tid < NE ? cnt[tid] : 0; int p = (n + 255) >> 8;
#pragma unroll
        for (int o = 1; o < 32; o <<= 1) { const int q = __shfl_up(p, o); if ((tid & 63) >= o) p += q; }
        if (tid < NE) { tw[LW_TST + tid + 1] = p; tw[LW_CNT + tid] = n; } if (tid == 0) tw[LW_TST] = 0; }
    __syncthreads();
}

FI void p10_run(const Args& A, LAS unsigned char* lds, int lane, int wave, int vcu, int G) {
    unsigned char* ws = A.ws;
    const float* x1 = (const float*)(ws + WS_X1); const bf16_t* Yd = (const bf16_t*)(ws + WS_YD);
    const float* mod = (const float*)(ws + WS_MODF); const float* gf = A.in[38];
    const int* pk = (const int*)(ws + WS_PK); const float* gate = (const float*)(ws + WS_GATE);
    const LAS int* tst = (const LAS int*)(lds + LDSCTL_OFF) + LW_TST;
    const int gw = vcu * NWAVES + wave, NGW = G * NWAVES;
    for (int row = gw; row < M; row += NGW) {
        const int b = row / SEQ; size_t hr[4]; float gk[4];
#pragma unroll
        for (int k = 0; k < 4; ++k) { const int p = pk[row * 4 + k], ex = p / M, slot = p % M; hr[k] = (size_t)(tst[ex] * 256 + slot) * D; gk[k] = gate[row * 4 + k]; }
        f32x4 x2[8]; float ss = 0.f;
#pragma unroll
        for (int j = 0; j < 8; ++j) { const int col = 4 * lane + 256 * j;
            f32x4 s = (f32x4){0.f, 0.f, 0.f, 0.f};
#pragma unroll
            for (int k = 0; k < 4; ++k) { const u32x2 y = *(const u32x2*)(Yd + hr[k] + col); s += (f32x4){bflo(y.x), bfhi(y.x), bflo(y.y), bfhi(y.y)} * gk[k]; }
            const f32x4 ga = *(const f32x4*)(mod + (size_t)b * 12288 + 5 * D + col);
            x2[j] = *(const f32x4*)(x1 + (size_t)row * D + col) + ga * s;
            ss += (x2[j].x * x2[j].x + x2[j].y * x2[j].y) + (x2[j].z * x2[j].z + x2[j].w * x2[j].w); }
        const float rstd = rsqrtf(wave_sum(ss) * (1.0f / D) + 1e-6f);
#pragma unroll
        for (int j = 0; j < 8; ++j) { const int col = 4 * lane + 256 * j; *(f32x4*)(A.out + (size_t)row * D + col) = x2[j] * rstd * *(const f32x4*)(gf + col); }
    }
}

__global__ void __launch_bounds__(NTHR, 2) fwd_kernel(Args args) {
    extern __shared__ __attribute__((aligned(16))) unsigned char lds_raw[];
    LAS unsigned char* lds = (LAS unsigned char*)lds_raw;
    const int tid = threadIdx.x, lane = tid & 63, wave = __builtin_amdgcn_readfirstlane(tid >> 6);
    const int G = gridDim.x; const int bx = blockIdx.x; const int vcu = (G % 8 == 0) ? (bx % 8) * (G / 8) + bx / 8 : bx;
    unsigned char* ws = args.ws;
    for (int u = tid; u < (LDS_BYTES - LDSCTL_OFF) / 4; u += NTHR) ((LAS unsigned*)(lds + LDSCTL_OFF))[u] = 0u;
    __syncthreads();
    XcdBarrier bar; bar.bar = (unsigned*)(ws + WS_CTL) + CW_BAR; bar.x = 0; bar.st = nullptr;
#if !MK_SPLIT
    bar = xcd_barrier_post((unsigned*)(ws + WS_CTL) + CW_BAR, (volatile LAS unsigned*)(lds + LDSCTL_OFF) + LW_BAR);
#endif
    const int lo = args.ph_lo, hi = args.ph_hi;
#ifndef PHASE_MASK
#define PHASE_MASK 0x7ff
#endif
#define IN(k) (((PHASE_MASK >> (k)) & 1) && lo <= (k) && (k) < hi)
#if MK_SPLIT
#define SEAM(k) do { } while (0)
#else
#define SEAM(k) do { if (IN(k) && IN((k) + 1)) xcd_barrier(bar); } while (0)
#endif
    const float* modp = (const float*)(ws + WS_MODF);

    if (IN(0)) { p0_run(args, lds, tid, lane, wave, vcu, G); } SEAM(0);
    if (IN(1)) { p1_run(args, tid, lane, wave, vcu, G); } SEAM(1);
    if (IN(2)) {
        pg8::DenseSched S{(const bf16_t*)(ws + WS_A1), (const bf16_t*)(ws + WS_WIN), 2 * D, M / 256, DIN / 256, G, bx, M / 256, MC / 256, S5W / 256};
        pg8::EpiStoreBf16 E{(bf16_t*)(ws + WS_P), DIN, nullptr, 0, 1.0f};
        _Pragma("unroll 1") for (int rep = 0; rep < REP2; ++rep)
        pg8::gemm_phase<false>(lds, 2 * D, S, E);
    } SEAM(2);
    if (IN(3)) {
        _Pragma("unroll 1") for (int rep = 0; rep < REP3; ++rep) {
        for (int u = vcu; u < 512; u += G) s5_unit(args, lds, u, lane, wave);
        for (int it = vcu; it < 2048; it += G) h1_item(args, lds, it, tid); }
    } SEAM(3);
    if (IN(4)) {
        _Pragma("unroll 1") for (int rep = 0; rep < REP4; ++rep) {
        s5_combine(args, vcu * NTHR + tid, G * NTHR);
        for (int c = vcu; c < HYW; c += G) longconv_channel(args, lds, c, tid, lane, wave); }
    } SEAM(4);
    if (IN(5)) {
        for (int it = vcu; it < 2048; it += G) h3_item(args, lds, it, tid);
        pg8::DenseSched S{(const bf16_t*)(ws + WS_YG), (const bf16_t*)(ws + WS_WGLU), 2 * S5W, M / 256, S5W / 256, G, bx, 0, 0, 0};
        pg8::EpiGlu E{(const bf16_t*)(ws + WS_YG), (bf16_t*)(ws + WS_YCAT), args.in[18]};
        pg8::gemm_phase<false>(lds, 2 * S5W, S, E);
    } SEAM(5);
    if (IN(6)) {
        pg8::DenseSched S{(const bf16_t*)(ws + WS_YCAT), (const bf16_t*)(ws + WS_WOUT), 2 * D, M / 256, D / 256, G, bx, 0, 0, 0};
        pg8::EpiResid E{args.in[0], (float*)(ws + WS_X1), modp};
        _Pragma("unroll 1") for (int rep = 0; rep < REP6; ++rep)
        pg8::gemm_phase<false>(lds, 2 * D, S, E);
    } SEAM(6);
    if (IN(7)) { p7_run(args, lds, lane, wave, vcu, G); } SEAM(7);
    if (IN(8)) {
        moe_table(args, lds, tid);
        pg8::MoeSched<true> S{ws + WS_A2, ws + WS_WGU, D, 16, G, bx, (size_t)4096 * D,
                              (const LAS int*)(lds + LDSCTL_OFF) + LW_TST, (const LAS int*)(lds + LDSCTL_OFF) + LW_CNT, (const int*)(ws + WS_ROWL)};
        pg8::EpiSwiglu E{ws + WS_H, args.in[35], 1.0f / WSCALE};
        _Pragma("unroll 1") for (int rep = 0; rep < REP8; ++rep)
        pg8::gemm_phase<true>(lds, D, S, E);
    } SEAM(8);
    if (IN(9)) {
        moe_table(args, lds, tid);
        pg8::MoeSched<false> S{ws + WS_H, ws + WS_WDN, DFF, 8, G, bx, (size_t)D * DFF,
                               (const LAS int*)(lds + LDSCTL_OFF) + LW_TST, (const LAS int*)(lds + LDSCTL_OFF) + LW_CNT, (const int*)(ws + WS_ROWL)};
        pg8::EpiStoreBf16 E{(bf16_t*)(ws + WS_YD), D, args.in[37], D, 1.0f / WSCALE};
        _Pragma("unroll 1") for (int rep = 0; rep < REP9; ++rep)
        pg8::gemm_phase<true>(lds, DFF, S, E);
    } SEAM(9);
    if (IN(10)) { moe_table(args, lds, tid); p10_run(args, lds, lane, wave, vcu, G); }
#undef IN
#undef SEAM
}

extern "C" void kernel_launch(void* const* d_in, const int* in_sizes, int n_in, void* d_out, int out_size, void* d_ws, size_t ws_size, hipStream_t stream) {
    static int grid = 0;
    if (grid == 0) {
        if (n_in != 39 || out_size != M * D || ws_size < WS_END) { fprintf(stderr, "kernel_launch: unexpected problem (n_in %d, out %d, ws %zu)\n", n_in, out_size, ws_size); grid = -1; return; }
        int dev = 0, cus = 0, per_cu = 0;
        if (hipGetDevice(&dev) != hipSuccess || hipDeviceGetAttribute(&cus, hipDeviceAttributeMultiprocessorCount, dev) != hipSuccess) { grid = -1; return; }
        if (hipFuncSetAttribute((const void*)fwd_kernel, hipFuncAttributeMaxDynamicSharedMemorySize, LDS_BYTES) != hipSuccess) { fprintf(stderr, "kernel_launch: hipFuncSetAttribute failed\n"); grid = -1; return; }
        if (hipOccupancyMaxActiveBlocksPerMultiprocessor(&per_cu, (const void*)fwd_kernel, NTHR, LDS_BYTES) != hipSuccess || per_cu < 1) fprintf(stderr, "kernel_launch: occupancy query says %d\n", per_cu);
        (void)hipGetLastError();
        grid = cus;
    }
    if (grid < 0) return;
    (void)in_sizes;
    if (hipMemsetAsync((char*)d_ws + WS_CTL, 0, CTL_ZERO_BYTES, stream) != hipSuccess) { fprintf(stderr, "kernel_launch: memset failed\n"); return; }
    Args a{};
    for (int i = 0; i < 39; ++i) a.in[i] = (const float*)d_in[i];
    a.out = (float*)d_out; a.ws = (unsigned char*)d_ws;
#if MK_SPLIT
    for (int p = 0; p < NPHASE; ++p) { a.ph_lo = p; a.ph_hi = p + 1; hipLaunchKernelGGL(fwd_kernel, dim3(grid), dim3(NTHR), LDS_BYTES, stream, a); }
#else
    a.ph_lo = 0; a.ph_hi = NPHASE;
    hipLaunchKernelGGL(fwd_kernel, dim3(grid), dim3(NTHR), LDS_BYTES, stream, a);
#endif
    const hipError_t le = hipPeekAtLastError();
    if (le != hipSuccess) fprintf(stderr, "kernel_launch: launch failed: %s\n", hipGetErrorName(le));
}
```

```cpp
#include <hip/hip_runtime.h>
#include <cstdio>
#include <cstdint>

#ifndef MK_SPLIT
#define MK_SPLIT 0
#endif

#ifndef REP0D
#define REP0D 1
#endif
#ifndef REP2
#define REP2 1
#endif
#ifndef REP1
#define REP1 1
#endif
#ifndef REP5
#define REP5 1
#endif
#ifndef REP7
#define REP7 1
#endif
#ifndef REP10
#define REP10 1
#endif
#ifndef REP0A
#define REP0A 1
#endif
#ifndef REP3
#define REP3 1
#endif
#ifndef REP4
#define REP4 1
#endif
#ifndef REP6
#define REP6 1
#endif
#ifndef REP8
#define REP8 1
#endif
#ifndef REP9
#define REP9 1
#endif
#define GAS __attribute__((address_space(1)))
#define LAS __attribute__((address_space(3)))
typedef unsigned short bf16_t;
typedef short bf16x8 __attribute__((ext_vector_type(8)));
typedef float f32x4 __attribute__((ext_vector_type(4)));
typedef float f32x16 __attribute__((ext_vector_type(16)));
typedef unsigned u32x4 __attribute__((ext_vector_type(4)));
typedef unsigned u32x2 __attribute__((ext_vector_type(2)));

constexpr int NWAVES = 8, NTHR = 512;
constexpr int D = 2048, NB = 8, SEQ = 2048, M = NB * SEQ, CTXL = 256, MC = NB * CTXL, MT = M + MC;
constexpr int DIN = 4096, S5W = 1024, HYW = 1024, NG = 64;
constexpr int NE = 32, DFF = 2048;
constexpr int NPHASE = 11;
constexpr float WSCALE = 64.0f;
constexpr int SEG = 288;

constexpr size_t MiB = 1u << 20;
constexpr size_t WS_CTL = 0, CTL_ZERO_BYTES = 1024 * 1024;
constexpr int CW_TMO = 0, CW_BAR = 4096, CW_CNT = 8192, CW_HNORM = 12288, CW_MOD = 16384;
constexpr size_t WS_LAM = 1 * MiB, WS_LAML = WS_LAM + 64 * 1024, WS_S5B = WS_LAM + 128 * 1024, WS_S5C = WS_LAM + 640 * 1024;
constexpr size_t WS_HRAW = 4 * MiB, WS_RG = 20 * MiB, WS_WIN = 28 * MiB, WS_WGLU = 44 * MiB, WS_WOUT = 46 * MiB;
constexpr size_t WS_PK = 54 * MiB, WS_GATE = WS_PK + 256 * 1024, WS_ROWL = 55 * MiB, WS_MODF = 58 * MiB;
constexpr size_t WS_A1 = 64 * MiB, WS_P = 136 * MiB, WS_YS5 = 280 * MiB, WS_VT = 344 * MiB, WS_LCT = 376 * MiB, WS_YG = 408 * MiB;
constexpr size_t WS_YCAT = 440 * MiB, WS_X1 = 504 * MiB, WS_A2 = 632 * MiB, WS_WGU = 704 * MiB, WS_WDN = 1216 * MiB;
constexpr size_t WS_H = 1472 * MiB, WS_YD = 1760 * MiB, WS_END = 2048 * MiB;
constexpr int HROWS = 73728;

constexpr int RING_BYTES = 131072, LDSCTL_OFF = RING_BYTES, LDS_BYTES = 147456;
constexpr int LW_BAR = 8, LW_TST = 64, LW_CNT = 128, LW_TE = 256;

__device__ __forceinline__ unsigned f2bf(float f) { unsigned u = __builtin_bit_cast(unsigned, f); return (u + 0x7fffu + ((u >> 16) & 1u)) >> 16; }
__device__ __forceinline__ unsigned pk2(float lo, float hi) { return f2bf(lo) | (f2bf(hi) << 16); }
__device__ __forceinline__ float bflo(unsigned w) { return __builtin_bit_cast(float, w << 16); }
__device__ __forceinline__ float bfhi(unsigned w) { return __builtin_bit_cast(float, w & 0xffff0000u); }
__device__ __forceinline__ float bf1(bf16_t b) { return __builtin_bit_cast(float, (unsigned)b << 16); }
__device__ __forceinline__ unsigned pk4_fp8(float a, float b, float c, float d) { int w = __builtin_amdgcn_cvt_pk_fp8_f32(a, b, 0, false); w = __builtin_amdgcn_cvt_pk_fp8_f32(c, d, w, true); return (unsigned)w; }
constexpr float FIX_SCALE = 4294967296.0f;
__device__ __forceinline__ void fix_add(unsigned long long* p, float v) { atomicAdd(p, (unsigned long long)__float2ll_rn(v * FIX_SCALE)); }
__device__ __forceinline__ float fix_get(const unsigned long long* p) { return (float)((double)(long long)(*p) * (1.0 / 4294967296.0)); }
__device__ __forceinline__ float wave_sum(float v) {
#pragma unroll
    for (int o = 1; o < 64; o <<= 1) v += __shfl_xor(v, o);
    return v;
}
#define LDS_WAIT() asm volatile("s_waitcnt lgkmcnt(0)" ::: "memory")
#define VM_WAIT() asm volatile("s_waitcnt vmcnt(0)" ::: "memory")

#define XB_TMO      128
#define XB_XCNT(j)  (256  + 64 * (j))
#define XB_XSUB(j)  (1280 + 64 * (j))
#define XB_XGEN(j)  (2304 + 64 * (j))
#define XB_TOP      3328
#define XB_TOPGEN   3392
#define XCD_BAR_WORDS 3456
#define XB_SPIN_CAP (1u << 18)
__device__ __forceinline__ unsigned xb_ld(unsigned* p)              { return __hip_atomic_load(p, __ATOMIC_RELAXED, __HIP_MEMORY_SCOPE_AGENT); }
__device__ __forceinline__ unsigned xb_add(unsigned* p, unsigned v) { return __hip_atomic_fetch_add(p, v, __ATOMIC_RELAXED, __HIP_MEMORY_SCOPE_AGENT); }
__device__ __forceinline__ unsigned xb_xcc_id() { return (unsigned)__builtin_amdgcn_s_getreg((3 << 11) | 20) & 0xFu; }
#define XB_SPIN(cond, bar) do { unsigned _sp = 0; while (cond) { __builtin_amdgcn_s_sleep(1); \
    if ((++_sp & 255u) == 0u) { if (xb_ld(&(bar)[XB_TMO])) break; if (_sp > XB_SPIN_CAP) { atomicAdd(&(bar)[XB_TMO], 1u); break; } } } } while (0)
struct XcdBarrier { unsigned* bar; unsigned x; volatile LAS unsigned* st; };
__device__ __forceinline__ XcdBarrier xcd_barrier_post(unsigned* bar, volatile LAS unsigned* st) {
    XcdBarrier b; b.bar = bar; b.x = xb_xcc_id(); b.st = st;
    if (threadIdx.x == 0) (void)xb_add(&bar[XB_XCNT(b.x)], 1u);
    return b;
}
__device__ __forceinline__ void xcd_barrier_complete(unsigned* bar, unsigned x, unsigned& nloc, unsigned& nx) {
    const unsigned G = gridDim.x * gridDim.y * gridDim.z;
    unsigned sum, cnt, mine, sp = 0u;
    for (;;) {
        sum = 0u; cnt = 0u; mine = 0u;
#pragma unroll
        for (unsigned j = 0; j < 16; ++j) { const unsigned c = xb_ld(&bar[XB_XCNT(j)]); sum += c; cnt += (c > 0u) ? 1u : 0u; mine = (j == x) ? c : mine; }
        if (sum == G) break;
        __builtin_amdgcn_s_sleep(1);
        if ((++sp & 255u) == 0u) { if (xb_ld(&bar[XB_TMO])) break; if (sp > XB_SPIN_CAP) { atomicAdd(&bar[XB_TMO], 1u); break; } }
    }
    nloc = mine > 0u ? mine : 1u; nx = cnt > 0u ? cnt : 1u;
}
__device__ __forceinline__ void xcd_barrier(const XcdBarrier& b) {
    asm volatile("s_waitcnt vmcnt(0)" ::: "memory");
    __syncthreads();
    if (threadIdx.x == 0) {
        unsigned* bar = b.bar;
        __builtin_amdgcn_s_waitcnt(0);
        unsigned nloc = b.st[0], nx = b.st[1];
        if (nloc == 0u) { xcd_barrier_complete(bar, b.x, nloc, nx); b.st[0] = nloc; b.st[1] = nx; }
        const unsigned old = xb_add(&bar[XB_XSUB(b.x)], 1u);
        const unsigned gen = old / nloc;
        if (old + 1u == (gen + 1u) * nloc) {
            __builtin_amdgcn_fence(__ATOMIC_RELEASE, "agent");
            asm volatile("s_waitcnt vmcnt(0)" ::: "memory");
            const unsigned og = xb_add(&bar[XB_TOP], 1u);
            const unsigned tg = og / nx;
            if (og + 1u == (tg + 1u) * nx) xb_add(&bar[XB_TOPGEN], 1u);
            else XB_SPIN(xb_ld(&bar[XB_TOPGEN]) == tg, bar);
            __builtin_amdgcn_fence(__ATOMIC_ACQUIRE, "agent");
            xb_add(&bar[XB_XGEN(b.x)], 1u);
            asm volatile("s_waitcnt vmcnt(0)" ::: "memory");
        } else {
            XB_SPIN(xb_ld(&bar[XB_XGEN(b.x)]) == gen, bar);
            __builtin_amdgcn_fence(__ATOMIC_ACQUIRE, "agent");
            asm volatile("s_waitcnt vmcnt(0)" ::: "memory");
        }
    }
    __syncthreads();
}

struct Args { const float* in[39]; float* out; unsigned char* ws; int ph_lo, ph_hi; };

namespace pg8 {
constexpr int BM = 256, BK = 64, HALF = 128, HTB = HALF * BK * 2, STAGE_BYTES = 8 * HTB, NXCD = 8, WGM = 8;
__device__ __forceinline__ int lds_byte(int r, int c) { const int st = (r >> 4) * 2 + (c >> 5), rr = r & 15, cc = c & 31, ob = rr * 64 + cc * 2; return st * 1024 + (ob ^ (((ob >> 9) & 1) << 5)); }
__device__ __forceinline__ void stage_rc(int b, int& R, int& C) { const int st = b / 1024, sb = b % 1024, swz = sb ^ (((sb >> 9) & 1) << 5); R = (st >> 1) * 16 + swz / 64; C = (st & 1) * 32 + (swz % 64) / 2; }
__device__ __forceinline__ int perm32(int rho) { const int n = rho >> 4, i = rho & 15; return 8 * (i >> 2) + 4 * n + (i & 3); }
struct Unit { int pm, pn, e; };
__device__ __forceinline__ unsigned cvt_pk_bf16(float lo, float hi) { unsigned r; asm volatile("v_cvt_pk_bf16_f32 %0, %1, %2" : "=v"(r) : "v"(lo), "v"(hi)); return r; }

__device__ __forceinline__ void tile_of(long L, int nM, int nN, int& pm, int& pn) {
    const int nwg = nM * nN; int wgid = (int)L;
    { const int q = nwg / NXCD, r = nwg % NXCD, xcd = wgid % NXCD, off = wgid / NXCD; wgid = (xcd < r ? xcd * (q + 1) : r * (q + 1) + (xcd - r) * q) + off; }
    const int nig = WGM * nN, gid = wgid / nig, fm = gid * WGM, gsz = (nM - fm) < WGM ? (nM - fm) : WGM;
    pm = fm + ((wgid % nig) % gsz); pn = (wgid % nig) / gsz;
}

struct DenseSched {
    const bf16_t* A; const bf16_t* Bt; int RB, nM, nN, G, c, xM0, xnM, xnN;
    __device__ __forceinline__ bool next(int i, Unit& u) const {
        const long L = (long)i * G + c; const int nwg = nM * nN;
        if (L < nwg) { tile_of(L, nM, nN, u.pm, u.pn); u.e = 0; return true; }
        const long r = L - nwg; if (r >= (long)xnM * xnN) return false;
        u.pm = xM0 + (int)(r % xnM); u.pn = (int)(r / xnM); u.e = 0; return true;
    }
    __device__ __forceinline__ const char* abase(const Unit& u) const { return (const char*)A + (size_t)u.pm * BM * RB; }
    __device__ __forceinline__ const char* bbase(const Unit& u) const { return (const char*)Bt + (size_t)u.pn * BM * RB; }
    __device__ __forceinline__ void rows(const Unit&, unsigned (&va)[2][2], const int (&R)[2], const int (&C)[2]) const {
#pragma unroll
        for (int h = 0; h < 2; ++h)
#pragma unroll
            for (int i = 0; i < 2; ++i) va[h][i] = (unsigned)((h * HALF + R[i]) * RB + 2 * C[i]);
    }
};
template <bool GATHER> struct MoeSched {
    const unsigned char* A; const unsigned char* Bt; int RB, nN, G, c; size_t estride;
    const LAS int* tst; const LAS int* cnts; const int* rowlist;
    __device__ __forceinline__ bool next(int i, Unit& u) const {
        const int TM = __builtin_amdgcn_readfirstlane(tst[NE]); const long L = (long)i * G + c; if (L >= (long)TM * nN) return false;
        tile_of(L, TM, nN, u.pm, u.pn);
        u.e = __builtin_amdgcn_readfirstlane(tst[(LW_TE - LW_TST) + u.pm]); return true;
    }
    __device__ __forceinline__ const char* abase(const Unit& u) const { return GATHER ? (const char*)A : (const char*)A + (size_t)u.pm * BM * RB; }
    __device__ __forceinline__ const char* bbase(const Unit& u) const { return (const char*)Bt + (size_t)u.e * estride + (size_t)u.pn * BM * RB; }
    __device__ __forceinline__ void rows(const Unit& u, unsigned (&va)[2][2], const int (&R)[2], const int (&C)[2]) const {
        if (GATHER) {
            const int n = __builtin_amdgcn_readfirstlane(cnts[u.e]), lt = u.pm - __builtin_amdgcn_readfirstlane(tst[u.e]);
#pragma unroll
            for (int h = 0; h < 2; ++h)
#pragma unroll
                for (int i = 0; i < 2; ++i) { int slot = lt * BM + h * HALF + R[i]; slot = slot < n ? slot : 0; const int tok = rowlist[u.e * M + slot]; va[h][i] = (unsigned)(tok * RB + 2 * C[i]); }
        } else {
#pragma unroll
            for (int h = 0; h < 2; ++h)
#pragma unroll
                for (int i = 0; i < 2; ++i) va[h][i] = (unsigned)((h * HALF + R[i]) * RB + 2 * C[i]);
        }
    }
};

typedef int i32x4 __attribute__((ext_vector_type(4)));
typedef int i32x8 __attribute__((ext_vector_type(8)));
template <bool FP8, class Epi, class Sched>
__device__ __forceinline__ void gemm_phase(LAS unsigned char* lds, const int RB, const Sched& S, const Epi& E) {
    const int tid = threadIdx.x, wid = __builtin_amdgcn_readfirstlane(tid >> 6), lane = tid & 63, wr = wid >> 2, wc = wid & 3, fr = lane & 15, fq = lane >> 4;
    const int nt = RB / 128;
    unsigned voffB[2]; int Rr[2], Cc[2];
#pragma unroll
    for (int i = 0; i < 2; ++i) { int R, C; stage_rc(tid * 16 + i * 8192, R, C); Rr[i] = R; Cc[i] = C; const int Rb = Epi::PERM ? ((R & ~31) + perm32(R & 31)) : R; voffB[i] = (unsigned)(Rb * RB + 2 * C); }
    const size_t kstep = (size_t)(BK * 2);
    const size_t hstep = (size_t)HALF * RB;
    const unsigned ldsw = (unsigned)wid * 1024u;
    const int aoff = lds_byte(wr * 64 + fr, fq * 8), boff = lds_byte(wc * 32 + fr, fq * 8);
#define PG8_SA(b, h) (((b) * 2 + (h)) * HTB)
#define PG8_SB(b, h) ((4 + (b) * 2 + (h)) * HTB)
#define PG8_STAGE(bufoff, gbase, voff) do { _Pragma("unroll") for (int _i = 0; _i < 2; ++_i) \
        __builtin_amdgcn_global_load_lds((const unsigned*)((const char*)(gbase) + (voff)[_i]), (LAS unsigned*)(lds + (bufoff) + ldsw + _i * 8192), 16, 0, 0); } while (0)
#define PG8_LDA(dst, b, h) do { _Pragma("unroll") for (int m = 0; m < 4; ++m) _Pragma("unroll") for (int k = 0; k < 2; ++k) dst[m][k] = *(const LAS bf16x8*)(lds + PG8_SA(b, h) + aoff + m * 2048 + k * 1024); } while (0)
#define PG8_LDB(dst, b, h) do { _Pragma("unroll") for (int n = 0; n < 2; ++n) _Pragma("unroll") for (int k = 0; k < 2; ++k) dst[n][k] = *(const LAS bf16x8*)(lds + PG8_SB(b, h) + boff + n * 2048 + k * 1024); } while (0)
#define PG8_MMA(ai, bj, At, Bt) do { __builtin_amdgcn_s_setprio(1); _Pragma("unroll") for (int m = 0; m < 4; ++m) _Pragma("unroll") for (int n = 0; n < 2; ++n) { \
        if constexpr (FP8) { const i32x8 bb_ = __builtin_shufflevector(__builtin_bit_cast(i32x4, Bt[n][0]), __builtin_bit_cast(i32x4, Bt[n][1]), 0, 1, 2, 3, 4, 5, 6, 7); \
            const i32x8 aa_ = __builtin_shufflevector(__builtin_bit_cast(i32x4, At[m][0]), __builtin_bit_cast(i32x4, At[m][1]), 0, 1, 2, 3, 4, 5, 6, 7); \
            asm volatile("v_mfma_scale_f32_16x16x128_f8f6f4 %0, %1, %2, %0, %3, %3 op_sel_hi:[0,0,0]" : "+v"(acc[ai][bj][m][n]) : "v"(bb_), "v"(aa_), "v"(one_scale)); } \
        else { _Pragma("unroll") for (int k = 0; k < 2; ++k) acc[ai][bj][m][n] = __builtin_amdgcn_mfma_f32_16x16x32_bf16(Bt[n][k], At[m][k], acc[ai][bj][m][n], 0, 0, 0); } } \
        __builtin_amdgcn_s_setprio(0); } while (0)
#define PG8_WAIT_V(n) asm volatile("s_waitcnt vmcnt(" #n ")" ::: "memory")
#define PG8_WAIT_L(n) asm volatile("s_waitcnt lgkmcnt(" #n ")" ::: "memory")
#define PG8_BAR __builtin_amdgcn_s_barrier()
#define PG8_SCHED __builtin_amdgcn_sched_barrier(0)
    Unit cur, nxt; int ui = 0;
    if (!S.next(0, cur)) return;
    f32x4 acc[2][2][4][2];
#pragma unroll
    for (int a = 0; a < 2; ++a)
#pragma unroll
        for (int b = 0; b < 2; ++b)
#pragma unroll
            for (int m = 0; m < 4; ++m)
#pragma unroll
                for (int n = 0; n < 2; ++n) acc[a][b][m][n] = (f32x4){0.f, 0.f, 0.f, 0.f};
    bf16x8 At[4][2], B0[2][2], B1[2][2];
    unsigned one_scale = 0x7F7F7F7Fu; asm volatile("" : "+v"(one_scale));
    unsigned vaC[2][2], vaN[2][2];
    S.rows(cur, vaC, Rr, Cc);
    const char* cA = S.abase(cur); const char* cB = S.bbase(cur);
    PG8_STAGE(PG8_SB(0, 0), cB, voffB); PG8_STAGE(PG8_SA(0, 0), cA, vaC[0]); PG8_STAGE(PG8_SB(0, 1), cB + hstep, voffB); PG8_STAGE(PG8_SA(0, 1), cA, vaC[1]);
    if (wr == 1) PG8_BAR;
    PG8_WAIT_V(4); PG8_BAR;
    PG8_STAGE(PG8_SB(1, 0), cB + kstep, voffB); PG8_STAGE(PG8_SA(1, 0), cA + kstep, vaC[0]); PG8_STAGE(PG8_SB(1, 1), cB + hstep + kstep, voffB);
    PG8_WAIT_V(6); PG8_BAR;
    for (;;) {
        const bool has_next = S.next(ui + 1, nxt);
        const char* nA = has_next ? S.abase(nxt) : cA; const char* nB = has_next ? S.bbase(nxt) : cB;
#pragma unroll
        for (int h = 0; h < 2; ++h)
#pragma unroll
            for (int i = 0; i < 2; ++i) vaN[h][i] = vaC[h][i];
        for (int t = 0; t < nt; t += 2) {
            const bool last = (t == nt - 2);
            const char* a1 = cA + (size_t)(t + 1) * kstep;
            const char* a2 = last ? nA : cA + (size_t)(t + 2) * kstep; const char* b2 = last ? nB : cB + (size_t)(t + 2) * kstep;
            const char* a3 = a2 + kstep; const char* b3 = b2 + kstep;
            if (last && has_next) S.rows(nxt, vaN, Rr, Cc);
            unsigned v2[2][2];
#pragma unroll
            for (int h = 0; h < 2; ++h)
#pragma unroll
                for (int i = 0; i < 2; ++i) v2[h][i] = last ? vaN[h][i] : vaC[h][i];
            PG8_LDB(B0, 0, 0); PG8_SCHED; PG8_LDA(At, 0, 0); PG8_STAGE(PG8_SA(1, 1), a1, vaC[1]);
            PG8_WAIT_L(8); PG8_BAR; PG8_WAIT_L(0); PG8_MMA(0, 0, At, B0); PG8_BAR; PG8_SCHED;
            PG8_LDB(B1, 0, 1); PG8_STAGE(PG8_SB(0, 0), b2, voffB);
            PG8_BAR; PG8_WAIT_L(0); PG8_MMA(0, 1, At, B1); PG8_BAR;
            PG8_LDA(At, 0, 1); PG8_STAGE(PG8_SA(0, 0), a2, v2[0]);
            PG8_BAR; PG8_WAIT_L(0); PG8_MMA(1, 0, At, B0); PG8_BAR; PG8_SCHED;
            PG8_STAGE(PG8_SB(0, 1), b2 + hstep, voffB);
            PG8_WAIT_V(6); PG8_BAR; PG8_MMA(1, 1, At, B1); PG8_BAR;
            PG8_LDB(B0, 1, 0); PG8_SCHED; PG8_LDA(At, 1, 0); PG8_STAGE(PG8_SA(0, 1), a2, v2[1]);
            PG8_WAIT_L(8); PG8_BAR; PG8_WAIT_L(0); PG8_MMA(0, 0, At, B0); PG8_BAR; PG8_SCHED;
            PG8_LDB(B1, 1, 1); PG8_STAGE(PG8_SB(1, 0), b3, voffB);
            PG8_BAR; PG8_WAIT_L(0); PG8_MMA(0, 1, At, B1); PG8_BAR;
            PG8_LDA(At, 1, 1); PG8_STAGE(PG8_SA(1, 0), a3, v2[0]);
            PG8_BAR; PG8_WAIT_L(0); PG8_MMA(1, 0, At, B0); PG8_BAR; PG8_SCHED;
            PG8_STAGE(PG8_SB(1, 1), b3 + hstep, voffB);
            PG8_WAIT_V(6); PG8_BAR; PG8_MMA(1, 1, At, B1); PG8_BAR;
        }
        if constexpr (FP8) asm volatile("s_nop 15\n\ts_nop 15" ::: "memory");
        E(acc, cur, wr, wc, fr, fq);
        if (!has_next) break;
#pragma unroll
        for (int a = 0; a < 2; ++a)
#pragma unroll
            for (int b = 0; b < 2; ++b)
#pragma unroll
                for (int m = 0; m < 4; ++m)
#pragma unroll
                    for (int n = 0; n < 2; ++n) acc[a][b][m][n] = (f32x4){0.f, 0.f, 0.f, 0.f};
        cur = nxt; cA = nA; cB = nB; ++ui;
#pragma unroll
        for (int h = 0; h < 2; ++h)
#pragma unroll
            for (int i = 0; i < 2; ++i) vaC[h][i] = vaN[h][i];
    }
    PG8_WAIT_V(0);
    if (wr == 0) PG8_BAR;
    PG8_BAR;
#undef PG8_SA
#undef PG8_SB
#undef PG8_STAGE
#undef PG8_LDA
#undef PG8_LDB
#undef PG8_MMA
#undef PG8_WAIT_V
#undef PG8_WAIT_L
#undef PG8_BAR
#undef PG8_SCHED
}

struct EpiStoreBf16 {
    static constexpr bool PERM = true;
    bf16_t* O; int ldc; const float* bias; int bias_estride; float sc;
    __device__ __forceinline__ void operator()(const f32x4 (&acc)[2][2][4][2], const Unit& u, int wr, int wc, int fr, int fq) const {
        const int row0 = u.pm * BM + wr * 64 + fr, col0 = u.pn * BM + wc * 32 + 8 * fq;
        f32x4 bv[2][2];
#pragma unroll
        for (int bj = 0; bj < 2; ++bj)
#pragma unroll
            for (int n = 0; n < 2; ++n) bv[bj][n] = bias ? *(const f32x4*)(bias + (size_t)u.e * bias_estride + col0 + bj * HALF + 4 * n) : (f32x4){0.f, 0.f, 0.f, 0.f};
#pragma unroll
        for (int ai = 0; ai < 2; ++ai)
#pragma unroll
            for (int m = 0; m < 4; ++m) { bf16_t* rowp = O + (size_t)(row0 + ai * HALF + m * 16) * ldc + col0;
#pragma unroll
                for (int bj = 0; bj < 2; ++bj) { const f32x4 v0 = acc[ai][bj][m][0] * sc + bv[bj][0], v1 = acc[ai][bj][m][1] * sc + bv[bj][1];
                    u32x4 w; w.x = cvt_pk_bf16(v0[0], v0[1]); w.y = cvt_pk_bf16(v0[2], v0[3]); w.z = cvt_pk_bf16(v1[0], v1[1]); w.w = cvt_pk_bf16(v1[2], v1[3]);
                    *(u32x4*)(rowp + bj * HALF) = w; } }
    }
};
struct EpiGlu {
    static constexpr bool PERM = true;
    const bf16_t* Yg; bf16_t* O; const float* bias;
    __device__ __forceinline__ void operator()(const f32x4 (&acc)[2][2][4][2], const Unit& u, int wr, int wc, int fr, int fq) const {
        const int row0 = u.pm * BM + wr * 64 + fr, col0 = u.pn * BM + wc * 32 + 8 * fq;
        f32x4 bv[2][2];
#pragma unroll
        for (int bj = 0; bj < 2; ++bj)
#pragma unroll
            for (int n = 0; n < 2; ++n) bv[bj][n] = *(const f32x4*)(bias + col0 + bj * HALF + 4 * n);
#pragma unroll
        for (int ai = 0; ai < 2; ++ai)
#pragma unroll
            for (int m = 0; m < 4; ++m) { const size_t r = (size_t)(row0 + ai * HALF + m * 16);
#pragma unroll
                for (int bj = 0; bj < 2; ++bj) { const f32x4 v0 = acc[ai][bj][m][0] + bv[bj][0], v1 = acc[ai][bj][m][1] + bv[bj][1];
                    const u32x4 y = *(const u32x4*)(Yg + r * S5W + col0 + bj * HALF);
                    float o[8];
                    o[0] = bflo(y.x) / (1.f + __expf(-v0[0])); o[1] = bfhi(y.x) / (1.f + __expf(-v0[1])); o[2] = bflo(y.y) / (1.f + __expf(-v0[2])); o[3] = bfhi(y.y) / (1.f + __expf(-v0[3]));
                    o[4] = bflo(y.z) / (1.f + __expf(-v1[0])); o[5] = bfhi(y.z) / (1.f + __expf(-v1[1])); o[6] = bflo(y.w) / (1.f + __expf(-v1[2])); o[7] = bfhi(y.w) / (1.f + __expf(-v1[3]));
                    u32x4 w; w.x = cvt_pk_bf16(o[0], o[1]); w.y = cvt_pk_bf16(o[2], o[3]); w.z = cvt_pk_bf16(o[4], o[5]); w.w = cvt_pk_bf16(o[6], o[7]);
                    *(u32x4*)(O + r * D + col0 + bj * HALF) = w; } }
    }
};
struct EpiResid {
    static constexpr bool PERM = false;
    const float* X; float* O; const float* mod;
    __device__ __forceinline__ void operator()(const f32x4 (&acc)[2][2][4][2], const Unit& u, int wr, int wc, int fr, int fq) const {
        const int row0 = u.pm * BM + wr * 64 + fr, col0 = u.pn * BM + wc * 32 + 4 * fq, b = u.pm >> 3;
        f32x4 gv[2][2];
#pragma unroll
        for (int bj = 0; bj < 2; ++bj)
#pragma unroll
            for (int n = 0; n < 2; ++n) { const int c = col0 + bj * HALF + n * 16; gv[bj][n] = *(const f32x4*)(mod + (size_t)b * 12288 + 2 * D + c); }
#pragma unroll
        for (int ai = 0; ai < 2; ++ai)
#pragma unroll
            for (int m = 0; m < 4; ++m) { const size_t off = (size_t)(row0 + ai * HALF + m * 16) * D + col0;
#pragma unroll
                for (int bj = 0; bj < 2; ++bj)
#pragma unroll
                    for (int n = 0; n < 2; ++n) { const f32x4 xv = *(const f32x4*)(X + off + bj * HALF + n * 16); *(f32x4*)(O + off + bj * HALF + n * 16) = xv + gv[bj][n] * acc[ai][bj][m][n]; } }
    }
};
struct EpiSwiglu {
    static constexpr bool PERM = true;
    unsigned char* O; const float* bias; float sc;
    __device__ __forceinline__ void operator()(const f32x4 (&acc)[2][2][4][2], const Unit& u, int wr, int wc, int fr, int fq) const {
        const int row0 = u.pm * BM + wr * 64 + fr, j0 = wc * 32 + 8 * fq, cb = u.pn * HALF + j0;
        f32x4 bg[2], bu[2];
#pragma unroll
        for (int n = 0; n < 2; ++n) { bg[n] = *(const f32x4*)(bias + (size_t)u.e * 4096 + cb + 4 * n); bu[n] = *(const f32x4*)(bias + (size_t)u.e * 4096 + 2048 + cb + 4 * n); }
#pragma unroll
        for (int ai = 0; ai < 2; ++ai)
#pragma unroll
            for (int m = 0; m < 4; ++m) { float o[8];
#pragma unroll
                for (int n = 0; n < 2; ++n)
#pragma unroll
                    for (int e = 0; e < 4; ++e) { float g = acc[ai][0][m][n][e] * sc + bg[n][e], uu = acc[ai][1][m][n][e] * sc + bu[n][e];
                        g = fminf(g, 7.0f); uu = fminf(fmaxf(uu, -7.0f), 7.0f);
                        o[4 * n + e] = (uu + 1.0f) * (g / (1.0f + __expf(-1.702f * g))); }
                u32x2 w; w.x = pk4_fp8(o[0], o[1], o[2], o[3]); w.y = pk4_fp8(o[4], o[5], o[6], o[7]);
                *(u32x2*)(O + (size_t)(row0 + ai * HALF + m * 16) * DFF + cb) = w; }
    }
};
}

#define FI __device__ __forceinline__

FI void transpose_item(const float* W, int K, int N, bf16_t* WT, int row_off, LAS float* scr, int kb, int nb, int lane) {
    const int k0 = 64 * kb, n0 = 32 * nb;
#pragma unroll 8
    for (int i = 0; i < 32; ++i) { const int kk = 2 * i + (lane >> 5); scr[kk * 33 + (lane & 31)] = W[(size_t)(k0 + kk) * N + n0 + (lane & 31)]; }
    LDS_WAIT(); asm volatile("" ::: "memory");
    const int c = lane & 7;
#pragma unroll
    for (int j = 0; j < 4; ++j) { const int n = (lane >> 3) + 8 * j; const LAS float* s = scr + (8 * c) * 33 + n;
        u32x4 o; o.x = pk2(s[0 * 33], s[1 * 33]); o.y = pk2(s[2 * 33], s[3 * 33]); o.z = pk2(s[4 * 33], s[5 * 33]); o.w = pk2(s[6 * 33], s[7 * 33]);
        *(u32x4*)(WT + (size_t)(row_off + n0 + n) * K + k0 + 8 * c) = o; }
    LDS_WAIT(); asm volatile("" ::: "memory");
}

FI void transpose_item_fp8(const float* W, int K, int N, unsigned char* WT, int row_off, LAS float* scr, int kb, int nb, int lane, float scale) {
    const int k0 = 64 * kb, n0 = 32 * nb;
#pragma unroll 8
    for (int i = 0; i < 32; ++i) { const int kk = 2 * i + (lane >> 5); scr[kk * 33 + (lane & 31)] = W[(size_t)(k0 + kk) * N + n0 + (lane & 31)]; }
    LDS_WAIT(); asm volatile("" ::: "memory");
    const int n = lane & 31, hf = lane >> 5; const LAS float* s = scr + (32 * hf) * 33 + n;
    u32x4 o0, o1;
    o0.x = pk4_fp8(s[0 * 33] * scale, s[1 * 33] * scale, s[2 * 33] * scale, s[3 * 33] * scale); o0.y = pk4_fp8(s[4 * 33] * scale, s[5 * 33] * scale, s[6 * 33] * scale, s[7 * 33] * scale);
    o0.z = pk4_fp8(s[8 * 33] * scale, s[9 * 33] * scale, s[10 * 33] * scale, s[11 * 33] * scale); o0.w = pk4_fp8(s[12 * 33] * scale, s[13 * 33] * scale, s[14 * 33] * scale, s[15 * 33] * scale);
    o1.x = pk4_fp8(s[16 * 33] * scale, s[17 * 33] * scale, s[18 * 33] * scale, s[19 * 33] * scale); o1.y = pk4_fp8(s[20 * 33] * scale, s[21 * 33] * scale, s[22 * 33] * scale, s[23 * 33] * scale);
    o1.z = pk4_fp8(s[24 * 33] * scale, s[25 * 33] * scale, s[26 * 33] * scale, s[27 * 33] * scale); o1.w = pk4_fp8(s[28 * 33] * scale, s[29 * 33] * scale, s[30 * 33] * scale, s[31 * 33] * scale);
    unsigned char* dst = WT + (size_t)(row_off + n0 + n) * K + k0 + 32 * hf;
    *(u32x4*)dst = o0; *(u32x4*)(dst + 16) = o1;
    LDS_WAIT(); asm volatile("" ::: "memory");
}

FI void p0_run(const Args& A, LAS unsigned char* lds, int tid, int lane, int wave, int vcu, int G) {
    unsigned char* ws = A.ws;
    unsigned long long* mod = (unsigned long long*)((unsigned*)(ws + WS_CTL) + CW_MOD); unsigned long long* hnorm = (unsigned long long*)((unsigned*)(ws + WS_CTL) + CW_HNORM);
    {
        LAS float* sl = (LAS float*)lds;
        LAS float* part = (LAS float*)(lds + 9 * 512 * 4);
        const float* c = A.in[1]; const float* cc = A.in[3]; const float* wada = A.in[4];
        _Pragma("unroll 1") for (int rep = 0; rep < REP0A; ++rep)
        for (int it = vcu; it < 192; it += G) {
            const int cg = it % 48, kq = it / 48, n0 = cg * 256 + 4 * lane, k0 = kq * 512;
            for (int i = tid; i < 9 * 512; i += NTHR) { const int r = i >> 9, k = k0 + (i & 511); const float v = r < 8 ? c[r * D + k] : cc[k]; sl[i] = v / (1.f + __expf(-v)); }
            __syncthreads();
            f32x4 acc[9];
#pragma unroll
            for (int r = 0; r < 9; ++r) acc[r] = (f32x4){0.f, 0.f, 0.f, 0.f};
#pragma unroll 8
            for (int kk = 0; kk < 64; ++kk) { const int kl = wave * 64 + kk; const f32x4 w = *(const f32x4*)(wada + (size_t)(k0 + kl) * 12288 + n0);
#pragma unroll
                for (int r = 0; r < 9; ++r) { const float sv = sl[r * 512 + kl]; acc[r] += w * sv; } }
#pragma unroll
            for (int r = 0; r < 9; ++r) *(LAS f32x4*)(part + (wave * 9 + r) * 256 + 4 * lane) = acc[r];
            __syncthreads();
            for (int i = tid; i < 9 * 256; i += NTHR) { const int r = i >> 8, col = i & 255; float sum = 0.f;
#pragma unroll
                for (int w = 0; w < 8; ++w) sum += part[(w * 9 + r) * 256 + col];
                fix_add(mod + r * 12288 + cg * 256 + col, rep == REP0A - 1 ? sum : 0.0f); }
            __syncthreads();
        }
    }
    {
        LAS float* L = (LAS float*)lds;
        LAS float *w1s = L, *w2s = L + 2112, *w3s = L + 6208, *b1s = L + 10304, *b2s = L + 10368, *b3s = L + 10432, *fqs = L + 10496, *zs = L + 10560, *h1 = L + 10824, *h2 = L + 11336, *h3 = L + 11848;
        for (int i = tid; i < 33 * 64; i += NTHR) w1s[i] = A.in[21][i];
        for (int i = tid; i < 4096; i += NTHR) { w2s[i] = A.in[23][i]; w3s[i] = A.in[25][i]; }
        if (tid < 64) { b1s[tid] = A.in[22][tid]; b2s[tid] = A.in[24][tid]; b3s[tid] = A.in[26][tid]; fqs[tid] = A.in[28][tid]; }
        __syncthreads();
        const float* w4 = A.in[27]; const float* dl = A.in[29]; float* hraw = (float*)(ws + WS_HRAW);
        for (int item = vcu; item < 256; item += G) {
            const int l0 = item * 8;
            if (tid < 264) { const int r = tid / 33, i = tid % 33, l = l0 + r; float z;
                if (i == 0) z = (float)l / 2047.0f;
                else { const int j = (i - 1) & 15; const float band = 1e-4f + (float)j * ((15.0f - 1e-4f) / 15.0f); const float ang = (6.283185307179586f / 2048.0f) * (float)l * band; z = (i <= 16) ? cosf(ang) : -sinf(ang); }
                zs[tid] = z; }
            __syncthreads();
            const int r = tid >> 6, o = tid & 63;
            { float s = b1s[o]; for (int i = 0; i < 33; ++i) s += zs[r * 33 + i] * w1s[i * 64 + o]; h1[r * 64 + o] = sinf(fqs[o] * s); }
            __syncthreads();
            { float s = b2s[o]; for (int i = 0; i < 64; ++i) s += h1[r * 64 + i] * w2s[i * 64 + o]; h2[r * 64 + o] = sinf(fqs[o] * s); }
            __syncthreads();
            { float s = b3s[o]; for (int i = 0; i < 64; ++i) s += h2[r * 64 + i] * w3s[i * 64 + o]; h3[r * 64 + o] = sinf(fqs[o] * s); }
            __syncthreads();
            f32x4 acc[8];
#pragma unroll
            for (int q = 0; q < 8; ++q) acc[q] = (f32x4){0.f, 0.f, 0.f, 0.f};
#pragma unroll 4
            for (int i = 0; i < 64; ++i) { const f32x4 w = *(const f32x4*)(w4 + (size_t)i * 2048 + 4 * tid);
#pragma unroll
                for (int q = 0; q < 8; ++q) acc[q] += w * h3[q * 64 + i]; }
            const f32x4 dv = *(const f32x4*)(dl + 4 * tid);
            f32x4 asum = (f32x4){0.f, 0.f, 0.f, 0.f};
#pragma unroll
            for (int q = 0; q < 8; ++q) { const int l = l0 + q; const float t = (float)l / 2047.0f; f32x4 v;
#pragma unroll
                for (int e = 0; e < 4; ++e) v[e] = acc[q][e] * expf(-t * fabsf(dv[e]));
                *(f32x4*)(hraw + (size_t)l * 2048 + 4 * tid) = v;
                if (!(l == 2047 && 4 * tid >= 1024)) {
#pragma unroll
                    for (int e = 0; e < 4; ++e) asum[e] += fabsf(v[e]); } }
#pragma unroll
            for (int e = 0; e < 4; ++e) fix_add(hnorm + 4 * tid + e, asum[e]);
            __syncthreads();
        }
    }
    {
        const float *lre = A.in[9], *lim = A.in[10], *lst = A.in[11], *bre = A.in[12], *bim = A.in[13], *cre = A.in[14], *cim = A.in[15];
        float* LAM = (float*)(ws + WS_LAM); float* LAML = (float*)(ws + WS_LAML); bf16_t* SB = (bf16_t*)(ws + WS_S5B); bf16_t* SC = (bf16_t*)(ws + WS_S5C);
        for (int idx = vcu * NTHR + tid; idx < 2 * 64 * 4 * 64; idx += G * NTHR) {
            const int ln = idx & 63, T = (idx >> 6) & 3, g = (idx >> 8) & 63, d = idx >> 14;
            {
                const int n = ln & 31, hq = ln >> 5, p = n + 32 * (T >> 1), part = T & 1;
                const int q = (d * 64 + g) * 64 + p;
                const float lr = fminf(lre[q], -1e-4f), li = lim[q], dt = expf(lst[q]), zr = lr * dt, zi = li * dt, er = expf(zr), br = er * cosf(zi), bi = er * sinf(zi);
                const float den = lr * lr + li * li, cr = ((br - 1.f) * lr + bi * li) / den, ci = (bi * lr - (br - 1.f) * li) / den;
                float v[8];
#pragma unroll
                for (int j = 0; j < 8; ++j) { const int h = 8 * hq + j; const float xr = bre[(size_t)q * 16 + h], xi = bim[(size_t)q * 16 + h]; v[j] = part ? (cr * xi + ci * xr) : (cr * xr - ci * xi); }
                u32x4 w; w.x = pk2(v[0], v[1]); w.y = pk2(v[2], v[3]); w.z = pk2(v[4], v[5]); w.w = pk2(v[6], v[7]);
                *(u32x4*)(SB + (size_t)idx * 8) = w;
                if (part == 0 && hq == 0) { LAM[q * 2] = br; LAM[q * 2 + 1] = bi; const float eL = expf((float)SEG * zr), aL = (float)SEG * zi; LAML[q * 2] = eL * cosf(aL); LAML[q * 2 + 1] = eL * sinf(aL); }
            }
            {
                const int hc = ln & 15, qq = ln >> 4; float v[8];
#pragma unroll
                for (int j = 0; j < 8; ++j) { const int k = 32 * T + 8 * qq + j, n = k >> 2, TT = k & 3, p = n + 32 * (TT >> 1), part = TT & 1; const size_t ci = ((size_t)(d * 64 + g) * 16 + hc) * 64 + p; v[j] = part ? -cim[ci] : cre[ci]; }
                u32x4 w; w.x = pk2(v[0], v[1]); w.y = pk2(v[2], v[3]); w.z = pk2(v[4], v[5]); w.w = pk2(v[6], v[7]);
                *(u32x4*)(SC + (size_t)idx * 8) = w;
            }
        }
    }
    {
        __syncthreads();
        LAS float* scr = (LAS float*)(lds + wave * 16384);
        const int gw = vcu * NWAVES + wave, NGW = G * NWAVES;
        constexpr int I_IN = 32 * 128, I_GLU = 16 * 32, I_OUT = 32 * 64, I_GU = 32 * 32 * 128, I_DN = 32 * 32 * 64;
        constexpr int NITEMS = I_IN + I_GLU + I_OUT + I_GU + I_DN;
        _Pragma("unroll 1") for (int rep = 0; rep < REP0D; ++rep)
        for (int it2 = gw; it2 < NITEMS / 2; it2 += NGW)
        _Pragma("unroll 1") for (int sub = 0; sub < 2; ++sub) {
            int r = 2 * it2 + sub;
            if (r < I_IN) { transpose_item(A.in[8], D, DIN, (bf16_t*)(ws + WS_WIN), 0, scr, r / 128, r % 128, lane); continue; } r -= I_IN;
            if (r < I_GLU) { transpose_item(A.in[17], S5W, S5W, (bf16_t*)(ws + WS_WGLU), 0, scr, r / 32, r % 32, lane); continue; } r -= I_GLU;
            if (r < I_OUT) { transpose_item(A.in[31], D, D, (bf16_t*)(ws + WS_WOUT), 0, scr, r / 64, r % 64, lane); continue; } r -= I_OUT;
            if (r < I_GU) { const int e = r / 4096, q = r % 4096, kb = (q >> 1) / 128 * 2 + (q & 1), nb = (q >> 1) % 128, n0 = 32 * nb;
                const int isU = n0 / 2048, pn = (n0 % 2048) / 128, j = n0 % 128, rowmap = 256 * pn + 128 * isU + j;
                transpose_item_fp8(A.in[34] + (size_t)e * D * 4096, D, 4096, ws + WS_WGU + (size_t)e * 4096 * D, rowmap - n0, scr, kb, nb, lane, WSCALE); continue; } r -= I_GU;
            { const int e = r / 2048, q = r % 2048, kb = (q >> 1) / 64 * 2 + (q & 1), nb = (q >> 1) % 64; transpose_item_fp8(A.in[36] + (size_t)e * DFF * D, DFF, D, ws + WS_WDN + (size_t)e * D * DFF, 0, scr, kb, nb, lane, WSCALE); }
        }
    }
}

FI void p1_run(const Args& A, int tid, int lane, int wave, int vcu, int G) {
    unsigned char* ws = A.ws;
    const unsigned long long* mod = (const unsigned long long*)((const unsigned*)(ws + WS_CTL) + CW_MOD); const unsigned long long* hnorm = (const unsigned long long*)((const unsigned*)(ws + WS_CTL) + CW_HNORM);
    const float* bada = A.in[5]; const float* g1 = A.in[6];
    bf16_t* A1 = (bf16_t*)(ws + WS_A1);
    const int gw = vcu * NWAVES + wave, NGW = G * NWAVES;
    { float* modf = (float*)(ws + WS_MODF); for (int i = vcu * NTHR + tid; i < 9 * 12288; i += G * NTHR) modf[i] = fix_get(mod + i) + bada[i % 12288]; }
    for (int m = gw; m < MT; m += NGW) {
        const float* src = m < M ? A.in[0] + (size_t)m * D : A.in[2] + (size_t)(m - M) * D;
        const int mr = m < M ? m / SEQ : 8;
        f32x4 v[8]; float ss = 0.f;
#pragma unroll
        for (int j = 0; j < 8; ++j) { v[j] = *(const f32x4*)(src + 4 * lane + 256 * j); ss += (v[j].x * v[j].x + v[j].y * v[j].y) + (v[j].z * v[j].z + v[j].w * v[j].w); }
        const float rstd = rsqrtf(wave_sum(ss) * (1.0f / D) + 1e-6f);
#pragma unroll
        for (int j = 0; j < 8; ++j) { const int c = 4 * lane + 256 * j;
            const f32x4 gv = *(const f32x4*)(g1 + c);
            const unsigned long long* mp = mod + (size_t)mr * 12288 + c;
            const f32x4 sh = (f32x4){fix_get(mp), fix_get(mp + 1), fix_get(mp + 2), fix_get(mp + 3)} + *(const f32x4*)(bada + c);
            const f32x4 sc = (f32x4){fix_get(mp + D), fix_get(mp + D + 1), fix_get(mp + D + 2), fix_get(mp + D + 3)} + *(const f32x4*)(bada + D + c);
            const f32x4 h = v[j] * rstd * gv * (sc + 1.0f) + sh;
            u32x2 w; w.x = pk2(h.x, h.y); w.y = pk2(h.z, h.w);
            *(u32x2*)(A1 + (size_t)m * D + c) = w; }
    }
    const float* hraw = (const float*)(ws + WS_HRAW); bf16_t* Rg = (bf16_t*)(ws + WS_RG);
    for (int it = gw; it < 512 * 16; it += NGW) {
        const int ib = it >> 4, c = (it & 15) * 64 + lane;
        const float inv = 1.0f / (fix_get(hnorm + c) + fix_get(hnorm + HYW + c));
        float v[8];
#pragma unroll
        for (int jj = 0; jj < 8; ++jj) { const int i = 8 * ib + jj; float x;
            if (i <= 2047) x = hraw[(size_t)(2047 - i) * 2048 + c]; else if (i <= 4094) x = hraw[(size_t)(i - 2048) * 2048 + HYW + c]; else x = 0.f;
            v[jj] = x * inv; }
        u32x4 w; w.x = pk2(v[0], v[1]); w.y = pk2(v[2], v[3]); w.z = pk2(v[4], v[5]); w.w = pk2(v[6], v[7]);
        *(u32x4*)(Rg + (size_t)c * 4096 + 8 * ib) = w;
    }
}

FI void s5_unit(const Args& A, LAS unsigned char* lds, int unit, int lane, int wave) {
    unsigned char* ws = A.ws;
    const int d = unit & 1, g = (unit >> 1) & 63, bp = unit >> 7, dg = d * 64 + g;
    const bf16_t* P = (const bf16_t*)(ws + WS_P); bf16_t* Ys = (bf16_t*)(ws + WS_YS5);
    bf16x8 Bf[4], Cf[4];
#pragma unroll
    for (int T = 0; T < 4; ++T) { Bf[T] = *(const bf16x8*)((const bf16_t*)(ws + WS_S5B) + ((size_t)(dg * 4 + T) * 64 + lane) * 8); Cf[T] = *(const bf16x8*)((const bf16_t*)(ws + WS_S5C) + ((size_t)(dg * 4 + T) * 64 + lane) * 8); }
    const int n = lane & 31, hh = lane >> 5;
    const float* LAM = (const float*)(ws + WS_LAM) + (size_t)dg * 128; const float* LAML = (const float*)(ws + WS_LAML) + (size_t)dg * 128;
    const float lr0 = LAM[n * 2], li0 = LAM[n * 2 + 1], lr1 = LAM[(n + 32) * 2], li1 = LAM[(n + 32) * 2 + 1];
    const int r = lane & 31, bsel = (r >> 2) & 1, tau = (r & 3) + 4 * (r >> 3), b = 2 * bp + bsel, kofs = g * 16 + 8 * (lane >> 5);
    const int seg0 = wave * SEG;
    auto rowp = [&](int pos) -> const bf16_t* {
        int row; if (pos < CTXL) { const int tc = d ? (CTXL - 1 - pos) : pos; row = M + b * CTXL + tc; } else { const int q = pos - CTXL; const int tl = d ? (SEQ - 1 - q) : q; row = b * SEQ + tl; }
        return P + (size_t)row * DIN + kofs; };
    const f32x16 z16 = {0.f, 0.f, 0.f, 0.f, 0.f, 0.f, 0.f, 0.f, 0.f, 0.f, 0.f, 0.f, 0.f, 0.f, 0.f, 0.f};
    float xr0 = 0.f, xi0 = 0.f, xr1 = 0.f, xi1 = 0.f;
    {
        bf16x8 uc[3], un[3];
#pragma unroll
        for (int q = 0; q < 3; ++q) { uc[q] = *(const bf16x8*)rowp(seg0 + 16 * q + tau); un[q] = uc[q]; }
#pragma unroll 1
        for (int ch = 0; ch < 6; ++ch) {
            if (ch < 5) {
#pragma unroll
                for (int q = 0; q < 3; ++q) un[q] = *(const bf16x8*)rowp(seg0 + 16 * (3 * (ch + 1) + q) + tau); }
#pragma unroll
            for (int q = 0; q < 3; ++q) {
                const f32x16 c0 = __builtin_amdgcn_mfma_f32_32x32x16_bf16(uc[q], Bf[0], z16, 0, 0, 0), c1 = __builtin_amdgcn_mfma_f32_32x32x16_bf16(uc[q], Bf[1], z16, 0, 0, 0);
                const f32x16 c2 = __builtin_amdgcn_mfma_f32_32x32x16_bf16(uc[q], Bf[2], z16, 0, 0, 0), c3 = __builtin_amdgcn_mfma_f32_32x32x16_bf16(uc[q], Bf[3], z16, 0, 0, 0);
#pragma unroll
                for (int tt = 0; tt < 16; ++tt) {
                    const float nr0 = lr0 * xr0 - li0 * xi0 + c0[tt], ni0 = lr0 * xi0 + li0 * xr0 + c1[tt]; xr0 = nr0; xi0 = ni0;
                    const float nr1 = lr1 * xr1 - li1 * xi1 + c2[tt], ni1 = lr1 * xi1 + li1 * xr1 + c3[tt]; xr1 = nr1; xi1 = ni1; }
            }
#pragma unroll
            for (int q = 0; q < 3; ++q) uc[q] = un[q];
        }
    }
    LAS float* Es = (LAS float*)(lds + 8 * 8704);
    *(LAS f32x4*)(Es + (wave * 64 + lane) * 4) = (f32x4){xr0, xi0, xr1, xi1};
    __syncthreads();
    {
        const float Lr0 = LAML[n * 2], Li0 = LAML[n * 2 + 1], Lr1 = LAML[(n + 32) * 2], Li1 = LAML[(n + 32) * 2 + 1];
        xr0 = 0.f; xi0 = 0.f; xr1 = 0.f; xi1 = 0.f;
#pragma unroll 1
        for (int w = 0; w < wave; ++w) { const f32x4 e = *(LAS f32x4*)(Es + (w * 64 + lane) * 4);
            const float nr0 = Lr0 * xr0 - Li0 * xi0 + e.x, ni0 = Lr0 * xi0 + Li0 * xr0 + e.y; xr0 = nr0; xi0 = ni0;
            const float nr1 = Lr1 * xr1 - Li1 * xi1 + e.z, ni1 = Lr1 * xi1 + Li1 * xr1 + e.w; xr1 = nr1; xi1 = ni1; }
    }
    {
        LAS unsigned char* Xs = lds + wave * 8704;
        bf16x8 uc[3], un[3];
#pragma unroll
        for (int q = 0; q < 3; ++q) { uc[q] = *(const bf16x8*)rowp(seg0 + 16 * q + tau); un[q] = uc[q]; }
#pragma unroll 1
        for (int ch = 0; ch < 6; ++ch) {
            if (ch < 5) {
#pragma unroll
                for (int q = 0; q < 3; ++q) un[q] = *(const bf16x8*)rowp(seg0 + 16 * (3 * (ch + 1) + q) + tau); }
#pragma unroll
            for (int q = 0; q < 3; ++q) {
                const int pos0 = seg0 + 16 * (3 * ch + q);
                f32x16 c0 = __builtin_amdgcn_mfma_f32_32x32x16_bf16(uc[q], Bf[0], z16, 0, 0, 0), c1 = __builtin_amdgcn_mfma_f32_32x32x16_bf16(uc[q], Bf[1], z16, 0, 0, 0);
                f32x16 c2 = __builtin_amdgcn_mfma_f32_32x32x16_bf16(uc[q], Bf[2], z16, 0, 0, 0), c3 = __builtin_amdgcn_mfma_f32_32x32x16_bf16(uc[q], Bf[3], z16, 0, 0, 0);
#pragma unroll
                for (int tt = 0; tt < 16; ++tt) {
                    const float nr0 = lr0 * xr0 - li0 * xi0 + c0[tt], ni0 = lr0 * xi0 + li0 * xr0 + c1[tt]; xr0 = nr0; xi0 = ni0; c0[tt] = nr0; c1[tt] = ni0;
                    const float nr1 = lr1 * xr1 - li1 * xi1 + c2[tt], ni1 = lr1 * xi1 + li1 * xr1 + c3[tt]; xr1 = nr1; xi1 = ni1; c2[tt] = nr1; c3[tt] = ni1; }
                if (pos0 >= CTXL) {
#pragma unroll
                    for (int tt = 0; tt < 16; ++tt) { u32x2 w; w.x = pk2(c0[tt], c1[tt]); w.y = pk2(c2[tt], c3[tt]); *(LAS u32x2*)(Xs + (hh * 16 + tt) * 272 + 8 * n) = w; }
                    LDS_WAIT();
#pragma unroll
                    for (int bt = 0; bt < 2; ++bt) {
                        f32x4 y = (f32x4){0.f, 0.f, 0.f, 0.f};
#pragma unroll
                        for (int ks = 0; ks < 4; ++ks) { const bf16x8 xf = *(const LAS bf16x8*)(Xs + (bt * 16 + (lane & 15)) * 272 + (32 * ks + 8 * (lane >> 4)) * 2); y = __builtin_amdgcn_mfma_f32_16x16x32_bf16(Cf[ks], xf, y, 0, 0, 0); }
                        const int qq = pos0 + (lane & 15) - CTXL, tl = d ? (SEQ - 1 - qq) : qq, bb = 2 * bp + bt;
                        u32x2 w; w.x = pk2(y[0], y[1]); w.y = pk2(y[2], y[3]);
                        *(u32x2*)(Ys + ((size_t)(d * M + bb * SEQ + tl)) * S5W + g * 16 + 4 * (lane >> 4)) = w;
                    }
                    LDS_WAIT();
                }
            }
#pragma unroll
            for (int q = 0; q < 3; ++q) uc[q] = un[q];
        }
    }
    __syncthreads();
}

FI void h1_item(const Args& A, LAS unsigned char* lds, int item, int tid) {
    unsigned char* ws = A.ws;
    const bf16_t* P = (const bf16_t*)(ws + WS_P); bf16_t* Vt = (bf16_t*)(ws + WS_VT);
    const int gr = item >> 3, cg = item & 7, b = gr >> 5, t0 = (gr & 31) * 64, c0 = cg * 128;
    for (int idx = tid; idx < 2 * 64 * 16; idx += NTHR) { const int ch = idx >> 10, rem = idx & 1023, row = rem >> 4, sg = rem & 15;
        const u32x4 v = *(const u32x4*)(P + (size_t)(b * SEQ + t0 + row) * DIN + S5W + ch * HYW + c0 + sg * 8);
        *(LAS u32x4*)(lds + ch * 16896 + (row + 1) * 256 + sg * 16) = v; }
    if (tid < 64) { const int ch = tid >> 5, rr = (tid >> 4) & 1, sg = tid & 15; *(LAS u32x4*)(lds + ch * 16896 + (rr ? 65 : 0) * 256 + sg * 16) = (u32x4){0u, 0u, 0u, 0u}; }
    __syncthreads();
    const int c = tid & 127, tq = tid >> 7, cc = c0 + c;
    const float* cw = A.in[19]; const float* cb = A.in[20];
    const float w0v = cw[cc], w1v = cw[3072 + cc], w2v = cw[6144 + cc], bv = cb[cc];
    const float w0x = cw[HYW + cc], w1x = cw[3072 + HYW + cc], w2x = cw[6144 + HYW + cc], bx = cb[HYW + cc];
    const LAS bf16_t* Vs = (const LAS bf16_t*)lds; const LAS bf16_t* Xs = (const LAS bf16_t*)(lds + 16896);
    float o[16];
#pragma unroll
    for (int i = 0; i < 16; ++i) { const int t = tq * 16 + i;
        const float v = w0v * bf1(Vs[t * 128 + c]) + w1v * bf1(Vs[(t + 1) * 128 + c]) + w2v * bf1(Vs[(t + 2) * 128 + c]) + bv;
        const float x = w0x * bf1(Xs[t * 128 + c]) + w1x * bf1(Xs[(t + 1) * 128 + c]) + w2x * bf1(Xs[(t + 2) * 128 + c]) + bx;
        o[i] = v * x; }
    bf16_t* dst = Vt + ((size_t)(cc * NB + b) * SEQ + t0 + tq * 16);
    u32x4 w0; w0.x = pk2(o[0], o[1]); w0.y = pk2(o[2], o[3]); w0.z = pk2(o[4], o[5]); w0.w = pk2(o[6], o[7]);
    u32x4 w1; w1.x = pk2(o[8], o[9]); w1.y = pk2(o[10], o[11]); w1.z = pk2(o[12], o[13]); w1.w = pk2(o[14], o[15]);
    *(u32x4*)dst = w0; *(u32x4*)(dst + 8) = w1;
    __syncthreads();
}

constexpr int RT_STRIDE = 8208, VS_OFF = 8 * RT_STRIDE, VS_STRIDE = 4112;
FI void longconv_channel(const Args& A, LAS unsigned char* lds, int c, int tid, int lane, int wave) {
    unsigned char* ws = A.ws;
    const bf16_t* Rg = (const bf16_t*)(ws + WS_RG) + (size_t)c * 4096; const bf16_t* Vt = (const bf16_t*)(ws + WS_VT) + (size_t)c * NB * SEQ; bf16_t* LC = (bf16_t*)(ws + WS_LCT) + (size_t)c * NB * SEQ;
    for (int i = tid; i < VS_OFF / 16; i += NTHR) *(LAS u32x4*)(lds + i * 16) = (u32x4){0u, 0u, 0u, 0u};
    for (int i = tid; i < NB * SEQ / 8; i += NTHR) { const int bb = i >> 8, s8 = i & 255; *(LAS u32x4*)(lds + VS_OFF + bb * VS_STRIDE + s8 * 16) = *(const u32x4*)(Vt + (size_t)bb * SEQ + s8 * 8); }
    __syncthreads();
    for (int i = tid; i < 4096; i += NTHR) { const bf16_t v = Rg[i];
#pragma unroll
        for (int r = 0; r < 8; ++r) *(LAS bf16_t*)(lds + r * RT_STRIDE + (i + r) * 2) = v; }
    __syncthreads();
    const int a = lane & 15, q = lane >> 4, r = (a + 1) & 7;
    const LAS unsigned char* vb = lds + VS_OFF + (lane & 7) * VS_STRIDE + 16 * q;
#pragma unroll 1
    for (int grp = 0; grp < 2; ++grp) {
        const int i0 = wave * 16 + grp * 8;
        const LAS unsigned char* rb = lds + r * RT_STRIDE + 2 * (2047 - 16 * (i0 + 7) - a + 8 * q + r);
        f32x4 acc[8];
#pragma unroll
        for (int ii = 0; ii < 8; ++ii) acc[ii] = (f32x4){0.f, 0.f, 0.f, 0.f};
        bf16x8 S[8];
#pragma unroll
        for (int ii = 2; ii < 8; ++ii) S[ii] = *(const LAS bf16x8*)(rb + 32 * (7 - ii));
#pragma unroll 1
        for (int j4 = 0; j4 < 64; j4 += 4) {
#pragma unroll
            for (int jj = 0; jj < 4; ++jj) {
                const int j = j4 + jj;
                const bf16x8 bfr = *(const LAS bf16x8*)(vb + 64 * j);
                S[(0 - 2 * jj) & 7] = *(const LAS bf16x8*)(rb + 32 * 7 + 64 * j);
                S[(1 - 2 * jj) & 7] = *(const LAS bf16x8*)(rb + 32 * 6 + 64 * j);
#pragma unroll
                for (int ii = 0; ii < 8; ++ii) acc[ii] = __builtin_amdgcn_mfma_f32_16x16x32_bf16(S[(ii - 2 * jj) & 7], bfr, acc[ii], 0, 0, 0);
            }
        }
        if (a < 8) {
#pragma unroll
            for (int ii = 0; ii < 8; ++ii) { u32x2 w; w.x = pk2(acc[ii][0], acc[ii][1]); w.y = pk2(acc[ii][2], acc[ii][3]); *(u32x2*)(LC + (size_t)a * SEQ + 16 * (i0 + ii) + 4 * q) = w; }
        }
    }
    __syncthreads();
}

FI void s5_combine(const Args& A, int gtid, int gthreads) {
    unsigned char* ws = A.ws;
    const bf16_t* P = (const bf16_t*)(ws + WS_P); const bf16_t* Ys = (const bf16_t*)(ws + WS_YS5); bf16_t* Yg = (bf16_t*)(ws + WS_YG); const float* dsk = A.in[16];
    for (int idx = gtid; idx < M * 128; idx += gthreads) {
        const int row = idx >> 7, c8 = (idx & 127) * 8;
        const u32x4 u = *(const u32x4*)(P + (size_t)row * DIN + c8), yf = *(const u32x4*)(Ys + (size_t)row * S5W + c8), yb = *(const u32x4*)(Ys + (size_t)(M + row) * S5W + c8);
        const f32x4 d0 = *(const f32x4*)(dsk + c8), d1 = *(const f32x4*)(dsk + c8 + 4);
        float y[8];
        y[0] = bflo(u.x) * d0.x + bflo(yf.x) + bflo(yb.x); y[1] = bfhi(u.x) * d0.y + bfhi(yf.x) + bfhi(yb.x);
        y[2] = bflo(u.y) * d0.z + bflo(yf.y) + bflo(yb.y); y[3] = bfhi(u.y) * d0.w + bfhi(yf.y) + bfhi(yb.y);
        y[4] = bflo(u.z) * d1.x + bflo(yf.z) + bflo(yb.z); y[5] = bfhi(u.z) * d1.y + bfhi(yf.z) + bfhi(yb.z);
        y[6] = bflo(u.w) * d1.z + bflo(yf.w) + bflo(yb.w); y[7] = bfhi(u.w) * d1.w + bfhi(yf.w) + bfhi(yb.w);
#pragma unroll
        for (int e = 0; e < 8; ++e) y[e] = 0.5f * y[e] * (1.0f + erff(y[e] * 0.70710678118654752f));
        u32x4 w; w.x = pk2(y[0], y[1]); w.y = pk2(y[2], y[3]); w.z = pk2(y[4], y[5]); w.w = pk2(y[6], y[7]);
        *(u32x4*)(Yg + (size_t)row * S5W + c8) = w;
    }
}

FI void h3_item(const Args& A, LAS unsigned char* lds, int item, int tid) {
    unsigned char* ws = A.ws;
    const bf16_t* P = (const bf16_t*)(ws + WS_P); const bf16_t* LC = (const bf16_t*)(ws + WS_LCT); bf16_t* Yc = (bf16_t*)(ws + WS_YCAT);
    const int gr = item >> 3, cg = item & 7, b = gr >> 5, t0 = (gr & 31) * 64, c0 = cg * 128;
    for (int idx = tid; idx < 3 * 64 * 16; idx += NTHR) { const int ch = idx >> 10, rem = idx & 1023, row = rem >> 4, sg = rem & 15;
        const u32x4 v = *(const u32x4*)(P + (size_t)(b * SEQ + t0 + row) * DIN + S5W + ch * HYW + c0 + sg * 8);
        *(LAS u32x4*)(lds + ch * 16896 + (row + 1) * 256 + sg * 16) = v; }
    if (tid < 96) { const int ch = tid >> 5, rr = (tid >> 4) & 1, sg = tid & 15; *(LAS u32x4*)(lds + ch * 16896 + (rr ? 65 : 0) * 256 + sg * 16) = (u32x4){0u, 0u, 0u, 0u}; }
    LAS bf16_t* Ls = (LAS bf16_t*)(lds + 3 * 16896);
    for (int idx = tid; idx < 128 * 8; idx += NTHR) { const int c = idx >> 3, pc = idx & 7;
        const u32x4 v = *(const u32x4*)(LC + (size_t)((c0 + c) * NB + b) * SEQ + t0 + pc * 8);
        const unsigned wv[4] = {v.x, v.y, v.z, v.w};
#pragma unroll
        for (int e = 0; e < 4; ++e) { Ls[(pc * 8 + 2 * e) * 128 + c] = (bf16_t)(wv[e] & 0xffffu); Ls[(pc * 8 + 2 * e + 1) * 128 + c] = (bf16_t)(wv[e] >> 16); } }
    __syncthreads();
    const int c = tid & 127, tq = tid >> 7, cc = c0 + c;
    const float* cw = A.in[19]; const float* cb = A.in[20];
    const float w0v = cw[cc], w1v = cw[3072 + cc], w2v = cw[6144 + cc], bv = cb[cc];
    const float w0x = cw[HYW + cc], w1x = cw[3072 + HYW + cc], w2x = cw[6144 + HYW + cc], bx = cb[HYW + cc];
    const float w0z = cw[2 * HYW + cc], w1z = cw[3072 + 2 * HYW + cc], w2z = cw[6144 + 2 * HYW + cc], bz = cb[2 * HYW + cc];
    const float dd = A.in[30][cc];
    const LAS bf16_t* Vs = (const LAS bf16_t*)lds; const LAS bf16_t* Xs = (const LAS bf16_t*)(lds + 16896); const LAS bf16_t* Zs = (const LAS bf16_t*)(lds + 2 * 16896);
#pragma unroll 4
    for (int i = 0; i < 16; ++i) { const int t = tq * 16 + i;
        const float v = w0v * bf1(Vs[t * 128 + c]) + w1v * bf1(Vs[(t + 1) * 128 + c]) + w2v * bf1(Vs[(t + 2) * 128 + c]) + bv;
        const float x = w0x * bf1(Xs[t * 128 + c]) + w1x * bf1(Xs[(t + 1) * 128 + c]) + w2x * bf1(Xs[(t + 2) * 128 + c]) + bx;
        const float z = w0z * bf1(Zs[t * 128 + c]) + w1z * bf1(Zs[(t + 1) * 128 + c]) + w2z * bf1(Zs[(t + 2) * 128 + c]) + bz;
        const float vg = v * x, y = (bf1(Ls[t * 128 + c]) + vg * dd) * z;
        Yc[(size_t)(b * SEQ + t0 + t) * D + S5W + cc] = (bf16_t)f2bf(y); }
    __syncthreads();
}

FI void p7_run(const Args& A, LAS unsigned char* lds, int lane, int wave, int vcu, int G, bool commit) {
    unsigned char* ws = A.ws;
    const float* x1 = (const float*)(ws + WS_X1); unsigned char* A2 = ws + WS_A2;
    const float* mod = (const float*)(ws + WS_MODF); const float* g2 = A.in[7];
    const float* wrt = A.in[32]; const float* brt = A.in[33];
    int* cnt = (int*)(ws + WS_CTL) + CW_CNT; int* rowl = (int*)(ws + WS_ROWL); int* pk = (int*)(ws + WS_PK); float* gate = (float*)(ws + WS_GATE);
    LAS float* hb = (LAS float*)(lds + wave * 8192);
    const int e = lane & 31, kh = lane >> 5;
    for (int it = vcu; it < M / 64; it += G) {
        const int rbase = it * 64 + wave * 8, b = rbase / SEQ;
        float rstd[8];
#pragma unroll
        for (int r = 0; r < 8; ++r) { float ss = 0.f;
#pragma unroll
            for (int j = 0; j < 8; ++j) { const f32x4 v = *(const f32x4*)(x1 + (size_t)(rbase + r) * D + 4 * lane + 256 * j); ss += (v.x * v.x + v.y * v.y) + (v.z * v.z + v.w * v.w); }
            rstd[r] = rsqrtf(wave_sum(ss) * (1.0f / D) + 1e-6f); }
        float lg[8];
#pragma unroll
        for (int r = 0; r < 8; ++r) lg[r] = 0.f;
#pragma unroll 1
        for (int kc = 0; kc < 8; ++kc) {
            const int col = kc * 256 + 4 * lane;
            const f32x4 gv = *(const f32x4*)(g2 + col);
            const f32x4 sh = *(const f32x4*)(mod + (size_t)b * 12288 + 3 * D + col);
            const f32x4 sc = *(const f32x4*)(mod + (size_t)b * 12288 + 4 * D + col) + 1.0f;
#pragma unroll
            for (int r = 0; r < 8; ++r) { const f32x4 xv = *(const f32x4*)(x1 + (size_t)(rbase + r) * D + col);
                const f32x4 h = xv * rstd[r] * gv * sc + sh;
                *(unsigned*)(A2 + (size_t)(rbase + r) * D + col) = pk4_fp8(h.x, h.y, h.z, h.w);
                *(LAS f32x4*)(hb + r * 256 + 4 * lane) = h; }
            LDS_WAIT();
            const float* wp = wrt + (size_t)(kc * 256 + kh * 128) * NE + e;
#pragma unroll 2
            for (int jj = 0; jj < 128; jj += 4) {
                const float w0 = wp[(jj + 0) * NE], w1 = wp[(jj + 1) * NE], w2 = wp[(jj + 2) * NE], w3 = wp[(jj + 3) * NE];
#pragma unroll
                for (int r = 0; r < 8; ++r) { const f32x4 hv = *(const LAS f32x4*)(hb + r * 256 + kh * 128 + jj); lg[r] += (hv.x * w0 + hv.y * w1) + (hv.z * w2 + hv.w * w3); }
            }
            LDS_WAIT();
        }
        const float be = brt[e];
#pragma unroll
        for (int r = 0; r < 8; ++r) {
            float v = lg[r] + __shfl_xor(lg[r], 32) + be;
            float tv[4]; int ti[4];
#pragma unroll
            for (int k = 0; k < 4; ++k) { float bvv = v; int bi = e;
#pragma unroll
                for (int o = 16; o >= 1; o >>= 1) { const float ov = __shfl_xor(bvv, o); const int oi = __shfl_xor(bi, o); if (ov > bvv || (ov == bvv && oi < bi)) { bvv = ov; bi = oi; } }
                tv[k] = bvv; ti[k] = bi; if (e == bi) v = -3.0e38f; }
            const float e1 = __expf(tv[1] - tv[0]), e2 = __expf(tv[2] - tv[0]), e3 = __expf(tv[3] - tv[0]), inv = 1.0f / (1.0f + e1 + e2 + e3);
            if (lane < 4 && commit) { const int ex = lane == 0 ? ti[0] : lane == 1 ? ti[1] : lane == 2 ? ti[2] : ti[3];
                const float gx = (lane == 0 ? 1.0f : lane == 1 ? e1 : lane == 2 ? e2 : e3) * inv;
                const int row = rbase + r, slot = atomicAdd(cnt + ex, 1);
                rowl[ex * M + slot] = row; pk[row * 4 + lane] = ex * M + slot; gate[row * 4 + lane] = gx; }
        }
    }
}

FI void moe_table(const Args& A, LAS unsigned char* lds, int tid) {
    const int* cnt = (const int*)(A.ws + WS_CTL) + CW_CNT;
    LAS int* tw = (LAS int*)(lds + LDSCTL_OFF);
    if (tid < 64) { const int n = tid < NE ? cnt[tid] : 0; int p = (n + 255) >> 8;
#pragma unroll
        for (int o = 1; o < 32; o <<= 1) { const int q = __shfl_up(p, o); if ((tid & 63) >= o) p += q; }
        if (tid < NE) { tw[LW_TST + tid + 1] = p; tw[LW_CNT + tid] = n; } if (tid == 0) tw[LW_TST] = 0; }
    __syncthreads();
    if (tid < 320) { int e = 0;
#pragma unroll 1
        for (int j = 1; j < NE; ++j) e += (tw[LW_TST + j] <= tid) ? 1 : 0;
        tw[LW_TE + tid] = e; }
    __syncthreads();
}

FI void p10_run(const Args& A, LAS unsigned char* lds, int lane, int wave, int vcu, int G) {
    unsigned char* ws = A.ws;
    const float* x1 = (const float*)(ws + WS_X1); const bf16_t* Yd = (const bf16_t*)(ws + WS_YD);
    const float* mod = (const float*)(ws + WS_MODF); const float* gf = A.in[38];
    const int* pk = (const int*)(ws + WS_PK); const float* gate = (const float*)(ws + WS_GATE);
    const LAS int* tst = (const LAS int*)(lds + LDSCTL_OFF) + LW_TST;
    const int gw = vcu * NWAVES + wave, NGW = G * NWAVES;
    for (int row = gw; row < M; row += NGW) {
        const int b = row / SEQ; size_t hr[4]; float gk[4];
#pragma unroll
        for (int k = 0; k < 4; ++k) { const int p = pk[row * 4 + k], ex = p / M, slot = p % M; hr[k] = (size_t)(tst[ex] * 256 + slot) * D; gk[k] = gate[row * 4 + k]; }
        f32x4 x2[8]; float ss = 0.f;
#pragma unroll
        for (int j = 0; j < 8; ++j) { const int col = 4 * lane + 256 * j;
            f32x4 s = (f32x4){0.f, 0.f, 0.f, 0.f};
#pragma unroll
            for (int k = 0; k < 4; ++k) { const u32x2 y = *(const u32x2*)(Yd + hr[k] + col); s += (f32x4){bflo(y.x), bfhi(y.x), bflo(y.y), bfhi(y.y)} * gk[k]; }
            const f32x4 ga = *(const f32x4*)(mod + (size_t)b * 12288 + 5 * D + col);
            x2[j] = *(const f32x4*)(x1 + (size_t)row * D + col) + ga * s;
            ss += (x2[j].x * x2[j].x + x2[j].y * x2[j].y) + (x2[j].z * x2[j].z + x2[j].w * x2[j].w); }
        const float rstd = rsqrtf(wave_sum(ss) * (1.0f / D) + 1e-6f);
#pragma unroll
        for (int j = 0; j < 8; ++j) { const int col = 4 * lane + 256 * j; *(f32x4*)(A.out + (size_t)row * D + col) = x2[j] * rstd * *(const f32x4*)(gf + col); }
    }
}

__global__ void __launch_bounds__(NTHR, 2) fwd_kernel(Args args) {
    extern __shared__ __attribute__((aligned(16))) unsigned char lds_raw[];
    LAS unsigned char* lds = (LAS unsigned char*)lds_raw;
    const int tid = threadIdx.x, lane = tid & 63, wave = __builtin_amdgcn_readfirstlane(tid >> 6);
    const int G = gridDim.x; const int bx = blockIdx.x; const int vcu = (G % 8 == 0) ? (bx % 8) * (G / 8) + bx / 8 : bx;
    unsigned char* ws = args.ws;
    for (int u = tid; u < (LDS_BYTES - LDSCTL_OFF) / 4; u += NTHR) ((LAS unsigned*)(lds + LDSCTL_OFF))[u] = 0u;
    __syncthreads();
    XcdBarrier bar; bar.bar = (unsigned*)(ws + WS_CTL) + CW_BAR; bar.x = 0; bar.st = nullptr;
#if !MK_SPLIT
    bar = xcd_barrier_post((unsigned*)(ws + WS_CTL) + CW_BAR, (volatile LAS unsigned*)(lds + LDSCTL_OFF) + LW_BAR);
#endif
    const int lo = args.ph_lo, hi = args.ph_hi;
#ifndef PHASE_MASK
#define PHASE_MASK 0x7ff
#endif
#define IN(k) (((PHASE_MASK >> (k)) & 1) && lo <= (k) && (k) < hi)
#if MK_SPLIT
#define SEAM(k) do { } while (0)
#else
#define SEAM(k) do { if (IN(k) && IN((k) + 1)) xcd_barrier(bar); } while (0)
#endif
    const float* modp = (const float*)(ws + WS_MODF);

    if (IN(0)) { p0_run(args, lds, tid, lane, wave, vcu, G); } SEAM(0);
    if (IN(1)) { _Pragma("unroll 1") for (int rep = 0; rep < REP1; ++rep) p1_run(args, tid, lane, wave, vcu, G); } SEAM(1);
    if (IN(2)) {
        pg8::DenseSched S{(const bf16_t*)(ws + WS_A1), (const bf16_t*)(ws + WS_WIN), 2 * D, M / 256, DIN / 256, G, bx, M / 256, MC / 256, S5W / 256};
        pg8::EpiStoreBf16 E{(bf16_t*)(ws + WS_P), DIN, nullptr, 0, 1.0f};
        _Pragma("unroll 1") for (int rep = 0; rep < REP2; ++rep)
        pg8::gemm_phase<false>(lds, 2 * D, S, E);
    } SEAM(2);
    if (IN(3)) {
        _Pragma("unroll 1") for (int rep = 0; rep < REP3; ++rep) {
        for (int u = vcu; u < 512; u += G) s5_unit(args, lds, u, lane, wave);
        for (int it = vcu; it < 2048; it += G) h1_item(args, lds, it, tid); }
    } SEAM(3);
    if (IN(4)) {
        _Pragma("unroll 1") for (int rep = 0; rep < REP4; ++rep) {
        s5_combine(args, vcu * NTHR + tid, G * NTHR);
        for (int c = vcu; c < HYW; c += G) longconv_channel(args, lds, c, tid, lane, wave); }
    } SEAM(4);
    if (IN(5)) {
        _Pragma("unroll 1") for (int rep = 0; rep < REP5; ++rep) for (int it = vcu; it < 2048; it += G) h3_item(args, lds, it, tid);
        pg8::DenseSched S{(const bf16_t*)(ws + WS_YG), (const bf16_t*)(ws + WS_WGLU), 2 * S5W, M / 256, S5W / 256, G, bx, 0, 0, 0};
        pg8::EpiGlu E{(const bf16_t*)(ws + WS_YG), (bf16_t*)(ws + WS_YCAT), args.in[18]};
        pg8::gemm_phase<false>(lds, 2 * S5W, S, E);
    } SEAM(5);
    if (IN(6)) {
        pg8::DenseSched S{(const bf16_t*)(ws + WS_YCAT), (const bf16_t*)(ws + WS_WOUT), 2 * D, M / 256, D / 256, G, bx, 0, 0, 0};
        pg8::EpiResid E{args.in[0], (float*)(ws + WS_X1), modp};
        _Pragma("unroll 1") for (int rep = 0; rep < REP6; ++rep)
        pg8::gemm_phase<false>(lds, 2 * D, S, E);
    } SEAM(6);
    if (IN(7)) { _Pragma("unroll 1") for (int rep = 0; rep < REP7; ++rep) p7_run(args, lds, lane, wave, vcu, G, rep == REP7 - 1); } SEAM(7);
    if (IN(8)) {
        moe_table(args, lds, tid);
        pg8::MoeSched<true> S{ws + WS_A2, ws + WS_WGU, D, 16, G, bx, (size_t)4096 * D,
                              (const LAS int*)(lds + LDSCTL_OFF) + LW_TST, (const LAS int*)(lds + LDSCTL_OFF) + LW_CNT, (const int*)(ws + WS_ROWL)};
        pg8::EpiSwiglu E{ws + WS_H, args.in[35], 1.0f / WSCALE};
        _Pragma("unroll 1") for (int rep = 0; rep < REP8; ++rep)
        pg8::gemm_phase<true>(lds, D, S, E);
    } SEAM(8);
    if (IN(9)) {
        moe_table(args, lds, tid);
        pg8::MoeSched<false> S{ws + WS_H, ws + WS_WDN, DFF, 8, G, bx, (size_t)D * DFF,
                               (const LAS int*)(lds + LDSCTL_OFF) + LW_TST, (const LAS int*)(lds + LDSCTL_OFF) + LW_CNT, (const int*)(ws + WS_ROWL)};
        pg8::EpiStoreBf16 E{(bf16_t*)(ws + WS_YD), D, args.in[37], D, 1.0f / WSCALE};
        _Pragma("unroll 1") for (int rep = 0; rep < REP9; ++rep)
        pg8::gemm_phase<true>(lds, DFF, S, E);
    } SEAM(9);
    if (IN(10)) { moe_table(args, lds, tid); _Pragma("unroll 1") for (int rep = 0; rep < REP10; ++rep) p10_run(args, lds, lane, wave, vcu, G); }
#undef IN
#undef SEAM
}

extern "C" void kernel_launch(void* const* d_in, const int* in_sizes, int n_in, void* d_out, int out_size, void* d_ws, size_t ws_size, hipStream_t stream) {
    static int grid = 0;
    if (grid == 0) {
        if (n_in != 39 || out_size != M * D || ws_size < WS_END) { fprintf(stderr, "kernel_launch: unexpected problem (n_in %d, out %d, ws %zu)\n", n_in, out_size, ws_size); grid = -1; return; }
        int dev = 0, cus = 0, per_cu = 0;
        if (hipGetDevice(&dev) != hipSuccess || hipDeviceGetAttribute(&cus, hipDeviceAttributeMultiprocessorCount, dev) != hipSuccess) { grid = -1; return; }
        if (hipFuncSetAttribute((const void*)fwd_kernel, hipFuncAttributeMaxDynamicSharedMemorySize, LDS_BYTES) != hipSuccess) { fprintf(stderr, "kernel_launch: hipFuncSetAttribute failed\n"); grid = -1; return; }
        if (hipOccupancyMaxActiveBlocksPerMultiprocessor(&per_cu, (const void*)fwd_kernel, NTHR, LDS_BYTES) != hipSuccess || per_cu < 1) fprintf(stderr, "kernel_launch: occupancy query says %d\n", per_cu);
        (void)hipGetLastError();
        grid = cus;
    }
    if (grid < 0) return;
    (void)in_sizes;
    if (hipMemsetAsync((char*)d_ws + WS_CTL, 0, CTL_ZERO_BYTES, stream) != hipSuccess) { fprintf(stderr, "kernel_launch: memset failed\n"); return; }
    Args a{};
    for (int i = 0; i < 39; ++i) a.in[i] = (const float*)d_in[i];
    a.out = (float*)d_out; a.ws = (unsigned char*)d_ws;
#if MK_SPLIT
    for (int p = 0; p < NPHASE; ++p) { a.ph_lo = p; a.ph_hi = p + 1; hipLaunchKernelGGL(fwd_kernel, dim3(grid), dim3(NTHR), LDS_BYTES, stream, a); }
#else
    a.ph_lo = 0; a.ph_hi = NPHASE;
    hipLaunchKernelGGL(fwd_kernel, dim3(grid), dim3(NTHR), LDS_BYTES, stream, a);
#endif
    const hipError_t le = hipPeekAtLastError();
    if (le != hipSuccess) fprintf(stderr, "kernel_launch: launch failed: %s\n", hipGetErrorName(le));
}
```

```cpp
#include <hip/hip_runtime.h>
#include <cstdio>
#include <cstdint>

#ifndef MK_SPLIT
#define MK_SPLIT 0
#endif

#ifndef REP0D
#define REP0D 1
#endif
#ifndef REP2
#define REP2 1
#endif
#ifndef AMP_PHASE
#define AMP_PHASE -1
#endif
#ifndef REP1
#define REP1 1
#endif
#ifndef REP5
#define REP5 1
#endif
#ifndef REP7
#define REP7 1
#endif
#ifndef REP10
#define REP10 1
#endif
#ifndef REP0A
#define REP0A 1
#endif
#ifndef REP3
#define REP3 1
#endif
#ifndef REP3A
#define REP3A 1
#endif
#ifndef REP3B
#define REP3B 1
#endif
#ifndef REP4A
#define REP4A 1
#endif
#ifndef REP4B
#define REP4B 1
#endif
#ifndef REP4
#define REP4 1
#endif
#ifndef REP6
#define REP6 1
#endif
#ifndef REP8
#define REP8 1
#endif
#ifndef REP9
#define REP9 1
#endif
#define GAS __attribute__((address_space(1)))
#define LAS __attribute__((address_space(3)))
typedef unsigned short bf16_t;
typedef short bf16x8 __attribute__((ext_vector_type(8)));
typedef float f32x4 __attribute__((ext_vector_type(4)));
typedef float f32x16 __attribute__((ext_vector_type(16)));
typedef unsigned u32x4 __attribute__((ext_vector_type(4)));
typedef unsigned u32x2 __attribute__((ext_vector_type(2)));

constexpr int NWAVES = 8, NTHR = 512;
constexpr int D = 2048, NB = 8, SEQ = 2048, M = NB * SEQ, CTXL = 256, MC = NB * CTXL, MT = M + MC;
constexpr int DIN = 4096, S5W = 1024, HYW = 1024, NG = 64;
constexpr int NE = 32, DFF = 2048;
constexpr int NPHASE = 11;
constexpr float WSCALE = 64.0f;
constexpr int SEG = 288;

constexpr size_t MiB = 1u << 20;
constexpr size_t WS_CTL = 0, CTL_ZERO_BYTES = 1024 * 1024;
constexpr int CW_TMO = 0, CW_BAR = 4096, CW_CNT = 8192, CW_HNORM = 12288, CW_MOD = 16384;
constexpr size_t WS_LAM = 1 * MiB, WS_LAML = WS_LAM + 64 * 1024, WS_S5B = WS_LAM + 128 * 1024, WS_S5C = WS_LAM + 640 * 1024;
constexpr size_t WS_HRAW = 4 * MiB, WS_RG = 20 * MiB, WS_WIN = 28 * MiB, WS_WGLU = 44 * MiB, WS_WOUT = 46 * MiB;
constexpr size_t WS_PK = 54 * MiB, WS_GATE = WS_PK + 256 * 1024, WS_ROWL = 55 * MiB, WS_MODF = 58 * MiB;
constexpr size_t WS_A1 = 64 * MiB, WS_P = 136 * MiB, WS_YS5 = 280 * MiB, WS_VT = 344 * MiB, WS_LCT = 376 * MiB, WS_YG = 408 * MiB;
constexpr size_t WS_YCAT = 440 * MiB, WS_X1 = 504 * MiB, WS_A2 = 632 * MiB, WS_WGU = 704 * MiB, WS_WDN = 1216 * MiB;
constexpr size_t WS_H = 1472 * MiB, WS_YD = 1760 * MiB, WS_END = 2048 * MiB;
constexpr int HROWS = 73728;

constexpr int RING_BYTES = 131072, LDSCTL_OFF = RING_BYTES, LDS_BYTES = 147456;
constexpr int LW_BAR = 8, LW_TST = 64, LW_CNT = 128, LW_TE = 256;

typedef __bf16 bf16v2 __attribute__((ext_vector_type(2)));
typedef float f32v2 __attribute__((ext_vector_type(2)));
__device__ __forceinline__ unsigned f2bf(float f) { return (unsigned)__builtin_bit_cast(unsigned short, (__bf16)f); }
__device__ __forceinline__ unsigned pk2(float lo, float hi) { const f32v2 v = {lo, hi}; return __builtin_bit_cast(unsigned, __builtin_convertvector(v, bf16v2)); }
__device__ __forceinline__ float bflo(unsigned w) { return __builtin_bit_cast(float, w << 16); }
__device__ __forceinline__ float bfhi(unsigned w) { return __builtin_bit_cast(float, w & 0xffff0000u); }
__device__ __forceinline__ float bf1(bf16_t b) { return __builtin_bit_cast(float, (unsigned)b << 16); }
__device__ __forceinline__ unsigned pk4_fp8(float a, float b, float c, float d) { int w = __builtin_amdgcn_cvt_pk_fp8_f32(a, b, 0, false); w = __builtin_amdgcn_cvt_pk_fp8_f32(c, d, w, true); return (unsigned)w; }
constexpr float FIX_SCALE = 4294967296.0f;
__device__ __forceinline__ void fix_add(unsigned long long* p, float v) { atomicAdd(p, (unsigned long long)__float2ll_rn(v * FIX_SCALE)); }
__device__ __forceinline__ float fix_get(const unsigned long long* p) { return (float)((double)(long long)(*p) * (1.0 / 4294967296.0)); }
__device__ __forceinline__ float wave_sum(float v) {
#pragma unroll
    for (int o = 1; o < 64; o <<= 1) v += __shfl_xor(v, o);
    return v;
}
#define LDS_WAIT() asm volatile("s_waitcnt lgkmcnt(0)" ::: "memory")
#define VM_WAIT() asm volatile("s_waitcnt vmcnt(0)" ::: "memory")

#define XB_TMO      128
#define XB_XCNT(j)  (256  + 64 * (j))
#define XB_XSUB(j)  (1280 + 64 * (j))
#define XB_XGEN(j)  (2304 + 64 * (j))
#define XB_TOP      3328
#define XB_TOPGEN   3392
#define XCD_BAR_WORDS 3456
#define XB_SPIN_CAP (1u << 18)
__device__ __forceinline__ unsigned xb_ld(unsigned* p)              { return __hip_atomic_load(p, __ATOMIC_RELAXED, __HIP_MEMORY_SCOPE_AGENT); }
__device__ __forceinline__ unsigned xb_add(unsigned* p, unsigned v) { return __hip_atomic_fetch_add(p, v, __ATOMIC_RELAXED, __HIP_MEMORY_SCOPE_AGENT); }
__device__ __forceinline__ unsigned xb_xcc_id() { return (unsigned)__builtin_amdgcn_s_getreg((3 << 11) | 20) & 0xFu; }
#define XB_SPIN(cond, bar) do { unsigned _sp = 0; while (cond) { __builtin_amdgcn_s_sleep(1); \
    if ((++_sp & 255u) == 0u) { if (xb_ld(&(bar)[XB_TMO])) break; if (_sp > XB_SPIN_CAP) { atomicAdd(&(bar)[XB_TMO], 1u); break; } } } } while (0)
struct XcdBarrier { unsigned* bar; unsigned x; volatile LAS unsigned* st; };
__device__ __forceinline__ XcdBarrier xcd_barrier_post(unsigned* bar, volatile LAS unsigned* st) {
    XcdBarrier b; b.bar = bar; b.x = xb_xcc_id(); b.st = st;
    if (threadIdx.x == 0) (void)xb_add(&bar[XB_XCNT(b.x)], 1u);
    return b;
}
__device__ __forceinline__ void xcd_barrier_complete(unsigned* bar, unsigned x, unsigned& nloc, unsigned& nx) {
    const unsigned G = gridDim.x * gridDim.y * gridDim.z;
    unsigned sum, cnt, mine, sp = 0u;
    for (;;) {
        sum = 0u; cnt = 0u; mine = 0u;
#pragma unroll
        for (unsigned j = 0; j < 16; ++j) { const unsigned c = xb_ld(&bar[XB_XCNT(j)]); sum += c; cnt += (c > 0u) ? 1u : 0u; mine = (j == x) ? c : mine; }
        if (sum == G) break;
        __builtin_amdgcn_s_sleep(1);
        if ((++sp & 255u) == 0u) { if (xb_ld(&bar[XB_TMO])) break; if (sp > XB_SPIN_CAP) { atomicAdd(&bar[XB_TMO], 1u); break; } }
    }
    nloc = mine > 0u ? mine : 1u; nx = cnt > 0u ? cnt : 1u;
}
__device__ __forceinline__ void xcd_barrier(const XcdBarrier& b) {
    asm volatile("s_waitcnt vmcnt(0)" ::: "memory");
    __syncthreads();
    if (threadIdx.x == 0) {
        unsigned* bar = b.bar;
        __builtin_amdgcn_s_waitcnt(0);
        unsigned nloc = b.st[0], nx = b.st[1];
        if (nloc == 0u) { xcd_barrier_complete(bar, b.x, nloc, nx); b.st[0] = nloc; b.st[1] = nx; }
        const unsigned old = xb_add(&bar[XB_XSUB(b.x)], 1u);
        const unsigned gen = old / nloc;
        if (old + 1u == (gen + 1u) * nloc) {
            __builtin_amdgcn_fence(__ATOMIC_RELEASE, "agent");
            asm volatile("s_waitcnt vmcnt(0)" ::: "memory");
            const unsigned og = xb_add(&bar[XB_TOP], 1u);
            const unsigned tg = og / nx;
            if (og + 1u == (tg + 1u) * nx) xb_add(&bar[XB_TOPGEN], 1u);
            else XB_SPIN(xb_ld(&bar[XB_TOPGEN]) == tg, bar);
            __builtin_amdgcn_fence(__ATOMIC_ACQUIRE, "agent");
            xb_add(&bar[XB_XGEN(b.x)], 1u);
            asm volatile("s_waitcnt vmcnt(0)" ::: "memory");
        } else {
            XB_SPIN(xb_ld(&bar[XB_XGEN(b.x)]) == gen, bar);
            __builtin_amdgcn_fence(__ATOMIC_ACQUIRE, "agent");
            asm volatile("s_waitcnt vmcnt(0)" ::: "memory");
        }
    }
    __syncthreads();
}

struct Args { const float* in[39]; float* out; unsigned char* ws; int ph_lo, ph_hi; };

namespace pg8 {
constexpr int BM = 256, BK = 64, HALF = 128, HTB = HALF * BK * 2, STAGE_BYTES = 8 * HTB, NXCD = 8, WGM = 8;
__device__ __forceinline__ int lds_byte(int r, int c) { const int st = (r >> 4) * 2 + (c >> 5), rr = r & 15, cc = c & 31, ob = rr * 64 + cc * 2; return st * 1024 + (ob ^ (((ob >> 9) & 1) << 5)); }
__device__ __forceinline__ void stage_rc(int b, int& R, int& C) { const int st = b / 1024, sb = b % 1024, swz = sb ^ (((sb >> 9) & 1) << 5); R = (st >> 1) * 16 + swz / 64; C = (st & 1) * 32 + (swz % 64) / 2; }
__device__ __forceinline__ int perm32(int rho) { const int n = rho >> 4, i = rho & 15; return 8 * (i >> 2) + 4 * n + (i & 3); }
struct Unit { int pm, pn, e; };
__device__ __forceinline__ unsigned cvt_pk_bf16(float lo, float hi) { unsigned r; asm volatile("v_cvt_pk_bf16_f32 %0, %1, %2" : "=v"(r) : "v"(lo), "v"(hi)); return r; }

__device__ __forceinline__ void tile_of(long L, int nM, int nN, int& pm, int& pn) {
    const int nwg = nM * nN; int wgid = (int)L;
    { const int q = nwg / NXCD, r = nwg % NXCD, xcd = wgid % NXCD, off = wgid / NXCD; wgid = (xcd < r ? xcd * (q + 1) : r * (q + 1) + (xcd - r) * q) + off; }
    const int nig = WGM * nN, gid = wgid / nig, fm = gid * WGM, gsz = (nM - fm) < WGM ? (nM - fm) : WGM;
    pm = fm + ((wgid % nig) % gsz); pn = (wgid % nig) / gsz;
}

struct DenseSched {
    const bf16_t* A; const bf16_t* Bt; int RB, nM, nN, G, c, xM0, xnM, xnN, xN0;
    __device__ __forceinline__ bool next(int i, Unit& u) const {
        const long L = (long)i * G + c; const int nwg = nM * nN;
        if (L < nwg) { tile_of(L, nM, nN, u.pm, u.pn); u.e = 0; return true; }
        const long r = L - nwg; if (r >= (long)xnM * xnN) return false;
        u.pm = xM0 + (int)(r % xnM); u.pn = xN0 + (int)(r / xnM); u.e = 0; return true;
    }
    __device__ __forceinline__ const char* abase(const Unit& u) const { return (const char*)A + (size_t)u.pm * BM * RB; }
    __device__ __forceinline__ const char* bbase(const Unit& u) const { return (const char*)Bt + (size_t)u.pn * BM * RB; }
    __device__ __forceinline__ void rows(const Unit&, unsigned (&va)[2][2], const int (&R)[2], const int (&C)[2]) const {
#pragma unroll
        for (int h = 0; h < 2; ++h)
#pragma unroll
            for (int i = 0; i < 2; ++i) va[h][i] = (unsigned)((h * HALF + R[i]) * RB + 2 * C[i]);
    }
};
template <bool GATHER> struct MoeSched {
    const unsigned char* A; const unsigned char* Bt; int RB, nN, G, c; size_t estride;
    const LAS int* tst; const LAS int* cnts; const int* rowlist;
    __device__ __forceinline__ bool next(int i, Unit& u) const {
        const int TM = __builtin_amdgcn_readfirstlane(tst[NE]); const long L = (long)i * G + c; if (L >= (long)TM * nN) return false;
        tile_of(L, TM, nN, u.pm, u.pn);
        u.e = __builtin_amdgcn_readfirstlane(tst[(LW_TE - LW_TST) + u.pm]); return true;
    }
    __device__ __forceinline__ const char* abase(const Unit& u) const { return GATHER ? (const char*)A : (const char*)A + (size_t)u.pm * BM * RB; }
    __device__ __forceinline__ const char* bbase(const Unit& u) const { return (const char*)Bt + (size_t)u.e * estride + (size_t)u.pn * BM * RB; }
    __device__ __forceinline__ void rows(const Unit& u, unsigned (&va)[2][2], const int (&R)[2], const int (&C)[2]) const {
        if (GATHER) {
            const int n = __builtin_amdgcn_readfirstlane(cnts[u.e]), lt = u.pm - __builtin_amdgcn_readfirstlane(tst[u.e]);
#pragma unroll
            for (int h = 0; h < 2; ++h)
#pragma unroll
                for (int i = 0; i < 2; ++i) { int slot = lt * BM + h * HALF + R[i]; slot = slot < n ? slot : 0; const int tok = rowlist[u.e * M + slot]; va[h][i] = (unsigned)(tok * RB + 2 * C[i]); }
        } else {
#pragma unroll
            for (int h = 0; h < 2; ++h)
#pragma unroll
                for (int i = 0; i < 2; ++i) va[h][i] = (unsigned)((h * HALF + R[i]) * RB + 2 * C[i]);
        }
    }
};

typedef int i32x4 __attribute__((ext_vector_type(4)));
typedef int i32x8 __attribute__((ext_vector_type(8)));
template <bool FP8, class Epi, class Sched>
__device__ __forceinline__ void gemm_phase(LAS unsigned char* lds, const int RB, const Sched& S, const Epi& E) {
    const int tid = threadIdx.x, wid = __builtin_amdgcn_readfirstlane(tid >> 6), lane = tid & 63, wr = wid >> 2, wc = wid & 3, fr = lane & 15, fq = lane >> 4;
    const int nt = RB / 128;
    unsigned voffB[2]; int Rr[2], Cc[2];
#pragma unroll
    for (int i = 0; i < 2; ++i) { int R, C; stage_rc(tid * 16 + i * 8192, R, C); Rr[i] = R; Cc[i] = C; const int Rb = Epi::PERM ? ((R & ~31) + perm32(R & 31)) : R; voffB[i] = (unsigned)(Rb * RB + 2 * C); }
    const size_t kstep = (size_t)(BK * 2);
    const size_t hstep = (size_t)HALF * RB;
    const unsigned ldsw = (unsigned)wid * 1024u;
    const int aoff = lds_byte(wr * 64 + fr, fq * 8), boff = lds_byte(wc * 32 + fr, fq * 8);
#define PG8_SA(b, h) (((b) * 2 + (h)) * HTB)
#define PG8_SB(b, h) ((4 + (b) * 2 + (h)) * HTB)
#define PG8_STAGE(bufoff, gbase, voff) do { _Pragma("unroll") for (int _i = 0; _i < 2; ++_i) \
        __builtin_amdgcn_global_load_lds((const unsigned*)((const char*)(gbase) + (voff)[_i]), (LAS unsigned*)(lds + (bufoff) + ldsw + _i * 8192), 16, 0, 0); } while (0)
#define PG8_LDA(dst, b, h) do { _Pragma("unroll") for (int m = 0; m < 4; ++m) _Pragma("unroll") for (int k = 0; k < 2; ++k) dst[m][k] = *(const LAS bf16x8*)(lds + PG8_SA(b, h) + aoff + m * 2048 + k * 1024); } while (0)
#define PG8_LDB(dst, b, h) do { _Pragma("unroll") for (int n = 0; n < 2; ++n) _Pragma("unroll") for (int k = 0; k < 2; ++k) dst[n][k] = *(const LAS bf16x8*)(lds + PG8_SB(b, h) + boff + n * 2048 + k * 1024); } while (0)
#define PG8_MMA(ai, bj, At, Bt) do { __builtin_amdgcn_s_setprio(1); _Pragma("unroll") for (int m = 0; m < 4; ++m) _Pragma("unroll") for (int n = 0; n < 2; ++n) { \
        if constexpr (FP8) { const i32x8 bb_ = __builtin_shufflevector(__builtin_bit_cast(i32x4, Bt[n][0]), __builtin_bit_cast(i32x4, Bt[n][1]), 0, 1, 2, 3, 4, 5, 6, 7); \
            const i32x8 aa_ = __builtin_shufflevector(__builtin_bit_cast(i32x4, At[m][0]), __builtin_bit_cast(i32x4, At[m][1]), 0, 1, 2, 3, 4, 5, 6, 7); \
            asm volatile("v_mfma_scale_f32_16x16x128_f8f6f4 %0, %1, %2, %0, %3, %3 op_sel_hi:[0,0,0]" : "+v"(acc[ai][bj][m][n]) : "v"(bb_), "v"(aa_), "v"(one_scale)); } \
        else { _Pragma("unroll") for (int k = 0; k < 2; ++k) acc[ai][bj][m][n] = __builtin_amdgcn_mfma_f32_16x16x32_bf16(Bt[n][k], At[m][k], acc[ai][bj][m][n], 0, 0, 0); } } \
        __builtin_amdgcn_s_setprio(0); } while (0)
#define PG8_WAIT_V(n) asm volatile("s_waitcnt vmcnt(" #n ")" ::: "memory")
#define PG8_WAIT_L(n) asm volatile("s_waitcnt lgkmcnt(" #n ")" ::: "memory")
#define PG8_BAR __builtin_amdgcn_s_barrier()
#define PG8_SCHED __builtin_amdgcn_sched_barrier(0)
    Unit cur, nxt; int ui = 0;
    if (!S.next(0, cur)) return;
    f32x4 acc[2][2][4][2];
#pragma unroll
    for (int a = 0; a < 2; ++a)
#pragma unroll
        for (int b = 0; b < 2; ++b)
#pragma unroll
            for (int m = 0; m < 4; ++m)
#pragma unroll
                for (int n = 0; n < 2; ++n) acc[a][b][m][n] = (f32x4){0.f, 0.f, 0.f, 0.f};
    bf16x8 At[4][2], B0[2][2], B1[2][2];
    unsigned one_scale = 0x7F7F7F7Fu; asm volatile("" : "+v"(one_scale));
    unsigned vaC[2][2], vaN[2][2];
    S.rows(cur, vaC, Rr, Cc);
    const char* cA = S.abase(cur); const char* cB = S.bbase(cur);
    PG8_STAGE(PG8_SB(0, 0), cB, voffB); PG8_STAGE(PG8_SA(0, 0), cA, vaC[0]); PG8_STAGE(PG8_SB(0, 1), cB + hstep, voffB); PG8_STAGE(PG8_SA(0, 1), cA, vaC[1]);
    if (wr == 1) PG8_BAR;
    PG8_WAIT_V(4); PG8_BAR;
    PG8_STAGE(PG8_SB(1, 0), cB + kstep, voffB); PG8_STAGE(PG8_SA(1, 0), cA + kstep, vaC[0]); PG8_STAGE(PG8_SB(1, 1), cB + hstep + kstep, voffB);
    PG8_WAIT_V(6); PG8_BAR;
    for (;;) {
        const bool has_next = S.next(ui + 1, nxt);
        const char* nA = has_next ? S.abase(nxt) : cA; const char* nB = has_next ? S.bbase(nxt) : cB;
#pragma unroll
        for (int h = 0; h < 2; ++h)
#pragma unroll
            for (int i = 0; i < 2; ++i) vaN[h][i] = vaC[h][i];
        for (int t = 0; t < nt; t += 2) {
            const bool last = (t == nt - 2);
            const char* a1 = cA + (size_t)(t + 1) * kstep;
            const char* a2 = last ? nA : cA + (size_t)(t + 2) * kstep; const char* b2 = last ? nB : cB + (size_t)(t + 2) * kstep;
            const char* a3 = a2 + kstep; const char* b3 = b2 + kstep;
            if (last && has_next) S.rows(nxt, vaN, Rr, Cc);
            unsigned v2[2][2];
#pragma unroll
            for (int h = 0; h < 2; ++h)
#pragma unroll
                for (int i = 0; i < 2; ++i) v2[h][i] = last ? vaN[h][i] : vaC[h][i];
            PG8_LDB(B0, 0, 0); PG8_SCHED; PG8_LDA(At, 0, 0); PG8_STAGE(PG8_SA(1, 1), a1, vaC[1]);
            PG8_WAIT_L(8); PG8_BAR; PG8_WAIT_L(0); PG8_MMA(0, 0, At, B0); PG8_BAR; PG8_SCHED;
            PG8_LDB(B1, 0, 1); PG8_STAGE(PG8_SB(0, 0), b2, voffB);
            PG8_BAR; PG8_WAIT_L(0); PG8_MMA(0, 1, At, B1); PG8_BAR;
            PG8_LDA(At, 0, 1); PG8_STAGE(PG8_SA(0, 0), a2, v2[0]);
            PG8_BAR; PG8_WAIT_L(0); PG8_MMA(1, 0, At, B0); PG8_BAR; PG8_SCHED;
            PG8_STAGE(PG8_SB(0, 1), b2 + hstep, voffB);
            PG8_WAIT_V(6); PG8_BAR; PG8_MMA(1, 1, At, B1); PG8_BAR;
            PG8_LDB(B0, 1, 0); PG8_SCHED; PG8_LDA(At, 1, 0); PG8_STAGE(PG8_SA(0, 1), a2, v2[1]);
            PG8_WAIT_L(8); PG8_BAR; PG8_WAIT_L(0); PG8_MMA(0, 0, At, B0); PG8_BAR; PG8_SCHED;
            PG8_LDB(B1, 1, 1); PG8_STAGE(PG8_SB(1, 0), b3, voffB);
            PG8_BAR; PG8_WAIT_L(0); PG8_MMA(0, 1, At, B1); PG8_BAR;
            PG8_LDA(At, 1, 1); PG8_STAGE(PG8_SA(1, 0), a3, v2[0]);
            PG8_BAR; PG8_WAIT_L(0); PG8_MMA(1, 0, At, B0); PG8_BAR; PG8_SCHED;
            PG8_STAGE(PG8_SB(1, 1), b3 + hstep, voffB);
            PG8_WAIT_V(6); PG8_BAR; PG8_MMA(1, 1, At, B1); PG8_BAR;
        }
        if constexpr (FP8) asm volatile("s_nop 15\n\ts_nop 15" ::: "memory");
        E(acc, cur, wr, wc, fr, fq);
        if (!has_next) break;
#pragma unroll
        for (int a = 0; a < 2; ++a)
#pragma unroll
            for (int b = 0; b < 2; ++b)
#pragma unroll
                for (int m = 0; m < 4; ++m)
#pragma unroll
                    for (int n = 0; n < 2; ++n) acc[a][b][m][n] = (f32x4){0.f, 0.f, 0.f, 0.f};
        cur = nxt; cA = nA; cB = nB; ++ui;
#pragma unroll
        for (int h = 0; h < 2; ++h)
#pragma unroll
            for (int i = 0; i < 2; ++i) vaC[h][i] = vaN[h][i];
    }
    PG8_WAIT_V(0);
    if (wr == 0) PG8_BAR;
    PG8_BAR;
#undef PG8_SA
#undef PG8_SB
#undef PG8_STAGE
#undef PG8_LDA
#undef PG8_LDB
#undef PG8_MMA
#undef PG8_WAIT_V
#undef PG8_WAIT_L
#undef PG8_BAR
#undef PG8_SCHED
}

struct EpiStoreBf16 {
    static constexpr bool PERM = true;
    bf16_t* O; int ldc; const float* bias; int bias_estride; float sc;
    __device__ __forceinline__ void operator()(const f32x4 (&acc)[2][2][4][2], const Unit& u, int wr, int wc, int fr, int fq) const {
        const int row0 = u.pm * BM + wr * 64 + fr, col0 = u.pn * BM + wc * 32 + 8 * fq;
        f32x4 bv[2][2];
#pragma unroll
        for (int bj = 0; bj < 2; ++bj)
#pragma unroll
            for (int n = 0; n < 2; ++n) bv[bj][n] = bias ? *(const f32x4*)(bias + (size_t)u.e * bias_estride + col0 + bj * HALF + 4 * n) : (f32x4){0.f, 0.f, 0.f, 0.f};
#pragma unroll
        for (int ai = 0; ai < 2; ++ai)
#pragma unroll
            for (int m = 0; m < 4; ++m) { bf16_t* rowp = O + (size_t)(row0 + ai * HALF + m * 16) * ldc + col0;
#pragma unroll
                for (int bj = 0; bj < 2; ++bj) { const f32x4 v0 = acc[ai][bj][m][0] * sc + bv[bj][0], v1 = acc[ai][bj][m][1] * sc + bv[bj][1];
                    u32x4 w; w.x = cvt_pk_bf16(v0[0], v0[1]); w.y = cvt_pk_bf16(v0[2], v0[3]); w.z = cvt_pk_bf16(v1[0], v1[1]); w.w = cvt_pk_bf16(v1[2], v1[3]);
                    *(u32x4*)(rowp + bj * HALF) = w; } }
    }
};
struct EpiGlu {
    static constexpr bool PERM = true;
    const bf16_t* Yg; bf16_t* O; const float* bias;
    __device__ __forceinline__ void operator()(const f32x4 (&acc)[2][2][4][2], const Unit& u, int wr, int wc, int fr, int fq) const {
        const int row0 = u.pm * BM + wr * 64 + fr, col0 = u.pn * BM + wc * 32 + 8 * fq;
        f32x4 bv[2][2];
#pragma unroll
        for (int bj = 0; bj < 2; ++bj)
#pragma unroll
            for (int n = 0; n < 2; ++n) bv[bj][n] = *(const f32x4*)(bias + col0 + bj * HALF + 4 * n);
#pragma unroll
        for (int ai = 0; ai < 2; ++ai)
#pragma unroll
            for (int m = 0; m < 4; ++m) { const size_t r = (size_t)(row0 + ai * HALF + m * 16);
#pragma unroll
                for (int bj = 0; bj < 2; ++bj) { const f32x4 v0 = acc[ai][bj][m][0] + bv[bj][0], v1 = acc[ai][bj][m][1] + bv[bj][1];
                    const u32x4 y = *(const u32x4*)(Yg + r * S5W + col0 + bj * HALF);
                    float o[8];
                    o[0] = bflo(y.x) / (1.f + __expf(-v0[0])); o[1] = bfhi(y.x) / (1.f + __expf(-v0[1])); o[2] = bflo(y.y) / (1.f + __expf(-v0[2])); o[3] = bfhi(y.y) / (1.f + __expf(-v0[3]));
                    o[4] = bflo(y.z) / (1.f + __expf(-v1[0])); o[5] = bfhi(y.z) / (1.f + __expf(-v1[1])); o[6] = bflo(y.w) / (1.f + __expf(-v1[2])); o[7] = bfhi(y.w) / (1.f + __expf(-v1[3]));
                    u32x4 w; w.x = cvt_pk_bf16(o[0], o[1]); w.y = cvt_pk_bf16(o[2], o[3]); w.z = cvt_pk_bf16(o[4], o[5]); w.w = cvt_pk_bf16(o[6], o[7]);
                    *(u32x4*)(O + r * D + col0 + bj * HALF) = w; } }
    }
};
struct EpiResid {
    static constexpr bool PERM = false;
    const float* X; float* O; const float* mod;
    __device__ __forceinline__ void operator()(const f32x4 (&acc)[2][2][4][2], const Unit& u, int wr, int wc, int fr, int fq) const {
        const int row0 = u.pm * BM + wr * 64 + fr, col0 = u.pn * BM + wc * 32 + 4 * fq, b = u.pm >> 3;
        f32x4 gv[2][2];
#pragma unroll
        for (int bj = 0; bj < 2; ++bj)
#pragma unroll
            for (int n = 0; n < 2; ++n) { const int c = col0 + bj * HALF + n * 16; gv[bj][n] = *(const f32x4*)(mod + (size_t)b * 12288 + 2 * D + c); }
#pragma unroll
        for (int ai = 0; ai < 2; ++ai)
#pragma unroll
            for (int m = 0; m < 4; ++m) { const size_t off = (size_t)(row0 + ai * HALF + m * 16) * D + col0;
#pragma unroll
                for (int bj = 0; bj < 2; ++bj)
#pragma unroll
                    for (int n = 0; n < 2; ++n) { const f32x4 xv = *(const f32x4*)(X + off + bj * HALF + n * 16); *(f32x4*)(O + off + bj * HALF + n * 16) = xv + gv[bj][n] * acc[ai][bj][m][n]; } }
    }
};
struct EpiSwiglu {
    static constexpr bool PERM = true;
    unsigned char* O; const float* bias; float sc;
    __device__ __forceinline__ void operator()(const f32x4 (&acc)[2][2][4][2], const Unit& u, int wr, int wc, int fr, int fq) const {
        const int row0 = u.pm * BM + wr * 64 + fr, j0 = wc * 32 + 8 * fq, cb = u.pn * HALF + j0;
        f32x4 bg[2], bu[2];
#pragma unroll
        for (int n = 0; n < 2; ++n) { bg[n] = *(const f32x4*)(bias + (size_t)u.e * 4096 + cb + 4 * n); bu[n] = *(const f32x4*)(bias + (size_t)u.e * 4096 + 2048 + cb + 4 * n); }
#pragma unroll
        for (int ai = 0; ai < 2; ++ai)
#pragma unroll
            for (int m = 0; m < 4; ++m) { float o[8];
#pragma unroll
                for (int n = 0; n < 2; ++n)
#pragma unroll
                    for (int e = 0; e < 4; ++e) { float g = acc[ai][0][m][n][e] * sc + bg[n][e], uu = acc[ai][1][m][n][e] * sc + bu[n][e];
                        g = fminf(g, 7.0f); uu = fminf(fmaxf(uu, -7.0f), 7.0f);
                        o[4 * n + e] = (uu + 1.0f) * (g / (1.0f + __expf(-1.702f * g))); }
                u32x2 w; w.x = pk4_fp8(o[0], o[1], o[2], o[3]); w.y = pk4_fp8(o[4], o[5], o[6], o[7]);
                *(u32x2*)(O + (size_t)(row0 + ai * HALF + m * 16) * DFF + cb) = w; }
    }
};
}

#define FI __device__ __forceinline__

FI void transpose_item(const float* W, int K, int N, bf16_t* WT, int row_off, LAS float* scr, int kb, int nb, int lane) {
    const int k0 = 64 * kb, n0 = 32 * nb;
#pragma unroll 8
    for (int i = 0; i < 32; ++i) { const int kk = 2 * i + (lane >> 5); scr[kk * 33 + (lane & 31)] = W[(size_t)(k0 + kk) * N + n0 + (lane & 31)]; }
    LDS_WAIT(); asm volatile("" ::: "memory");
    const int c = lane & 7;
#pragma unroll
    for (int j = 0; j < 4; ++j) { const int n = (lane >> 3) + 8 * j; const LAS float* s = scr + (8 * c) * 33 + n;
        u32x4 o; o.x = pk2(s[0 * 33], s[1 * 33]); o.y = pk2(s[2 * 33], s[3 * 33]); o.z = pk2(s[4 * 33], s[5 * 33]); o.w = pk2(s[6 * 33], s[7 * 33]);
        *(u32x4*)(WT + (size_t)(row_off + n0 + n) * K + k0 + 8 * c) = o; }
    LDS_WAIT(); asm volatile("" ::: "memory");
}

FI void transpose_item_fp8(const float* W, int K, int N, unsigned char* WT, int row_off, LAS float* scr, int kb, int nb, int lane, float scale) {
    const int k0 = 64 * kb, n0 = 32 * nb;
#pragma unroll 8
    for (int i = 0; i < 32; ++i) { const int kk = 2 * i + (lane >> 5); scr[kk * 33 + (lane & 31)] = W[(size_t)(k0 + kk) * N + n0 + (lane & 31)]; }
    LDS_WAIT(); asm volatile("" ::: "memory");
    const int n = lane & 31, hf = lane >> 5; const LAS float* s = scr + (32 * hf) * 33 + n;
    u32x4 o0, o1;
    o0.x = pk4_fp8(s[0 * 33] * scale, s[1 * 33] * scale, s[2 * 33] * scale, s[3 * 33] * scale); o0.y = pk4_fp8(s[4 * 33] * scale, s[5 * 33] * scale, s[6 * 33] * scale, s[7 * 33] * scale);
    o0.z = pk4_fp8(s[8 * 33] * scale, s[9 * 33] * scale, s[10 * 33] * scale, s[11 * 33] * scale); o0.w = pk4_fp8(s[12 * 33] * scale, s[13 * 33] * scale, s[14 * 33] * scale, s[15 * 33] * scale);
    o1.x = pk4_fp8(s[16 * 33] * scale, s[17 * 33] * scale, s[18 * 33] * scale, s[19 * 33] * scale); o1.y = pk4_fp8(s[20 * 33] * scale, s[21 * 33] * scale, s[22 * 33] * scale, s[23 * 33] * scale);
    o1.z = pk4_fp8(s[24 * 33] * scale, s[25 * 33] * scale, s[26 * 33] * scale, s[27 * 33] * scale); o1.w = pk4_fp8(s[28 * 33] * scale, s[29 * 33] * scale, s[30 * 33] * scale, s[31 * 33] * scale);
    unsigned char* dst = WT + (size_t)(row_off + n0 + n) * K + k0 + 32 * hf;
    *(u32x4*)dst = o0; *(u32x4*)(dst + 16) = o1;
    LDS_WAIT(); asm volatile("" ::: "memory");
}

FI void tr8_item(const float* W, int N, int K, unsigned char* WT, int row_off, LAS unsigned char* T, int k0, int n0, int lane, float scale) {
    const int nq = lane & 15, kr = lane >> 4;
    const float* src = W + (size_t)(k0 + 4 * kr) * N + n0 + 4 * nq;
#pragma unroll
    for (int rg = 0; rg < 8; ++rg) {
        f32x4 v[4];
#pragma unroll
        for (int j = 0; j < 4; ++j) v[j] = *(const f32x4*)(src + (size_t)(rg * 16 + j) * N) * scale;
#pragma unroll
        for (int i = 0; i < 4; ++i) *(LAS unsigned*)(T + (4 * nq + i) * 128 + ((rg ^ (nq & 7)) << 4) + kr * 4) = pk4_fp8(v[0][i], v[1][i], v[2][i], v[3][i]);
    }
    LDS_WAIT(); asm volatile("" ::: "memory");
#pragma unroll
    for (int t = 0; t < 8; ++t) { const int n = 8 * t + (lane >> 3), p = lane & 7;
        const u32x4 o = *(const LAS u32x4*)(T + n * 128 + ((p ^ ((n >> 2) & 7)) << 4));
        *(u32x4*)(WT + (size_t)(row_off + n0 + n) * K + k0 + 16 * p) = o; }
    LDS_WAIT(); asm volatile("" ::: "memory");
}
FI void moe_weight_item(const Args& A, LAS unsigned char* T, int q, int lane) {
    unsigned char* ws = A.ws;
    if (q < 32768) { const int e = q >> 10, r = q & 1023, kb = r >> 6, nb = r & 63, n0 = 64 * nb;
        const int isU = n0 / 2048, pn = (n0 % 2048) / 128, j = n0 % 128, rowmap = 256 * pn + 128 * isU + j;
        tr8_item(A.in[34] + (size_t)e * D * 4096, 4096, D, ws + WS_WGU + (size_t)e * 4096 * D, rowmap - n0, T, 128 * kb, n0, lane, WSCALE); }
    else { const int q2 = q - 32768, e = q2 >> 9, r = q2 & 511, kb = r >> 5, nb = r & 31;
        tr8_item(A.in[36] + (size_t)e * DFF * D, D, DFF, ws + WS_WDN + (size_t)e * D * DFF, 0, T, 128 * kb, 64 * nb, lane, WSCALE); }
}

FI void p0_run(const Args& A, LAS unsigned char* lds, int tid, int lane, int wave, int vcu, int G) {
    unsigned char* ws = A.ws;
    unsigned long long* mod = (unsigned long long*)((unsigned*)(ws + WS_CTL) + CW_MOD); unsigned long long* hnorm = (unsigned long long*)((unsigned*)(ws + WS_CTL) + CW_HNORM);
    {
        LAS float* sl = (LAS float*)lds;
        LAS float* part = (LAS float*)(lds + 9 * 512 * 4);
        const float* c = A.in[1]; const float* cc = A.in[3]; const float* wada = A.in[4];
        _Pragma("unroll 1") for (int rep = 0; rep < REP0A; ++rep)
        for (int it = vcu; it < 192; it += G) {
            const int cg = it % 48, kq = it / 48, n0 = cg * 256 + 4 * lane, k0 = kq * 512;
            for (int i = tid; i < 9 * 512; i += NTHR) { const int r = i >> 9, k = k0 + (i & 511); const float v = r < 8 ? c[r * D + k] : cc[k]; sl[i] = v / (1.f + __expf(-v)); }
            __syncthreads();
            f32x4 acc[9];
#pragma unroll
            for (int r = 0; r < 9; ++r) acc[r] = (f32x4){0.f, 0.f, 0.f, 0.f};
#pragma unroll 8
            for (int kk = 0; kk < 64; ++kk) { const int kl = wave * 64 + kk; const f32x4 w = *(const f32x4*)(wada + (size_t)(k0 + kl) * 12288 + n0);
#pragma unroll
                for (int r = 0; r < 9; ++r) { const float sv = sl[r * 512 + kl]; acc[r] += w * sv; } }
#pragma unroll
            for (int r = 0; r < 9; ++r) *(LAS f32x4*)(part + (wave * 9 + r) * 256 + 4 * lane) = acc[r];
            __syncthreads();
            for (int i = tid; i < 9 * 256; i += NTHR) { const int r = i >> 8, col = i & 255; float sum = 0.f;
#pragma unroll
                for (int w = 0; w < 8; ++w) sum += part[(w * 9 + r) * 256 + col];
                fix_add(mod + r * 12288 + cg * 256 + col, rep == REP0A - 1 ? sum : 0.0f); }
            __syncthreads();
        }
    }
    {
        LAS float* L = (LAS float*)lds;
        LAS float *w1s = L, *w2s = L + 2112, *w3s = L + 6208, *b1s = L + 10304, *b2s = L + 10368, *b3s = L + 10432, *fqs = L + 10496, *zs = L + 10560, *h1 = L + 10824, *h2 = L + 11336, *h3 = L + 11848;
        for (int i = tid; i < 33 * 64; i += NTHR) w1s[i] = A.in[21][i];
        for (int i = tid; i < 4096; i += NTHR) { w2s[i] = A.in[23][i]; w3s[i] = A.in[25][i]; }
        if (tid < 64) { b1s[tid] = A.in[22][tid]; b2s[tid] = A.in[24][tid]; b3s[tid] = A.in[26][tid]; fqs[tid] = A.in[28][tid]; }
        __syncthreads();
        const float* w4 = A.in[27]; const float* dl = A.in[29]; float* hraw = (float*)(ws + WS_HRAW);
        for (int item = vcu; item < 256; item += G) {
            const int l0 = item * 8;
            if (tid < 264) { const int r = tid / 33, i = tid % 33, l = l0 + r; float z;
                if (i == 0) z = (float)l / 2047.0f;
                else { const int j = (i - 1) & 15; const float band = 1e-4f + (float)j * ((15.0f - 1e-4f) / 15.0f); const float ang = (6.283185307179586f / 2048.0f) * (float)l * band; z = (i <= 16) ? cosf(ang) : -sinf(ang); }
                zs[tid] = z; }
            __syncthreads();
            const int r = tid >> 6, o = tid & 63;
            { float s = b1s[o]; for (int i = 0; i < 33; ++i) s += zs[r * 33 + i] * w1s[i * 64 + o]; h1[r * 64 + o] = sinf(fqs[o] * s); }
            __syncthreads();
            { float s = b2s[o]; for (int i = 0; i < 64; ++i) s += h1[r * 64 + i] * w2s[i * 64 + o]; h2[r * 64 + o] = sinf(fqs[o] * s); }
            __syncthreads();
            { float s = b3s[o]; for (int i = 0; i < 64; ++i) s += h2[r * 64 + i] * w3s[i * 64 + o]; h3[r * 64 + o] = sinf(fqs[o] * s); }
            __syncthreads();
            f32x4 acc[8];
#pragma unroll
            for (int q = 0; q < 8; ++q) acc[q] = (f32x4){0.f, 0.f, 0.f, 0.f};
#pragma unroll 4
            for (int i = 0; i < 64; ++i) { const f32x4 w = *(const f32x4*)(w4 + (size_t)i * 2048 + 4 * tid);
#pragma unroll
                for (int q = 0; q < 8; ++q) acc[q] += w * h3[q * 64 + i]; }
            const f32x4 dv = *(const f32x4*)(dl + 4 * tid);
            f32x4 asum = (f32x4){0.f, 0.f, 0.f, 0.f};
#pragma unroll
            for (int q = 0; q < 8; ++q) { const int l = l0 + q; const float t = (float)l / 2047.0f; f32x4 v;
#pragma unroll
                for (int e = 0; e < 4; ++e) v[e] = acc[q][e] * expf(-t * fabsf(dv[e]));
                *(f32x4*)(hraw + (size_t)l * 2048 + 4 * tid) = v;
                if (!(l == 2047 && 4 * tid >= 1024)) {
#pragma unroll
                    for (int e = 0; e < 4; ++e) asum[e] += fabsf(v[e]); } }
#pragma unroll
            for (int e = 0; e < 4; ++e) fix_add(hnorm + 4 * tid + e, asum[e]);
            __syncthreads();
        }
    }
    {
        const float *lre = A.in[9], *lim = A.in[10], *lst = A.in[11], *bre = A.in[12], *bim = A.in[13], *cre = A.in[14], *cim = A.in[15];
        float* LAM = (float*)(ws + WS_LAM); float* LAML = (float*)(ws + WS_LAML); bf16_t* SB = (bf16_t*)(ws + WS_S5B); bf16_t* SC = (bf16_t*)(ws + WS_S5C);
        for (int idx = vcu * NTHR + tid; idx < 2 * 64 * 4 * 64; idx += G * NTHR) {
            const int ln = idx & 63, T = (idx >> 6) & 3, g = (idx >> 8) & 63, d = idx >> 14;
            {
                const int n = ln & 31, hq = ln >> 5, p = n + 32 * (T >> 1), part = T & 1;
                const int q = (d * 64 + g) * 64 + p;
                const float lr = fminf(lre[q], -1e-4f), li = lim[q], dt = expf(lst[q]), zr = lr * dt, zi = li * dt, er = expf(zr), br = er * cosf(zi), bi = er * sinf(zi);
                const float den = lr * lr + li * li, cr = ((br - 1.f) * lr + bi * li) / den, ci = (bi * lr - (br - 1.f) * li) / den;
                float v[8];
#pragma unroll
                for (int j = 0; j < 8; ++j) { const int h = 8 * hq + j; const float xr = bre[(size_t)q * 16 + h], xi = bim[(size_t)q * 16 + h]; v[j] = part ? (cr * xi + ci * xr) : (cr * xr - ci * xi); }
                u32x4 w; w.x = pk2(v[0], v[1]); w.y = pk2(v[2], v[3]); w.z = pk2(v[4], v[5]); w.w = pk2(v[6], v[7]);
                *(u32x4*)(SB + (size_t)idx * 8) = w;
                if (part == 0 && hq == 0) { LAM[q * 2] = br; LAM[q * 2 + 1] = bi; const float eL = expf((float)SEG * zr), aL = (float)SEG * zi; LAML[q * 2] = eL * cosf(aL); LAML[q * 2 + 1] = eL * sinf(aL); }
            }
            {
                const int hc = ln & 15, qq = ln >> 4; float v[8];
#pragma unroll
                for (int j = 0; j < 8; ++j) { const int k = 32 * T + 8 * qq + j, n = k >> 2, TT = k & 3, p = n + 32 * (TT >> 1), part = TT & 1; const size_t ci = ((size_t)(d * 64 + g) * 16 + hc) * 64 + p; v[j] = part ? -cim[ci] : cre[ci]; }
                u32x4 w; w.x = pk2(v[0], v[1]); w.y = pk2(v[2], v[3]); w.z = pk2(v[4], v[5]); w.w = pk2(v[6], v[7]);
                *(u32x4*)(SC + (size_t)idx * 8) = w;
            }
        }
    }
    {
        __syncthreads();
        LAS float* scr = (LAS float*)(lds + wave * 16384);
        const int gw = vcu * NWAVES + wave, NGW = G * NWAVES;
        constexpr int I_IN = 32 * 128, I_GLU = 16 * 32, I_OUT = 32 * 64;
        constexpr int NITEMS = I_IN + I_GLU + I_OUT;
        for (int it = gw; it < NITEMS; it += NGW) {
            int r = it;
            if (r < I_IN) { transpose_item(A.in[8], D, DIN, (bf16_t*)(ws + WS_WIN), 0, scr, r / 128, r % 128, lane); continue; } r -= I_IN;
            if (r < I_GLU) { transpose_item(A.in[17], S5W, S5W, (bf16_t*)(ws + WS_WGLU), 0, scr, r / 32, r % 32, lane); continue; } r -= I_GLU;
            transpose_item(A.in[31], D, D, (bf16_t*)(ws + WS_WOUT), 0, scr, r / 64, r % 64, lane);
        }
        _Pragma("unroll 1") for (int rep = 0; rep < REP0D; ++rep)
        for (int q = gw; q < 49152; q += NGW) moe_weight_item(A, lds + wave * 16384, q, lane);
    }
}

FI void p1_run(const Args& A, int tid, int lane, int wave, int vcu, int G, int m0, int m1, bool extras) {
    unsigned char* ws = A.ws;
    const unsigned long long* mod = (const unsigned long long*)((const unsigned*)(ws + WS_CTL) + CW_MOD); const unsigned long long* hnorm = (const unsigned long long*)((const unsigned*)(ws + WS_CTL) + CW_HNORM);
    const float* bada = A.in[5]; const float* g1 = A.in[6];
    bf16_t* A1 = (bf16_t*)(ws + WS_A1);
    const int gw = vcu * NWAVES + wave, NGW = G * NWAVES;
    if (extras) { float* modf = (float*)(ws + WS_MODF); for (int i = vcu * NTHR + tid; i < 9 * 12288; i += G * NTHR) modf[i] = fix_get(mod + i) + bada[i % 12288]; }
    for (int mb = m0 + gw; mb < m1; mb += 4 * NGW) {
        f32x4 v[4][8]; float rstd[4];
#pragma unroll
        for (int r = 0; r < 4; ++r) { int m = mb + r * NGW; m = m < m1 ? m : m1 - 1;
            const float* src = m < M ? A.in[0] + (size_t)m * D : A.in[2] + (size_t)(m - M) * D;
#pragma unroll
            for (int j = 0; j < 8; ++j) v[r][j] = *(const f32x4*)(src + 4 * lane + 256 * j); }
#pragma unroll
        for (int r = 0; r < 4; ++r) { float ss = 0.f;
#pragma unroll
            for (int j = 0; j < 8; ++j) ss += (v[r][j].x * v[r][j].x + v[r][j].y * v[r][j].y) + (v[r][j].z * v[r][j].z + v[r][j].w * v[r][j].w);
            rstd[r] = rsqrtf(wave_sum(ss) * (1.0f / D) + 1e-6f); }
#pragma unroll
        for (int r = 0; r < 4; ++r) { const int m = mb + r * NGW; if (m < m1) { const int mr = m < M ? m / SEQ : 8;
#pragma unroll
            for (int j = 0; j < 8; ++j) { const int c = 4 * lane + 256 * j;
                const f32x4 gv = *(const f32x4*)(g1 + c);
                const unsigned long long* mp = mod + (size_t)mr * 12288 + c;
                const f32x4 sh = (f32x4){fix_get(mp), fix_get(mp + 1), fix_get(mp + 2), fix_get(mp + 3)} + *(const f32x4*)(bada + c);
                const f32x4 sc = (f32x4){fix_get(mp + D), fix_get(mp + D + 1), fix_get(mp + D + 2), fix_get(mp + D + 3)} + *(const f32x4*)(bada + D + c);
                const f32x4 h = v[r][j] * rstd[r] * gv * (sc + 1.0f) + sh;
                u32x2 w; w.x = pk2(h.x, h.y); w.y = pk2(h.z, h.w);
                *(u32x2*)(A1 + (size_t)m * D + c) = w; } } }
    }
    const float* hraw = (const float*)(ws + WS_HRAW); bf16_t* Rg = (bf16_t*)(ws + WS_RG);
    if (extras)
    for (int it = gw; it < 512 * 16; it += NGW) {
        const int ib = it >> 4, c = (it & 15) * 64 + lane;
        const float inv = 1.0f / (fix_get(hnorm + c) + fix_get(hnorm + HYW + c));
        float v[8];
#pragma unroll
        for (int jj = 0; jj < 8; ++jj) { const int i = 8 * ib + jj; float x;
            if (i <= 2047) x = hraw[(size_t)(2047 - i) * 2048 + c]; else if (i <= 4094) x = hraw[(size_t)(i - 2048) * 2048 + HYW + c]; else x = 0.f;
            v[jj] = x * inv; }
        u32x4 w; w.x = pk2(v[0], v[1]); w.y = pk2(v[2], v[3]); w.z = pk2(v[4], v[5]); w.w = pk2(v[6], v[7]);
        *(u32x4*)(Rg + (size_t)c * 4096 + 8 * ib) = w;
    }
}

FI void s5_unit(const Args& A, LAS unsigned char* lds, int unit, int lane, int wave) {
    unsigned char* ws = A.ws;
    const int d = unit & 1, g = (unit >> 1) & 63, bp = unit >> 7, dg = d * 64 + g;
    const bf16_t* P = (const bf16_t*)(ws + WS_P); bf16_t* Ys = (bf16_t*)(ws + WS_YS5);
    bf16x8 Bf[4], Cf[4];
#pragma unroll
    for (int T = 0; T < 4; ++T) { Bf[T] = *(const bf16x8*)((const bf16_t*)(ws + WS_S5B) + ((size_t)(dg * 4 + T) * 64 + lane) * 8); Cf[T] = *(const bf16x8*)((const bf16_t*)(ws + WS_S5C) + ((size_t)(dg * 4 + T) * 64 + lane) * 8); }
    const int n = lane & 31, hh = lane >> 5;
    const float* LAM = (const float*)(ws + WS_LAM) + (size_t)dg * 128; const float* LAML = (const float*)(ws + WS_LAML) + (size_t)dg * 128;
    const float lr0 = LAM[n * 2], li0 = LAM[n * 2 + 1], lr1 = LAM[(n + 32) * 2], li1 = LAM[(n + 32) * 2 + 1];
    const int r = lane & 31, bsel = (r >> 2) & 1, tau = (r & 3) + 4 * (r >> 3), b = 2 * bp + bsel, kofs = g * 16 + 8 * (lane >> 5);
    const int seg0 = wave * SEG;
    auto rowp = [&](int pos) -> const bf16_t* {
        int row; if (pos < CTXL) { const int tc = d ? (CTXL - 1 - pos) : pos; row = M + b * CTXL + tc; } else { const int q = pos - CTXL; const int tl = d ? (SEQ - 1 - q) : q; row = b * SEQ + tl; }
        return P + (size_t)row * DIN + kofs; };
    const f32x16 z16 = {0.f, 0.f, 0.f, 0.f, 0.f, 0.f, 0.f, 0.f, 0.f, 0.f, 0.f, 0.f, 0.f, 0.f, 0.f, 0.f};
    float xr0 = 0.f, xi0 = 0.f, xr1 = 0.f, xi1 = 0.f;
    {
        bf16x8 uc[3], un[3];
#pragma unroll
        for (int q = 0; q < 3; ++q) { uc[q] = *(const bf16x8*)rowp(seg0 + 16 * q + tau); un[q] = uc[q]; }
#pragma unroll 1
        for (int ch = 0; ch < 6; ++ch) {
            if (ch < 5) {
#pragma unroll
                for (int q = 0; q < 3; ++q) un[q] = *(const bf16x8*)rowp(seg0 + 16 * (3 * (ch + 1) + q) + tau); }
#pragma unroll
            for (int q = 0; q < 3; ++q) {
                const f32x16 c0 = __builtin_amdgcn_mfma_f32_32x32x16_bf16(uc[q], Bf[0], z16, 0, 0, 0), c1 = __builtin_amdgcn_mfma_f32_32x32x16_bf16(uc[q], Bf[1], z16, 0, 0, 0);
                const f32x16 c2 = __builtin_amdgcn_mfma_f32_32x32x16_bf16(uc[q], Bf[2], z16, 0, 0, 0), c3 = __builtin_amdgcn_mfma_f32_32x32x16_bf16(uc[q], Bf[3], z16, 0, 0, 0);
#pragma unroll
                for (int tt = 0; tt < 16; ++tt) {
                    const float nr0 = lr0 * xr0 - li0 * xi0 + c0[tt], ni0 = lr0 * xi0 + li0 * xr0 + c1[tt]; xr0 = nr0; xi0 = ni0;
                    const float nr1 = lr1 * xr1 - li1 * xi1 + c2[tt], ni1 = lr1 * xi1 + li1 * xr1 + c3[tt]; xr1 = nr1; xi1 = ni1; }
            }
#pragma unroll
            for (int q = 0; q < 3; ++q) uc[q] = un[q];
        }
    }
    LAS float* Es = (LAS float*)(lds + 8 * 8704);
    *(LAS f32x4*)(Es + (wave * 64 + lane) * 4) = (f32x4){xr0, xi0, xr1, xi1};
    __syncthreads();
    {
        const float Lr0 = LAML[n * 2], Li0 = LAML[n * 2 + 1], Lr1 = LAML[(n + 32) * 2], Li1 = LAML[(n + 32) * 2 + 1];
        xr0 = 0.f; xi0 = 0.f; xr1 = 0.f; xi1 = 0.f;
#pragma unroll 1
        for (int w = 0; w < wave; ++w) { const f32x4 e = *(LAS f32x4*)(Es + (w * 64 + lane) * 4);
            const float nr0 = Lr0 * xr0 - Li0 * xi0 + e.x, ni0 = Lr0 * xi0 + Li0 * xr0 + e.y; xr0 = nr0; xi0 = ni0;
            const float nr1 = Lr1 * xr1 - Li1 * xi1 + e.z, ni1 = Lr1 * xi1 + Li1 * xr1 + e.w; xr1 = nr1; xi1 = ni1; }
    }
    {
        LAS unsigned char* Xs = lds + wave * 8704;
        bf16x8 uc[3], un[3];
#pragma unroll
        for (int q = 0; q < 3; ++q) { uc[q] = *(const bf16x8*)rowp(seg0 + 16 * q + tau); un[q] = uc[q]; }
#pragma unroll 1
        for (int ch = 0; ch < 6; ++ch) {
            if (ch < 5) {
#pragma unroll
                for (int q = 0; q < 3; ++q) un[q] = *(const bf16x8*)rowp(seg0 + 16 * (3 * (ch + 1) + q) + tau); }
#pragma unroll
            for (int q = 0; q < 3; ++q) {
                const int pos0 = seg0 + 16 * (3 * ch + q);
                f32x16 c0 = __builtin_amdgcn_mfma_f32_32x32x16_bf16(uc[q], Bf[0], z16, 0, 0, 0), c1 = __builtin_amdgcn_mfma_f32_32x32x16_bf16(uc[q], Bf[1], z16, 0, 0, 0);
                f32x16 c2 = __builtin_amdgcn_mfma_f32_32x32x16_bf16(uc[q], Bf[2], z16, 0, 0, 0), c3 = __builtin_amdgcn_mfma_f32_32x32x16_bf16(uc[q], Bf[3], z16, 0, 0, 0);
#pragma unroll
                for (int tt = 0; tt < 16; ++tt) {
                    const float nr0 = lr0 * xr0 - li0 * xi0 + c0[tt], ni0 = lr0 * xi0 + li0 * xr0 + c1[tt]; xr0 = nr0; xi0 = ni0; c0[tt] = nr0; c1[tt] = ni0;
                    const float nr1 = lr1 * xr1 - li1 * xi1 + c2[tt], ni1 = lr1 * xi1 + li1 * xr1 + c3[tt]; xr1 = nr1; xi1 = ni1; c2[tt] = nr1; c3[tt] = ni1; }
                if (pos0 >= CTXL) {
#pragma unroll
                    for (int tt = 0; tt < 16; ++tt) { u32x2 w; w.x = pk2(c0[tt], c1[tt]); w.y = pk2(c2[tt], c3[tt]); *(LAS u32x2*)(Xs + (hh * 16 + tt) * 272 + 8 * n) = w; }
                    LDS_WAIT();
#pragma unroll
                    for (int bt = 0; bt < 2; ++bt) {
                        f32x4 y = (f32x4){0.f, 0.f, 0.f, 0.f};
#pragma unroll
                        for (int ks = 0; ks < 4; ++ks) { const bf16x8 xf = *(const LAS bf16x8*)(Xs + (bt * 16 + (lane & 15)) * 272 + (32 * ks + 8 * (lane >> 4)) * 2); y = __builtin_amdgcn_mfma_f32_16x16x32_bf16(Cf[ks], xf, y, 0, 0, 0); }
                        const int qq = pos0 + (lane & 15) - CTXL, tl = d ? (SEQ - 1 - qq) : qq, bb = 2 * bp + bt;
                        u32x2 w; w.x = pk2(y[0], y[1]); w.y = pk2(y[2], y[3]);
                        *(u32x2*)(Ys + ((size_t)(d * M + bb * SEQ + tl)) * S5W + g * 16 + 4 * (lane >> 4)) = w;
                    }
                    LDS_WAIT();
                }
            }
#pragma unroll
            for (int q = 0; q < 3; ++q) uc[q] = un[q];
        }
    }
    __syncthreads();
}

FI void h1_item(const Args& A, LAS unsigned char* lds, int item, int tid) {
    unsigned char* ws = A.ws;
    const bf16_t* P = (const bf16_t*)(ws + WS_P); bf16_t* Vt = (bf16_t*)(ws + WS_VT);
    const int gr = item >> 3, cg = item & 7, b = gr >> 5, t0 = (gr & 31) * 64, c0 = cg * 128;
    for (int idx = tid; idx < 2 * 64 * 16; idx += NTHR) { const int ch = idx >> 10, rem = idx & 1023, row = rem >> 4, sg = rem & 15;
        const u32x4 v = *(const u32x4*)(P + (size_t)(b * SEQ + t0 + row) * DIN + S5W + ch * HYW + c0 + sg * 8);
        *(LAS u32x4*)(lds + ch * 16896 + (row + 1) * 256 + sg * 16) = v; }
    if (tid < 64) { const int ch = tid >> 5, rr = (tid >> 4) & 1, sg = tid & 15; *(LAS u32x4*)(lds + ch * 16896 + (rr ? 65 : 0) * 256 + sg * 16) = (u32x4){0u, 0u, 0u, 0u}; }
    __syncthreads();
    const int c = tid & 127, tq = tid >> 7, cc = c0 + c;
    const float* cw = A.in[19]; const float* cb = A.in[20];
    const float w0v = cw[cc], w1v = cw[3072 + cc], w2v = cw[6144 + cc], bv = cb[cc];
    const float w0x = cw[HYW + cc], w1x = cw[3072 + HYW + cc], w2x = cw[6144 + HYW + cc], bx = cb[HYW + cc];
    const LAS bf16_t* Vs = (const LAS bf16_t*)lds; const LAS bf16_t* Xs = (const LAS bf16_t*)(lds + 16896);
    float o[16];
#pragma unroll
    for (int i = 0; i < 16; ++i) { const int t = tq * 16 + i;
        const float v = w0v * bf1(Vs[t * 128 + c]) + w1v * bf1(Vs[(t + 1) * 128 + c]) + w2v * bf1(Vs[(t + 2) * 128 + c]) + bv;
        const float x = w0x * bf1(Xs[t * 128 + c]) + w1x * bf1(Xs[(t + 1) * 128 + c]) + w2x * bf1(Xs[(t + 2) * 128 + c]) + bx;
        o[i] = v * x; }
    bf16_t* dst = Vt + ((size_t)(cc * NB + b) * SEQ + t0 + tq * 16);
    u32x4 w0; w0.x = pk2(o[0], o[1]); w0.y = pk2(o[2], o[3]); w0.z = pk2(o[4], o[5]); w0.w = pk2(o[6], o[7]);
    u32x4 w1; w1.x = pk2(o[8], o[9]); w1.y = pk2(o[10], o[11]); w1.z = pk2(o[12], o[13]); w1.w = pk2(o[14], o[15]);
    *(u32x4*)dst = w0; *(u32x4*)(dst + 8) = w1;
    __syncthreads();
}

constexpr int RT_STRIDE = 8208, VS_OFF = 8 * RT_STRIDE, VS_STRIDE = 4112;
FI void longconv_channel(const Args& A, LAS unsigned char* lds, int c, int tid, int lane, int wave) {
    unsigned char* ws = A.ws;
    const bf16_t* Rg = (const bf16_t*)(ws + WS_RG) + (size_t)c * 4096; const bf16_t* Vt = (const bf16_t*)(ws + WS_VT) + (size_t)c * NB * SEQ; bf16_t* LC = (bf16_t*)(ws + WS_LCT) + (size_t)c * NB * SEQ;
    for (int i = tid; i < VS_OFF / 16; i += NTHR) *(LAS u32x4*)(lds + i * 16) = (u32x4){0u, 0u, 0u, 0u};
    for (int i = tid; i < NB * SEQ / 8; i += NTHR) { const int bb = i >> 8, s8 = i & 255; *(LAS u32x4*)(lds + VS_OFF + bb * VS_STRIDE + s8 * 16) = *(const u32x4*)(Vt + (size_t)bb * SEQ + s8 * 8); }
    __syncthreads();
    for (int i = tid; i < 4096; i += NTHR) { const bf16_t v = Rg[i];
#pragma unroll
        for (int r = 0; r < 8; ++r) *(LAS bf16_t*)(lds + r * RT_STRIDE + (i + r) * 2) = v; }
    __syncthreads();
    const int a = lane & 15, q = lane >> 4, r = (a + 1) & 7;
    const LAS unsigned char* vb = lds + VS_OFF + (lane & 7) * VS_STRIDE + 16 * q;
#pragma unroll 1
    for (int grp = 0; grp < 2; ++grp) {
        const int i0 = wave * 16 + grp * 8;
        const LAS unsigned char* rb = lds + r * RT_STRIDE + 2 * (2047 - 16 * (i0 + 7) - a + 8 * q + r);
        f32x4 acc[8];
#pragma unroll
        for (int ii = 0; ii < 8; ++ii) acc[ii] = (f32x4){0.f, 0.f, 0.f, 0.f};
        bf16x8 S[8];
#pragma unroll
        for (int ii = 2; ii < 8; ++ii) S[ii] = *(const LAS bf16x8*)(rb + 32 * (7 - ii));
#pragma unroll 1
        for (int j4 = 0; j4 < 64; j4 += 4) {
#pragma unroll
            for (int jj = 0; jj < 4; ++jj) {
                const int j = j4 + jj;
                const bf16x8 bfr = *(const LAS bf16x8*)(vb + 64 * j);
                S[(0 - 2 * jj) & 7] = *(const LAS bf16x8*)(rb + 32 * 7 + 64 * j);
                S[(1 - 2 * jj) & 7] = *(const LAS bf16x8*)(rb + 32 * 6 + 64 * j);
#pragma unroll
                for (int ii = 0; ii < 8; ++ii) acc[ii] = __builtin_amdgcn_mfma_f32_16x16x32_bf16(S[(ii - 2 * jj) & 7], bfr, acc[ii], 0, 0, 0);
            }
        }
        if (a < 8) {
#pragma unroll
            for (int ii = 0; ii < 8; ++ii) { u32x2 w; w.x = pk2(acc[ii][0], acc[ii][1]); w.y = pk2(acc[ii][2], acc[ii][3]); *(u32x2*)(LC + (size_t)a * SEQ + 16 * (i0 + ii) + 4 * q) = w; }
        }
    }
    __syncthreads();
}

FI void s5_combine(const Args& A, int gtid, int gthreads) {
    unsigned char* ws = A.ws;
    const bf16_t* P = (const bf16_t*)(ws + WS_P); const bf16_t* Ys = (const bf16_t*)(ws + WS_YS5); bf16_t* Yg = (bf16_t*)(ws + WS_YG); const float* dsk = A.in[16];
    for (int idx = gtid; idx < M * 128; idx += gthreads) {
        const int row = idx >> 7, c8 = (idx & 127) * 8;
        const u32x4 u = *(const u32x4*)(P + (size_t)row * DIN + c8), yf = *(const u32x4*)(Ys + (size_t)row * S5W + c8), yb = *(const u32x4*)(Ys + (size_t)(M + row) * S5W + c8);
        const f32x4 d0 = *(const f32x4*)(dsk + c8), d1 = *(const f32x4*)(dsk + c8 + 4);
        float y[8];
        y[0] = bflo(u.x) * d0.x + bflo(yf.x) + bflo(yb.x); y[1] = bfhi(u.x) * d0.y + bfhi(yf.x) + bfhi(yb.x);
        y[2] = bflo(u.y) * d0.z + bflo(yf.y) + bflo(yb.y); y[3] = bfhi(u.y) * d0.w + bfhi(yf.y) + bfhi(yb.y);
        y[4] = bflo(u.z) * d1.x + bflo(yf.z) + bflo(yb.z); y[5] = bfhi(u.z) * d1.y + bfhi(yf.z) + bfhi(yb.z);
        y[6] = bflo(u.w) * d1.z + bflo(yf.w) + bflo(yb.w); y[7] = bfhi(u.w) * d1.w + bfhi(yf.w) + bfhi(yb.w);
#pragma unroll
        for (int e = 0; e < 8; ++e) y[e] = 0.5f * y[e] * (1.0f + erff(y[e] * 0.70710678118654752f));
        u32x4 w; w.x = pk2(y[0], y[1]); w.y = pk2(y[2], y[3]); w.z = pk2(y[4], y[5]); w.w = pk2(y[6], y[7]);
        *(u32x4*)(Yg + (size_t)row * S5W + c8) = w;
    }
}

FI void h3_item(const Args& A, LAS unsigned char* lds, int item, int tid) {
    unsigned char* ws = A.ws;
    const bf16_t* P = (const bf16_t*)(ws + WS_P); const bf16_t* LC = (const bf16_t*)(ws + WS_LCT); bf16_t* Yc = (bf16_t*)(ws + WS_YCAT);
    const int gr = item >> 3, cg = item & 7, b = gr >> 5, t0 = (gr & 31) * 64, c0 = cg * 128;
    for (int idx = tid; idx < 3 * 64 * 16; idx += NTHR) { const int ch = idx >> 10, rem = idx & 1023, row = rem >> 4, sg = rem & 15;
        const u32x4 v = *(const u32x4*)(P + (size_t)(b * SEQ + t0 + row) * DIN + S5W + ch * HYW + c0 + sg * 8);
        *(LAS u32x4*)(lds + ch * 16896 + (row + 1) * 256 + sg * 16) = v; }
    if (tid < 96) { const int ch = tid >> 5, rr = (tid >> 4) & 1, sg = tid & 15; *(LAS u32x4*)(lds + ch * 16896 + (rr ? 65 : 0) * 256 + sg * 16) = (u32x4){0u, 0u, 0u, 0u}; }
    LAS bf16_t* Ls = (LAS bf16_t*)(lds + 3 * 16896);
    for (int idx = tid; idx < 128 * 8; idx += NTHR) { const int c = idx >> 3, pc = idx & 7;
        const u32x4 v = *(const u32x4*)(LC + (size_t)((c0 + c) * NB + b) * SEQ + t0 + pc * 8);
        const unsigned wv[4] = {v.x, v.y, v.z, v.w};
#pragma unroll
        for (int e = 0; e < 4; ++e) { Ls[(pc * 8 + 2 * e) * 128 + c] = (bf16_t)(wv[e] & 0xffffu); Ls[(pc * 8 + 2 * e + 1) * 128 + c] = (bf16_t)(wv[e] >> 16); } }
    __syncthreads();
    const int c = tid & 127, tq = tid >> 7, cc = c0 + c;
    const float* cw = A.in[19]; const float* cb = A.in[20];
    const float w0v = cw[cc], w1v = cw[3072 + cc], w2v = cw[6144 + cc], bv = cb[cc];
    const float w0x = cw[HYW + cc], w1x = cw[3072 + HYW + cc], w2x = cw[6144 + HYW + cc], bx = cb[HYW + cc];
    const float w0z = cw[2 * HYW + cc], w1z = cw[3072 + 2 * HYW + cc], w2z = cw[6144 + 2 * HYW + cc], bz = cb[2 * HYW + cc];
    const float dd = A.in[30][cc];
    const LAS bf16_t* Vs = (const LAS bf16_t*)lds; const LAS bf16_t* Xs = (const LAS bf16_t*)(lds + 16896); const LAS bf16_t* Zs = (const LAS bf16_t*)(lds + 2 * 16896);
#pragma unroll 4
    for (int i = 0; i < 16; ++i) { const int t = tq * 16 + i;
        const float v = w0v * bf1(Vs[t * 128 + c]) + w1v * bf1(Vs[(t + 1) * 128 + c]) + w2v * bf1(Vs[(t + 2) * 128 + c]) + bv;
        const float x = w0x * bf1(Xs[t * 128 + c]) + w1x * bf1(Xs[(t + 1) * 128 + c]) + w2x * bf1(Xs[(t + 2) * 128 + c]) + bx;
        const float z = w0z * bf1(Zs[t * 128 + c]) + w1z * bf1(Zs[(t + 1) * 128 + c]) + w2z * bf1(Zs[(t + 2) * 128 + c]) + bz;
        const float vg = v * x, y = (bf1(Ls[t * 128 + c]) + vg * dd) * z;
        Yc[(size_t)(b * SEQ + t0 + t) * D + S5W + cc] = (bf16_t)f2bf(y); }
    __syncthreads();
}

FI void p7_run(const Args& A, LAS unsigned char* lds, int lane, int wave, int vcu, int G, bool commit) {
    unsigned char* ws = A.ws;
    const float* x1 = (const float*)(ws + WS_X1); unsigned char* A2 = ws + WS_A2;
    const float* mod = (const float*)(ws + WS_MODF); const float* g2 = A.in[7];
    const float* wrt = A.in[32]; const float* brt = A.in[33];
    int* cnt = (int*)(ws + WS_CTL) + CW_CNT; int* rowl = (int*)(ws + WS_ROWL); int* pk = (int*)(ws + WS_PK); float* gate = (float*)(ws + WS_GATE);
    LAS float* hb = (LAS float*)(lds + wave * 8192);
    const int e = lane & 31, kh = lane >> 5;
    for (int it = vcu; it < M / 64; it += G) {
        const int rbase = it * 64 + wave * 8, b = rbase / SEQ;
        float rstd[8];
#pragma unroll
        for (int r = 0; r < 8; ++r) { float ss = 0.f;
#pragma unroll
            for (int j = 0; j < 8; ++j) { const f32x4 v = *(const f32x4*)(x1 + (size_t)(rbase + r) * D + 4 * lane + 256 * j); ss += (v.x * v.x + v.y * v.y) + (v.z * v.z + v.w * v.w); }
            rstd[r] = rsqrtf(wave_sum(ss) * (1.0f / D) + 1e-6f); }
        float lg[8];
#pragma unroll
        for (int r = 0; r < 8; ++r) lg[r] = 0.f;
#pragma unroll 1
        for (int kc = 0; kc < 8; ++kc) {
            const int col = kc * 256 + 4 * lane;
            const f32x4 gv = *(const f32x4*)(g2 + col);
            const f32x4 sh = *(const f32x4*)(mod + (size_t)b * 12288 + 3 * D + col);
            const f32x4 sc = *(const f32x4*)(mod + (size_t)b * 12288 + 4 * D + col) + 1.0f;
#pragma unroll
            for (int r = 0; r < 8; ++r) { const f32x4 xv = *(const f32x4*)(x1 + (size_t)(rbase + r) * D + col);
                const f32x4 h = xv * rstd[r] * gv * sc + sh;
                *(unsigned*)(A2 + (size_t)(rbase + r) * D + col) = pk4_fp8(h.x, h.y, h.z, h.w);
                *(LAS f32x4*)(hb + r * 256 + 4 * lane) = h; }
            LDS_WAIT();
            const float* wp = wrt + (size_t)(kc * 256 + kh * 128) * NE + e;
#pragma unroll 2
            for (int jj = 0; jj < 128; jj += 4) {
                const float w0 = wp[(jj + 0) * NE], w1 = wp[(jj + 1) * NE], w2 = wp[(jj + 2) * NE], w3 = wp[(jj + 3) * NE];
#pragma unroll
                for (int r = 0; r < 8; ++r) { const f32x4 hv = *(const LAS f32x4*)(hb + r * 256 + kh * 128 + jj); lg[r] += (hv.x * w0 + hv.y * w1) + (hv.z * w2 + hv.w * w3); }
            }
            LDS_WAIT();
        }
        const float be = brt[e];
        LAS int* lcnt = (LAS int*)(lds + 65536);
        __syncthreads();
        if (threadIdx.x < 64) lcnt[threadIdx.x] = 0;
        __syncthreads();
        int myex[8], myrank[8]; float mygate[8];
#pragma unroll
        for (int r = 0; r < 8; ++r) {
            float v = lg[r] + __shfl_xor(lg[r], 32) + be;
            float tv[4]; int ti[4];
#pragma unroll
            for (int k = 0; k < 4; ++k) { float bvv = v; int bi = e;
#pragma unroll
                for (int o = 16; o >= 1; o >>= 1) { const float ov = __shfl_xor(bvv, o); const int oi = __shfl_xor(bi, o); if (ov > bvv || (ov == bvv && oi < bi)) { bvv = ov; bi = oi; } }
                tv[k] = bvv; ti[k] = bi; if (e == bi) v = -3.0e38f; }
            const float e1 = __expf(tv[1] - tv[0]), e2 = __expf(tv[2] - tv[0]), e3 = __expf(tv[3] - tv[0]), inv = 1.0f / (1.0f + e1 + e2 + e3);
            myex[r] = lane == 0 ? ti[0] : lane == 1 ? ti[1] : lane == 2 ? ti[2] : ti[3];
            mygate[r] = (lane == 0 ? 1.0f : lane == 1 ? e1 : lane == 2 ? e2 : e3) * inv;
            myrank[r] = 0;
            if (lane < 4) myrank[r] = __hip_atomic_fetch_add(lcnt + myex[r], 1, __ATOMIC_RELAXED, __HIP_MEMORY_SCOPE_WORKGROUP);
        }
        __syncthreads();
        if (threadIdx.x < NE) { const int n = lcnt[threadIdx.x]; lcnt[32 + threadIdx.x] = (n > 0 && commit) ? atomicAdd(cnt + threadIdx.x, n) : 0; }
        __syncthreads();
        if (lane < 4 && commit) {
#pragma unroll
            for (int r = 0; r < 8; ++r) { const int row = rbase + r, slot = lcnt[32 + myex[r]] + myrank[r];
                rowl[myex[r] * M + slot] = row; pk[row * 4 + lane] = myex[r] * M + slot; gate[row * 4 + lane] = mygate[r]; }
        }
    }
}

FI void moe_table(const Args& A, LAS unsigned char* lds, int tid) {
    const int* cnt = (const int*)(A.ws + WS_CTL) + CW_CNT;
    LAS int* tw = (LAS int*)(lds + LDSCTL_OFF);
    if (tid < 64) { const int n = tid < NE ? cnt[tid] : 0; int p = (n + 255) >> 8;
#pragma unroll
        for (int o = 1; o < 32; o <<= 1) { const int q = __shfl_up(p, o); if ((tid & 63) >= o) p += q; }
        if (tid < NE) { tw[LW_TST + tid + 1] = p; tw[LW_CNT + tid] = n; } if (tid == 0) tw[LW_TST] = 0; }
    __syncthreads();
    if (tid < 320) { int e = 0;
#pragma unroll 1
        for (int j = 1; j < NE; ++j) e += (tw[LW_TST + j] <= tid) ? 1 : 0;
        tw[LW_TE + tid] = e; }
    __syncthreads();
}

FI void p10_run(const Args& A, LAS unsigned char* lds, int lane, int wave, int vcu, int G) {
    unsigned char* ws = A.ws;
    const float* x1 = (const float*)(ws + WS_X1); const bf16_t* Yd = (const bf16_t*)(ws + WS_YD);
    const float* mod = (const float*)(ws + WS_MODF); const float* gf = A.in[38];
    const int* pk = (const int*)(ws + WS_PK); const float* gate = (const float*)(ws + WS_GATE);
    const LAS int* tst = (const LAS int*)(lds + LDSCTL_OFF) + LW_TST;
    const int gw = vcu * NWAVES + wave, NGW = G * NWAVES;
    for (int row = gw; row < M; row += NGW) {
        const int b = row / SEQ; size_t hr[4]; float gk[4];
#pragma unroll
        for (int k = 0; k < 4; ++k) { const int p = pk[row * 4 + k], ex = p / M, slot = p % M; hr[k] = (size_t)(tst[ex] * 256 + slot) * D; gk[k] = gate[row * 4 + k]; }
        f32x4 x2[8]; float ss = 0.f;
#pragma unroll
        for (int j = 0; j < 8; ++j) { const int col = 4 * lane + 256 * j;
            f32x4 s = (f32x4){0.f, 0.f, 0.f, 0.f};
#pragma unroll
            for (int k = 0; k < 4; ++k) { const u32x2 y = *(const u32x2*)(Yd + hr[k] + col); s += (f32x4){bflo(y.x), bfhi(y.x), bflo(y.y), bfhi(y.y)} * gk[k]; }
            const f32x4 ga = *(const f32x4*)(mod + (size_t)b * 12288 + 5 * D + col);
            x2[j] = *(const f32x4*)(x1 + (size_t)row * D + col) + ga * s;
            ss += (x2[j].x * x2[j].x + x2[j].y * x2[j].y) + (x2[j].z * x2[j].z + x2[j].w * x2[j].w); }
        const float rstd = rsqrtf(wave_sum(ss) * (1.0f / D) + 1e-6f);
#pragma unroll
        for (int j = 0; j < 8; ++j) { const int col = 4 * lane + 256 * j; *(f32x4*)(A.out + (size_t)row * D + col) = x2[j] * rstd * *(const f32x4*)(gf + col); }
    }
}

__global__ void __launch_bounds__(NTHR, 2) fwd_kernel(Args args) {
    extern __shared__ __attribute__((aligned(16))) unsigned char lds_raw[];
    LAS unsigned char* lds = (LAS unsigned char*)lds_raw;
    const int tid = threadIdx.x, lane = tid & 63, wave = __builtin_amdgcn_readfirstlane(tid >> 6);
    const int G = gridDim.x; const int bx = blockIdx.x; const int vcu = (G % 8 == 0) ? (bx % 8) * (G / 8) + bx / 8 : bx;
    unsigned char* ws = args.ws;
    for (int u = tid; u < (LDS_BYTES - LDSCTL_OFF) / 4; u += NTHR) ((LAS unsigned*)(lds + LDSCTL_OFF))[u] = 0u;
    __syncthreads();
    XcdBarrier bar; bar.bar = (unsigned*)(ws + WS_CTL) + CW_BAR; bar.x = 0; bar.st = nullptr;
#if !MK_SPLIT
    bar = xcd_barrier_post((unsigned*)(ws + WS_CTL) + CW_BAR, (volatile LAS unsigned*)(lds + LDSCTL_OFF) + LW_BAR);
#endif
    const int lo = args.ph_lo, hi = args.ph_hi;
#ifndef PHASE_MASK
#define PHASE_MASK 0x7ff
#endif
#define IN(k) (((PHASE_MASK >> (k)) & 1) && lo <= (k) && (k) < hi)
#if MK_SPLIT
#define SEAM(k) do { } while (0)
#else
#define SEAM(k) do { if (IN(k) && IN((k) + 1)) xcd_barrier(bar); } while (0)
#endif
    const float* modp = (const float*)(ws + WS_MODF);
    unsigned long long amp_t0 = 0, amp_dt = 0;
#define AMP_BEGIN(k) do { if (AMP_PHASE == (k) && bx == 0 && tid == 0) amp_t0 = __builtin_amdgcn_s_memrealtime(); } while (0)
#define AMP_END(k) do { if (AMP_PHASE == (k) && bx == 0 && tid == 0) amp_dt = __builtin_amdgcn_s_memrealtime() - amp_t0; } while (0)

    AMP_BEGIN(0);
    if (IN(0)) { p0_run(args, lds, tid, lane, wave, vcu, G); } SEAM(0); AMP_END(0);
    AMP_BEGIN(1);
    if (IN(1)) { _Pragma("unroll 1") for (int rep = 0; rep < REP1; ++rep) p1_run(args, tid, lane, wave, vcu, G, 0, MT, true); } SEAM(1); AMP_END(1);
    AMP_BEGIN(2);
    if (IN(2)) {
        pg8::DenseSched S{(const bf16_t*)(ws + WS_A1), (const bf16_t*)(ws + WS_WIN), 2 * D, M / 256, DIN / 256, G, bx, M / 256, MC / 256, S5W / 256, 0};
        pg8::EpiStoreBf16 E{(bf16_t*)(ws + WS_P), DIN, nullptr, 0, 1.0f};
        _Pragma("unroll 1") for (int rep = 0; rep < REP2; ++rep)
        pg8::gemm_phase<false>(lds, 2 * D, S, E);
    } SEAM(2); AMP_END(2);
    AMP_BEGIN(3);
    if (IN(3)) {
        _Pragma("unroll 1") for (int rep = 0; rep < REP3; ++rep) {
        _Pragma("unroll 1") for (int r2 = 0; r2 < REP3A; ++r2) for (int u = vcu; u < 512; u += G) s5_unit(args, lds, u, lane, wave);
        _Pragma("unroll 1") for (int r2 = 0; r2 < REP3B; ++r2) for (int it = vcu; it < 2048; it += G) h1_item(args, lds, it, tid); }
    } SEAM(3); AMP_END(3);
    AMP_BEGIN(4);
    if (IN(4)) {
        _Pragma("unroll 1") for (int rep = 0; rep < REP4; ++rep) {
        _Pragma("unroll 1") for (int r2 = 0; r2 < REP4A; ++r2) s5_combine(args, vcu * NTHR + tid, G * NTHR);
        _Pragma("unroll 1") for (int r2 = 0; r2 < REP4B; ++r2) for (int c = vcu; c < HYW; c += G) longconv_channel(args, lds, c, tid, lane, wave); }
    } SEAM(4); AMP_END(4);
    AMP_BEGIN(5);
    if (IN(5)) {
        _Pragma("unroll 1") for (int rep = 0; rep < REP5; ++rep) for (int it = vcu; it < 2048; it += G) h3_item(args, lds, it, tid);
        pg8::DenseSched S{(const bf16_t*)(ws + WS_YG), (const bf16_t*)(ws + WS_WGLU), 2 * S5W, M / 256, S5W / 256, G, bx, 0, 0, 0, 0};
        pg8::EpiGlu E{(const bf16_t*)(ws + WS_YG), (bf16_t*)(ws + WS_YCAT), args.in[18]};
        pg8::gemm_phase<false>(lds, 2 * S5W, S, E);
    } SEAM(5); AMP_END(5);
    AMP_BEGIN(6);
    if (IN(6)) {
        pg8::DenseSched S{(const bf16_t*)(ws + WS_YCAT), (const bf16_t*)(ws + WS_WOUT), 2 * D, M / 256, D / 256, G, bx, 0, 0, 0, 0};
        pg8::EpiResid E{args.in[0], (float*)(ws + WS_X1), modp};
        _Pragma("unroll 1") for (int rep = 0; rep < REP6; ++rep)
        pg8::gemm_phase<false>(lds, 2 * D, S, E);
    } SEAM(6); AMP_END(6);
    AMP_BEGIN(7);
    if (IN(7)) { _Pragma("unroll 1") for (int rep = 0; rep < REP7; ++rep) p7_run(args, lds, lane, wave, vcu, G, rep == REP7 - 1); } SEAM(7); AMP_END(7);
    AMP_BEGIN(8);
    if (IN(8)) {
        moe_table(args, lds, tid);
        pg8::MoeSched<true> S{ws + WS_A2, ws + WS_WGU, D, 16, G, bx, (size_t)4096 * D,
                              (const LAS int*)(lds + LDSCTL_OFF) + LW_TST, (const LAS int*)(lds + LDSCTL_OFF) + LW_CNT, (const int*)(ws + WS_ROWL)};
        pg8::EpiSwiglu E{ws + WS_H, args.in[35], 1.0f / WSCALE};
        _Pragma("unroll 1") for (int rep = 0; rep < REP8; ++rep)
        pg8::gemm_phase<true>(lds, D, S, E);
    } SEAM(8); AMP_END(8);
    AMP_BEGIN(9);
    if (IN(9)) {
        moe_table(args, lds, tid);
        pg8::MoeSched<false> S{ws + WS_H, ws + WS_WDN, DFF, 8, G, bx, (size_t)D * DFF,
                               (const LAS int*)(lds + LDSCTL_OFF) + LW_TST, (const LAS int*)(lds + LDSCTL_OFF) + LW_CNT, (const int*)(ws + WS_ROWL)};
        pg8::EpiStoreBf16 E{(bf16_t*)(ws + WS_YD), D, args.in[37], D, 1.0f / WSCALE};
        _Pragma("unroll 1") for (int rep = 0; rep < REP9; ++rep)
        pg8::gemm_phase<true>(lds, DFF, S, E);
    } SEAM(9); AMP_END(9);
    AMP_BEGIN(10);
    if (IN(10)) { moe_table(args, lds, tid); _Pragma("unroll 1") for (int rep = 0; rep < REP10; ++rep) p10_run(args, lds, lane, wave, vcu, G); }
    AMP_END(10);
    if (AMP_PHASE >= 0 && bx == 0 && tid == 0) { const unsigned long long t0 = __builtin_amdgcn_s_memrealtime(); while (__builtin_amdgcn_s_memrealtime() - t0 < 4ull * amp_dt) __builtin_amdgcn_s_sleep(16); }
#undef IN
#undef SEAM
}

extern "C" void kernel_launch(void* const* d_in, const int* in_sizes, int n_in, void* d_out, int out_size, void* d_ws, size_t ws_size, hipStream_t stream) {
    static int grid = 0;
    if (grid == 0) {
        if (n_in != 39 || out_size != M * D || ws_size < WS_END) { fprintf(stderr, "kernel_launch: unexpected problem (n_in %d, out %d, ws %zu)\n", n_in, out_size, ws_size); grid = -1; return; }
        int dev = 0, cus = 0, per_cu = 0;
        if (hipGetDevice(&dev) != hipSuccess || hipDeviceGetAttribute(&cus, hipDeviceAttributeMultiprocessorCount, dev) != hipSuccess) { grid = -1; return; }
        if (hipFuncSetAttribute((const void*)fwd_kernel, hipFuncAttributeMaxDynamicSharedMemorySize, LDS_BYTES) != hipSuccess) { fprintf(stderr, "kernel_launch: hipFuncSetAttribute failed\n"); grid = -1; return; }
        if (hipOccupancyMaxActiveBlocksPerMultiprocessor(&per_cu, (const void*)fwd_kernel, NTHR, LDS_BYTES) != hipSuccess || per_cu < 1) fprintf(stderr, "kernel_launch: occupancy query says %d\n", per_cu);
        (void)hipGetLastError();
        grid = cus;
    }
    if (grid < 0) return;
    (void)in_sizes;
    if (hipMemsetAsync((char*)d_ws + WS_CTL, 0, CTL_ZERO_BYTES, stream) != hipSuccess) { fprintf(stderr, "kernel_launch: memset failed\n"); return; }
    Args a{};
    for (int i = 0; i < 39; ++i) a.in[i] = (const float*)d_in[i];
    a.out = (float*)d_out; a.ws = (unsigned char*)d_ws;
#if MK_SPLIT
    for (int p = 0; p < NPHASE; ++p) { a.ph_lo = p; a.ph_hi = p + 1; hipLaunchKernelGGL(fwd_kernel, dim3(grid), dim3(NTHR), LDS_BYTES, stream, a); }
#else
    a.ph_lo = 0; a.ph_hi = NPHASE;
    hipLaunchKernelGGL(fwd_kernel, dim3(grid), dim3(NTHR), LDS_BYTES, stream, a);
#endif
    const hipError_t le = hipPeekAtLastError();
    if (le != hipSuccess) fprintf(stderr, "kernel_launch: launch failed: %s\n", hipGetErrorName(le));
}
```

```cpp
#include <hip/hip_runtime.h>
#include <cstdio>
#include <cstdint>

#ifndef MK_SPLIT
#define MK_SPLIT 0
#endif

#ifndef REP0D
#define REP0D 1
#endif
#ifndef REP2
#define REP2 1
#endif
#ifndef AMP_PHASE
#define AMP_PHASE -1
#endif
#ifndef REP1
#define REP1 1
#endif
#ifndef REP5
#define REP5 1
#endif
#ifndef REP7
#define REP7 1
#endif
#ifndef REP10
#define REP10 1
#endif
#ifndef REP0A
#define REP0A 1
#endif
#ifndef REP3
#define REP3 1
#endif
#ifndef REP3A
#define REP3A 1
#endif
#ifndef REP3B
#define REP3B 1
#endif
#ifndef REP4A
#define REP4A 1
#endif
#ifndef REP4B
#define REP4B 1
#endif
#ifndef REP4
#define REP4 1
#endif
#ifndef REP6
#define REP6 1
#endif
#ifndef REP8
#define REP8 1
#endif
#ifndef REP9
#define REP9 1
#endif
#define GAS __attribute__((address_space(1)))
#define LAS __attribute__((address_space(3)))
typedef unsigned short bf16_t;
typedef short bf16x8 __attribute__((ext_vector_type(8)));
typedef float f32x4 __attribute__((ext_vector_type(4)));
typedef float f32x16 __attribute__((ext_vector_type(16)));
typedef unsigned u32x4 __attribute__((ext_vector_type(4)));
typedef unsigned u32x2 __attribute__((ext_vector_type(2)));

constexpr int NWAVES = 8, NTHR = 512;
constexpr int D = 2048, NB = 8, SEQ = 2048, M = NB * SEQ, CTXL = 256, MC = NB * CTXL, MT = M + MC;
constexpr int DIN = 4096, S5W = 1024, HYW = 1024, NG = 64;
constexpr int NE = 32, DFF = 2048;
constexpr int NPHASE = 11;
constexpr float WSCALE = 64.0f;
constexpr int SEG = 288;

constexpr size_t MiB = 1u << 20;
constexpr size_t WS_CTL = 0, CTL_ZERO_BYTES = 1024 * 1024;
constexpr int CW_TMO = 0, CW_BAR = 4096, CW_CNT = 8192, CW_HNORM = 12288, CW_MOD = 16384;
constexpr size_t WS_LAM = 1 * MiB, WS_LAML = WS_LAM + 64 * 1024, WS_S5B = WS_LAM + 128 * 1024, WS_S5C = WS_LAM + 640 * 1024;
constexpr size_t WS_HRAW = 4 * MiB, WS_RG = 20 * MiB, WS_WIN = 28 * MiB, WS_WGLU = 44 * MiB, WS_WOUT = 46 * MiB;
constexpr size_t WS_PK = 54 * MiB, WS_GATE = WS_PK + 256 * 1024, WS_ROWL = 55 * MiB, WS_MODF = 58 * MiB, WS_WRF = 59 * MiB;
constexpr size_t WS_A1 = 64 * MiB, WS_P = 136 * MiB, WS_YS5 = 280 * MiB, WS_VT = 344 * MiB, WS_LCT = 376 * MiB, WS_YG = 408 * MiB;
constexpr size_t WS_YCAT = 440 * MiB, WS_X1 = 504 * MiB, WS_A2 = 632 * MiB, WS_WGU = 704 * MiB, WS_WDN = 1216 * MiB;
constexpr size_t WS_H = 1472 * MiB, WS_YD = 1760 * MiB, WS_END = 2048 * MiB;
constexpr int HROWS = 73728;

constexpr int RING_BYTES = 131072, LDSCTL_OFF = RING_BYTES, LDS_BYTES = 147456;
constexpr int LW_BAR = 8, LW_TST = 64, LW_CNT = 128, LW_TE = 256;

typedef __bf16 bf16v2 __attribute__((ext_vector_type(2)));
typedef float f32v2 __attribute__((ext_vector_type(2)));
__device__ __forceinline__ unsigned f2bf(float f) { return (unsigned)__builtin_bit_cast(unsigned short, (__bf16)f); }
__device__ __forceinline__ unsigned pk2(float lo, float hi) { const f32v2 v = {lo, hi}; return __builtin_bit_cast(unsigned, __builtin_convertvector(v, bf16v2)); }
__device__ __forceinline__ float bflo(unsigned w) { return __builtin_bit_cast(float, w << 16); }
__device__ __forceinline__ float bfhi(unsigned w) { return __builtin_bit_cast(float, w & 0xffff0000u); }
__device__ __forceinline__ float bf1(bf16_t b) { return __builtin_bit_cast(float, (unsigned)b << 16); }
__device__ __forceinline__ unsigned pk4_fp8(float a, float b, float c, float d) { int w = __builtin_amdgcn_cvt_pk_fp8_f32(a, b, 0, false); w = __builtin_amdgcn_cvt_pk_fp8_f32(c, d, w, true); return (unsigned)w; }
constexpr float FIX_SCALE = 4294967296.0f;
__device__ __forceinline__ void fix_add(unsigned long long* p, float v) { atomicAdd(p, (unsigned long long)__float2ll_rn(v * FIX_SCALE)); }
__device__ __forceinline__ float fix_get(const unsigned long long* p) { return (float)((double)(long long)(*p) * (1.0 / 4294967296.0)); }
__device__ __forceinline__ float sigm(float v) { return __builtin_amdgcn_rcpf(1.0f + __builtin_amdgcn_exp2f(-1.44269504f * v)); }
__device__ __forceinline__ float wave_sum(float v) {
#pragma unroll
    for (int o = 1; o < 64; o <<= 1) v += __shfl_xor(v, o);
    return v;
}
#define LDS_WAIT() asm volatile("s_waitcnt lgkmcnt(0)" ::: "memory")
#define VM_WAIT() asm volatile("s_waitcnt vmcnt(0)" ::: "memory")

#define XB_TMO      128
#define XB_XCNT(j)  (256  + 64 * (j))
#define XB_XSUB(j)  (1280 + 64 * (j))
#define XB_XGEN(j)  (2304 + 64 * (j))
#define XB_TOP      3328
#define XB_TOPGEN   3392
#define XCD_BAR_WORDS 3456
#define XB_SPIN_CAP (1u << 18)
__device__ __forceinline__ unsigned xb_ld(unsigned* p)              { return __hip_atomic_load(p, __ATOMIC_RELAXED, __HIP_MEMORY_SCOPE_AGENT); }
__device__ __forceinline__ unsigned xb_add(unsigned* p, unsigned v) { return __hip_atomic_fetch_add(p, v, __ATOMIC_RELAXED, __HIP_MEMORY_SCOPE_AGENT); }
__device__ __forceinline__ unsigned xb_xcc_id() { return (unsigned)__builtin_amdgcn_s_getreg((3 << 11) | 20) & 0xFu; }
#define XB_SPIN(cond, bar) do { unsigned _sp = 0; while (cond) { __builtin_amdgcn_s_sleep(1); \
    if ((++_sp & 255u) == 0u) { if (xb_ld(&(bar)[XB_TMO])) break; if (_sp > XB_SPIN_CAP) { atomicAdd(&(bar)[XB_TMO], 1u); break; } } } } while (0)
struct XcdBarrier { unsigned* bar; unsigned x; volatile LAS unsigned* st; };
__device__ __forceinline__ XcdBarrier xcd_barrier_post(unsigned* bar, volatile LAS unsigned* st) {
    XcdBarrier b; b.bar = bar; b.x = xb_xcc_id(); b.st = st;
    if (threadIdx.x == 0) (void)xb_add(&bar[XB_XCNT(b.x)], 1u);
    return b;
}
__device__ __forceinline__ void xcd_barrier_complete(unsigned* bar, unsigned x, unsigned& nloc, unsigned& nx) {
    const unsigned G = gridDim.x * gridDim.y * gridDim.z;
    unsigned sum, cnt, mine, sp = 0u;
    for (;;) {
        sum = 0u; cnt = 0u; mine = 0u;
#pragma unroll
        for (unsigned j = 0; j < 16; ++j) { const unsigned c = xb_ld(&bar[XB_XCNT(j)]); sum += c; cnt += (c > 0u) ? 1u : 0u; mine = (j == x) ? c : mine; }
        if (sum == G) break;
        __builtin_amdgcn_s_sleep(1);
        if ((++sp & 255u) == 0u) { if (xb_ld(&bar[XB_TMO])) break; if (sp > XB_SPIN_CAP) { atomicAdd(&bar[XB_TMO], 1u); break; } }
    }
    nloc = mine > 0u ? mine : 1u; nx = cnt > 0u ? cnt : 1u;
}
__device__ __forceinline__ void xcd_barrier(const XcdBarrier& b) {
    asm volatile("s_waitcnt vmcnt(0)" ::: "memory");
    __syncthreads();
    if (threadIdx.x == 0) {
        unsigned* bar = b.bar;
        __builtin_amdgcn_s_waitcnt(0);
        unsigned nloc = b.st[0], nx = b.st[1];
        if (nloc == 0u) { xcd_barrier_complete(bar, b.x, nloc, nx); b.st[0] = nloc; b.st[1] = nx; }
        const unsigned old = xb_add(&bar[XB_XSUB(b.x)], 1u);
        const unsigned gen = old / nloc;
        if (old + 1u == (gen + 1u) * nloc) {
            __builtin_amdgcn_fence(__ATOMIC_RELEASE, "agent");
            asm volatile("s_waitcnt vmcnt(0)" ::: "memory");
            const unsigned og = xb_add(&bar[XB_TOP], 1u);
            const unsigned tg = og / nx;
            if (og + 1u == (tg + 1u) * nx) xb_add(&bar[XB_TOPGEN], 1u);
            else XB_SPIN(xb_ld(&bar[XB_TOPGEN]) == tg, bar);
            __builtin_amdgcn_fence(__ATOMIC_ACQUIRE, "agent");
            xb_add(&bar[XB_XGEN(b.x)], 1u);
            asm volatile("s_waitcnt vmcnt(0)" ::: "memory");
        } else {
            XB_SPIN(xb_ld(&bar[XB_XGEN(b.x)]) == gen, bar);
            __builtin_amdgcn_fence(__ATOMIC_ACQUIRE, "agent");
            asm volatile("s_waitcnt vmcnt(0)" ::: "memory");
        }
    }
    __syncthreads();
}

struct Args { const float* in[39]; float* out; unsigned char* ws; int ph_lo, ph_hi; };

namespace pg8 {
constexpr int BM = 256, BK = 64, HALF = 128, HTB = HALF * BK * 2, STAGE_BYTES = 8 * HTB, NXCD = 8, WGM = 8;
__device__ __forceinline__ int lds_byte(int r, int c) { const int st = (r >> 4) * 2 + (c >> 5), rr = r & 15, cc = c & 31, ob = rr * 64 + cc * 2; return st * 1024 + (ob ^ (((ob >> 9) & 1) << 5)); }
__device__ __forceinline__ void stage_rc(int b, int& R, int& C) { const int st = b / 1024, sb = b % 1024, swz = sb ^ (((sb >> 9) & 1) << 5); R = (st >> 1) * 16 + swz / 64; C = (st & 1) * 32 + (swz % 64) / 2; }
__device__ __forceinline__ int perm32(int rho) { const int n = rho >> 4, i = rho & 15; return 8 * (i >> 2) + 4 * n + (i & 3); }
struct Unit { int pm, pn, e; };
__device__ __forceinline__ unsigned cvt_pk_bf16(float lo, float hi) { unsigned r; asm volatile("v_cvt_pk_bf16_f32 %0, %1, %2" : "=v"(r) : "v"(lo), "v"(hi)); return r; }

__device__ __forceinline__ void tile_of(long L, int nM, int nN, int& pm, int& pn) {
    const int nwg = nM * nN; int wgid = (int)L;
    { const int q = nwg / NXCD, r = nwg % NXCD, xcd = wgid % NXCD, off = wgid / NXCD; wgid = (xcd < r ? xcd * (q + 1) : r * (q + 1) + (xcd - r) * q) + off; }
    const int nig = WGM * nN, gid = wgid / nig, fm = gid * WGM, gsz = (nM - fm) < WGM ? (nM - fm) : WGM;
    pm = fm + ((wgid % nig) % gsz); pn = (wgid % nig) / gsz;
}

struct DenseSched {
    const bf16_t* A; const bf16_t* Bt; int RB, nM, nN, G, c, xM0, xnM, xnN, xN0;
    __device__ __forceinline__ bool next(int i, Unit& u) const {
        const long L = (long)i * G + c; const int nwg = nM * nN;
        if (L < nwg) { tile_of(L, nM, nN, u.pm, u.pn); u.e = 0; return true; }
        const long r = L - nwg; if (r >= (long)xnM * xnN) return false;
        u.pm = xM0 + (int)(r % xnM); u.pn = xN0 + (int)(r / xnM); u.e = 0; return true;
    }
    __device__ __forceinline__ const char* abase(const Unit& u) const { return (const char*)A + (size_t)u.pm * BM * RB; }
    __device__ __forceinline__ const char* bbase(const Unit& u) const { return (const char*)Bt + (size_t)u.pn * BM * RB; }
    __device__ __forceinline__ void rows(const Unit&, unsigned (&va)[2][2], const int (&R)[2], const int (&C)[2]) const {
#pragma unroll
        for (int h = 0; h < 2; ++h)
#pragma unroll
            for (int i = 0; i < 2; ++i) va[h][i] = (unsigned)((h * HALF + R[i]) * RB + 2 * C[i]);
    }
};
template <bool GATHER> struct MoeSched {
    const unsigned char* A; const unsigned char* Bt; int RB, nN, G, c; size_t estride;
    const LAS int* tst; const LAS int* cnts; const int* rowlist;
    __device__ __forceinline__ bool next(int i, Unit& u) const {
        const int TM = __builtin_amdgcn_readfirstlane(tst[NE]); const long L = (long)i * G + c; if (L >= (long)TM * nN) return false;
        tile_of(L, TM, nN, u.pm, u.pn);
        u.e = __builtin_amdgcn_readfirstlane(tst[(LW_TE - LW_TST) + u.pm]); return true;
    }
    __device__ __forceinline__ const char* abase(const Unit& u) const { return GATHER ? (const char*)A : (const char*)A + (size_t)u.pm * BM * RB; }
    __device__ __forceinline__ const char* bbase(const Unit& u) const { return (const char*)Bt + (size_t)u.e * estride + (size_t)u.pn * BM * RB; }
    __device__ __forceinline__ void rows(const Unit& u, unsigned (&va)[2][2], const int (&R)[2], const int (&C)[2]) const {
        if (GATHER) {
            const int n = __builtin_amdgcn_readfirstlane(cnts[u.e]), lt = u.pm - __builtin_amdgcn_readfirstlane(tst[u.e]);
#pragma unroll
            for (int h = 0; h < 2; ++h)
#pragma unroll
                for (int i = 0; i < 2; ++i) { int slot = lt * BM + h * HALF + R[i]; slot = slot < n ? slot : 0; const int tok = rowlist[u.e * M + slot]; va[h][i] = (unsigned)(tok * RB + 2 * C[i]); }
        } else {
#pragma unroll
            for (int h = 0; h < 2; ++h)
#pragma unroll
                for (int i = 0; i < 2; ++i) va[h][i] = (unsigned)((h * HALF + R[i]) * RB + 2 * C[i]);
        }
    }
};

typedef int i32x4 __attribute__((ext_vector_type(4)));
typedef int i32x8 __attribute__((ext_vector_type(8)));
template <bool FP8, class Epi, class Sched>
__device__ __forceinline__ void gemm_phase(LAS unsigned char* lds, const int RB, const Sched& S, const Epi& E) {
    const int tid = threadIdx.x, wid = __builtin_amdgcn_readfirstlane(tid >> 6), lane = tid & 63, wr = wid >> 2, wc = wid & 3, fr = lane & 15, fq = lane >> 4;
    const int nt = RB / 128;
    unsigned voffB[2]; int Rr[2], Cc[2];
#pragma unroll
    for (int i = 0; i < 2; ++i) { int R, C; stage_rc(tid * 16 + i * 8192, R, C); Rr[i] = R; Cc[i] = C; const int Rb = Epi::PERM ? ((R & ~31) + perm32(R & 31)) : R; voffB[i] = (unsigned)(Rb * RB + 2 * C); }
    const size_t kstep = (size_t)(BK * 2);
    const size_t hstep = (size_t)HALF * RB;
    const unsigned ldsw = (unsigned)wid * 1024u;
    const int aoff = lds_byte(wr * 64 + fr, fq * 8), boff = lds_byte(wc * 32 + fr, fq * 8);
#define PG8_SA(b, h) (((b) * 2 + (h)) * HTB)
#define PG8_SB(b, h) ((4 + (b) * 2 + (h)) * HTB)
#define PG8_STAGE(bufoff, gbase, voff) do { _Pragma("unroll") for (int _i = 0; _i < 2; ++_i) \
        __builtin_amdgcn_global_load_lds((const unsigned*)((const char*)(gbase) + (voff)[_i]), (LAS unsigned*)(lds + (bufoff) + ldsw + _i * 8192), 16, 0, 0); } while (0)
#define PG8_LDA(dst, b, h) do { _Pragma("unroll") for (int m = 0; m < 4; ++m) _Pragma("unroll") for (int k = 0; k < 2; ++k) dst[m][k] = *(const LAS bf16x8*)(lds + PG8_SA(b, h) + aoff + m * 2048 + k * 1024); } while (0)
#define PG8_LDB(dst, b, h) do { _Pragma("unroll") for (int n = 0; n < 2; ++n) _Pragma("unroll") for (int k = 0; k < 2; ++k) dst[n][k] = *(const LAS bf16x8*)(lds + PG8_SB(b, h) + boff + n * 2048 + k * 1024); } while (0)
#define PG8_MMA(ai, bj, At, Bt) do { __builtin_amdgcn_s_setprio(1); _Pragma("unroll") for (int m = 0; m < 4; ++m) _Pragma("unroll") for (int n = 0; n < 2; ++n) { \
        if constexpr (FP8) { const i32x8 bb_ = __builtin_shufflevector(__builtin_bit_cast(i32x4, Bt[n][0]), __builtin_bit_cast(i32x4, Bt[n][1]), 0, 1, 2, 3, 4, 5, 6, 7); \
            const i32x8 aa_ = __builtin_shufflevector(__builtin_bit_cast(i32x4, At[m][0]), __builtin_bit_cast(i32x4, At[m][1]), 0, 1, 2, 3, 4, 5, 6, 7); \
            asm volatile("v_mfma_scale_f32_16x16x128_f8f6f4 %0, %1, %2, %0, %3, %3 op_sel_hi:[0,0,0]" : "+v"(acc[ai][bj][m][n]) : "v"(bb_), "v"(aa_), "v"(one_scale)); } \
        else { _Pragma("unroll") for (int k = 0; k < 2; ++k) acc[ai][bj][m][n] = __builtin_amdgcn_mfma_f32_16x16x32_bf16(Bt[n][k], At[m][k], acc[ai][bj][m][n], 0, 0, 0); } } \
        __builtin_amdgcn_s_setprio(0); } while (0)
#define PG8_WAIT_V(n) asm volatile("s_waitcnt vmcnt(" #n ")" ::: "memory")
#define PG8_WAIT_L(n) asm volatile("s_waitcnt lgkmcnt(" #n ")" ::: "memory")
#define PG8_BAR __builtin_amdgcn_s_barrier()
#define PG8_SCHED __builtin_amdgcn_sched_barrier(0)
    Unit cur, nxt; int ui = 0;
    if (!S.next(0, cur)) return;
    f32x4 acc[2][2][4][2];
#pragma unroll
    for (int a = 0; a < 2; ++a)
#pragma unroll
        for (int b = 0; b < 2; ++b)
#pragma unroll
            for (int m = 0; m < 4; ++m)
#pragma unroll
                for (int n = 0; n < 2; ++n) acc[a][b][m][n] = (f32x4){0.f, 0.f, 0.f, 0.f};
    bf16x8 At[4][2], B0[2][2], B1[2][2];
    unsigned one_scale = 0x7F7F7F7Fu; asm volatile("" : "+v"(one_scale));
    unsigned vaC[2][2], vaN[2][2];
    S.rows(cur, vaC, Rr, Cc);
    const char* cA = S.abase(cur); const char* cB = S.bbase(cur);
    PG8_STAGE(PG8_SB(0, 0), cB, voffB); PG8_STAGE(PG8_SA(0, 0), cA, vaC[0]); PG8_STAGE(PG8_SB(0, 1), cB + hstep, voffB); PG8_STAGE(PG8_SA(0, 1), cA, vaC[1]);
    if (wr == 1) PG8_BAR;
    PG8_WAIT_V(4); PG8_BAR;
    PG8_STAGE(PG8_SB(1, 0), cB + kstep, voffB); PG8_STAGE(PG8_SA(1, 0), cA + kstep, vaC[0]); PG8_STAGE(PG8_SB(1, 1), cB + hstep + kstep, voffB);
    PG8_WAIT_V(6); PG8_BAR;
    for (;;) {
        const bool has_next = S.next(ui + 1, nxt);
        const char* nA = has_next ? S.abase(nxt) : cA; const char* nB = has_next ? S.bbase(nxt) : cB;
#pragma unroll
        for (int h = 0; h < 2; ++h)
#pragma unroll
            for (int i = 0; i < 2; ++i) vaN[h][i] = vaC[h][i];
        for (int t = 0; t < nt; t += 2) {
            const bool last = (t == nt - 2);
            const char* a1 = cA + (size_t)(t + 1) * kstep;
            const char* a2 = last ? nA : cA + (size_t)(t + 2) * kstep; const char* b2 = last ? nB : cB + (size_t)(t + 2) * kstep;
            const char* a3 = a2 + kstep; const char* b3 = b2 + kstep;
            if (last && has_next) S.rows(nxt, vaN, Rr, Cc);
            unsigned v2[2][2];
#pragma unroll
            for (int h = 0; h < 2; ++h)
#pragma unroll
                for (int i = 0; i < 2; ++i) v2[h][i] = last ? vaN[h][i] : vaC[h][i];
            PG8_LDB(B0, 0, 0); PG8_SCHED; PG8_LDA(At, 0, 0); PG8_STAGE(PG8_SA(1, 1), a1, vaC[1]);
            PG8_WAIT_L(8); PG8_BAR; PG8_WAIT_L(0); PG8_MMA(0, 0, At, B0); PG8_BAR; PG8_SCHED;
            PG8_LDB(B1, 0, 1); PG8_STAGE(PG8_SB(0, 0), b2, voffB);
            PG8_BAR; PG8_WAIT_L(0); PG8_MMA(0, 1, At, B1); PG8_BAR;
            PG8_LDA(At, 0, 1); PG8_STAGE(PG8_SA(0, 0), a2, v2[0]);
            PG8_BAR; PG8_WAIT_L(0); PG8_MMA(1, 0, At, B0); PG8_BAR; PG8_SCHED;
            PG8_STAGE(PG8_SB(0, 1), b2 + hstep, voffB);
            PG8_WAIT_V(6); PG8_BAR; PG8_MMA(1, 1, At, B1); PG8_BAR;
            PG8_LDB(B0, 1, 0); PG8_SCHED; PG8_LDA(At, 1, 0); PG8_STAGE(PG8_SA(0, 1), a2, v2[1]);
            PG8_WAIT_L(8); PG8_BAR; PG8_WAIT_L(0); PG8_MMA(0, 0, At, B0); PG8_BAR; PG8_SCHED;
            PG8_LDB(B1, 1, 1); PG8_STAGE(PG8_SB(1, 0), b3, voffB);
            PG8_BAR; PG8_WAIT_L(0); PG8_MMA(0, 1, At, B1); PG8_BAR;
            PG8_LDA(At, 1, 1); PG8_STAGE(PG8_SA(1, 0), a3, v2[0]);
            PG8_BAR; PG8_WAIT_L(0); PG8_MMA(1, 0, At, B0); PG8_BAR; PG8_SCHED;
            PG8_STAGE(PG8_SB(1, 1), b3 + hstep, voffB);
            PG8_WAIT_V(6); PG8_BAR; PG8_MMA(1, 1, At, B1); PG8_BAR;
        }
        if constexpr (FP8) asm volatile("s_nop 15\n\ts_nop 15" ::: "memory");
        E(acc, cur, wr, wc, fr, fq);
        if (!has_next) break;
#pragma unroll
        for (int a = 0; a < 2; ++a)
#pragma unroll
            for (int b = 0; b < 2; ++b)
#pragma unroll
                for (int m = 0; m < 4; ++m)
#pragma unroll
                    for (int n = 0; n < 2; ++n) acc[a][b][m][n] = (f32x4){0.f, 0.f, 0.f, 0.f};
        cur = nxt; cA = nA; cB = nB; ++ui;
#pragma unroll
        for (int h = 0; h < 2; ++h)
#pragma unroll
            for (int i = 0; i < 2; ++i) vaC[h][i] = vaN[h][i];
    }
    PG8_WAIT_V(0);
    if (wr == 0) PG8_BAR;
    PG8_BAR;
#undef PG8_SA
#undef PG8_SB
#undef PG8_STAGE
#undef PG8_LDA
#undef PG8_LDB
#undef PG8_MMA
#undef PG8_WAIT_V
#undef PG8_WAIT_L
#undef PG8_BAR
#undef PG8_SCHED
}

template <bool HAS_BIAS> struct EpiStoreBf16 {
    static constexpr bool PERM = true;
    bf16_t* O; int ldc; const float* bias; int bias_estride; float sc;
    __device__ __forceinline__ void operator()(const f32x4 (&acc)[2][2][4][2], const Unit& u, int wr, int wc, int fr, int fq) const {
        const int row0 = u.pm * BM + wr * 64 + fr, col0 = u.pn * BM + wc * 32 + 8 * fq;
        f32x4 bv[2][2];
#pragma unroll
        for (int bj = 0; bj < 2; ++bj)
#pragma unroll
            for (int n = 0; n < 2; ++n) { if constexpr (HAS_BIAS) bv[bj][n] = *(const f32x4*)(bias + (size_t)u.e * bias_estride + col0 + bj * HALF + 4 * n); else bv[bj][n] = (f32x4){0.f, 0.f, 0.f, 0.f}; }
#pragma unroll
        for (int ai = 0; ai < 2; ++ai)
#pragma unroll
            for (int m = 0; m < 4; ++m) { bf16_t* rowp = O + (size_t)(row0 + ai * HALF + m * 16) * ldc + col0;
#pragma unroll
                for (int bj = 0; bj < 2; ++bj) { const f32x4 v0 = acc[ai][bj][m][0] * sc + bv[bj][0], v1 = acc[ai][bj][m][1] * sc + bv[bj][1];
                    u32x4 w; w.x = cvt_pk_bf16(v0[0], v0[1]); w.y = cvt_pk_bf16(v0[2], v0[3]); w.z = cvt_pk_bf16(v1[0], v1[1]); w.w = cvt_pk_bf16(v1[2], v1[3]);
                    *(u32x4*)(rowp + bj * HALF) = w; } }
    }
};
struct EpiGlu {
    static constexpr bool PERM = true;
    const bf16_t* Yg; bf16_t* O; const float* bias;
    __device__ __forceinline__ void operator()(const f32x4 (&acc)[2][2][4][2], const Unit& u, int wr, int wc, int fr, int fq) const {
        const int row0 = u.pm * BM + wr * 64 + fr, col0 = u.pn * BM + wc * 32 + 8 * fq;
        f32x4 bv[2][2];
#pragma unroll
        for (int bj = 0; bj < 2; ++bj)
#pragma unroll
            for (int n = 0; n < 2; ++n) bv[bj][n] = *(const f32x4*)(bias + col0 + bj * HALF + 4 * n);
#pragma unroll
        for (int ai = 0; ai < 2; ++ai)
#pragma unroll
            for (int m = 0; m < 4; ++m) { const size_t r = (size_t)(row0 + ai * HALF + m * 16);
#pragma unroll
                for (int bj = 0; bj < 2; ++bj) { const f32x4 v0 = acc[ai][bj][m][0] + bv[bj][0], v1 = acc[ai][bj][m][1] + bv[bj][1];
                    const u32x4 y = *(const u32x4*)(Yg + r * S5W + col0 + bj * HALF);
                    float o[8];
                    o[0] = bflo(y.x) * sigm(v0[0]); o[1] = bfhi(y.x) * sigm(v0[1]); o[2] = bflo(y.y) * sigm(v0[2]); o[3] = bfhi(y.y) * sigm(v0[3]);
                    o[4] = bflo(y.z) * sigm(v1[0]); o[5] = bfhi(y.z) * sigm(v1[1]); o[6] = bflo(y.w) * sigm(v1[2]); o[7] = bfhi(y.w) * sigm(v1[3]);
                    u32x4 w; w.x = cvt_pk_bf16(o[0], o[1]); w.y = cvt_pk_bf16(o[2], o[3]); w.z = cvt_pk_bf16(o[4], o[5]); w.w = cvt_pk_bf16(o[6], o[7]);
                    *(u32x4*)(O + r * D + col0 + bj * HALF) = w; } }
    }
};
struct EpiResid {
    static constexpr bool PERM = false;
    const float* X; float* O; const float* mod;
    __device__ __forceinline__ void operator()(const f32x4 (&acc)[2][2][4][2], const Unit& u, int wr, int wc, int fr, int fq) const {
        const int row0 = u.pm * BM + wr * 64 + fr, col0 = u.pn * BM + wc * 32 + 4 * fq, b = u.pm >> 3;
        f32x4 gv[2][2];
#pragma unroll
        for (int bj = 0; bj < 2; ++bj)
#pragma unroll
            for (int n = 0; n < 2; ++n) { const int c = col0 + bj * HALF + n * 16; gv[bj][n] = *(const f32x4*)(mod + (size_t)b * 12288 + 2 * D + c); }
#pragma unroll
        for (int ai = 0; ai < 2; ++ai)
#pragma unroll
            for (int m = 0; m < 4; ++m) { const size_t off = (size_t)(row0 + ai * HALF + m * 16) * D + col0;
#pragma unroll
                for (int bj = 0; bj < 2; ++bj)
#pragma unroll
                    for (int n = 0; n < 2; ++n) { const f32x4 xv = *(const f32x4*)(X + off + bj * HALF + n * 16); *(f32x4*)(O + off + bj * HALF + n * 16) = xv + gv[bj][n] * acc[ai][bj][m][n]; } }
    }
};
struct EpiSwiglu {
    static constexpr bool PERM = true;
    unsigned char* O; const float* bias; float sc;
    __device__ __forceinline__ void operator()(const f32x4 (&acc)[2][2][4][2], const Unit& u, int wr, int wc, int fr, int fq) const {
        const int row0 = u.pm * BM + wr * 64 + fr, j0 = wc * 32 + 8 * fq, cb = u.pn * HALF + j0;
        f32x4 bg[2], bu[2];
#pragma unroll
        for (int n = 0; n < 2; ++n) { bg[n] = *(const f32x4*)(bias + (size_t)u.e * 4096 + cb + 4 * n); bu[n] = *(const f32x4*)(bias + (size_t)u.e * 4096 + 2048 + cb + 4 * n); }
#pragma unroll
        for (int ai = 0; ai < 2; ++ai)
#pragma unroll
            for (int m = 0; m < 4; ++m) { float o[8];
#pragma unroll
                for (int n = 0; n < 2; ++n)
#pragma unroll
                    for (int e = 0; e < 4; ++e) { float g = acc[ai][0][m][n][e] * sc + bg[n][e], uu = acc[ai][1][m][n][e] * sc + bu[n][e];
                        g = fminf(g, 7.0f); uu = fminf(fmaxf(uu, -7.0f), 7.0f);
                        o[4 * n + e] = (uu + 1.0f) * (g * sigm(1.702f * g)); }
                u32x2 w; w.x = pk4_fp8(o[0], o[1], o[2], o[3]); w.y = pk4_fp8(o[4], o[5], o[6], o[7]);
                *(u32x2*)(O + (size_t)(row0 + ai * HALF + m * 16) * DFF + cb) = w; }
    }
};
}

#define FI __device__ __forceinline__

FI void transpose_item(const float* W, int K, int N, bf16_t* WT, int row_off, LAS float* scr, int kb, int nb, int lane) {
    const int k0 = 64 * kb, n0 = 32 * nb;
#pragma unroll 8
    for (int i = 0; i < 32; ++i) { const int kk = 2 * i + (lane >> 5); scr[kk * 33 + (lane & 31)] = W[(size_t)(k0 + kk) * N + n0 + (lane & 31)]; }
    LDS_WAIT(); asm volatile("" ::: "memory");
    const int c = lane & 7;
#pragma unroll
    for (int j = 0; j < 4; ++j) { const int n = (lane >> 3) + 8 * j; const LAS float* s = scr + (8 * c) * 33 + n;
        u32x4 o; o.x = pk2(s[0 * 33], s[1 * 33]); o.y = pk2(s[2 * 33], s[3 * 33]); o.z = pk2(s[4 * 33], s[5 * 33]); o.w = pk2(s[6 * 33], s[7 * 33]);
        *(u32x4*)(WT + (size_t)(row_off + n0 + n) * K + k0 + 8 * c) = o; }
    LDS_WAIT(); asm volatile("" ::: "memory");
}

FI void transpose_item_fp8(const float* W, int K, int N, unsigned char* WT, int row_off, LAS float* scr, int kb, int nb, int lane, float scale) {
    const int k0 = 64 * kb, n0 = 32 * nb;
#pragma unroll 8
    for (int i = 0; i < 32; ++i) { const int kk = 2 * i + (lane >> 5); scr[kk * 33 + (lane & 31)] = W[(size_t)(k0 + kk) * N + n0 + (lane & 31)]; }
    LDS_WAIT(); asm volatile("" ::: "memory");
    const int n = lane & 31, hf = lane >> 5; const LAS float* s = scr + (32 * hf) * 33 + n;
    u32x4 o0, o1;
    o0.x = pk4_fp8(s[0 * 33] * scale, s[1 * 33] * scale, s[2 * 33] * scale, s[3 * 33] * scale); o0.y = pk4_fp8(s[4 * 33] * scale, s[5 * 33] * scale, s[6 * 33] * scale, s[7 * 33] * scale);
    o0.z = pk4_fp8(s[8 * 33] * scale, s[9 * 33] * scale, s[10 * 33] * scale, s[11 * 33] * scale); o0.w = pk4_fp8(s[12 * 33] * scale, s[13 * 33] * scale, s[14 * 33] * scale, s[15 * 33] * scale);
    o1.x = pk4_fp8(s[16 * 33] * scale, s[17 * 33] * scale, s[18 * 33] * scale, s[19 * 33] * scale); o1.y = pk4_fp8(s[20 * 33] * scale, s[21 * 33] * scale, s[22 * 33] * scale, s[23 * 33] * scale);
    o1.z = pk4_fp8(s[24 * 33] * scale, s[25 * 33] * scale, s[26 * 33] * scale, s[27 * 33] * scale); o1.w = pk4_fp8(s[28 * 33] * scale, s[29 * 33] * scale, s[30 * 33] * scale, s[31 * 33] * scale);
    unsigned char* dst = WT + (size_t)(row_off + n0 + n) * K + k0 + 32 * hf;
    *(u32x4*)dst = o0; *(u32x4*)(dst + 16) = o1;
    LDS_WAIT(); asm volatile("" ::: "memory");
}

FI void tr8_item(const float* W, int N, int K, unsigned char* WT, int row_off, LAS unsigned char* T, int k0, int n0, int lane, float scale) {
    const int nq = lane & 15, kr = lane >> 4;
    const float* src = W + (size_t)(k0 + 4 * kr) * N + n0 + 4 * nq;
#pragma unroll
    for (int rg = 0; rg < 8; ++rg) {
        f32x4 v[4];
#pragma unroll
        for (int j = 0; j < 4; ++j) v[j] = *(const f32x4*)(src + (size_t)(rg * 16 + j) * N) * scale;
#pragma unroll
        for (int i = 0; i < 4; ++i) *(LAS unsigned*)(T + (4 * nq + i) * 128 + ((rg ^ (nq & 7)) << 4) + kr * 4) = pk4_fp8(v[0][i], v[1][i], v[2][i], v[3][i]);
    }
    LDS_WAIT(); asm volatile("" ::: "memory");
#pragma unroll
    for (int t = 0; t < 8; ++t) { const int n = 8 * t + (lane >> 3), p = lane & 7;
        const u32x4 o = *(const LAS u32x4*)(T + n * 128 + ((p ^ ((n >> 2) & 7)) << 4));
        *(u32x4*)(WT + (size_t)(row_off + n0 + n) * K + k0 + 16 * p) = o; }
    LDS_WAIT(); asm volatile("" ::: "memory");
}
FI void moe_weight_item(const Args& A, LAS unsigned char* T, int q, int lane) {
    unsigned char* ws = A.ws;
    if (q < 32768) { const int e = q >> 10, r = q & 1023, kb = r >> 6, nb = r & 63, n0 = 64 * nb;
        const int isU = n0 / 2048, pn = (n0 % 2048) / 128, j = n0 % 128, rowmap = 256 * pn + 128 * isU + j;
        tr8_item(A.in[34] + (size_t)e * D * 4096, 4096, D, ws + WS_WGU + (size_t)e * 4096 * D, rowmap - n0, T, 128 * kb, n0, lane, WSCALE); }
    else { const int q2 = q - 32768, e = q2 >> 9, r = q2 & 511, kb = r >> 5, nb = r & 31;
        tr8_item(A.in[36] + (size_t)e * DFF * D, D, DFF, ws + WS_WDN + (size_t)e * D * DFF, 0, T, 128 * kb, 64 * nb, lane, WSCALE); }
}

FI void p0_run(const Args& A, LAS unsigned char* lds, int tid, int lane, int wave, int vcu, int G) {
    unsigned char* ws = A.ws;
    unsigned long long* mod = (unsigned long long*)((unsigned*)(ws + WS_CTL) + CW_MOD); unsigned long long* hnorm = (unsigned long long*)((unsigned*)(ws + WS_CTL) + CW_HNORM);
    {
        LAS float* sl = (LAS float*)lds;
        LAS float* part = (LAS float*)(lds + 9 * 512 * 4);
        const float* c = A.in[1]; const float* cc = A.in[3]; const float* wada = A.in[4];
        _Pragma("unroll 1") for (int rep = 0; rep < REP0A; ++rep)
        for (int it = vcu; it < 192; it += G) {
            const int cg = it % 48, kq = it / 48, n0 = cg * 256 + 4 * lane, k0 = kq * 512;
            for (int i = tid; i < 9 * 512; i += NTHR) { const int r = i >> 9, k = k0 + (i & 511); const float v = r < 8 ? c[r * D + k] : cc[k]; sl[i] = v / (1.f + __expf(-v)); }
            __syncthreads();
            f32x4 acc[9];
#pragma unroll
            for (int r = 0; r < 9; ++r) acc[r] = (f32x4){0.f, 0.f, 0.f, 0.f};
#pragma unroll 8
            for (int kk = 0; kk < 64; ++kk) { const int kl = wave * 64 + kk; const f32x4 w = *(const f32x4*)(wada + (size_t)(k0 + kl) * 12288 + n0);
#pragma unroll
                for (int r = 0; r < 9; ++r) { const float sv = sl[r * 512 + kl]; acc[r] += w * sv; } }
#pragma unroll
            for (int r = 0; r < 9; ++r) *(LAS f32x4*)(part + (wave * 9 + r) * 256 + 4 * lane) = acc[r];
            __syncthreads();
            for (int i = tid; i < 9 * 256; i += NTHR) { const int r = i >> 8, col = i & 255; float sum = 0.f;
#pragma unroll
                for (int w = 0; w < 8; ++w) sum += part[(w * 9 + r) * 256 + col];
                fix_add(mod + r * 12288 + cg * 256 + col, rep == REP0A - 1 ? sum : 0.0f); }
            __syncthreads();
        }
    }
    {
        LAS float* L = (LAS float*)lds;
        LAS float *w1s = L, *w2s = L + 2112, *w3s = L + 6208, *b1s = L + 10304, *b2s = L + 10368, *b3s = L + 10432, *fqs = L + 10496, *zs = L + 10560, *h1 = L + 10824, *h2 = L + 11336, *h3 = L + 11848;
        for (int i = tid; i < 33 * 64; i += NTHR) w1s[i] = A.in[21][i];
        for (int i = tid; i < 4096; i += NTHR) { w2s[i] = A.in[23][i]; w3s[i] = A.in[25][i]; }
        if (tid < 64) { b1s[tid] = A.in[22][tid]; b2s[tid] = A.in[24][tid]; b3s[tid] = A.in[26][tid]; fqs[tid] = A.in[28][tid]; }
        __syncthreads();
        const float* w4 = A.in[27]; const float* dl = A.in[29]; float* hraw = (float*)(ws + WS_HRAW);
        for (int item = vcu; item < 256; item += G) {
            const int l0 = item * 8;
            if (tid < 264) { const int r = tid / 33, i = tid % 33, l = l0 + r; float z;
                if (i == 0) z = (float)l / 2047.0f;
                else { const int j = (i - 1) & 15; const float band = 1e-4f + (float)j * ((15.0f - 1e-4f) / 15.0f); const float ang = (6.283185307179586f / 2048.0f) * (float)l * band; z = (i <= 16) ? cosf(ang) : -sinf(ang); }
                zs[tid] = z; }
            __syncthreads();
            const int r = tid >> 6, o = tid & 63;
            { float s = b1s[o]; for (int i = 0; i < 33; ++i) s += zs[r * 33 + i] * w1s[i * 64 + o]; h1[r * 64 + o] = sinf(fqs[o] * s); }
            __syncthreads();
            { float s = b2s[o]; for (int i = 0; i < 64; ++i) s += h1[r * 64 + i] * w2s[i * 64 + o]; h2[r * 64 + o] = sinf(fqs[o] * s); }
            __syncthreads();
            { float s = b3s[o]; for (int i = 0; i < 64; ++i) s += h2[r * 64 + i] * w3s[i * 64 + o]; h3[r * 64 + o] = sinf(fqs[o] * s); }
            __syncthreads();
            f32x4 acc[8];
#pragma unroll
            for (int q = 0; q < 8; ++q) acc[q] = (f32x4){0.f, 0.f, 0.f, 0.f};
#pragma unroll 4
            for (int i = 0; i < 64; ++i) { const f32x4 w = *(const f32x4*)(w4 + (size_t)i * 2048 + 4 * tid);
#pragma unroll
                for (int q = 0; q < 8; ++q) acc[q] += w * h3[q * 64 + i]; }
            const f32x4 dv = *(const f32x4*)(dl + 4 * tid);
            f32x4 asum = (f32x4){0.f, 0.f, 0.f, 0.f};
#pragma unroll
            for (int q = 0; q < 8; ++q) { const int l = l0 + q; const float t = (float)l / 2047.0f; f32x4 v;
#pragma unroll
                for (int e = 0; e < 4; ++e) v[e] = acc[q][e] * expf(-t * fabsf(dv[e]));
                *(f32x4*)(hraw + (size_t)l * 2048 + 4 * tid) = v;
                if (!(l == 2047 && 4 * tid >= 1024)) {
#pragma unroll
                    for (int e = 0; e < 4; ++e) asum[e] += fabsf(v[e]); } }
#pragma unroll
            for (int e = 0; e < 4; ++e) fix_add(hnorm + 4 * tid + e, asum[e]);
            __syncthreads();
        }
    }
    {
        const float *lre = A.in[9], *lim = A.in[10], *lst = A.in[11], *bre = A.in[12], *bim = A.in[13], *cre = A.in[14], *cim = A.in[15];
        float* LAM = (float*)(ws + WS_LAM); float* LAML = (float*)(ws + WS_LAML); bf16_t* SB = (bf16_t*)(ws + WS_S5B); bf16_t* SC = (bf16_t*)(ws + WS_S5C);
        for (int idx = vcu * NTHR + tid; idx < 2 * 64 * 4 * 64; idx += G * NTHR) {
            const int ln = idx & 63, T = (idx >> 6) & 3, g = (idx >> 8) & 63, d = idx >> 14;
            {
                const int n = ln & 31, hq = ln >> 5, p = n + 32 * (T >> 1), part = T & 1;
                const int q = (d * 64 + g) * 64 + p;
                const float lr = fminf(lre[q], -1e-4f), li = lim[q], dt = expf(lst[q]), zr = lr * dt, zi = li * dt, er = expf(zr), br = er * cosf(zi), bi = er * sinf(zi);
                const float den = lr * lr + li * li, cr = ((br - 1.f) * lr + bi * li) / den, ci = (bi * lr - (br - 1.f) * li) / den;
                float v[8];
#pragma unroll
                for (int j = 0; j < 8; ++j) { const int h = 8 * hq + j; const float xr = bre[(size_t)q * 16 + h], xi = bim[(size_t)q * 16 + h]; v[j] = part ? (cr * xi + ci * xr) : (cr * xr - ci * xi); }
                u32x4 w; w.x = pk2(v[0], v[1]); w.y = pk2(v[2], v[3]); w.z = pk2(v[4], v[5]); w.w = pk2(v[6], v[7]);
                *(u32x4*)(SB + (size_t)idx * 8) = w;
                if (part == 0 && hq == 0) { LAM[q * 2] = br; LAM[q * 2 + 1] = bi; const float eL = expf((float)SEG * zr), aL = (float)SEG * zi; LAML[q * 2] = eL * cosf(aL); LAML[q * 2 + 1] = eL * sinf(aL); }
            }
            {
                const int hc = ln & 15, qq = ln >> 4; float v[8];
#pragma unroll
                for (int j = 0; j < 8; ++j) { const int k = 32 * T + 8 * qq + j, n = k >> 2, TT = k & 3, p = n + 32 * (TT >> 1), part = TT & 1; const size_t ci = ((size_t)(d * 64 + g) * 16 + hc) * 64 + p; v[j] = part ? -cim[ci] : cre[ci]; }
                u32x4 w; w.x = pk2(v[0], v[1]); w.y = pk2(v[2], v[3]); w.z = pk2(v[4], v[5]); w.w = pk2(v[6], v[7]);
                *(u32x4*)(SC + (size_t)idx * 8) = w;
            }
        }
    }
    {
        const float* wrt = A.in[32]; bf16_t* WRF = (bf16_t*)(ws + WS_WRF);
        for (int idx = vcu * NTHR + tid; idx < 64 * 2 * 64; idx += G * NTHR) {
            const int ln = idx & 63, nt = (idx >> 6) & 1, ks = idx >> 7, ex = 16 * nt + (ln & 15), k0 = 32 * ks + 8 * (ln >> 4);
            float v[8], rsd[8];
#pragma unroll
            for (int j = 0; j < 8; ++j) { v[j] = wrt[(size_t)(k0 + j) * NE + ex]; rsd[j] = v[j] - bf1((bf16_t)f2bf(v[j])); }
            u32x4 hi, lo; hi.x = pk2(v[0], v[1]); hi.y = pk2(v[2], v[3]); hi.z = pk2(v[4], v[5]); hi.w = pk2(v[6], v[7]);
            lo.x = pk2(rsd[0], rsd[1]); lo.y = pk2(rsd[2], rsd[3]); lo.z = pk2(rsd[4], rsd[5]); lo.w = pk2(rsd[6], rsd[7]);
            *(u32x4*)(WRF + ((size_t)((ks * 2 + nt) * 2 + 0) * 64 + ln) * 8) = hi;
            *(u32x4*)(WRF + ((size_t)((ks * 2 + nt) * 2 + 1) * 64 + ln) * 8) = lo;
        }
    }
    {
        __syncthreads();
        LAS float* scr = (LAS float*)(lds + wave * 16384);
        const int gw = vcu * NWAVES + wave, NGW = G * NWAVES;
        constexpr int I_IN = 32 * 128, I_GLU = 16 * 32, I_OUT = 32 * 64;
        constexpr int NITEMS = I_IN + I_GLU + I_OUT;
        for (int it = gw; it < NITEMS; it += NGW) {
            int r = it;
            if (r < I_IN) { transpose_item(A.in[8], D, DIN, (bf16_t*)(ws + WS_WIN), 0, scr, r / 128, r % 128, lane); continue; } r -= I_IN;
            if (r < I_GLU) { transpose_item(A.in[17], S5W, S5W, (bf16_t*)(ws + WS_WGLU), 0, scr, r / 32, r % 32, lane); continue; } r -= I_GLU;
            transpose_item(A.in[31], D, D, (bf16_t*)(ws + WS_WOUT), 0, scr, r / 64, r % 64, lane);
        }
    }
}
#ifndef P0_SPLIT_ITEMS
#define P0_SPLIT_ITEMS 28000
#endif
FI void p0d_run(const Args& A, LAS unsigned char* lds, int lane, int wave, int q0, int q1, int vcu, int G) {
    const int gw = vcu * NWAVES + wave, NGW = G * NWAVES;
    _Pragma("unroll 1") for (int rep = 0; rep < REP0D; ++rep)
    for (int q = q0 + gw; q < q1; q += NGW) moe_weight_item(A, lds + wave * 16384, q, lane);
}

FI void p1_run(const Args& A, int tid, int lane, int wave, int vcu, int G, int m0, int m1, bool extras) {
    unsigned char* ws = A.ws;
    const unsigned long long* mod = (const unsigned long long*)((const unsigned*)(ws + WS_CTL) + CW_MOD); const unsigned long long* hnorm = (const unsigned long long*)((const unsigned*)(ws + WS_CTL) + CW_HNORM);
    const float* bada = A.in[5]; const float* g1 = A.in[6];
    bf16_t* A1 = (bf16_t*)(ws + WS_A1);
    const int gw = vcu * NWAVES + wave, NGW = G * NWAVES;
    if (extras) { float* modf = (float*)(ws + WS_MODF); for (int i = vcu * NTHR + tid; i < 9 * 12288; i += G * NTHR) modf[i] = fix_get(mod + i) + bada[i % 12288]; }
    for (int mb = m0 + gw; mb < m1; mb += 4 * NGW) {
        f32x4 v[4][8]; float rstd[4];
#pragma unroll
        for (int r = 0; r < 4; ++r) { int m = mb + r * NGW; m = m < m1 ? m : m1 - 1;
            const float* src = m < M ? A.in[0] + (size_t)m * D : A.in[2] + (size_t)(m - M) * D;
#pragma unroll
            for (int j = 0; j < 8; ++j) v[r][j] = *(const f32x4*)(src + 4 * lane + 256 * j); }
#pragma unroll
        for (int r = 0; r < 4; ++r) { float ss = 0.f;
#pragma unroll
            for (int j = 0; j < 8; ++j) ss += (v[r][j].x * v[r][j].x + v[r][j].y * v[r][j].y) + (v[r][j].z * v[r][j].z + v[r][j].w * v[r][j].w);
            rstd[r] = rsqrtf(wave_sum(ss) * (1.0f / D) + 1e-6f); }
#pragma unroll
        for (int r = 0; r < 4; ++r) { const int m = mb + r * NGW; if (m < m1) { const int mr = m < M ? m / SEQ : 8;
#pragma unroll
            for (int j = 0; j < 8; ++j) { const int c = 4 * lane + 256 * j;
                const f32x4 gv = *(const f32x4*)(g1 + c);
                const unsigned long long* mp = mod + (size_t)mr * 12288 + c;
                const f32x4 sh = (f32x4){fix_get(mp), fix_get(mp + 1), fix_get(mp + 2), fix_get(mp + 3)} + *(const f32x4*)(bada + c);
                const f32x4 sc = (f32x4){fix_get(mp + D), fix_get(mp + D + 1), fix_get(mp + D + 2), fix_get(mp + D + 3)} + *(const f32x4*)(bada + D + c);
                const f32x4 h = v[r][j] * rstd[r] * gv * (sc + 1.0f) + sh;
                u32x2 w; w.x = pk2(h.x, h.y); w.y = pk2(h.z, h.w);
                *(u32x2*)(A1 + (size_t)m * D + c) = w; } } }
    }
    const float* hraw = (const float*)(ws + WS_HRAW); bf16_t* Rg = (bf16_t*)(ws + WS_RG);
    if (extras)
    for (int it = gw; it < 512 * 16; it += NGW) {
        const int ib = it >> 4, c = (it & 15) * 64 + lane;
        const float inv = 1.0f / (fix_get(hnorm + c) + fix_get(hnorm + HYW + c));
        float v[8];
#pragma unroll
        for (int jj = 0; jj < 8; ++jj) { const int i = 8 * ib + jj; float x;
            if (i <= 2047) x = hraw[(size_t)(2047 - i) * 2048 + c]; else if (i <= 4094) x = hraw[(size_t)(i - 2048) * 2048 + HYW + c]; else x = 0.f;
            v[jj] = x * inv; }
        u32x4 w; w.x = pk2(v[0], v[1]); w.y = pk2(v[2], v[3]); w.z = pk2(v[4], v[5]); w.w = pk2(v[6], v[7]);
        *(u32x4*)(Rg + (size_t)c * 4096 + 8 * ib) = w;
    }
}

FI void s5_unit(const Args& A, LAS unsigned char* lds, int unit, int lane, int wave) {
    unsigned char* ws = A.ws;
    const int d = unit & 1, g = (unit >> 1) & 63, bp = unit >> 7, dg = d * 64 + g;
    const bf16_t* P = (const bf16_t*)(ws + WS_P); bf16_t* Ys = (bf16_t*)(ws + WS_YS5);
    bf16x8 Bf[4], Cf[4];
#pragma unroll
    for (int T = 0; T < 4; ++T) { Bf[T] = *(const bf16x8*)((const bf16_t*)(ws + WS_S5B) + ((size_t)(dg * 4 + T) * 64 + lane) * 8); Cf[T] = *(const bf16x8*)((const bf16_t*)(ws + WS_S5C) + ((size_t)(dg * 4 + T) * 64 + lane) * 8); }
    const int n = lane & 31, hh = lane >> 5;
    const float* LAM = (const float*)(ws + WS_LAM) + (size_t)dg * 128; const float* LAML = (const float*)(ws + WS_LAML) + (size_t)dg * 128;
    const float lr0 = LAM[n * 2], li0 = LAM[n * 2 + 1], lr1 = LAM[(n + 32) * 2], li1 = LAM[(n + 32) * 2 + 1];
    const int r = lane & 31, bsel = (r >> 2) & 1, tau = (r & 3) + 4 * (r >> 3), b = 2 * bp + bsel, kofs = g * 16 + 8 * (lane >> 5);
    const int seg0 = wave * SEG;
    auto rowp = [&](int pos) -> const bf16_t* {
        int row; if (pos < CTXL) { const int tc = d ? (CTXL - 1 - pos) : pos; row = M + b * CTXL + tc; } else { const int q = pos - CTXL; const int tl = d ? (SEQ - 1 - q) : q; row = b * SEQ + tl; }
        return P + (size_t)row * DIN + kofs; };
    const f32x16 z16 = {0.f, 0.f, 0.f, 0.f, 0.f, 0.f, 0.f, 0.f, 0.f, 0.f, 0.f, 0.f, 0.f, 0.f, 0.f, 0.f};
    float xr0 = 0.f, xi0 = 0.f, xr1 = 0.f, xi1 = 0.f;
    {
        bf16x8 uc[3], un[3];
#pragma unroll
        for (int q = 0; q < 3; ++q) { uc[q] = *(const bf16x8*)rowp(seg0 + 16 * q + tau); un[q] = uc[q]; }
#pragma unroll 1
        for (int ch = 0; ch < 6; ++ch) {
            if (ch < 5) {
#pragma unroll
                for (int q = 0; q < 3; ++q) un[q] = *(const bf16x8*)rowp(seg0 + 16 * (3 * (ch + 1) + q) + tau); }
#pragma unroll
            for (int q = 0; q < 3; ++q) {
                const f32x16 c0 = __builtin_amdgcn_mfma_f32_32x32x16_bf16(uc[q], Bf[0], z16, 0, 0, 0), c1 = __builtin_amdgcn_mfma_f32_32x32x16_bf16(uc[q], Bf[1], z16, 0, 0, 0);
                const f32x16 c2 = __builtin_amdgcn_mfma_f32_32x32x16_bf16(uc[q], Bf[2], z16, 0, 0, 0), c3 = __builtin_amdgcn_mfma_f32_32x32x16_bf16(uc[q], Bf[3], z16, 0, 0, 0);
#pragma unroll
                for (int tt = 0; tt < 16; ++tt) {
                    const float nr0 = lr0 * xr0 - li0 * xi0 + c0[tt], ni0 = lr0 * xi0 + li0 * xr0 + c1[tt]; xr0 = nr0; xi0 = ni0;
                    const float nr1 = lr1 * xr1 - li1 * xi1 + c2[tt], ni1 = lr1 * xi1 + li1 * xr1 + c3[tt]; xr1 = nr1; xi1 = ni1; }
            }
#pragma unroll
            for (int q = 0; q < 3; ++q) uc[q] = un[q];
        }
    }
    LAS float* Es = (LAS float*)(lds + 8 * 8704);
    *(LAS f32x4*)(Es + (wave * 64 + lane) * 4) = (f32x4){xr0, xi0, xr1, xi1};
    __syncthreads();
    {
        const float Lr0 = LAML[n * 2], Li0 = LAML[n * 2 + 1], Lr1 = LAML[(n + 32) * 2], Li1 = LAML[(n + 32) * 2 + 1];
        xr0 = 0.f; xi0 = 0.f; xr1 = 0.f; xi1 = 0.f;
#pragma unroll 1
        for (int w = 0; w < wave; ++w) { const f32x4 e = *(LAS f32x4*)(Es + (w * 64 + lane) * 4);
            const float nr0 = Lr0 * xr0 - Li0 * xi0 + e.x, ni0 = Lr0 * xi0 + Li0 * xr0 + e.y; xr0 = nr0; xi0 = ni0;
            const float nr1 = Lr1 * xr1 - Li1 * xi1 + e.z, ni1 = Lr1 * xi1 + Li1 * xr1 + e.w; xr1 = nr1; xi1 = ni1; }
    }
    {
        LAS unsigned char* Xs = lds + wave * 8704;
        bf16x8 uc[3], un[3];
#pragma unroll
        for (int q = 0; q < 3; ++q) { uc[q] = *(const bf16x8*)rowp(seg0 + 16 * q + tau); un[q] = uc[q]; }
#pragma unroll 1
        for (int ch = 0; ch < 6; ++ch) {
            if (ch < 5) {
#pragma unroll
                for (int q = 0; q < 3; ++q) un[q] = *(const bf16x8*)rowp(seg0 + 16 * (3 * (ch + 1) + q) + tau); }
#pragma unroll
            for (int q = 0; q < 3; ++q) {
                const int pos0 = seg0 + 16 * (3 * ch + q);
                f32x16 c0 = __builtin_amdgcn_mfma_f32_32x32x16_bf16(uc[q], Bf[0], z16, 0, 0, 0), c1 = __builtin_amdgcn_mfma_f32_32x32x16_bf16(uc[q], Bf[1], z16, 0, 0, 0);
                f32x16 c2 = __builtin_amdgcn_mfma_f32_32x32x16_bf16(uc[q], Bf[2], z16, 0, 0, 0), c3 = __builtin_amdgcn_mfma_f32_32x32x16_bf16(uc[q], Bf[3], z16, 0, 0, 0);
#pragma unroll
                for (int tt = 0; tt < 16; ++tt) {
                    const float nr0 = lr0 * xr0 - li0 * xi0 + c0[tt], ni0 = lr0 * xi0 + li0 * xr0 + c1[tt]; xr0 = nr0; xi0 = ni0; c0[tt] = nr0; c1[tt] = ni0;
                    const float nr1 = lr1 * xr1 - li1 * xi1 + c2[tt], ni1 = lr1 * xi1 + li1 * xr1 + c3[tt]; xr1 = nr1; xi1 = ni1; c2[tt] = nr1; c3[tt] = ni1; }
                if (pos0 >= CTXL) {
#pragma unroll
                    for (int tt = 0; tt < 16; ++tt) { u32x2 w; w.x = pk2(c0[tt], c1[tt]); w.y = pk2(c2[tt], c3[tt]); *(LAS u32x2*)(Xs + (hh * 16 + tt) * 272 + 8 * n) = w; }
                    LDS_WAIT();
#pragma unroll
                    for (int bt = 0; bt < 2; ++bt) {
                        f32x4 y = (f32x4){0.f, 0.f, 0.f, 0.f};
#pragma unroll
                        for (int ks = 0; ks < 4; ++ks) { const bf16x8 xf = *(const LAS bf16x8*)(Xs + (bt * 16 + (lane & 15)) * 272 + (32 * ks + 8 * (lane >> 4)) * 2); y = __builtin_amdgcn_mfma_f32_16x16x32_bf16(Cf[ks], xf, y, 0, 0, 0); }
                        const int qq = pos0 + (lane & 15) - CTXL, tl = d ? (SEQ - 1 - qq) : qq, bb = 2 * bp + bt;
                        u32x2 w; w.x = pk2(y[0], y[1]); w.y = pk2(y[2], y[3]);
                        *(u32x2*)(Ys + ((size_t)(d * M + bb * SEQ + tl)) * S5W + g * 16 + 4 * (lane >> 4)) = w;
                    }
                    LDS_WAIT();
                }
            }
#pragma unroll
            for (int q = 0; q < 3; ++q) uc[q] = un[q];
        }
    }
    __syncthreads();
}

FI void h1_item(const Args& A, LAS unsigned char* lds, int item, int tid) {
    unsigned char* ws = A.ws;
    const bf16_t* P = (const bf16_t*)(ws + WS_P); bf16_t* Vt = (bf16_t*)(ws + WS_VT);
    const int gr = item >> 3, cg = item & 7, b = gr >> 5, t0 = (gr & 31) * 64, c0 = cg * 128;
    for (int idx = tid; idx < 2 * 64 * 16; idx += NTHR) { const int ch = idx >> 10, rem = idx & 1023, row = rem >> 4, sg = rem & 15;
        const u32x4 v = *(const u32x4*)(P + (size_t)(b * SEQ + t0 + row) * DIN + S5W + ch * HYW + c0 + sg * 8);
        *(LAS u32x4*)(lds + ch * 16896 + (row + 1) * 256 + sg * 16) = v; }
    if (tid < 64) { const int ch = tid >> 5, rr = (tid >> 4) & 1, sg = tid & 15; *(LAS u32x4*)(lds + ch * 16896 + (rr ? 65 : 0) * 256 + sg * 16) = (u32x4){0u, 0u, 0u, 0u}; }
    __syncthreads();
    const int c = tid & 127, tq = tid >> 7, cc = c0 + c;
    const float* cw = A.in[19]; const float* cb = A.in[20];
    const float w0v = cw[cc], w1v = cw[3072 + cc], w2v = cw[6144 + cc], bv = cb[cc];
    const float w0x = cw[HYW + cc], w1x = cw[3072 + HYW + cc], w2x = cw[6144 + HYW + cc], bx = cb[HYW + cc];
    const LAS bf16_t* Vs = (const LAS bf16_t*)lds; const LAS bf16_t* Xs = (const LAS bf16_t*)(lds + 16896);
    float o[16];
#pragma unroll
    for (int i = 0; i < 16; ++i) { const int t = tq * 16 + i;
        const float v = w0v * bf1(Vs[t * 128 + c]) + w1v * bf1(Vs[(t + 1) * 128 + c]) + w2v * bf1(Vs[(t + 2) * 128 + c]) + bv;
        const float x = w0x * bf1(Xs[t * 128 + c]) + w1x * bf1(Xs[(t + 1) * 128 + c]) + w2x * bf1(Xs[(t + 2) * 128 + c]) + bx;
        o[i] = v * x; }
    bf16_t* dst = Vt + ((size_t)(cc * NB + b) * SEQ + t0 + tq * 16);
    u32x4 w0; w0.x = pk2(o[0], o[1]); w0.y = pk2(o[2], o[3]); w0.z = pk2(o[4], o[5]); w0.w = pk2(o[6], o[7]);
    u32x4 w1; w1.x = pk2(o[8], o[9]); w1.y = pk2(o[10], o[11]); w1.z = pk2(o[12], o[13]); w1.w = pk2(o[14], o[15]);
    *(u32x4*)dst = w0; *(u32x4*)(dst + 8) = w1;
    __syncthreads();
}

constexpr int RT_STRIDE = 8208, VS_OFF = 8 * RT_STRIDE, VS_STRIDE = 4112;
FI void longconv_channel(const Args& A, LAS unsigned char* lds, int c, int tid, int lane, int wave) {
    unsigned char* ws = A.ws;
    const bf16_t* Rg = (const bf16_t*)(ws + WS_RG) + (size_t)c * 4096; const bf16_t* Vt = (const bf16_t*)(ws + WS_VT) + (size_t)c * NB * SEQ; bf16_t* LC = (bf16_t*)(ws + WS_LCT) + (size_t)c * NB * SEQ;
    for (int i = tid; i < VS_OFF / 16; i += NTHR) *(LAS u32x4*)(lds + i * 16) = (u32x4){0u, 0u, 0u, 0u};
    for (int i = tid; i < NB * SEQ / 8; i += NTHR) { const int bb = i >> 8, s8 = i & 255; *(LAS u32x4*)(lds + VS_OFF + bb * VS_STRIDE + s8 * 16) = *(const u32x4*)(Vt + (size_t)bb * SEQ + s8 * 8); }
    __syncthreads();
    for (int i = tid; i < 4096; i += NTHR) { const bf16_t v = Rg[i];
#pragma unroll
        for (int r = 0; r < 8; ++r) *(LAS bf16_t*)(lds + r * RT_STRIDE + (i + r) * 2) = v; }
    __syncthreads();
    const int a = lane & 15, q = lane >> 4, r = (a + 1) & 7;
    const LAS unsigned char* vb = lds + VS_OFF + (lane & 7) * VS_STRIDE + 16 * q;
#pragma unroll 1
    for (int grp = 0; grp < 2; ++grp) {
        const int i0 = wave * 16 + grp * 8;
        const LAS unsigned char* rb = lds + r * RT_STRIDE + 2 * (2047 - 16 * (i0 + 7) - a + 8 * q + r);
        f32x4 acc[8];
#pragma unroll
        for (int ii = 0; ii < 8; ++ii) acc[ii] = (f32x4){0.f, 0.f, 0.f, 0.f};
        bf16x8 S[8];
#pragma unroll
        for (int ii = 2; ii < 8; ++ii) S[ii] = *(const LAS bf16x8*)(rb + 32 * (7 - ii));
#pragma unroll 1
        for (int j4 = 0; j4 < 64; j4 += 4) {
#pragma unroll
            for (int jj = 0; jj < 4; ++jj) {
                const int j = j4 + jj;
                const bf16x8 bfr = *(const LAS bf16x8*)(vb + 64 * j);
                S[(0 - 2 * jj) & 7] = *(const LAS bf16x8*)(rb + 32 * 7 + 64 * j);
                S[(1 - 2 * jj) & 7] = *(const LAS bf16x8*)(rb + 32 * 6 + 64 * j);
#pragma unroll
                for (int ii = 0; ii < 8; ++ii) acc[ii] = __builtin_amdgcn_mfma_f32_16x16x32_bf16(S[(ii - 2 * jj) & 7], bfr, acc[ii], 0, 0, 0);
            }
        }
        if (a < 8) {
#pragma unroll
            for (int ii = 0; ii < 8; ++ii) { u32x2 w; w.x = pk2(acc[ii][0], acc[ii][1]); w.y = pk2(acc[ii][2], acc[ii][3]); *(u32x2*)(LC + (size_t)a * SEQ + 16 * (i0 + ii) + 4 * q) = w; }
        }
    }
    __syncthreads();
}

FI void s5_combine(const Args& A, int gtid, int gthreads) {
    unsigned char* ws = A.ws;
    const bf16_t* P = (const bf16_t*)(ws + WS_P); const bf16_t* Ys = (const bf16_t*)(ws + WS_YS5); bf16_t* Yg = (bf16_t*)(ws + WS_YG); const float* dsk = A.in[16];
    for (int idx = gtid; idx < M * 128; idx += gthreads) {
        const int row = idx >> 7, c8 = (idx & 127) * 8;
        const u32x4 u = *(const u32x4*)(P + (size_t)row * DIN + c8), yf = *(const u32x4*)(Ys + (size_t)row * S5W + c8), yb = *(const u32x4*)(Ys + (size_t)(M + row) * S5W + c8);
        const f32x4 d0 = *(const f32x4*)(dsk + c8), d1 = *(const f32x4*)(dsk + c8 + 4);
        float y[8];
        y[0] = bflo(u.x) * d0.x + bflo(yf.x) + bflo(yb.x); y[1] = bfhi(u.x) * d0.y + bfhi(yf.x) + bfhi(yb.x);
        y[2] = bflo(u.y) * d0.z + bflo(yf.y) + bflo(yb.y); y[3] = bfhi(u.y) * d0.w + bfhi(yf.y) + bfhi(yb.y);
        y[4] = bflo(u.z) * d1.x + bflo(yf.z) + bflo(yb.z); y[5] = bfhi(u.z) * d1.y + bfhi(yf.z) + bfhi(yb.z);
        y[6] = bflo(u.w) * d1.z + bflo(yf.w) + bflo(yb.w); y[7] = bfhi(u.w) * d1.w + bfhi(yf.w) + bfhi(yb.w);
#pragma unroll
        for (int e = 0; e < 8; ++e) y[e] = 0.5f * y[e] * (1.0f + erff(y[e] * 0.70710678118654752f));
        u32x4 w; w.x = pk2(y[0], y[1]); w.y = pk2(y[2], y[3]); w.z = pk2(y[4], y[5]); w.w = pk2(y[6], y[7]);
        *(u32x4*)(Yg + (size_t)row * S5W + c8) = w;
    }
}

FI void h3_item(const Args& A, LAS unsigned char* lds, int item, int tid) {
    unsigned char* ws = A.ws;
    const bf16_t* P = (const bf16_t*)(ws + WS_P); const bf16_t* LC = (const bf16_t*)(ws + WS_LCT); bf16_t* Yc = (bf16_t*)(ws + WS_YCAT);
    const int gr = item >> 3, cg = item & 7, b = gr >> 5, t0 = (gr & 31) * 64, c0 = cg * 128;
    for (int idx = tid; idx < 3 * 64 * 16; idx += NTHR) { const int ch = idx >> 10, rem = idx & 1023, row = rem >> 4, sg = rem & 15;
        const u32x4 v = *(const u32x4*)(P + (size_t)(b * SEQ + t0 + row) * DIN + S5W + ch * HYW + c0 + sg * 8);
        *(LAS u32x4*)(lds + ch * 16896 + (row + 1) * 256 + sg * 16) = v; }
    if (tid < 96) { const int ch = tid >> 5, rr = (tid >> 4) & 1, sg = tid & 15; *(LAS u32x4*)(lds + ch * 16896 + (rr ? 65 : 0) * 256 + sg * 16) = (u32x4){0u, 0u, 0u, 0u}; }
    LAS bf16_t* Ls = (LAS bf16_t*)(lds + 3 * 16896);
    for (int idx = tid; idx < 128 * 8; idx += NTHR) { const int c = idx >> 3, pc = idx & 7;
        const u32x4 v = *(const u32x4*)(LC + (size_t)((c0 + c) * NB + b) * SEQ + t0 + pc * 8);
        const unsigned wv[4] = {v.x, v.y, v.z, v.w};
#pragma unroll
        for (int e = 0; e < 4; ++e) { Ls[(pc * 8 + 2 * e) * 128 + c] = (bf16_t)(wv[e] & 0xffffu); Ls[(pc * 8 + 2 * e + 1) * 128 + c] = (bf16_t)(wv[e] >> 16); } }
    __syncthreads();
    const int c = tid & 127, tq = tid >> 7, cc = c0 + c;
    const float* cw = A.in[19]; const float* cb = A.in[20];
    const float w0v = cw[cc], w1v = cw[3072 + cc], w2v = cw[6144 + cc], bv = cb[cc];
    const float w0x = cw[HYW + cc], w1x = cw[3072 + HYW + cc], w2x = cw[6144 + HYW + cc], bx = cb[HYW + cc];
    const float w0z = cw[2 * HYW + cc], w1z = cw[3072 + 2 * HYW + cc], w2z = cw[6144 + 2 * HYW + cc], bz = cb[2 * HYW + cc];
    const float dd = A.in[30][cc];
    const LAS bf16_t* Vs = (const LAS bf16_t*)lds; const LAS bf16_t* Xs = (const LAS bf16_t*)(lds + 16896); const LAS bf16_t* Zs = (const LAS bf16_t*)(lds + 2 * 16896);
#pragma unroll 4
    for (int i = 0; i < 16; ++i) { const int t = tq * 16 + i;
        const float v = w0v * bf1(Vs[t * 128 + c]) + w1v * bf1(Vs[(t + 1) * 128 + c]) + w2v * bf1(Vs[(t + 2) * 128 + c]) + bv;
        const float x = w0x * bf1(Xs[t * 128 + c]) + w1x * bf1(Xs[(t + 1) * 128 + c]) + w2x * bf1(Xs[(t + 2) * 128 + c]) + bx;
        const float z = w0z * bf1(Zs[t * 128 + c]) + w1z * bf1(Zs[(t + 1) * 128 + c]) + w2z * bf1(Zs[(t + 2) * 128 + c]) + bz;
        const float vg = v * x, y = (bf1(Ls[t * 128 + c]) + vg * dd) * z;
        Yc[(size_t)(b * SEQ + t0 + t) * D + S5W + cc] = (bf16_t)f2bf(y); }
    __syncthreads();
}

FI void p7_run(const Args& A, LAS unsigned char* lds, int lane, int wave, int vcu, int G, bool commit) {
    unsigned char* ws = A.ws;
    const float* x1 = (const float*)(ws + WS_X1); unsigned char* A2 = ws + WS_A2;
    const float* mod = (const float*)(ws + WS_MODF); const float* g2 = A.in[7]; const float* brt = A.in[33];
    const bf16x8* WRF = (const bf16x8*)(ws + WS_WRF);
    int* cnt = (int*)(ws + WS_CTL) + CW_CNT; int* rowl = (int*)(ws + WS_ROWL); int* pk = (int*)(ws + WS_PK); float* gate = (float*)(ws + WS_GATE);
    const int t = lane & 15, q = lane >> 4, pair = wave >> 1, kh = wave & 1;
    LAS float* xch = (LAS float*)(lds + 32768);
    LAS float* part = (LAS float*)(lds + 34816);
    LAS int* lcnt = (LAS int*)(lds + 65536);
    for (int it = vcu; it < M / 64; it += G) {
        const int row = it * 64 + pair * 16 + t, b = (it * 64) / SEQ;
        const float* xr = x1 + (size_t)row * D + kh * 1024 + 8 * q;
        if (threadIdx.x < 64) lcnt[threadIdx.x] = 0;
        float ss = 0.f;
#pragma unroll 8
        for (int ks = 0; ks < 32; ++ks) { const f32x4 a = *(const f32x4*)(xr + 32 * ks), c = *(const f32x4*)(xr + 32 * ks + 4);
            ss += ((a.x * a.x + a.y * a.y) + (a.z * a.z + a.w * a.w)) + ((c.x * c.x + c.y * c.y) + (c.z * c.z + c.w * c.w)); }
        ss += __shfl_xor(ss, 16); ss += __shfl_xor(ss, 32);
        if (q == 0) xch[wave * 16 + t] = ss;
        __syncthreads();
        const float rstd = rsqrtf((xch[(pair * 2) * 16 + t] + xch[(pair * 2 + 1) * 16 + t]) * (1.0f / D) + 1e-6f);
        f32x4 acc0 = (f32x4){0.f, 0.f, 0.f, 0.f}, acc1 = (f32x4){0.f, 0.f, 0.f, 0.f};
        const float* gp = g2 + kh * 1024 + 8 * q; const float* shp = mod + (size_t)b * 12288 + 3 * D + kh * 1024 + 8 * q; const float* scp = mod + (size_t)b * 12288 + 4 * D + kh * 1024 + 8 * q;
        unsigned char* a2p = A2 + (size_t)row * D + kh * 1024 + 8 * q;
#pragma unroll 4
        for (int ks = 0; ks < 32; ++ks) {
            const f32x4 xa = *(const f32x4*)(xr + 32 * ks), xb = *(const f32x4*)(xr + 32 * ks + 4);
            const f32x4 ha = xa * rstd * *(const f32x4*)(gp + 32 * ks) * (*(const f32x4*)(scp + 32 * ks) + 1.0f) + *(const f32x4*)(shp + 32 * ks);
            const f32x4 hb = xb * rstd * *(const f32x4*)(gp + 32 * ks + 4) * (*(const f32x4*)(scp + 32 * ks + 4) + 1.0f) + *(const f32x4*)(shp + 32 * ks + 4);
            u32x2 w8; w8.x = pk4_fp8(ha.x, ha.y, ha.z, ha.w); w8.y = pk4_fp8(hb.x, hb.y, hb.z, hb.w); *(u32x2*)(a2p + 32 * ks) = w8;
            u32x4 hi; hi.x = pk2(ha.x, ha.y); hi.y = pk2(ha.z, ha.w); hi.z = pk2(hb.x, hb.y); hi.w = pk2(hb.z, hb.w);
            u32x4 lo; lo.x = pk2(ha.x - bflo(hi.x), ha.y - bfhi(hi.x)); lo.y = pk2(ha.z - bflo(hi.y), ha.w - bfhi(hi.y)); lo.z = pk2(hb.x - bflo(hi.z), hb.y - bfhi(hi.z)); lo.w = pk2(hb.z - bflo(hi.w), hb.w - bfhi(hi.w));
            const bf16x8 Hh = __builtin_bit_cast(bf16x8, hi), Hl = __builtin_bit_cast(bf16x8, lo);
            const bf16x8* wf = WRF + (size_t)((kh * 32 + ks) * 4) * 64 + lane;
            const bf16x8 wh0 = wf[0], wl0 = wf[64], wh1 = wf[128], wl1 = wf[192];
            acc0 = __builtin_amdgcn_mfma_f32_16x16x32_bf16(wh0, Hh, acc0, 0, 0, 0); acc1 = __builtin_amdgcn_mfma_f32_16x16x32_bf16(wh1, Hh, acc1, 0, 0, 0);
            acc0 = __builtin_amdgcn_mfma_f32_16x16x32_bf16(wl0, Hh, acc0, 0, 0, 0); acc1 = __builtin_amdgcn_mfma_f32_16x16x32_bf16(wl1, Hh, acc1, 0, 0, 0);
            acc0 = __builtin_amdgcn_mfma_f32_16x16x32_bf16(wh0, Hl, acc0, 0, 0, 0); acc1 = __builtin_amdgcn_mfma_f32_16x16x32_bf16(wh1, Hl, acc1, 0, 0, 0);
        }
        if (kh == 1) { *(LAS f32x4*)(part + (pair * 64 + lane) * 8) = acc0; *(LAS f32x4*)(part + (pair * 64 + lane) * 8 + 4) = acc1; }
        __syncthreads();
        int myex = 0, myrank = 0; float mygate = 0.f;
        if (kh == 0) {
            acc0 += *(const LAS f32x4*)(part + (pair * 64 + lane) * 8); acc1 += *(const LAS f32x4*)(part + (pair * 64 + lane) * 8 + 4);
            float v[8]; int ix[8];
#pragma unroll
            for (int r = 0; r < 4; ++r) { ix[r] = 4 * q + r; ix[4 + r] = 16 + 4 * q + r; v[r] = acc0[r] + brt[4 * q + r]; v[4 + r] = acc1[r] + brt[16 + 4 * q + r]; }
            float tv[4]; int ti[4];
#pragma unroll
            for (int k = 0; k < 4; ++k) { float bv = v[0]; int bi = ix[0];
#pragma unroll
                for (int r = 1; r < 8; ++r) if (v[r] > bv) { bv = v[r]; bi = ix[r]; }
#pragma unroll
                for (int o = 16; o <= 32; o <<= 1) { const float ov = __shfl_xor(bv, o); const int oi = __shfl_xor(bi, o); if (ov > bv || (ov == bv && oi < bi)) { bv = ov; bi = oi; } }
                tv[k] = bv; ti[k] = bi;
#pragma unroll
                for (int r = 0; r < 8; ++r) if (ix[r] == bi) v[r] = -3.0e38f; }
            const float e1 = __expf(tv[1] - tv[0]), e2 = __expf(tv[2] - tv[0]), e3 = __expf(tv[3] - tv[0]), inv = 1.0f / (1.0f + e1 + e2 + e3);
            myex = q == 0 ? ti[0] : q == 1 ? ti[1] : q == 2 ? ti[2] : ti[3];
            mygate = (q == 0 ? 1.0f : q == 1 ? e1 : q == 2 ? e2 : e3) * inv;
            myrank = __hip_atomic_fetch_add(lcnt + myex, 1, __ATOMIC_RELAXED, __HIP_MEMORY_SCOPE_WORKGROUP);
        }
        __syncthreads();
        if (threadIdx.x < NE) { const int n = lcnt[threadIdx.x]; lcnt[32 + threadIdx.x] = (n > 0 && commit) ? atomicAdd(cnt + threadIdx.x, n) : 0; }
        __syncthreads();
        if (kh == 0 && commit) { const int slot = lcnt[32 + myex] + myrank;
            rowl[myex * M + slot] = row; pk[row * 4 + q] = myex * M + slot; gate[row * 4 + q] = mygate; }
        __syncthreads();
    }
}

FI void moe_table(const Args& A, LAS unsigned char* lds, int tid) {
    const int* cnt = (const int*)(A.ws + WS_CTL) + CW_CNT;
    LAS int* tw = (LAS int*)(lds + LDSCTL_OFF);
    if (tid < 64) { const int n = tid < NE ? cnt[tid] : 0; int p = (n + 255) >> 8;
#pragma unroll
        for (int o = 1; o < 32; o <<= 1) { const int q = __shfl_up(p, o); if ((tid & 63) >= o) p += q; }
        if (tid < NE) { tw[LW_TST + tid + 1] = p; tw[LW_CNT + tid] = n; } if (tid == 0) tw[LW_TST] = 0; }
    __syncthreads();
    if (tid < 320) { int e = 0;
#pragma unroll 1
        for (int j = 1; j < NE; ++j) e += (tw[LW_TST + j] <= tid) ? 1 : 0;
        tw[LW_TE + tid] = e; }
    __syncthreads();
}

FI void p10_run(const Args& A, LAS unsigned char* lds, int lane, int wave, int vcu, int G) {
    unsigned char* ws = A.ws;
    const float* x1 = (const float*)(ws + WS_X1); const bf16_t* Yd = (const bf16_t*)(ws + WS_YD);
    const float* mod = (const float*)(ws + WS_MODF); const float* gf = A.in[38];
    const int* pk = (const int*)(ws + WS_PK); const float* gate = (const float*)(ws + WS_GATE);
    const LAS int* tst = (const LAS int*)(lds + LDSCTL_OFF) + LW_TST;
    const int gw = vcu * NWAVES + wave, NGW = G * NWAVES;
    for (int row = gw; row < M; row += NGW) {
        const int b = row / SEQ; size_t hr[4]; float gk[4];
#pragma unroll
        for (int k = 0; k < 4; ++k) { const int p = pk[row * 4 + k], ex = p / M, slot = p % M; hr[k] = (size_t)(tst[ex] * 256 + slot) * D; gk[k] = gate[row * 4 + k]; }
        f32x4 x2[8]; float ss = 0.f;
#pragma unroll
        for (int j = 0; j < 8; ++j) { const int col = 4 * lane + 256 * j;
            f32x4 s = (f32x4){0.f, 0.f, 0.f, 0.f};
#pragma unroll
            for (int k = 0; k < 4; ++k) { const u32x2 y = *(const u32x2*)(Yd + hr[k] + col); s += (f32x4){bflo(y.x), bfhi(y.x), bflo(y.y), bfhi(y.y)} * gk[k]; }
            const f32x4 ga = *(const f32x4*)(mod + (size_t)b * 12288 + 5 * D + col);
            x2[j] = *(const f32x4*)(x1 + (size_t)row * D + col) + ga * s;
            ss += (x2[j].x * x2[j].x + x2[j].y * x2[j].y) + (x2[j].z * x2[j].z + x2[j].w * x2[j].w); }
        const float rstd = rsqrtf(wave_sum(ss) * (1.0f / D) + 1e-6f);
#pragma unroll
        for (int j = 0; j < 8; ++j) { const int col = 4 * lane + 256 * j; *(f32x4*)(A.out + (size_t)row * D + col) = x2[j] * rstd * *(const f32x4*)(gf + col); }
    }
}

__global__ void __launch_bounds__(NTHR, 2) fwd_kernel(Args args) {
    extern __shared__ __attribute__((aligned(16))) unsigned char lds_raw[];
    LAS unsigned char* lds = (LAS unsigned char*)lds_raw;
    const int tid = threadIdx.x, lane = tid & 63, wave = __builtin_amdgcn_readfirstlane(tid >> 6);
    const int G = gridDim.x; const int bx = blockIdx.x; const int vcu = (G % 8 == 0) ? (bx % 8) * (G / 8) + bx / 8 : bx;
    unsigned char* ws = args.ws;
    for (int u = tid; u < (LDS_BYTES - LDSCTL_OFF) / 4; u += NTHR) ((LAS unsigned*)(lds + LDSCTL_OFF))[u] = 0u;
    __syncthreads();
    XcdBarrier bar; bar.bar = (unsigned*)(ws + WS_CTL) + CW_BAR; bar.x = 0; bar.st = nullptr;
#if !MK_SPLIT
    bar = xcd_barrier_post((unsigned*)(ws + WS_CTL) + CW_BAR, (volatile LAS unsigned*)(lds + LDSCTL_OFF) + LW_BAR);
#endif
    const int lo = args.ph_lo, hi = args.ph_hi;
#ifndef PHASE_MASK
#define PHASE_MASK 0x7ff
#endif
#define IN(k) (((PHASE_MASK >> (k)) & 1) && lo <= (k) && (k) < hi)
#if MK_SPLIT
#define SEAM(k) do { } while (0)
#else
#define SEAM(k) do { if (IN(k) && IN((k) + 1)) xcd_barrier(bar); } while (0)
#endif
    const float* modp = (const float*)(ws + WS_MODF);
    unsigned long long amp_t0 = 0, amp_dt = 0;
#ifndef AMP_CLK
#define AMP_CLK 0
#endif
#define AMP_NOW() (AMP_CLK ? (unsigned long long)__builtin_amdgcn_s_memtime() / 128ull : (unsigned long long)__builtin_amdgcn_s_memrealtime())
#define AMP_BEGIN(k) do { if (AMP_PHASE == (k) && bx == 0 && tid == 0) amp_t0 = AMP_NOW(); } while (0)
#define AMP_END(k) do { if (AMP_PHASE == (k) && bx == 0 && tid == 0) amp_dt = AMP_NOW() - amp_t0; } while (0)

    AMP_BEGIN(0);
    AMP_BEGIN(11);
    if (IN(0)) {
        if ((G & 1) == 0 && G >= 64) {
            if ((bx & 1) == 0) { p0_run(args, lds, tid, lane, wave, bx >> 1, G >> 1); __syncthreads(); p0d_run(args, lds, lane, wave, P0_SPLIT_ITEMS, 49152, bx >> 1, G >> 1); }
            else p0d_run(args, lds, lane, wave, 0, P0_SPLIT_ITEMS, bx >> 1, G >> 1);
        } else { p0_run(args, lds, tid, lane, wave, vcu, G); __syncthreads(); p0d_run(args, lds, lane, wave, 0, 49152, vcu, G); }
    }
    AMP_END(11);
    SEAM(0); AMP_END(0);
    AMP_BEGIN(1);
    if (IN(1)) { _Pragma("unroll 1") for (int rep = 0; rep < REP1; ++rep) p1_run(args, tid, lane, wave, vcu, G, 0, MT, true); } SEAM(1); AMP_END(1);
    AMP_BEGIN(2);
    if (IN(2)) {
        pg8::DenseSched S{(const bf16_t*)(ws + WS_A1), (const bf16_t*)(ws + WS_WIN), 2 * D, M / 256, DIN / 256, G, bx, M / 256, MC / 256, S5W / 256, 0};
        pg8::EpiStoreBf16<false> E{(bf16_t*)(ws + WS_P), DIN, nullptr, 0, 1.0f};
        _Pragma("unroll 1") for (int rep = 0; rep < REP2; ++rep)
        pg8::gemm_phase<false>(lds, 2 * D, S, E);
    } SEAM(2); AMP_END(2);
    AMP_BEGIN(3);
    if (IN(3)) {
        _Pragma("unroll 1") for (int rep = 0; rep < REP3; ++rep) {
        _Pragma("unroll 1") for (int r2 = 0; r2 < REP3A; ++r2) for (int u = vcu; u < 512; u += G) s5_unit(args, lds, u, lane, wave);
        _Pragma("unroll 1") for (int r2 = 0; r2 < REP3B; ++r2) for (int it = vcu; it < 2048; it += G) h1_item(args, lds, it, tid); }
    } SEAM(3); AMP_END(3);
    AMP_BEGIN(4);
    if (IN(4)) {
        _Pragma("unroll 1") for (int rep = 0; rep < REP4; ++rep) {
        _Pragma("unroll 1") for (int r2 = 0; r2 < REP4A; ++r2) s5_combine(args, vcu * NTHR + tid, G * NTHR);
        _Pragma("unroll 1") for (int r2 = 0; r2 < REP4B; ++r2) for (int c = vcu; c < HYW; c += G) longconv_channel(args, lds, c, tid, lane, wave); }
    } SEAM(4); AMP_END(4);
    AMP_BEGIN(5);
    if (IN(5)) {
        _Pragma("unroll 1") for (int rep = 0; rep < REP5; ++rep) for (int it = vcu; it < 2048; it += G) h3_item(args, lds, it, tid);
        pg8::DenseSched S{(const bf16_t*)(ws + WS_YG), (const bf16_t*)(ws + WS_WGLU), 2 * S5W, M / 256, S5W / 256, G, bx, 0, 0, 0, 0};
        pg8::EpiGlu E{(const bf16_t*)(ws + WS_YG), (bf16_t*)(ws + WS_YCAT), args.in[18]};
        pg8::gemm_phase<false>(lds, 2 * S5W, S, E);
    } SEAM(5); AMP_END(5);
    AMP_BEGIN(6);
    if (IN(6)) {
        pg8::DenseSched S{(const bf16_t*)(ws + WS_YCAT), (const bf16_t*)(ws + WS_WOUT), 2 * D, M / 256, D / 256, G, bx, 0, 0, 0, 0};
        pg8::EpiResid E{args.in[0], (float*)(ws + WS_X1), modp};
        _Pragma("unroll 1") for (int rep = 0; rep < REP6; ++rep)
        pg8::gemm_phase<false>(lds, 2 * D, S, E);
    } SEAM(6); AMP_END(6);
    AMP_BEGIN(7);
    if (IN(7)) { _Pragma("unroll 1") for (int rep = 0; rep < REP7; ++rep) p7_run(args, lds, lane, wave, vcu, G, rep == REP7 - 1); } SEAM(7); AMP_END(7);
    AMP_BEGIN(8);
    if (IN(8)) {
        moe_table(args, lds, tid);
        pg8::MoeSched<true> S{ws + WS_A2, ws + WS_WGU, D, 16, G, bx, (size_t)4096 * D,
                              (const LAS int*)(lds + LDSCTL_OFF) + LW_TST, (const LAS int*)(lds + LDSCTL_OFF) + LW_CNT, (const int*)(ws + WS_ROWL)};
        pg8::EpiSwiglu E{ws + WS_H, args.in[35], 1.0f / WSCALE};
        _Pragma("unroll 1") for (int rep = 0; rep < REP8; ++rep)
        pg8::gemm_phase<true>(lds, D, S, E);
    } SEAM(8); AMP_END(8);
    AMP_BEGIN(9);
    if (IN(9)) {
        moe_table(args, lds, tid);
        pg8::MoeSched<false> S{ws + WS_H, ws + WS_WDN, DFF, 8, G, bx, (size_t)D * DFF,
                               (const LAS int*)(lds + LDSCTL_OFF) + LW_TST, (const LAS int*)(lds + LDSCTL_OFF) + LW_CNT, (const int*)(ws + WS_ROWL)};
        pg8::EpiStoreBf16<true> E{(bf16_t*)(ws + WS_YD), D, args.in[37], D, 1.0f / WSCALE};
        _Pragma("unroll 1") for (int rep = 0; rep < REP9; ++rep)
        pg8::gemm_phase<true>(lds, DFF, S, E);
    } SEAM(9); AMP_END(9);
    AMP_BEGIN(10);
    if (IN(10)) { moe_table(args, lds, tid); _Pragma("unroll 1") for (int rep = 0; rep < REP10; ++rep) p10_run(args, lds, lane, wave, vcu, G); }
    AMP_END(10);
    if (AMP_PHASE >= 0 && bx == 0 && tid == 0) { const unsigned long long t0 = __builtin_amdgcn_s_memrealtime(); while (__builtin_amdgcn_s_memrealtime() - t0 < 4ull * amp_dt) __builtin_amdgcn_s_sleep(16); }
#undef IN
#undef SEAM
}

extern "C" void kernel_launch(void* const* d_in, const int* in_sizes, int n_in, void* d_out, int out_size, void* d_ws, size_t ws_size, hipStream_t stream) {
    static int grid = 0;
    if (grid == 0) {
        if (n_in != 39 || out_size != M * D || ws_size < WS_END) { fprintf(stderr, "kernel_launch: unexpected problem (n_in %d, out %d, ws %zu)\n", n_in, out_size, ws_size); grid = -1; return; }
        int dev = 0, cus = 0, per_cu = 0;
        if (hipGetDevice(&dev) != hipSuccess || hipDeviceGetAttribute(&cus, hipDeviceAttributeMultiprocessorCount, dev) != hipSuccess) { grid = -1; return; }
        if (hipFuncSetAttribute((const void*)fwd_kernel, hipFuncAttributeMaxDynamicSharedMemorySize, LDS_BYTES) != hipSuccess) { fprintf(stderr, "kernel_launch: hipFuncSetAttribute failed\n"); grid = -1; return; }
        if (hipOccupancyMaxActiveBlocksPerMultiprocessor(&per_cu, (const void*)fwd_kernel, NTHR, LDS_BYTES) != hipSuccess || per_cu < 1) fprintf(stderr, "kernel_launch: occupancy query says %d\n", per_cu);
        (void)hipGetLastError();
        grid = cus;
    }
    if (grid < 0) return;
    (void)in_sizes;
    if (hipMemsetAsync((char*)d_ws + WS_CTL, 0, CTL_ZERO_BYTES, stream) != hipSuccess) { fprintf(stderr, "kernel_launch: memset failed\n"); return; }
    Args a{};
    for (int i = 0; i < 39; ++i) a.in[i] = (const float*)d_in[i];
    a.out = (float*)d_out; a.ws = (unsigned char*)d_ws;
#if MK_SPLIT
    for (int p = 0; p < NPHASE; ++p) { a.ph_lo = p; a.ph_hi = p + 1; hipLaunchKernelGGL(fwd_kernel, dim3(grid), dim3(NTHR), LDS_BYTES, stream, a); }
#else
    a.ph_lo = 0; a.ph_hi = NPHASE;
    hipLaunchKernelGGL(fwd_kernel, dim3(grid), dim3(NTHR), LDS_BYTES, stream, a);
#endif
    const hipError_t le = hipPeekAtLastError();
    if (le != hipSuccess) fprintf(stderr, "kernel_launch: launch failed: %s\n", hipGetErrorName(le));
}
```

```cpp
#include <hip/hip_runtime.h>
#include <cstdio>
#include <cstdint>

#ifndef MK_SPLIT
#define MK_SPLIT 0
#endif

#ifndef REP0D
#define REP0D 1
#endif
#ifndef REP2
#define REP2 1
#endif
#ifndef AMP_PHASE
#define AMP_PHASE -1
#endif
#ifndef REP1
#define REP1 1
#endif
#ifndef REP5
#define REP5 1
#endif
#ifndef REP7
#define REP7 1
#endif
#ifndef REP10
#define REP10 1
#endif
#ifndef REP0A
#define REP0A 1
#endif
#ifndef REP3
#define REP3 1
#endif
#ifndef REP3A
#define REP3A 1
#endif
#ifndef REP3B
#define REP3B 1
#endif
#ifndef REP4A
#define REP4A 1
#endif
#ifndef REP4B
#define REP4B 1
#endif
#ifndef REP4
#define REP4 1
#endif
#ifndef REP6
#define REP6 1
#endif
#ifndef REP8
#define REP8 1
#endif
#ifndef REP9
#define REP9 1
#endif
#define GAS __attribute__((address_space(1)))
#define LAS __attribute__((address_space(3)))
typedef unsigned short bf16_t;
typedef short bf16x8 __attribute__((ext_vector_type(8)));
typedef float f32x4 __attribute__((ext_vector_type(4)));
typedef float f32x16 __attribute__((ext_vector_type(16)));
typedef unsigned u32x4 __attribute__((ext_vector_type(4)));
typedef unsigned u32x2 __attribute__((ext_vector_type(2)));

constexpr int NWAVES = 8, NTHR = 512;
constexpr int D = 2048, NB = 8, SEQ = 2048, M = NB * SEQ, CTXL = 256, MC = NB * CTXL, MT = M + MC;
constexpr int DIN = 4096, S5W = 1024, HYW = 1024, NG = 64;
constexpr int NE = 32, DFF = 2048;
constexpr int NPHASE = 11;
constexpr float WSCALE = 64.0f;
constexpr int SEG = 288;

constexpr size_t MiB = 1u << 20;
constexpr size_t WS_CTL = 0, CTL_ZERO_BYTES = 1024 * 1024;
constexpr int CW_TMO = 0, CW_BAR = 4096, CW_CNT = 8192, CW_HNORM = 12288, CW_MOD = 16384;
constexpr size_t WS_LAM = 1 * MiB, WS_LAML = WS_LAM + 64 * 1024, WS_S5B = WS_LAM + 128 * 1024, WS_S5C = WS_LAM + 640 * 1024;
constexpr size_t WS_HRAW = 4 * MiB, WS_RG = 20 * MiB, WS_WIN = 28 * MiB, WS_WGLU = 44 * MiB, WS_WOUT = 46 * MiB;
constexpr size_t WS_PK = 54 * MiB, WS_GATE = WS_PK + 256 * 1024, WS_ROWL = 55 * MiB, WS_MODF = 58 * MiB, WS_WRF = 59 * MiB;
constexpr size_t WS_A1 = 64 * MiB, WS_P = 136 * MiB, WS_YS5 = 280 * MiB, WS_VT = 344 * MiB, WS_LCT = 376 * MiB, WS_YG = 408 * MiB;
constexpr size_t WS_YCAT = 440 * MiB, WS_X1 = 504 * MiB, WS_A2 = 632 * MiB, WS_WGU = 704 * MiB, WS_WDN = 1216 * MiB;
constexpr size_t WS_H = 1472 * MiB, WS_YD = 1760 * MiB, WS_END = 2048 * MiB;
constexpr int HROWS = 73728;

constexpr int RING_BYTES = 131072, LDSCTL_OFF = RING_BYTES, LDS_BYTES = 147456;
constexpr int LW_BAR = 8, LW_TST = 64, LW_CNT = 128, LW_TE = 256;

typedef __bf16 bf16v2 __attribute__((ext_vector_type(2)));
typedef float f32v2 __attribute__((ext_vector_type(2)));
__device__ __forceinline__ unsigned f2bf(float f) { return (unsigned)__builtin_bit_cast(unsigned short, (__bf16)f); }
__device__ __forceinline__ unsigned pk2(float lo, float hi) { const f32v2 v = {lo, hi}; return __builtin_bit_cast(unsigned, __builtin_convertvector(v, bf16v2)); }
__device__ __forceinline__ float bflo(unsigned w) { return __builtin_bit_cast(float, w << 16); }
__device__ __forceinline__ float bfhi(unsigned w) { return __builtin_bit_cast(float, w & 0xffff0000u); }
__device__ __forceinline__ float bf1(bf16_t b) { return __builtin_bit_cast(float, (unsigned)b << 16); }
__device__ __forceinline__ unsigned pk4_fp8(float a, float b, float c, float d) { int w = __builtin_amdgcn_cvt_pk_fp8_f32(a, b, 0, false); w = __builtin_amdgcn_cvt_pk_fp8_f32(c, d, w, true); return (unsigned)w; }
constexpr float FIX_SCALE = 4294967296.0f;
__device__ __forceinline__ void fix_add(unsigned long long* p, float v) { atomicAdd(p, (unsigned long long)__float2ll_rn(v * FIX_SCALE)); }
__device__ __forceinline__ float fix_get(const unsigned long long* p) { return (float)((double)(long long)(*p) * (1.0 / 4294967296.0)); }
__device__ __forceinline__ float sigm(float v) { return __builtin_amdgcn_rcpf(1.0f + __builtin_amdgcn_exp2f(-1.44269504f * v)); }
__device__ __forceinline__ float wave_sum(float v) {
#pragma unroll
    for (int o = 1; o < 64; o <<= 1) v += __shfl_xor(v, o);
    return v;
}
#define LDS_WAIT() asm volatile("s_waitcnt lgkmcnt(0)" ::: "memory")
#define VM_WAIT() asm volatile("s_waitcnt vmcnt(0)" ::: "memory")

#define XB_TMO      128
#define XB_XCNT(j)  (256  + 64 * (j))
#define XB_XSUB(j)  (1280 + 64 * (j))
#define XB_XGEN(j)  (2304 + 64 * (j))
#define XB_TOP      3328
#define XB_TOPGEN   3392
#define XCD_BAR_WORDS 3456
#define XB_SPIN_CAP (1u << 18)
__device__ __forceinline__ unsigned xb_ld(unsigned* p)              { return __hip_atomic_load(p, __ATOMIC_RELAXED, __HIP_MEMORY_SCOPE_AGENT); }
__device__ __forceinline__ unsigned xb_add(unsigned* p, unsigned v) { return __hip_atomic_fetch_add(p, v, __ATOMIC_RELAXED, __HIP_MEMORY_SCOPE_AGENT); }
__device__ __forceinline__ unsigned xb_xcc_id() { return (unsigned)__builtin_amdgcn_s_getreg((3 << 11) | 20) & 0xFu; }
#define XB_SPIN(cond, bar) do { unsigned _sp = 0; while (cond) { __builtin_amdgcn_s_sleep(1); \
    if ((++_sp & 255u) == 0u) { if (xb_ld(&(bar)[XB_TMO])) break; if (_sp > XB_SPIN_CAP) { atomicAdd(&(bar)[XB_TMO], 1u); break; } } } } while (0)
struct XcdBarrier { unsigned* bar; unsigned x; volatile LAS unsigned* st; };
__device__ __forceinline__ XcdBarrier xcd_barrier_post(unsigned* bar, volatile LAS unsigned* st) {
    XcdBarrier b; b.bar = bar; b.x = xb_xcc_id(); b.st = st;
    if (threadIdx.x == 0) (void)xb_add(&bar[XB_XCNT(b.x)], 1u);
    return b;
}
__device__ __forceinline__ void xcd_barrier_complete(unsigned* bar, unsigned x, unsigned& nloc, unsigned& nx) {
    const unsigned G = gridDim.x * gridDim.y * gridDim.z;
    unsigned sum, cnt, mine, sp = 0u;
    for (;;) {
        sum = 0u; cnt = 0u; mine = 0u;
#pragma unroll
        for (unsigned j = 0; j < 16; ++j) { const unsigned c = xb_ld(&bar[XB_XCNT(j)]); sum += c; cnt += (c > 0u) ? 1u : 0u; mine = (j == x) ? c : mine; }
        if (sum == G) break;
        __builtin_amdgcn_s_sleep(1);
        if ((++sp & 255u) == 0u) { if (xb_ld(&bar[XB_TMO])) break; if (sp > XB_SPIN_CAP) { atomicAdd(&bar[XB_TMO], 1u); break; } }
    }
    nloc = mine > 0u ? mine : 1u; nx = cnt > 0u ? cnt : 1u;
}
__device__ __forceinline__ void xcd_barrier(const XcdBarrier& b) {
    asm volatile("s_waitcnt vmcnt(0)" ::: "memory");
    __syncthreads();
    if (threadIdx.x == 0) {
        unsigned* bar = b.bar;
        __builtin_amdgcn_s_waitcnt(0);
        unsigned nloc = b.st[0], nx = b.st[1];
        if (nloc == 0u) { xcd_barrier_complete(bar, b.x, nloc, nx); b.st[0] = nloc; b.st[1] = nx; }
        const unsigned old = xb_add(&bar[XB_XSUB(b.x)], 1u);
        const unsigned gen = old / nloc;
        if (old + 1u == (gen + 1u) * nloc) {
            __builtin_amdgcn_fence(__ATOMIC_RELEASE, "agent");
            asm volatile("s_waitcnt vmcnt(0)" ::: "memory");
            const unsigned og = xb_add(&bar[XB_TOP], 1u);
            const unsigned tg = og / nx;
            if (og + 1u == (tg + 1u) * nx) xb_add(&bar[XB_TOPGEN], 1u);
            else XB_SPIN(xb_ld(&bar[XB_TOPGEN]) == tg, bar);
            __builtin_amdgcn_fence(__ATOMIC_ACQUIRE, "agent");
            xb_add(&bar[XB_XGEN(b.x)], 1u);
            asm volatile("s_waitcnt vmcnt(0)" ::: "memory");
        } else {
            XB_SPIN(xb_ld(&bar[XB_XGEN(b.x)]) == gen, bar);
            __builtin_amdgcn_fence(__ATOMIC_ACQUIRE, "agent");
            asm volatile("s_waitcnt vmcnt(0)" ::: "memory");
        }
    }
    __syncthreads();
}

struct Args { const float* in[39]; float* out; unsigned char* ws; int ph_lo, ph_hi; };

namespace pg8 {
constexpr int BM = 256, BK = 64, HALF = 128, HTB = HALF * BK * 2, STAGE_BYTES = 8 * HTB, NXCD = 8, WGM = 8;
__device__ __forceinline__ int lds_byte(int r, int c) { const int st = (r >> 4) * 2 + (c >> 5), rr = r & 15, cc = c & 31, ob = rr * 64 + cc * 2; return st * 1024 + (ob ^ (((ob >> 9) & 1) << 5)); }
__device__ __forceinline__ void stage_rc(int b, int& R, int& C) { const int st = b / 1024, sb = b % 1024, swz = sb ^ (((sb >> 9) & 1) << 5); R = (st >> 1) * 16 + swz / 64; C = (st & 1) * 32 + (swz % 64) / 2; }
__device__ __forceinline__ int perm32(int rho) { const int n = rho >> 4, i = rho & 15; return 8 * (i >> 2) + 4 * n + (i & 3); }
struct Unit { int pm, pn, e; };
__device__ __forceinline__ unsigned cvt_pk_bf16(float lo, float hi) { unsigned r; asm volatile("v_cvt_pk_bf16_f32 %0, %1, %2" : "=v"(r) : "v"(lo), "v"(hi)); return r; }

__device__ __forceinline__ void tile_of(long L, int nM, int nN, int& pm, int& pn) {
    const int nwg = nM * nN; int wgid = (int)L;
    { const int q = nwg / NXCD, r = nwg % NXCD, xcd = wgid % NXCD, off = wgid / NXCD; wgid = (xcd < r ? xcd * (q + 1) : r * (q + 1) + (xcd - r) * q) + off; }
    const int nig = WGM * nN, gid = wgid / nig, fm = gid * WGM, gsz = (nM - fm) < WGM ? (nM - fm) : WGM;
    pm = fm + ((wgid % nig) % gsz); pn = (wgid % nig) / gsz;
}

struct DenseSched {
    const bf16_t* A; const bf16_t* Bt; int RB, nM, nN, G, c, xM0, xnM, xnN, xN0;
    __device__ __forceinline__ bool next(int i, Unit& u) const {
        const long L = (long)i * G + c; const int nwg = nM * nN;
        if (L < nwg) { tile_of(L, nM, nN, u.pm, u.pn); u.e = 0; return true; }
        const long r = L - nwg; if (r >= (long)xnM * xnN) return false;
        u.pm = xM0 + (int)(r % xnM); u.pn = xN0 + (int)(r / xnM); u.e = 0; return true;
    }
    __device__ __forceinline__ const char* abase(const Unit& u) const { return (const char*)A + (size_t)u.pm * BM * RB; }
    __device__ __forceinline__ const char* bbase(const Unit& u) const { return (const char*)Bt + (size_t)u.pn * BM * RB; }
    __device__ __forceinline__ void rows(const Unit&, unsigned (&va)[2][2], const int (&R)[2], const int (&C)[2]) const {
#pragma unroll
        for (int h = 0; h < 2; ++h)
#pragma unroll
            for (int i = 0; i < 2; ++i) va[h][i] = (unsigned)((h * HALF + R[i]) * RB + 2 * C[i]);
    }
};
template <bool GATHER> struct MoeSched {
    const unsigned char* A; const unsigned char* Bt; int RB, nN, G, c; size_t estride;
    const LAS int* tst; const LAS int* cnts; const int* rowlist;
    __device__ __forceinline__ bool next(int i, Unit& u) const {
        const int TM = __builtin_amdgcn_readfirstlane(tst[NE]); const long L = (long)i * G + c; if (L >= (long)TM * nN) return false;
        tile_of(L, TM, nN, u.pm, u.pn);
        u.e = __builtin_amdgcn_readfirstlane(tst[(LW_TE - LW_TST) + u.pm]); return true;
    }
    __device__ __forceinline__ const char* abase(const Unit& u) const { return GATHER ? (const char*)A : (const char*)A + (size_t)u.pm * BM * RB; }
    __device__ __forceinline__ const char* bbase(const Unit& u) const { return (const char*)Bt + (size_t)u.e * estride + (size_t)u.pn * BM * RB; }
    __device__ __forceinline__ void rows(const Unit& u, unsigned (&va)[2][2], const int (&R)[2], const int (&C)[2]) const {
        if (GATHER) {
            const int n = __builtin_amdgcn_readfirstlane(cnts[u.e]), lt = u.pm - __builtin_amdgcn_readfirstlane(tst[u.e]);
#pragma unroll
            for (int h = 0; h < 2; ++h)
#pragma unroll
                for (int i = 0; i < 2; ++i) { int slot = lt * BM + h * HALF + R[i]; slot = slot < n ? slot : 0; const int tok = rowlist[u.e * M + slot]; va[h][i] = (unsigned)(tok * RB + 2 * C[i]); }
        } else {
#pragma unroll
            for (int h = 0; h < 2; ++h)
#pragma unroll
                for (int i = 0; i < 2; ++i) va[h][i] = (unsigned)((h * HALF + R[i]) * RB + 2 * C[i]);
        }
    }
};

typedef int i32x4 __attribute__((ext_vector_type(4)));
typedef int i32x8 __attribute__((ext_vector_type(8)));
template <bool FP8, class Epi, class Sched>
__device__ __forceinline__ void gemm_phase(LAS unsigned char* lds, const int RB, const Sched& S, const Epi& E) {
    const int tid = threadIdx.x, wid = __builtin_amdgcn_readfirstlane(tid >> 6), lane = tid & 63, wr = wid >> 2, wc = wid & 3, fr = lane & 15, fq = lane >> 4;
    const int nt = RB / 128;
    unsigned voffB[2]; int Rr[2], Cc[2];
#pragma unroll
    for (int i = 0; i < 2; ++i) { int R, C; stage_rc(tid * 16 + i * 8192, R, C); Rr[i] = R; Cc[i] = C; const int Rb = Epi::PERM ? ((R & ~31) + perm32(R & 31)) : R; voffB[i] = (unsigned)(Rb * RB + 2 * C); }
    const size_t kstep = (size_t)(BK * 2);
    const size_t hstep = (size_t)HALF * RB;
    const unsigned ldsw = (unsigned)wid * 1024u;
    const int aoff = lds_byte(wr * 64 + fr, fq * 8), boff = lds_byte(wc * 32 + fr, fq * 8);
#define PG8_SA(b, h) (((b) * 2 + (h)) * HTB)
#define PG8_SB(b, h) ((4 + (b) * 2 + (h)) * HTB)
#define PG8_STAGE(bufoff, gbase, voff) do { _Pragma("unroll") for (int _i = 0; _i < 2; ++_i) \
        __builtin_amdgcn_global_load_lds((const unsigned*)((const char*)(gbase) + (voff)[_i]), (LAS unsigned*)(lds + (bufoff) + ldsw + _i * 8192), 16, 0, 0); } while (0)
#define PG8_LDA(dst, b, h) do { _Pragma("unroll") for (int m = 0; m < 4; ++m) _Pragma("unroll") for (int k = 0; k < 2; ++k) dst[m][k] = *(const LAS bf16x8*)(lds + PG8_SA(b, h) + aoff + m * 2048 + k * 1024); } while (0)
#define PG8_LDB(dst, b, h) do { _Pragma("unroll") for (int n = 0; n < 2; ++n) _Pragma("unroll") for (int k = 0; k < 2; ++k) dst[n][k] = *(const LAS bf16x8*)(lds + PG8_SB(b, h) + boff + n * 2048 + k * 1024); } while (0)
#define PG8_MMA(ai, bj, At, Bt) do { __builtin_amdgcn_s_setprio(1); _Pragma("unroll") for (int m = 0; m < 4; ++m) _Pragma("unroll") for (int n = 0; n < 2; ++n) { \
        if constexpr (FP8) { const i32x8 bb_ = __builtin_shufflevector(__builtin_bit_cast(i32x4, Bt[n][0]), __builtin_bit_cast(i32x4, Bt[n][1]), 0, 1, 2, 3, 4, 5, 6, 7); \
            const i32x8 aa_ = __builtin_shufflevector(__builtin_bit_cast(i32x4, At[m][0]), __builtin_bit_cast(i32x4, At[m][1]), 0, 1, 2, 3, 4, 5, 6, 7); \
            asm volatile("v_mfma_scale_f32_16x16x128_f8f6f4 %0, %1, %2, %0, %3, %3 op_sel_hi:[0,0,0]" : "+v"(acc[ai][bj][m][n]) : "v"(bb_), "v"(aa_), "v"(one_scale)); } \
        else { _Pragma("unroll") for (int k = 0; k < 2; ++k) acc[ai][bj][m][n] = __builtin_amdgcn_mfma_f32_16x16x32_bf16(Bt[n][k], At[m][k], acc[ai][bj][m][n], 0, 0, 0); } } \
        __builtin_amdgcn_s_setprio(0); } while (0)
#define PG8_WAIT_V(n) asm volatile("s_waitcnt vmcnt(" #n ")" ::: "memory")
#define PG8_WAIT_L(n) asm volatile("s_waitcnt lgkmcnt(" #n ")" ::: "memory")
#define PG8_BAR __builtin_amdgcn_s_barrier()
#define PG8_SCHED __builtin_amdgcn_sched_barrier(0)
    Unit cur, nxt; int ui = 0;
    if (!S.next(0, cur)) return;
    f32x4 acc[2][2][4][2];
#pragma unroll
    for (int a = 0; a < 2; ++a)
#pragma unroll
        for (int b = 0; b < 2; ++b)
#pragma unroll
            for (int m = 0; m < 4; ++m)
#pragma unroll
                for (int n = 0; n < 2; ++n) acc[a][b][m][n] = (f32x4){0.f, 0.f, 0.f, 0.f};
    bf16x8 At[4][2], B0[2][2], B1[2][2];
    unsigned one_scale = 0x7F7F7F7Fu; asm volatile("" : "+v"(one_scale));
    unsigned vaC[2][2], vaN[2][2];
    S.rows(cur, vaC, Rr, Cc);
    const char* cA = S.abase(cur); const char* cB = S.bbase(cur);
    PG8_STAGE(PG8_SB(0, 0), cB, voffB); PG8_STAGE(PG8_SA(0, 0), cA, vaC[0]); PG8_STAGE(PG8_SB(0, 1), cB + hstep, voffB); PG8_STAGE(PG8_SA(0, 1), cA, vaC[1]);
    if (wr == 1) PG8_BAR;
    PG8_WAIT_V(4); PG8_BAR;
    PG8_STAGE(PG8_SB(1, 0), cB + kstep, voffB); PG8_STAGE(PG8_SA(1, 0), cA + kstep, vaC[0]); PG8_STAGE(PG8_SB(1, 1), cB + hstep + kstep, voffB);
    PG8_WAIT_V(6); PG8_BAR;
    for (;;) {
        const bool has_next = S.next(ui + 1, nxt);
        const char* nA = has_next ? S.abase(nxt) : cA; const char* nB = has_next ? S.bbase(nxt) : cB;
#pragma unroll
        for (int h = 0; h < 2; ++h)
#pragma unroll
            for (int i = 0; i < 2; ++i) vaN[h][i] = vaC[h][i];
        for (int t = 0; t < nt; t += 2) {
            const bool last = (t == nt - 2);
            const char* a1 = cA + (size_t)(t + 1) * kstep;
            const char* a2 = last ? nA : cA + (size_t)(t + 2) * kstep; const char* b2 = last ? nB : cB + (size_t)(t + 2) * kstep;
            const char* a3 = a2 + kstep; const char* b3 = b2 + kstep;
            if (last && has_next) S.rows(nxt, vaN, Rr, Cc);
            unsigned v2[2][2];
#pragma unroll
            for (int h = 0; h < 2; ++h)
#pragma unroll
                for (int i = 0; i < 2; ++i) v2[h][i] = last ? vaN[h][i] : vaC[h][i];
            PG8_LDB(B0, 0, 0); PG8_SCHED; PG8_LDA(At, 0, 0); PG8_STAGE(PG8_SA(1, 1), a1, vaC[1]);
            PG8_WAIT_L(8); PG8_BAR; PG8_WAIT_L(0); PG8_MMA(0, 0, At, B0); PG8_BAR; PG8_SCHED;
            PG8_LDB(B1, 0, 1); PG8_STAGE(PG8_SB(0, 0), b2, voffB);
            PG8_BAR; PG8_WAIT_L(0); PG8_MMA(0, 1, At, B1); PG8_BAR;
            PG8_LDA(At, 0, 1); PG8_STAGE(PG8_SA(0, 0), a2, v2[0]);
            PG8_BAR; PG8_WAIT_L(0); PG8_MMA(1, 0, At, B0); PG8_BAR; PG8_SCHED;
            PG8_STAGE(PG8_SB(0, 1), b2 + hstep, voffB);
            PG8_WAIT_V(6); PG8_BAR; PG8_MMA(1, 1, At, B1); PG8_BAR;
            PG8_LDB(B0, 1, 0); PG8_SCHED; PG8_LDA(At, 1, 0); PG8_STAGE(PG8_SA(0, 1), a2, v2[1]);
            PG8_WAIT_L(8); PG8_BAR; PG8_WAIT_L(0); PG8_MMA(0, 0, At, B0); PG8_BAR; PG8_SCHED;
            PG8_LDB(B1, 1, 1); PG8_STAGE(PG8_SB(1, 0), b3, voffB);
            PG8_BAR; PG8_WAIT_L(0); PG8_MMA(0, 1, At, B1); PG8_BAR;
            PG8_LDA(At, 1, 1); PG8_STAGE(PG8_SA(1, 0), a3, v2[0]);
            PG8_BAR; PG8_WAIT_L(0); PG8_MMA(1, 0, At, B0); PG8_BAR; PG8_SCHED;
            PG8_STAGE(PG8_SB(1, 1), b3 + hstep, voffB);
            PG8_WAIT_V(6); PG8_BAR; PG8_MMA(1, 1, At, B1); PG8_BAR;
        }
        if constexpr (FP8) asm volatile("s_nop 15\n\ts_nop 15" ::: "memory");
        E(acc, cur, wr, wc, fr, fq);
        if (!has_next) break;
#pragma unroll
        for (int a = 0; a < 2; ++a)
#pragma unroll
            for (int b = 0; b < 2; ++b)
#pragma unroll
                for (int m = 0; m < 4; ++m)
#pragma unroll
                    for (int n = 0; n < 2; ++n) acc[a][b][m][n] = (f32x4){0.f, 0.f, 0.f, 0.f};
        cur = nxt; cA = nA; cB = nB; ++ui;
#pragma unroll
        for (int h = 0; h < 2; ++h)
#pragma unroll
            for (int i = 0; i < 2; ++i) vaC[h][i] = vaN[h][i];
    }
    PG8_WAIT_V(0);
    if (wr == 0) PG8_BAR;
    PG8_BAR;
#undef PG8_SA
#undef PG8_SB
#undef PG8_STAGE
#undef PG8_LDA
#undef PG8_LDB
#undef PG8_MMA
#undef PG8_WAIT_V
#undef PG8_WAIT_L
#undef PG8_BAR
#undef PG8_SCHED
}

template <bool HAS_BIAS> struct EpiStoreBf16 {
    static constexpr bool PERM = true;
    bf16_t* O; int ldc; const float* bias; int bias_estride; float sc;
    __device__ __forceinline__ void operator()(const f32x4 (&acc)[2][2][4][2], const Unit& u, int wr, int wc, int fr, int fq) const {
        const int row0 = u.pm * BM + wr * 64 + fr, col0 = u.pn * BM + wc * 32 + 8 * fq;
        f32x4 bv[2][2];
#pragma unroll
        for (int bj = 0; bj < 2; ++bj)
#pragma unroll
            for (int n = 0; n < 2; ++n) { if constexpr (HAS_BIAS) bv[bj][n] = *(const f32x4*)(bias + (size_t)u.e * bias_estride + col0 + bj * HALF + 4 * n); else bv[bj][n] = (f32x4){0.f, 0.f, 0.f, 0.f}; }
#pragma unroll
        for (int ai = 0; ai < 2; ++ai)
#pragma unroll
            for (int m = 0; m < 4; ++m) { bf16_t* rowp = O + (size_t)(row0 + ai * HALF + m * 16) * ldc + col0;
#pragma unroll
                for (int bj = 0; bj < 2; ++bj) { const f32x4 v0 = acc[ai][bj][m][0] * sc + bv[bj][0], v1 = acc[ai][bj][m][1] * sc + bv[bj][1];
                    u32x4 w; w.x = cvt_pk_bf16(v0[0], v0[1]); w.y = cvt_pk_bf16(v0[2], v0[3]); w.z = cvt_pk_bf16(v1[0], v1[1]); w.w = cvt_pk_bf16(v1[2], v1[3]);
                    *(u32x4*)(rowp + bj * HALF) = w; } }
    }
};
struct EpiStoreFp8 {
    static constexpr bool PERM = true;
    unsigned char* O; int ldc; float sc;
    __device__ __forceinline__ void operator()(const f32x4 (&acc)[2][2][4][2], const Unit& u, int wr, int wc, int fr, int fq) const {
        const int row0 = u.pm * BM + wr * 64 + fr, col0 = u.pn * BM + wc * 32 + 8 * fq;
#pragma unroll
        for (int ai = 0; ai < 2; ++ai)
#pragma unroll
            for (int m = 0; m < 4; ++m) { unsigned char* rowp = O + (size_t)(row0 + ai * HALF + m * 16) * ldc + col0;
#pragma unroll
                for (int bj = 0; bj < 2; ++bj) { const f32x4 v0 = acc[ai][bj][m][0] * sc, v1 = acc[ai][bj][m][1] * sc;
                    u32x2 w; w.x = pk4_fp8(v0[0], v0[1], v0[2], v0[3]); w.y = pk4_fp8(v1[0], v1[1], v1[2], v1[3]);
                    *(u32x2*)(rowp + bj * HALF) = w; } }
    }
};
struct EpiGlu {
    static constexpr bool PERM = true;
    const bf16_t* Yg; bf16_t* O; const float* bias;
    __device__ __forceinline__ void operator()(const f32x4 (&acc)[2][2][4][2], const Unit& u, int wr, int wc, int fr, int fq) const {
        const int row0 = u.pm * BM + wr * 64 + fr, col0 = u.pn * BM + wc * 32 + 8 * fq;
        f32x4 bv[2][2];
#pragma unroll
        for (int bj = 0; bj < 2; ++bj)
#pragma unroll
            for (int n = 0; n < 2; ++n) bv[bj][n] = *(const f32x4*)(bias + col0 + bj * HALF + 4 * n);
#pragma unroll
        for (int ai = 0; ai < 2; ++ai)
#pragma unroll
            for (int m = 0; m < 4; ++m) { const size_t r = (size_t)(row0 + ai * HALF + m * 16);
#pragma unroll
                for (int bj = 0; bj < 2; ++bj) { const f32x4 v0 = acc[ai][bj][m][0] + bv[bj][0], v1 = acc[ai][bj][m][1] + bv[bj][1];
                    const u32x4 y = *(const u32x4*)(Yg + r * S5W + col0 + bj * HALF);
                    float o[8];
                    o[0] = bflo(y.x) * sigm(v0[0]); o[1] = bfhi(y.x) * sigm(v0[1]); o[2] = bflo(y.y) * sigm(v0[2]); o[3] = bfhi(y.y) * sigm(v0[3]);
                    o[4] = bflo(y.z) * sigm(v1[0]); o[5] = bfhi(y.z) * sigm(v1[1]); o[6] = bflo(y.w) * sigm(v1[2]); o[7] = bfhi(y.w) * sigm(v1[3]);
                    u32x4 w; w.x = cvt_pk_bf16(o[0], o[1]); w.y = cvt_pk_bf16(o[2], o[3]); w.z = cvt_pk_bf16(o[4], o[5]); w.w = cvt_pk_bf16(o[6], o[7]);
                    *(u32x4*)(O + r * D + col0 + bj * HALF) = w; } }
    }
};
struct EpiResid {
    static constexpr bool PERM = false;
    const float* X; float* O; const float* mod;
    __device__ __forceinline__ void operator()(const f32x4 (&acc)[2][2][4][2], const Unit& u, int wr, int wc, int fr, int fq) const {
        const int row0 = u.pm * BM + wr * 64 + fr, col0 = u.pn * BM + wc * 32 + 4 * fq, b = u.pm >> 3;
        f32x4 gv[2][2];
#pragma unroll
        for (int bj = 0; bj < 2; ++bj)
#pragma unroll
            for (int n = 0; n < 2; ++n) { const int c = col0 + bj * HALF + n * 16; gv[bj][n] = *(const f32x4*)(mod + (size_t)b * 12288 + 2 * D + c); }
#pragma unroll
        for (int ai = 0; ai < 2; ++ai)
#pragma unroll
            for (int m = 0; m < 4; ++m) { const size_t off = (size_t)(row0 + ai * HALF + m * 16) * D + col0;
#pragma unroll
                for (int bj = 0; bj < 2; ++bj)
#pragma unroll
                    for (int n = 0; n < 2; ++n) { const f32x4 xv = *(const f32x4*)(X + off + bj * HALF + n * 16); *(f32x4*)(O + off + bj * HALF + n * 16) = xv + gv[bj][n] * acc[ai][bj][m][n]; } }
    }
};
struct EpiSwiglu {
    static constexpr bool PERM = true;
    unsigned char* O; const float* bias; float sc;
    __device__ __forceinline__ void operator()(const f32x4 (&acc)[2][2][4][2], const Unit& u, int wr, int wc, int fr, int fq) const {
        const int row0 = u.pm * BM + wr * 64 + fr, j0 = wc * 32 + 8 * fq, cb = u.pn * HALF + j0;
        f32x4 bg[2], bu[2];
#pragma unroll
        for (int n = 0; n < 2; ++n) { bg[n] = *(const f32x4*)(bias + (size_t)u.e * 4096 + cb + 4 * n); bu[n] = *(const f32x4*)(bias + (size_t)u.e * 4096 + 2048 + cb + 4 * n); }
#pragma unroll
        for (int ai = 0; ai < 2; ++ai)
#pragma unroll
            for (int m = 0; m < 4; ++m) { float o[8];
#pragma unroll
                for (int n = 0; n < 2; ++n)
#pragma unroll
                    for (int e = 0; e < 4; ++e) { float g = acc[ai][0][m][n][e] * sc + bg[n][e], uu = acc[ai][1][m][n][e] * sc + bu[n][e];
                        g = fminf(g, 7.0f); uu = fminf(fmaxf(uu, -7.0f), 7.0f);
                        o[4 * n + e] = (uu + 1.0f) * (g * sigm(1.702f * g)); }
                u32x2 w; w.x = pk4_fp8(o[0], o[1], o[2], o[3]); w.y = pk4_fp8(o[4], o[5], o[6], o[7]);
                *(u32x2*)(O + (size_t)(row0 + ai * HALF + m * 16) * DFF + cb) = w; }
    }
};
}

#define FI __device__ __forceinline__

FI void transpose_item(const float* W, int K, int N, bf16_t* WT, int row_off, LAS float* scr, int kb, int nb, int lane) {
    const int k0 = 64 * kb, n0 = 32 * nb;
#pragma unroll 8
    for (int i = 0; i < 32; ++i) { const int kk = 2 * i + (lane >> 5); scr[kk * 33 + (lane & 31)] = W[(size_t)(k0 + kk) * N + n0 + (lane & 31)]; }
    LDS_WAIT(); asm volatile("" ::: "memory");
    const int c = lane & 7;
#pragma unroll
    for (int j = 0; j < 4; ++j) { const int n = (lane >> 3) + 8 * j; const LAS float* s = scr + (8 * c) * 33 + n;
        u32x4 o; o.x = pk2(s[0 * 33], s[1 * 33]); o.y = pk2(s[2 * 33], s[3 * 33]); o.z = pk2(s[4 * 33], s[5 * 33]); o.w = pk2(s[6 * 33], s[7 * 33]);
        *(u32x4*)(WT + (size_t)(row_off + n0 + n) * K + k0 + 8 * c) = o; }
    LDS_WAIT(); asm volatile("" ::: "memory");
}

FI void transpose_item_fp8(const float* W, int K, int N, unsigned char* WT, int row_off, LAS float* scr, int kb, int nb, int lane, float scale) {
    const int k0 = 64 * kb, n0 = 32 * nb;
#pragma unroll 8
    for (int i = 0; i < 32; ++i) { const int kk = 2 * i + (lane >> 5); scr[kk * 33 + (lane & 31)] = W[(size_t)(k0 + kk) * N + n0 + (lane & 31)]; }
    LDS_WAIT(); asm volatile("" ::: "memory");
    const int n = lane & 31, hf = lane >> 5; const LAS float* s = scr + (32 * hf) * 33 + n;
    u32x4 o0, o1;
    o0.x = pk4_fp8(s[0 * 33] * scale, s[1 * 33] * scale, s[2 * 33] * scale, s[3 * 33] * scale); o0.y = pk4_fp8(s[4 * 33] * scale, s[5 * 33] * scale, s[6 * 33] * scale, s[7 * 33] * scale);
    o0.z = pk4_fp8(s[8 * 33] * scale, s[9 * 33] * scale, s[10 * 33] * scale, s[11 * 33] * scale); o0.w = pk4_fp8(s[12 * 33] * scale, s[13 * 33] * scale, s[14 * 33] * scale, s[15 * 33] * scale);
    o1.x = pk4_fp8(s[16 * 33] * scale, s[17 * 33] * scale, s[18 * 33] * scale, s[19 * 33] * scale); o1.y = pk4_fp8(s[20 * 33] * scale, s[21 * 33] * scale, s[22 * 33] * scale, s[23 * 33] * scale);
    o1.z = pk4_fp8(s[24 * 33] * scale, s[25 * 33] * scale, s[26 * 33] * scale, s[27 * 33] * scale); o1.w = pk4_fp8(s[28 * 33] * scale, s[29 * 33] * scale, s[30 * 33] * scale, s[31 * 33] * scale);
    unsigned char* dst = WT + (size_t)(row_off + n0 + n) * K + k0 + 32 * hf;
    *(u32x4*)dst = o0; *(u32x4*)(dst + 16) = o1;
    LDS_WAIT(); asm volatile("" ::: "memory");
}

FI void tr8_item(const float* W, int N, int K, unsigned char* WT, int row_off, LAS unsigned char* T, int k0, int n0, int lane, float scale) {
    const int nq = lane & 15, kr = lane >> 4;
    const float* src = W + (size_t)(k0 + 4 * kr) * N + n0 + 4 * nq;
#pragma unroll
    for (int rg = 0; rg < 8; ++rg) {
        f32x4 v[4];
#pragma unroll
        for (int j = 0; j < 4; ++j) v[j] = *(const f32x4*)(src + (size_t)(rg * 16 + j) * N) * scale;
#pragma unroll
        for (int i = 0; i < 4; ++i) *(LAS unsigned*)(T + (4 * nq + i) * 128 + ((rg ^ (nq & 7)) << 4) + kr * 4) = pk4_fp8(v[0][i], v[1][i], v[2][i], v[3][i]);
    }
    LDS_WAIT(); asm volatile("" ::: "memory");
#pragma unroll
    for (int t = 0; t < 8; ++t) { const int n = 8 * t + (lane >> 3), p = lane & 7;
        const u32x4 o = *(const LAS u32x4*)(T + n * 128 + ((p ^ ((n >> 2) & 7)) << 4));
        *(u32x4*)(WT + (size_t)(row_off + n0 + n) * K + k0 + 16 * p) = o; }
    LDS_WAIT(); asm volatile("" ::: "memory");
}
FI void moe_weight_item(const Args& A, LAS unsigned char* T, int q, int lane) {
    unsigned char* ws = A.ws;
    if (q < 32768) { const int e = q >> 10, r = q & 1023, kb = r >> 6, nb = r & 63, n0 = 64 * nb;
        const int isU = n0 / 2048, pn = (n0 % 2048) / 128, j = n0 % 128, rowmap = 256 * pn + 128 * isU + j;
        tr8_item(A.in[34] + (size_t)e * D * 4096, 4096, D, ws + WS_WGU + (size_t)e * 4096 * D, rowmap - n0, T, 128 * kb, n0, lane, WSCALE); }
    else { const int q2 = q - 32768, e = q2 >> 9, r = q2 & 511, kb = r >> 5, nb = r & 31;
        tr8_item(A.in[36] + (size_t)e * DFF * D, D, DFF, ws + WS_WDN + (size_t)e * D * DFF, 0, T, 128 * kb, 64 * nb, lane, WSCALE); }
}

FI void p0_run(const Args& A, LAS unsigned char* lds, int tid, int lane, int wave, int vcu, int G) {
    unsigned char* ws = A.ws;
    unsigned long long* mod = (unsigned long long*)((unsigned*)(ws + WS_CTL) + CW_MOD); unsigned long long* hnorm = (unsigned long long*)((unsigned*)(ws + WS_CTL) + CW_HNORM);
    {
        LAS float* sl = (LAS float*)lds;
        LAS float* part = (LAS float*)(lds + 9 * 512 * 4);
        const float* c = A.in[1]; const float* cc = A.in[3]; const float* wada = A.in[4];
        _Pragma("unroll 1") for (int rep = 0; rep < REP0A; ++rep)
        for (int it = vcu; it < 192; it += G) {
            const int cg = it % 48, kq = it / 48, n0 = cg * 256 + 4 * lane, k0 = kq * 512;
            for (int i = tid; i < 9 * 512; i += NTHR) { const int r = i >> 9, k = k0 + (i & 511); const float v = r < 8 ? c[r * D + k] : cc[k]; sl[i] = v / (1.f + __expf(-v)); }
            __syncthreads();
            f32x4 acc[9];
#pragma unroll
            for (int r = 0; r < 9; ++r) acc[r] = (f32x4){0.f, 0.f, 0.f, 0.f};
#pragma unroll 8
            for (int kk = 0; kk < 64; ++kk) { const int kl = wave * 64 + kk; const f32x4 w = *(const f32x4*)(wada + (size_t)(k0 + kl) * 12288 + n0);
#pragma unroll
                for (int r = 0; r < 9; ++r) { const float sv = sl[r * 512 + kl]; acc[r] += w * sv; } }
#pragma unroll
            for (int r = 0; r < 9; ++r) *(LAS f32x4*)(part + (wave * 9 + r) * 256 + 4 * lane) = acc[r];
            __syncthreads();
            for (int i = tid; i < 9 * 256; i += NTHR) { const int r = i >> 8, col = i & 255; float sum = 0.f;
#pragma unroll
                for (int w = 0; w < 8; ++w) sum += part[(w * 9 + r) * 256 + col];
                fix_add(mod + r * 12288 + cg * 256 + col, rep == REP0A - 1 ? sum : 0.0f); }
            __syncthreads();
        }
    }
    {
        LAS float* L = (LAS float*)lds;
        LAS float *w1s = L, *w2s = L + 2112, *w3s = L + 6208, *b1s = L + 10304, *b2s = L + 10368, *b3s = L + 10432, *fqs = L + 10496, *zs = L + 10560, *h1 = L + 10824, *h2 = L + 11336, *h3 = L + 11848;
        for (int i = tid; i < 33 * 64; i += NTHR) w1s[i] = A.in[21][i];
        for (int i = tid; i < 4096; i += NTHR) { w2s[i] = A.in[23][i]; w3s[i] = A.in[25][i]; }
        if (tid < 64) { b1s[tid] = A.in[22][tid]; b2s[tid] = A.in[24][tid]; b3s[tid] = A.in[26][tid]; fqs[tid] = A.in[28][tid]; }
        __syncthreads();
        const float* w4 = A.in[27]; const float* dl = A.in[29]; float* hraw = (float*)(ws + WS_HRAW);
        for (int item = vcu; item < 256; item += G) {
            const int l0 = item * 8;
            if (tid < 264) { const int r = tid / 33, i = tid % 33, l = l0 + r; float z;
                if (i == 0) z = (float)l / 2047.0f;
                else { const int j = (i - 1) & 15; const float band = 1e-4f + (float)j * ((15.0f - 1e-4f) / 15.0f); const float ang = (6.283185307179586f / 2048.0f) * (float)l * band; z = (i <= 16) ? cosf(ang) : -sinf(ang); }
                zs[tid] = z; }
            __syncthreads();
            const int r = tid >> 6, o = tid & 63;
            { float s = b1s[o]; for (int i = 0; i < 33; ++i) s += zs[r * 33 + i] * w1s[i * 64 + o]; h1[r * 64 + o] = sinf(fqs[o] * s); }
            __syncthreads();
            { float s = b2s[o]; for (int i = 0; i < 64; ++i) s += h1[r * 64 + i] * w2s[i * 64 + o]; h2[r * 64 + o] = sinf(fqs[o] * s); }
            __syncthreads();
            { float s = b3s[o]; for (int i = 0; i < 64; ++i) s += h2[r * 64 + i] * w3s[i * 64 + o]; h3[r * 64 + o] = sinf(fqs[o] * s); }
            __syncthreads();
            f32x4 acc[8];
#pragma unroll
            for (int q = 0; q < 8; ++q) acc[q] = (f32x4){0.f, 0.f, 0.f, 0.f};
#pragma unroll 4
            for (int i = 0; i < 64; ++i) { const f32x4 w = *(const f32x4*)(w4 + (size_t)i * 2048 + 4 * tid);
#pragma unroll
                for (int q = 0; q < 8; ++q) acc[q] += w * h3[q * 64 + i]; }
            const f32x4 dv = *(const f32x4*)(dl + 4 * tid);
            f32x4 asum = (f32x4){0.f, 0.f, 0.f, 0.f};
#pragma unroll
            for (int q = 0; q < 8; ++q) { const int l = l0 + q; const float t = (float)l / 2047.0f; f32x4 v;
#pragma unroll
                for (int e = 0; e < 4; ++e) v[e] = acc[q][e] * expf(-t * fabsf(dv[e]));
                *(f32x4*)(hraw + (size_t)l * 2048 + 4 * tid) = v;
                if (!(l == 2047 && 4 * tid >= 1024)) {
#pragma unroll
                    for (int e = 0; e < 4; ++e) asum[e] += fabsf(v[e]); } }
#pragma unroll
            for (int e = 0; e < 4; ++e) fix_add(hnorm + 4 * tid + e, asum[e]);
            __syncthreads();
        }
    }
    {
        const float *lre = A.in[9], *lim = A.in[10], *lst = A.in[11], *bre = A.in[12], *bim = A.in[13], *cre = A.in[14], *cim = A.in[15];
        float* LAM = (float*)(ws + WS_LAM); float* LAML = (float*)(ws + WS_LAML); bf16_t* SB = (bf16_t*)(ws + WS_S5B); bf16_t* SC = (bf16_t*)(ws + WS_S5C);
        for (int idx = vcu * NTHR + tid; idx < 2 * 64 * 4 * 64; idx += G * NTHR) {
            const int ln = idx & 63, T = (idx >> 6) & 3, g = (idx >> 8) & 63, d = idx >> 14;
            {
                const int n = ln & 31, hq = ln >> 5, p = n + 32 * (T >> 1), part = T & 1;
                const int q = (d * 64 + g) * 64 + p;
                const float lr = fminf(lre[q], -1e-4f), li = lim[q], dt = expf(lst[q]), zr = lr * dt, zi = li * dt, er = expf(zr), br = er * cosf(zi), bi = er * sinf(zi);
                const float den = lr * lr + li * li, cr = ((br - 1.f) * lr + bi * li) / den, ci = (bi * lr - (br - 1.f) * li) / den;
                float v[8];
#pragma unroll
                for (int j = 0; j < 8; ++j) { const int h = 8 * hq + j; const float xr = bre[(size_t)q * 16 + h], xi = bim[(size_t)q * 16 + h]; v[j] = part ? (cr * xi + ci * xr) : (cr * xr - ci * xi); }
                u32x4 w; w.x = pk2(v[0], v[1]); w.y = pk2(v[2], v[3]); w.z = pk2(v[4], v[5]); w.w = pk2(v[6], v[7]);
                *(u32x4*)(SB + (size_t)idx * 8) = w;
                if (part == 0 && hq == 0) { LAM[q * 2] = br; LAM[q * 2 + 1] = bi; const float eL = expf((float)SEG * zr), aL = (float)SEG * zi; LAML[q * 2] = eL * cosf(aL); LAML[q * 2 + 1] = eL * sinf(aL); }
            }
            {
                const int hc = ln & 15, qq = ln >> 4; float v[8];
#pragma unroll
                for (int j = 0; j < 8; ++j) { const int k = 32 * T + 8 * qq + j, n = k >> 2, TT = k & 3, p = n + 32 * (TT >> 1), part = TT & 1; const size_t ci = ((size_t)(d * 64 + g) * 16 + hc) * 64 + p; v[j] = part ? -cim[ci] : cre[ci]; }
                u32x4 w; w.x = pk2(v[0], v[1]); w.y = pk2(v[2], v[3]); w.z = pk2(v[4], v[5]); w.w = pk2(v[6], v[7]);
                *(u32x4*)(SC + (size_t)idx * 8) = w;
            }
        }
    }
    {
        const float* wrt = A.in[32]; bf16_t* WRF = (bf16_t*)(ws + WS_WRF);
        for (int idx = vcu * NTHR + tid; idx < 64 * 2 * 64; idx += G * NTHR) {
            const int ln = idx & 63, nt = (idx >> 6) & 1, ks = idx >> 7, ex = 16 * nt + (ln & 15), k0 = 32 * ks + 8 * (ln >> 4);
            float v[8], rsd[8];
#pragma unroll
            for (int j = 0; j < 8; ++j) { v[j] = wrt[(size_t)(k0 + j) * NE + ex]; rsd[j] = v[j] - bf1((bf16_t)f2bf(v[j])); }
            u32x4 hi, lo; hi.x = pk2(v[0], v[1]); hi.y = pk2(v[2], v[3]); hi.z = pk2(v[4], v[5]); hi.w = pk2(v[6], v[7]);
            lo.x = pk2(rsd[0], rsd[1]); lo.y = pk2(rsd[2], rsd[3]); lo.z = pk2(rsd[4], rsd[5]); lo.w = pk2(rsd[6], rsd[7]);
            *(u32x4*)(WRF + ((size_t)((ks * 2 + nt) * 2 + 0) * 64 + ln) * 8) = hi;
            *(u32x4*)(WRF + ((size_t)((ks * 2 + nt) * 2 + 1) * 64 + ln) * 8) = lo;
        }
    }
    {
        __syncthreads();
        LAS float* scr = (LAS float*)(lds + wave * 16384);
        const int gw = vcu * NWAVES + wave, NGW = G * NWAVES;
        constexpr int I_IN = 32 * 128, I_GLU = 16 * 32, I_OUT = 32 * 64;
        constexpr int NITEMS = I_IN + I_GLU + I_OUT;
        for (int it = gw; it < NITEMS; it += NGW) {
            int r = it;
            if (r < I_IN) { transpose_item(A.in[8], D, DIN, (bf16_t*)(ws + WS_WIN), 0, scr, r / 128, r % 128, lane); continue; } r -= I_IN;
            if (r < I_GLU) { transpose_item(A.in[17], S5W, S5W, (bf16_t*)(ws + WS_WGLU), 0, scr, r / 32, r % 32, lane); continue; } r -= I_GLU;
            transpose_item(A.in[31], D, D, (bf16_t*)(ws + WS_WOUT), 0, scr, r / 64, r % 64, lane);
        }
    }
}
#ifndef P0_SPLIT_ITEMS
#define P0_SPLIT_ITEMS 28000
#endif
FI void p0d_run(const Args& A, LAS unsigned char* lds, int lane, int wave, int q0, int q1, int vcu, int G) {
    const int gw = vcu * NWAVES + wave, NGW = G * NWAVES;
    _Pragma("unroll 1") for (int rep = 0; rep < REP0D; ++rep)
    for (int q = q0 + gw; q < q1; q += NGW) moe_weight_item(A, lds + wave * 16384, q, lane);
}

FI void p1_run(const Args& A, int tid, int lane, int wave, int vcu, int G, int m0, int m1, bool extras) {
    unsigned char* ws = A.ws;
    const unsigned long long* mod = (const unsigned long long*)((const unsigned*)(ws + WS_CTL) + CW_MOD); const unsigned long long* hnorm = (const unsigned long long*)((const unsigned*)(ws + WS_CTL) + CW_HNORM);
    const float* bada = A.in[5]; const float* g1 = A.in[6];
    bf16_t* A1 = (bf16_t*)(ws + WS_A1);
    const int gw = vcu * NWAVES + wave, NGW = G * NWAVES;
    if (extras) { float* modf = (float*)(ws + WS_MODF); for (int i = vcu * NTHR + tid; i < 9 * 12288; i += G * NTHR) modf[i] = fix_get(mod + i) + bada[i % 12288]; }
    for (int m = m0 + gw; m < m1; m += NGW) {
        const float* src = m < M ? A.in[0] + (size_t)m * D : A.in[2] + (size_t)(m - M) * D;
        const int mr = m < M ? m / SEQ : 8;
        f32x4 v[8]; float ss = 0.f;
#pragma unroll
        for (int j = 0; j < 8; ++j) { v[j] = *(const f32x4*)(src + 4 * lane + 256 * j); ss += (v[j].x * v[j].x + v[j].y * v[j].y) + (v[j].z * v[j].z + v[j].w * v[j].w); }
        const float rstd = rsqrtf(wave_sum(ss) * (1.0f / D) + 1e-6f);
#pragma unroll
        for (int j = 0; j < 8; ++j) { const int c = 4 * lane + 256 * j;
            const f32x4 gv = *(const f32x4*)(g1 + c);
            const unsigned long long* mp = mod + (size_t)mr * 12288 + c;
            const f32x4 sh = (f32x4){fix_get(mp), fix_get(mp + 1), fix_get(mp + 2), fix_get(mp + 3)} + *(const f32x4*)(bada + c);
            const f32x4 sc = (f32x4){fix_get(mp + D), fix_get(mp + D + 1), fix_get(mp + D + 2), fix_get(mp + D + 3)} + *(const f32x4*)(bada + D + c);
            const f32x4 h = v[j] * rstd * gv * (sc + 1.0f) + sh;
            u32x2 w; w.x = pk2(h.x, h.y); w.y = pk2(h.z, h.w);
            *(u32x2*)(A1 + (size_t)m * D + c) = w; }
    }
    const float* hraw = (const float*)(ws + WS_HRAW); bf16_t* Rg = (bf16_t*)(ws + WS_RG);
    if (extras)
    for (int it = gw; it < 512 * 16; it += NGW) {
        const int ib = it >> 4, c = (it & 15) * 64 + lane;
        const float inv = 1.0f / (fix_get(hnorm + c) + fix_get(hnorm + HYW + c));
        float v[8];
#pragma unroll
        for (int jj = 0; jj < 8; ++jj) { const int i = 8 * ib + jj; float x;
            if (i <= 2047) x = hraw[(size_t)(2047 - i) * 2048 + c]; else if (i <= 4094) x = hraw[(size_t)(i - 2048) * 2048 + HYW + c]; else x = 0.f;
            v[jj] = x * inv; }
        u32x4 w; w.x = pk2(v[0], v[1]); w.y = pk2(v[2], v[3]); w.z = pk2(v[4], v[5]); w.w = pk2(v[6], v[7]);
        *(u32x4*)(Rg + (size_t)c * 4096 + 8 * ib) = w;
    }
}

FI void s5_unit(const Args& A, LAS unsigned char* lds, int unit, int lane, int wave) {
    unsigned char* ws = A.ws;
    const int d = unit & 1, g = (unit >> 1) & 63, bp = unit >> 7, dg = d * 64 + g;
    const bf16_t* P = (const bf16_t*)(ws + WS_P); bf16_t* Ys = (bf16_t*)(ws + WS_YS5);
    bf16x8 Bf[4], Cf[4];
#pragma unroll
    for (int T = 0; T < 4; ++T) { Bf[T] = *(const bf16x8*)((const bf16_t*)(ws + WS_S5B) + ((size_t)(dg * 4 + T) * 64 + lane) * 8); Cf[T] = *(const bf16x8*)((const bf16_t*)(ws + WS_S5C) + ((size_t)(dg * 4 + T) * 64 + lane) * 8); }
    const int n = lane & 31, hh = lane >> 5;
    const float* LAM = (const float*)(ws + WS_LAM) + (size_t)dg * 128; const float* LAML = (const float*)(ws + WS_LAML) + (size_t)dg * 128;
    const float lr0 = LAM[n * 2], li0 = LAM[n * 2 + 1], lr1 = LAM[(n + 32) * 2], li1 = LAM[(n + 32) * 2 + 1];
    const int r = lane & 31, bsel = (r >> 2) & 1, tau = (r & 3) + 4 * (r >> 3), b = 2 * bp + bsel, kofs = g * 16 + 8 * (lane >> 5);
    const int seg0 = wave * SEG;
    auto rowp = [&](int pos) -> const bf16_t* {
        int row; if (pos < CTXL) { const int tc = d ? (CTXL - 1 - pos) : pos; row = M + b * CTXL + tc; } else { const int q = pos - CTXL; const int tl = d ? (SEQ - 1 - q) : q; row = b * SEQ + tl; }
        return P + (size_t)row * DIN + kofs; };
    const f32x16 z16 = {0.f, 0.f, 0.f, 0.f, 0.f, 0.f, 0.f, 0.f, 0.f, 0.f, 0.f, 0.f, 0.f, 0.f, 0.f, 0.f};
    float xr0 = 0.f, xi0 = 0.f, xr1 = 0.f, xi1 = 0.f;
#define S5_FMA(dst, a, b, c) asm volatile("v_fma_f32 %0, %1, %2, %3" : "=v"(dst) : "v"(a), "v"(b), "v"(c))
#define S5_SETTLE(c0, c1, c2, c3) asm volatile("s_nop 15\n\ts_nop 7" : "+v"(c0), "+v"(c1), "+v"(c2), "+v"(c3))
#define S5_TOKEN(tt, R0, I0, R1, I1) do { float t0_, t1_, s0_, s1_; \
        S5_FMA(t0_, nli0, xi0, c0[tt]); S5_FMA(t1_, nli1, xi1, c2[tt]); S5_FMA(s0_, li0, xr0, c1[tt]); S5_FMA(s1_, li1, xr1, c3[tt]); \
        S5_FMA(R0, lr0, xr0, t0_); S5_FMA(R1, lr1, xr1, t1_); S5_FMA(I0, lr0, xi0, s0_); S5_FMA(I1, lr1, xi1, s1_); \
        xr0 = R0; xi0 = I0; xr1 = R1; xi1 = I1; } while (0)
    const float nli0 = -li0, nli1 = -li1;
    {
        bf16x8 uc[3], un[3];
#pragma unroll
        for (int q = 0; q < 3; ++q) { uc[q] = *(const bf16x8*)rowp(seg0 + 16 * q + tau); un[q] = uc[q]; }
#pragma unroll 1
        for (int ch = 0; ch < 6; ++ch) {
            if (ch < 5) {
#pragma unroll
                for (int q = 0; q < 3; ++q) un[q] = *(const bf16x8*)rowp(seg0 + 16 * (3 * (ch + 1) + q) + tau); }
#pragma unroll
            for (int q = 0; q < 3; ++q) {
                f32x16 c0 = __builtin_amdgcn_mfma_f32_32x32x16_bf16(uc[q], Bf[0], z16, 0, 0, 0), c1 = __builtin_amdgcn_mfma_f32_32x32x16_bf16(uc[q], Bf[1], z16, 0, 0, 0);
                f32x16 c2 = __builtin_amdgcn_mfma_f32_32x32x16_bf16(uc[q], Bf[2], z16, 0, 0, 0), c3 = __builtin_amdgcn_mfma_f32_32x32x16_bf16(uc[q], Bf[3], z16, 0, 0, 0);
                S5_SETTLE(c0, c1, c2, c3);
#pragma unroll
                for (int tt = 0; tt < 16; ++tt) { float r0_, i0_, r1_, i1_; S5_TOKEN(tt, r0_, i0_, r1_, i1_); }
            }
#pragma unroll
            for (int q = 0; q < 3; ++q) uc[q] = un[q];
        }
    }
    LAS float* Es = (LAS float*)(lds + 8 * 8704);
    *(LAS f32x4*)(Es + (wave * 64 + lane) * 4) = (f32x4){xr0, xi0, xr1, xi1};
    __syncthreads();
    {
        const float Lr0 = LAML[n * 2], Li0 = LAML[n * 2 + 1], Lr1 = LAML[(n + 32) * 2], Li1 = LAML[(n + 32) * 2 + 1];
        xr0 = 0.f; xi0 = 0.f; xr1 = 0.f; xi1 = 0.f;
#pragma unroll 1
        for (int w = 0; w < wave; ++w) { const f32x4 e = *(LAS f32x4*)(Es + (w * 64 + lane) * 4);
            const float nr0 = Lr0 * xr0 - Li0 * xi0 + e.x, ni0 = Lr0 * xi0 + Li0 * xr0 + e.y; xr0 = nr0; xi0 = ni0;
            const float nr1 = Lr1 * xr1 - Li1 * xi1 + e.z, ni1 = Lr1 * xi1 + Li1 * xr1 + e.w; xr1 = nr1; xi1 = ni1; }
    }
    {
        LAS unsigned char* Xs = lds + wave * 8704;
        bf16x8 uc[3], un[3];
#pragma unroll
        for (int q = 0; q < 3; ++q) { uc[q] = *(const bf16x8*)rowp(seg0 + 16 * q + tau); un[q] = uc[q]; }
#pragma unroll 1
        for (int ch = 0; ch < 6; ++ch) {
            if (ch < 5) {
#pragma unroll
                for (int q = 0; q < 3; ++q) un[q] = *(const bf16x8*)rowp(seg0 + 16 * (3 * (ch + 1) + q) + tau); }
#pragma unroll
            for (int q = 0; q < 3; ++q) {
                const int pos0 = seg0 + 16 * (3 * ch + q);
                f32x16 c0 = __builtin_amdgcn_mfma_f32_32x32x16_bf16(uc[q], Bf[0], z16, 0, 0, 0), c1 = __builtin_amdgcn_mfma_f32_32x32x16_bf16(uc[q], Bf[1], z16, 0, 0, 0);
                f32x16 c2 = __builtin_amdgcn_mfma_f32_32x32x16_bf16(uc[q], Bf[2], z16, 0, 0, 0), c3 = __builtin_amdgcn_mfma_f32_32x32x16_bf16(uc[q], Bf[3], z16, 0, 0, 0);
                S5_SETTLE(c0, c1, c2, c3);
                float R0[16], I0[16], R1[16], I1[16];
#pragma unroll
                for (int tt = 0; tt < 16; ++tt) S5_TOKEN(tt, R0[tt], I0[tt], R1[tt], I1[tt]);
                if (pos0 >= CTXL) {
#pragma unroll
                    for (int tt = 0; tt < 16; ++tt) { u32x2 w; w.x = pk2(R0[tt], I0[tt]); w.y = pk2(R1[tt], I1[tt]); *(LAS u32x2*)(Xs + (hh * 16 + tt) * 272 + 8 * n) = w; }
                    LDS_WAIT();
#pragma unroll
                    for (int bt = 0; bt < 2; ++bt) {
                        f32x4 y = (f32x4){0.f, 0.f, 0.f, 0.f};
#pragma unroll
                        for (int ks = 0; ks < 4; ++ks) { const bf16x8 xf = *(const LAS bf16x8*)(Xs + (bt * 16 + (lane & 15)) * 272 + (32 * ks + 8 * (lane >> 4)) * 2); y = __builtin_amdgcn_mfma_f32_16x16x32_bf16(Cf[ks], xf, y, 0, 0, 0); }
                        const int qq = pos0 + (lane & 15) - CTXL, tl = d ? (SEQ - 1 - qq) : qq, bb = 2 * bp + bt;
                        u32x2 w; w.x = pk2(y[0], y[1]); w.y = pk2(y[2], y[3]);
                        *(u32x2*)(Ys + ((size_t)(d * M + bb * SEQ + tl)) * S5W + g * 16 + 4 * (lane >> 4)) = w;
                    }
                    LDS_WAIT();
                }
            }
#pragma unroll
            for (int q = 0; q < 3; ++q) uc[q] = un[q];
        }
    }
    __syncthreads();
#undef S5_FMA
#undef S5_SETTLE
#undef S5_TOKEN
}

FI void h1_item(const Args& A, LAS unsigned char* lds, int item, int tid) {
    unsigned char* ws = A.ws;
    const bf16_t* P = (const bf16_t*)(ws + WS_P); bf16_t* Vt = (bf16_t*)(ws + WS_VT);
    const int gr = item >> 3, cg = item & 7, b = gr >> 5, t0 = (gr & 31) * 64, c0 = cg * 128;
    for (int idx = tid; idx < 2 * 64 * 16; idx += NTHR) { const int ch = idx >> 10, rem = idx & 1023, row = rem >> 4, sg = rem & 15;
        const u32x4 v = *(const u32x4*)(P + (size_t)(b * SEQ + t0 + row) * DIN + S5W + ch * HYW + c0 + sg * 8);
        *(LAS u32x4*)(lds + ch * 16896 + (row + 1) * 256 + sg * 16) = v; }
    if (tid < 64) { const int ch = tid >> 5, rr = (tid >> 4) & 1, sg = tid & 15; *(LAS u32x4*)(lds + ch * 16896 + (rr ? 65 : 0) * 256 + sg * 16) = (u32x4){0u, 0u, 0u, 0u}; }
    __syncthreads();
    const int c = tid & 127, tq = tid >> 7, cc = c0 + c;
    const float* cw = A.in[19]; const float* cb = A.in[20];
    const float w0v = cw[cc], w1v = cw[3072 + cc], w2v = cw[6144 + cc], bv = cb[cc];
    const float w0x = cw[HYW + cc], w1x = cw[3072 + HYW + cc], w2x = cw[6144 + HYW + cc], bx = cb[HYW + cc];
    const LAS bf16_t* Vs = (const LAS bf16_t*)lds; const LAS bf16_t* Xs = (const LAS bf16_t*)(lds + 16896);
    float o[16];
#pragma unroll
    for (int i = 0; i < 16; ++i) { const int t = tq * 16 + i;
        const float v = w0v * bf1(Vs[t * 128 + c]) + w1v * bf1(Vs[(t + 1) * 128 + c]) + w2v * bf1(Vs[(t + 2) * 128 + c]) + bv;
        const float x = w0x * bf1(Xs[t * 128 + c]) + w1x * bf1(Xs[(t + 1) * 128 + c]) + w2x * bf1(Xs[(t + 2) * 128 + c]) + bx;
        o[i] = v * x; }
    bf16_t* dst = Vt + ((size_t)(cc * NB + b) * SEQ + t0 + tq * 16);
    u32x4 w0; w0.x = pk2(o[0], o[1]); w0.y = pk2(o[2], o[3]); w0.z = pk2(o[4], o[5]); w0.w = pk2(o[6], o[7]);
    u32x4 w1; w1.x = pk2(o[8], o[9]); w1.y = pk2(o[10], o[11]); w1.z = pk2(o[12], o[13]); w1.w = pk2(o[14], o[15]);
    *(u32x4*)dst = w0; *(u32x4*)(dst + 8) = w1;
    __syncthreads();
}

constexpr int RT_STRIDE = 8208, VS_OFF = 8 * RT_STRIDE, VS_STRIDE = 4112;
FI void longconv_channel(const Args& A, LAS unsigned char* lds, int c, int tid, int lane, int wave) {
    unsigned char* ws = A.ws;
    const bf16_t* Rg = (const bf16_t*)(ws + WS_RG) + (size_t)c * 4096; const bf16_t* Vt = (const bf16_t*)(ws + WS_VT) + (size_t)c * NB * SEQ; bf16_t* LC = (bf16_t*)(ws + WS_LCT) + (size_t)c * NB * SEQ;
    for (int i = tid; i < VS_OFF / 16; i += NTHR) *(LAS u32x4*)(lds + i * 16) = (u32x4){0u, 0u, 0u, 0u};
    for (int i = tid; i < NB * SEQ / 8; i += NTHR) { const int bb = i >> 8, s8 = i & 255; *(LAS u32x4*)(lds + VS_OFF + bb * VS_STRIDE + s8 * 16) = *(const u32x4*)(Vt + (size_t)bb * SEQ + s8 * 8); }
    __syncthreads();
    for (int i = tid; i < 4096; i += NTHR) { const bf16_t v = Rg[i];
#pragma unroll
        for (int r = 0; r < 8; ++r) *(LAS bf16_t*)(lds + r * RT_STRIDE + (i + r) * 2) = v; }
    __syncthreads();
    const int a = lane & 15, q = lane >> 4, r = (a + 1) & 7;
    const LAS unsigned char* vb = lds + VS_OFF + (lane & 7) * VS_STRIDE + 16 * q;
#pragma unroll 1
    for (int grp = 0; grp < 2; ++grp) {
        const int i0 = wave * 16 + grp * 8;
        const LAS unsigned char* rb = lds + r * RT_STRIDE + 2 * (2047 - 16 * (i0 + 7) - a + 8 * q + r);
        f32x4 acc[8];
#pragma unroll
        for (int ii = 0; ii < 8; ++ii) acc[ii] = (f32x4){0.f, 0.f, 0.f, 0.f};
        bf16x8 S[8];
#pragma unroll
        for (int ii = 2; ii < 8; ++ii) S[ii] = *(const LAS bf16x8*)(rb + 32 * (7 - ii));
#pragma unroll 1
        for (int j4 = 0; j4 < 64; j4 += 4) {
#pragma unroll
            for (int jj = 0; jj < 4; ++jj) {
                const int j = j4 + jj;
                const bf16x8 bfr = *(const LAS bf16x8*)(vb + 64 * j);
                S[(0 - 2 * jj) & 7] = *(const LAS bf16x8*)(rb + 32 * 7 + 64 * j);
                S[(1 - 2 * jj) & 7] = *(const LAS bf16x8*)(rb + 32 * 6 + 64 * j);
#pragma unroll
                for (int ii = 0; ii < 8; ++ii) acc[ii] = __builtin_amdgcn_mfma_f32_16x16x32_bf16(S[(ii - 2 * jj) & 7], bfr, acc[ii], 0, 0, 0);
            }
        }
        if (a < 8) {
#pragma unroll
            for (int ii = 0; ii < 8; ++ii) { u32x2 w; w.x = pk2(acc[ii][0], acc[ii][1]); w.y = pk2(acc[ii][2], acc[ii][3]); *(u32x2*)(LC + (size_t)a * SEQ + 16 * (i0 + ii) + 4 * q) = w; }
        }
    }
    __syncthreads();
}

FI void s5_combine(const Args& A, int gtid, int gthreads) {
    unsigned char* ws = A.ws;
    const bf16_t* P = (const bf16_t*)(ws + WS_P); const bf16_t* Ys = (const bf16_t*)(ws + WS_YS5); bf16_t* Yg = (bf16_t*)(ws + WS_YG); const float* dsk = A.in[16];
    for (int idx = gtid; idx < M * 128; idx += gthreads) {
        const int row = idx >> 7, c8 = (idx & 127) * 8;
        const u32x4 u = *(const u32x4*)(P + (size_t)row * DIN + c8), yf = *(const u32x4*)(Ys + (size_t)row * S5W + c8), yb = *(const u32x4*)(Ys + (size_t)(M + row) * S5W + c8);
        const f32x4 d0 = *(const f32x4*)(dsk + c8), d1 = *(const f32x4*)(dsk + c8 + 4);
        float y[8];
        y[0] = bflo(u.x) * d0.x + bflo(yf.x) + bflo(yb.x); y[1] = bfhi(u.x) * d0.y + bfhi(yf.x) + bfhi(yb.x);
        y[2] = bflo(u.y) * d0.z + bflo(yf.y) + bflo(yb.y); y[3] = bfhi(u.y) * d0.w + bfhi(yf.y) + bfhi(yb.y);
        y[4] = bflo(u.z) * d1.x + bflo(yf.z) + bflo(yb.z); y[5] = bfhi(u.z) * d1.y + bfhi(yf.z) + bfhi(yb.z);
        y[6] = bflo(u.w) * d1.z + bflo(yf.w) + bflo(yb.w); y[7] = bfhi(u.w) * d1.w + bfhi(yf.w) + bfhi(yb.w);
#pragma unroll
        for (int e = 0; e < 8; ++e) y[e] = 0.5f * y[e] * (1.0f + erff(y[e] * 0.70710678118654752f));
        u32x4 w; w.x = pk2(y[0], y[1]); w.y = pk2(y[2], y[3]); w.z = pk2(y[4], y[5]); w.w = pk2(y[6], y[7]);
        *(u32x4*)(Yg + (size_t)row * S5W + c8) = w;
    }
}

FI void h3_item(const Args& A, LAS unsigned char* lds, int item, int tid) {
    unsigned char* ws = A.ws;
    const bf16_t* P = (const bf16_t*)(ws + WS_P); const bf16_t* LC = (const bf16_t*)(ws + WS_LCT); bf16_t* Yc = (bf16_t*)(ws + WS_YCAT);
    const int gr = item >> 3, cg = item & 7, b = gr >> 5, t0 = (gr & 31) * 64, c0 = cg * 128;
    for (int idx = tid; idx < 3 * 64 * 16; idx += NTHR) { const int ch = idx >> 10, rem = idx & 1023, row = rem >> 4, sg = rem & 15;
        const u32x4 v = *(const u32x4*)(P + (size_t)(b * SEQ + t0 + row) * DIN + S5W + ch * HYW + c0 + sg * 8);
        *(LAS u32x4*)(lds + ch * 16896 + (row + 1) * 256 + sg * 16) = v; }
    if (tid < 96) { const int ch = tid >> 5, rr = (tid >> 4) & 1, sg = tid & 15; *(LAS u32x4*)(lds + ch * 16896 + (rr ? 65 : 0) * 256 + sg * 16) = (u32x4){0u, 0u, 0u, 0u}; }
    LAS bf16_t* Ls = (LAS bf16_t*)(lds + 3 * 16896);
    for (int idx = tid; idx < 128 * 8; idx += NTHR) { const int c = idx >> 3, pc = idx & 7;
        const u32x4 v = *(const u32x4*)(LC + (size_t)((c0 + c) * NB + b) * SEQ + t0 + pc * 8);
        const unsigned wv[4] = {v.x, v.y, v.z, v.w};
#pragma unroll
        for (int e = 0; e < 4; ++e) { Ls[(pc * 8 + 2 * e) * 128 + c] = (bf16_t)(wv[e] & 0xffffu); Ls[(pc * 8 + 2 * e + 1) * 128 + c] = (bf16_t)(wv[e] >> 16); } }
    __syncthreads();
    const int c = tid & 127, tq = tid >> 7, cc = c0 + c;
    const float* cw = A.in[19]; const float* cb = A.in[20];
    const float w0v = cw[cc], w1v = cw[3072 + cc], w2v = cw[6144 + cc], bv = cb[cc];
    const float w0x = cw[HYW + cc], w1x = cw[3072 + HYW + cc], w2x = cw[6144 + HYW + cc], bx = cb[HYW + cc];
    const float w0z = cw[2 * HYW + cc], w1z = cw[3072 + 2 * HYW + cc], w2z = cw[6144 + 2 * HYW + cc], bz = cb[2 * HYW + cc];
    const float dd = A.in[30][cc];
    const LAS bf16_t* Vs = (const LAS bf16_t*)lds; const LAS bf16_t* Xs = (const LAS bf16_t*)(lds + 16896); const LAS bf16_t* Zs = (const LAS bf16_t*)(lds + 2 * 16896);
#pragma unroll 4
    for (int i = 0; i < 16; ++i) { const int t = tq * 16 + i;
        const float v = w0v * bf1(Vs[t * 128 + c]) + w1v * bf1(Vs[(t + 1) * 128 + c]) + w2v * bf1(Vs[(t + 2) * 128 + c]) + bv;
        const float x = w0x * bf1(Xs[t * 128 + c]) + w1x * bf1(Xs[(t + 1) * 128 + c]) + w2x * bf1(Xs[(t + 2) * 128 + c]) + bx;
        const float z = w0z * bf1(Zs[t * 128 + c]) + w1z * bf1(Zs[(t + 1) * 128 + c]) + w2z * bf1(Zs[(t + 2) * 128 + c]) + bz;
        const float vg = v * x, y = (bf1(Ls[t * 128 + c]) + vg * dd) * z;
        Yc[(size_t)(b * SEQ + t0 + t) * D + S5W + cc] = (bf16_t)f2bf(y); }
    __syncthreads();
}

FI void p7_run(const Args& A, LAS unsigned char* lds, int lane, int wave, int vcu, int G, bool commit) {
    unsigned char* ws = A.ws;
    const float* x1 = (const float*)(ws + WS_X1); unsigned char* A2 = ws + WS_A2;
    const float* mod = (const float*)(ws + WS_MODF); const float* g2 = A.in[7]; const float* brt = A.in[33];
    const bf16x8* WRF = (const bf16x8*)(ws + WS_WRF);
    int* cnt = (int*)(ws + WS_CTL) + CW_CNT; int* rowl = (int*)(ws + WS_ROWL); int* pk = (int*)(ws + WS_PK); float* gate = (float*)(ws + WS_GATE);
    const int t = lane & 15, q = lane >> 4, pair = wave >> 1, kh = wave & 1;
    LAS float* xch = (LAS float*)(lds + 32768);
    LAS float* part = (LAS float*)(lds + 34816);
    LAS int* lcnt = (LAS int*)(lds + 65536);
    for (int it = vcu; it < M / 64; it += G) {
        const int row = it * 64 + pair * 16 + t, b = (it * 64) / SEQ;
        const float* xr = x1 + (size_t)row * D + kh * 1024 + 8 * q;
        if (threadIdx.x < 64) lcnt[threadIdx.x] = 0;
        float ss = 0.f;
#pragma unroll 8
        for (int ks = 0; ks < 32; ++ks) { const f32x4 a = *(const f32x4*)(xr + 32 * ks), c = *(const f32x4*)(xr + 32 * ks + 4);
            ss += ((a.x * a.x + a.y * a.y) + (a.z * a.z + a.w * a.w)) + ((c.x * c.x + c.y * c.y) + (c.z * c.z + c.w * c.w)); }
        ss += __shfl_xor(ss, 16); ss += __shfl_xor(ss, 32);
        if (q == 0) xch[wave * 16 + t] = ss;
        __syncthreads();
        const float rstd = rsqrtf((xch[(pair * 2) * 16 + t] + xch[(pair * 2 + 1) * 16 + t]) * (1.0f / D) + 1e-6f);
        f32x4 acc0 = (f32x4){0.f, 0.f, 0.f, 0.f}, acc1 = (f32x4){0.f, 0.f, 0.f, 0.f};
        const float* gp = g2 + kh * 1024 + 8 * q; const float* shp = mod + (size_t)b * 12288 + 3 * D + kh * 1024 + 8 * q; const float* scp = mod + (size_t)b * 12288 + 4 * D + kh * 1024 + 8 * q;
        unsigned char* a2p = A2 + (size_t)row * D + kh * 1024 + 8 * q;
#pragma unroll 4
        for (int ks = 0; ks < 32; ++ks) {
            const f32x4 xa = *(const f32x4*)(xr + 32 * ks), xb = *(const f32x4*)(xr + 32 * ks + 4);
            const f32x4 ha = xa * rstd * *(const f32x4*)(gp + 32 * ks) * (*(const f32x4*)(scp + 32 * ks) + 1.0f) + *(const f32x4*)(shp + 32 * ks);
            const f32x4 hb = xb * rstd * *(const f32x4*)(gp + 32 * ks + 4) * (*(const f32x4*)(scp + 32 * ks + 4) + 1.0f) + *(const f32x4*)(shp + 32 * ks + 4);
            u32x2 w8; w8.x = pk4_fp8(ha.x, ha.y, ha.z, ha.w); w8.y = pk4_fp8(hb.x, hb.y, hb.z, hb.w); *(u32x2*)(a2p + 32 * ks) = w8;
            u32x4 hi; hi.x = pk2(ha.x, ha.y); hi.y = pk2(ha.z, ha.w); hi.z = pk2(hb.x, hb.y); hi.w = pk2(hb.z, hb.w);
            u32x4 lo; lo.x = pk2(ha.x - bflo(hi.x), ha.y - bfhi(hi.x)); lo.y = pk2(ha.z - bflo(hi.y), ha.w - bfhi(hi.y)); lo.z = pk2(hb.x - bflo(hi.z), hb.y - bfhi(hi.z)); lo.w = pk2(hb.z - bflo(hi.w), hb.w - bfhi(hi.w));
            const bf16x8 Hh = __builtin_bit_cast(bf16x8, hi), Hl = __builtin_bit_cast(bf16x8, lo);
            const bf16x8* wf = WRF + (size_t)((kh * 32 + ks) * 4) * 64 + lane;
            const bf16x8 wh0 = wf[0], wl0 = wf[64], wh1 = wf[128], wl1 = wf[192];
            acc0 = __builtin_amdgcn_mfma_f32_16x16x32_bf16(wh0, Hh, acc0, 0, 0, 0); acc1 = __builtin_amdgcn_mfma_f32_16x16x32_bf16(wh1, Hh, acc1, 0, 0, 0);
            acc0 = __builtin_amdgcn_mfma_f32_16x16x32_bf16(wl0, Hh, acc0, 0, 0, 0); acc1 = __builtin_amdgcn_mfma_f32_16x16x32_bf16(wl1, Hh, acc1, 0, 0, 0);
            acc0 = __builtin_amdgcn_mfma_f32_16x16x32_bf16(wh0, Hl, acc0, 0, 0, 0); acc1 = __builtin_amdgcn_mfma_f32_16x16x32_bf16(wh1, Hl, acc1, 0, 0, 0);
        }
        if (kh == 1) { *(LAS f32x4*)(part + (pair * 64 + lane) * 8) = acc0; *(LAS f32x4*)(part + (pair * 64 + lane) * 8 + 4) = acc1; }
        __syncthreads();
        int myex = 0, myrank = 0; float mygate = 0.f;
        if (kh == 0) {
            acc0 += *(const LAS f32x4*)(part + (pair * 64 + lane) * 8); acc1 += *(const LAS f32x4*)(part + (pair * 64 + lane) * 8 + 4);
            float v[8]; int ix[8];
#pragma unroll
            for (int r = 0; r < 4; ++r) { ix[r] = 4 * q + r; ix[4 + r] = 16 + 4 * q + r; v[r] = acc0[r] + brt[4 * q + r]; v[4 + r] = acc1[r] + brt[16 + 4 * q + r]; }
            float tv[4]; int ti[4];
#pragma unroll
            for (int k = 0; k < 4; ++k) { float bv = v[0]; int bi = ix[0];
#pragma unroll
                for (int r = 1; r < 8; ++r) if (v[r] > bv) { bv = v[r]; bi = ix[r]; }
#pragma unroll
                for (int o = 16; o <= 32; o <<= 1) { const float ov = __shfl_xor(bv, o); const int oi = __shfl_xor(bi, o); if (ov > bv || (ov == bv && oi < bi)) { bv = ov; bi = oi; } }
                tv[k] = bv; ti[k] = bi;
#pragma unroll
                for (int r = 0; r < 8; ++r) if (ix[r] == bi) v[r] = -3.0e38f; }
            const float e1 = __expf(tv[1] - tv[0]), e2 = __expf(tv[2] - tv[0]), e3 = __expf(tv[3] - tv[0]), inv = 1.0f / (1.0f + e1 + e2 + e3);
            myex = q == 0 ? ti[0] : q == 1 ? ti[1] : q == 2 ? ti[2] : ti[3];
            mygate = (q == 0 ? 1.0f : q == 1 ? e1 : q == 2 ? e2 : e3) * inv;
            myrank = __hip_atomic_fetch_add(lcnt + myex, 1, __ATOMIC_RELAXED, __HIP_MEMORY_SCOPE_WORKGROUP);
        }
        __syncthreads();
        if (threadIdx.x < NE) { const int n = lcnt[threadIdx.x]; lcnt[32 + threadIdx.x] = (n > 0 && commit) ? atomicAdd(cnt + threadIdx.x, n) : 0; }
        __syncthreads();
        if (kh == 0 && commit) { const int slot = lcnt[32 + myex] + myrank;
            rowl[myex * M + slot] = row; pk[row * 4 + q] = myex * M + slot; gate[row * 4 + q] = mygate; }
        __syncthreads();
    }
}

FI void moe_table(const Args& A, LAS unsigned char* lds, int tid) {
    const int* cnt = (const int*)(A.ws + WS_CTL) + CW_CNT;
    LAS int* tw = (LAS int*)(lds + LDSCTL_OFF);
    if (tid < 64) { const int n = tid < NE ? cnt[tid] : 0; int p = (n + 255) >> 8;
#pragma unroll
        for (int o = 1; o < 32; o <<= 1) { const int q = __shfl_up(p, o); if ((tid & 63) >= o) p += q; }
        if (tid < NE) { tw[LW_TST + tid + 1] = p; tw[LW_CNT + tid] = n; } if (tid == 0) tw[LW_TST] = 0; }
    __syncthreads();
    if (tid < 320) { int e = 0;
#pragma unroll 1
        for (int j = 1; j < NE; ++j) e += (tw[LW_TST + j] <= tid) ? 1 : 0;
        tw[LW_TE + tid] = e; }
    __syncthreads();
}

FI void p10_run(const Args& A, LAS unsigned char* lds, int lane, int wave, int vcu, int G) {
    unsigned char* ws = A.ws;
    const float* x1 = (const float*)(ws + WS_X1); const unsigned char* Yd = ws + WS_YD; const float* bdn = A.in[37];
    const float* mod = (const float*)(ws + WS_MODF); const float* gf = A.in[38];
    const int* pk = (const int*)(ws + WS_PK); const float* gate = (const float*)(ws + WS_GATE);
    const LAS int* tst = (const LAS int*)(lds + LDSCTL_OFF) + LW_TST;
    const int gw = vcu * NWAVES + wave, NGW = G * NWAVES;
    for (int row = gw; row < M; row += NGW) {
        const int b = row / SEQ; unsigned hr[4], bo[4]; float gk[4];
#pragma unroll
        for (int k = 0; k < 4; ++k) { const int p = __builtin_amdgcn_readfirstlane(pk[row * 4 + k]), ex = p / M, slot = p % M;
            hr[k] = (unsigned)(__builtin_amdgcn_readfirstlane(tst[ex]) * 256 + slot) * (unsigned)D; gk[k] = __builtin_bit_cast(float, __builtin_amdgcn_readfirstlane(__builtin_bit_cast(int, gate[row * 4 + k]))); bo[k] = (unsigned)ex * (unsigned)D; }
        f32x4 x2[8]; float ss = 0.f;
#pragma unroll
        for (int j = 0; j < 8; ++j) { const int col = 4 * lane + 256 * j;
            f32x4 s = (f32x4){0.f, 0.f, 0.f, 0.f};
#pragma unroll
            for (int k = 0; k < 4; ++k) { const int y = *(const int*)(Yd + hr[k] + col); const f32v2 lo = __builtin_amdgcn_cvt_pk_f32_fp8(y, false), hi = __builtin_amdgcn_cvt_pk_f32_fp8(y, true);
                s += ((f32x4){lo.x, lo.y, hi.x, hi.y} + *(const f32x4*)(bdn + bo[k] + col)) * gk[k]; }
            const f32x4 ga = *(const f32x4*)(mod + (size_t)b * 12288 + 5 * D + col);
            x2[j] = *(const f32x4*)(x1 + (size_t)row * D + col) + ga * s;
            ss += (x2[j].x * x2[j].x + x2[j].y * x2[j].y) + (x2[j].z * x2[j].z + x2[j].w * x2[j].w); }
        const float rstd = rsqrtf(wave_sum(ss) * (1.0f / D) + 1e-6f);
#pragma unroll
        for (int j = 0; j < 8; ++j) { const int col = 4 * lane + 256 * j; *(f32x4*)(A.out + (size_t)row * D + col) = x2[j] * rstd * *(const f32x4*)(gf + col); }
    }
}

__global__ void __launch_bounds__(NTHR, 2) fwd_kernel(Args args) {
    extern __shared__ __attribute__((aligned(16))) unsigned char lds_raw[];
    LAS unsigned char* lds = (LAS unsigned char*)lds_raw;
    const int tid = threadIdx.x, lane = tid & 63, wave = __builtin_amdgcn_readfirstlane(tid >> 6);
    const int G = gridDim.x; const int bx = blockIdx.x; const int vcu = (G % 8 == 0) ? (bx % 8) * (G / 8) + bx / 8 : bx;
    unsigned char* ws = args.ws;
    for (int u = tid; u < (LDS_BYTES - LDSCTL_OFF) / 4; u += NTHR) ((LAS unsigned*)(lds + LDSCTL_OFF))[u] = 0u;
    __syncthreads();
    XcdBarrier bar; bar.bar = (unsigned*)(ws + WS_CTL) + CW_BAR; bar.x = 0; bar.st = nullptr;
#if !MK_SPLIT
    bar = xcd_barrier_post((unsigned*)(ws + WS_CTL) + CW_BAR, (volatile LAS unsigned*)(lds + LDSCTL_OFF) + LW_BAR);
#endif
    const int lo = args.ph_lo, hi = args.ph_hi;
#ifndef PHASE_MASK
#define PHASE_MASK 0x7ff
#endif
#define IN(k) (((PHASE_MASK >> (k)) & 1) && lo <= (k) && (k) < hi)
#if MK_SPLIT
#define SEAM(k) do { } while (0)
#else
#define SEAM(k) do { if (IN(k) && IN((k) + 1)) xcd_barrier(bar); } while (0)
#endif
    const float* modp = (const float*)(ws + WS_MODF);
    unsigned long long amp_t0 = 0, amp_dt = 0;
#ifndef AMP_CLK
#define AMP_CLK 0
#endif
#define AMP_NOW() (AMP_CLK ? (unsigned long long)__builtin_amdgcn_s_memtime() / 128ull : (unsigned long long)__builtin_amdgcn_s_memrealtime())
#define AMP_BEGIN(k) do { if (AMP_PHASE == (k) && bx == 0 && tid == 0) amp_t0 = AMP_NOW(); } while (0)
#define AMP_END(k) do { if (AMP_PHASE == (k) && bx == 0 && tid == 0) amp_dt = AMP_NOW() - amp_t0; } while (0)

    AMP_BEGIN(0);
    AMP_BEGIN(11);
    if (IN(0)) {
        if ((G & 1) == 0 && G >= 64) {
            if ((bx & 1) == 0) { p0_run(args, lds, tid, lane, wave, bx >> 1, G >> 1); __syncthreads(); p0d_run(args, lds, lane, wave, P0_SPLIT_ITEMS, 49152, bx >> 1, G >> 1); }
            else p0d_run(args, lds, lane, wave, 0, P0_SPLIT_ITEMS, bx >> 1, G >> 1);
        } else { p0_run(args, lds, tid, lane, wave, vcu, G); __syncthreads(); p0d_run(args, lds, lane, wave, 0, 49152, vcu, G); }
    }
    AMP_END(11);
    SEAM(0); AMP_END(0);
    AMP_BEGIN(1);
    if (IN(1)) { _Pragma("unroll 1") for (int rep = 0; rep < REP1; ++rep) p1_run(args, tid, lane, wave, vcu, G, 0, MT, true); } SEAM(1); AMP_END(1);
    AMP_BEGIN(2);
    if (IN(2)) {
        pg8::DenseSched S{(const bf16_t*)(ws + WS_A1), (const bf16_t*)(ws + WS_WIN), 2 * D, M / 256, DIN / 256, G, bx, M / 256, MC / 256, S5W / 256, 0};
        pg8::EpiStoreBf16<false> E{(bf16_t*)(ws + WS_P), DIN, nullptr, 0, 1.0f};
        _Pragma("unroll 1") for (int rep = 0; rep < REP2; ++rep)
        pg8::gemm_phase<false>(lds, 2 * D, S, E);
    } SEAM(2); AMP_END(2);
    AMP_BEGIN(3);
    if (IN(3)) {
        _Pragma("unroll 1") for (int rep = 0; rep < REP3; ++rep) {
        _Pragma("unroll 1") for (int r2 = 0; r2 < REP3A; ++r2) for (int u = vcu; u < 512; u += G) s5_unit(args, lds, u, lane, wave);
        _Pragma("unroll 1") for (int r2 = 0; r2 < REP3B; ++r2) for (int it = vcu; it < 2048; it += G) h1_item(args, lds, it, tid); }
    } SEAM(3); AMP_END(3);
    AMP_BEGIN(4);
    if (IN(4)) {
        _Pragma("unroll 1") for (int rep = 0; rep < REP4; ++rep) {
        _Pragma("unroll 1") for (int r2 = 0; r2 < REP4A; ++r2) s5_combine(args, vcu * NTHR + tid, G * NTHR);
        _Pragma("unroll 1") for (int r2 = 0; r2 < REP4B; ++r2) for (int c = vcu; c < HYW; c += G) longconv_channel(args, lds, c, tid, lane, wave); }
    } SEAM(4); AMP_END(4);
    AMP_BEGIN(5);
    if (IN(5)) {
        _Pragma("unroll 1") for (int rep = 0; rep < REP5; ++rep) for (int it = vcu; it < 2048; it += G) h3_item(args, lds, it, tid);
        pg8::DenseSched S{(const bf16_t*)(ws + WS_YG), (const bf16_t*)(ws + WS_WGLU), 2 * S5W, M / 256, S5W / 256, G, bx, 0, 0, 0, 0};
        pg8::EpiGlu E{(const bf16_t*)(ws + WS_YG), (bf16_t*)(ws + WS_YCAT), args.in[18]};
        pg8::gemm_phase<false>(lds, 2 * S5W, S, E);
    } SEAM(5); AMP_END(5);
    AMP_BEGIN(6);
    if (IN(6)) {
        pg8::DenseSched S{(const bf16_t*)(ws + WS_YCAT), (const bf16_t*)(ws + WS_WOUT), 2 * D, M / 256, D / 256, G, bx, 0, 0, 0, 0};
        pg8::EpiResid E{args.in[0], (float*)(ws + WS_X1), modp};
        _Pragma("unroll 1") for (int rep = 0; rep < REP6; ++rep)
        pg8::gemm_phase<false>(lds, 2 * D, S, E);
    } SEAM(6); AMP_END(6);
    AMP_BEGIN(7);
    if (IN(7)) { _Pragma("unroll 1") for (int rep = 0; rep < REP7; ++rep) p7_run(args, lds, lane, wave, vcu, G, rep == REP7 - 1); } SEAM(7); AMP_END(7);
    AMP_BEGIN(8);
    if (IN(8)) {
        moe_table(args, lds, tid);
        pg8::MoeSched<true> S{ws + WS_A2, ws + WS_WGU, D, 16, G, bx, (size_t)4096 * D,
                              (const LAS int*)(lds + LDSCTL_OFF) + LW_TST, (const LAS int*)(lds + LDSCTL_OFF) + LW_CNT, (const int*)(ws + WS_ROWL)};
        pg8::EpiSwiglu E{ws + WS_H, args.in[35], 1.0f / WSCALE};
        _Pragma("unroll 1") for (int rep = 0; rep < REP8; ++rep)
        pg8::gemm_phase<true>(lds, D, S, E);
    } SEAM(8); AMP_END(8);
    AMP_BEGIN(9);
    if (IN(9)) {
        moe_table(args, lds, tid);
        pg8::MoeSched<false> S{ws + WS_H, ws + WS_WDN, DFF, 8, G, bx, (size_t)D * DFF,
                               (const LAS int*)(lds + LDSCTL_OFF) + LW_TST, (const LAS int*)(lds + LDSCTL_OFF) + LW_CNT, (const int*)(ws + WS_ROWL)};
        pg8::EpiStoreFp8 E{ws + WS_YD, D, 1.0f / WSCALE};
        _Pragma("unroll 1") for (int rep = 0; rep < REP9; ++rep)
        pg8::gemm_phase<true>(lds, DFF, S, E);
    } SEAM(9); AMP_END(9);
    AMP_BEGIN(10);
    if (IN(10)) { moe_table(args, lds, tid); _Pragma("unroll 1") for (int rep = 0; rep < REP10; ++rep) p10_run(args, lds, lane, wave, vcu, G); }
    AMP_END(10);
    if (AMP_PHASE >= 0 && bx == 0 && tid == 0) { const unsigned long long t0 = __builtin_amdgcn_s_memrealtime(); while (__builtin_amdgcn_s_memrealtime() - t0 < 4ull * amp_dt) __builtin_amdgcn_s_sleep(16); }
#undef IN
#undef SEAM
}

extern "C" void kernel_launch(void* const* d_in, const int* in_sizes, int n_in, void* d_out, int out_size, void* d_ws, size_t ws_size, hipStream_t stream) {
    static int grid = 0;
    if (grid == 0) {
        if (n_in != 39 || out_size != M * D || ws_size < WS_END) { fprintf(stderr, "kernel_launch: unexpected problem (n_in %d, out %d, ws %zu)\n", n_in, out_size, ws_size); grid = -1; return; }
        int dev = 0, cus = 0, per_cu = 0;
        if (hipGetDevice(&dev) != hipSuccess || hipDeviceGetAttribute(&cus, hipDeviceAttributeMultiprocessorCount, dev) != hipSuccess) { grid = -1; return; }
        if (hipFuncSetAttribute((const void*)fwd_kernel, hipFuncAttributeMaxDynamicSharedMemorySize, LDS_BYTES) != hipSuccess) { fprintf(stderr, "kernel_launch: hipFuncSetAttribute failed\n"); grid = -1; return; }
        if (hipOccupancyMaxActiveBlocksPerMultiprocessor(&per_cu, (const void*)fwd_kernel, NTHR, LDS_BYTES) != hipSuccess || per_cu < 1) fprintf(stderr, "kernel_launch: occupancy query says %d\n", per_cu);
        (void)hipGetLastError();
        grid = cus;
    }
    if (grid < 0) return;
    (void)in_sizes;
    if (hipMemsetAsync((char*)d_ws + WS_CTL, 0, CTL_ZERO_BYTES, stream) != hipSuccess) { fprintf(stderr, "kernel_launch: memset failed\n"); return; }
    Args a{};
    for (int i = 0; i < 39; ++i) a.in[i] = (const float*)d_in[i];
    a.out = (float*)d_out; a.ws = (unsigned char*)d_ws;
#if MK_SPLIT
    for (int p = 0; p < NPHASE; ++p) { a.ph_lo = p; a.ph_hi = p + 1; hipLaunchKernelGGL(fwd_kernel, dim3(grid), dim3(NTHR), LDS_BYTES, stream, a); }
#else
    a.ph_lo = 0; a.ph_hi = NPHASE;
    hipLaunchKernelGGL(fwd_kernel, dim3(grid), dim3(NTHR), LDS_BYTES, stream, a);
#endif
    const hipError_t le = hipPeekAtLastError();
    if (le != hipSuccess) fprintf(stderr, "kernel_launch: launch failed: %s\n", hipGetErrorName(le));
}
```

```cpp
#include <hip/hip_runtime.h>
#include <cstdio>
#include <cstdint>

#ifndef MK_SPLIT
#define MK_SPLIT 0
#endif

#ifndef REP0D
#define REP0D 1
#endif
#ifndef REP2
#define REP2 1
#endif
#ifndef AMP_PHASE
#define AMP_PHASE -1
#endif
#ifndef REP1
#define REP1 1
#endif
#ifndef REP5
#define REP5 1
#endif
#ifndef REP7
#define REP7 1
#endif
#ifndef REP10
#define REP10 1
#endif
#ifndef REP0A
#define REP0A 1
#endif
#ifndef REP3
#define REP3 1
#endif
#ifndef REP3A
#define REP3A 1
#endif
#ifndef REP3B
#define REP3B 1
#endif
#ifndef REP4A
#define REP4A 1
#endif
#ifndef REP4B
#define REP4B 1
#endif
#ifndef REP4
#define REP4 1
#endif
#ifndef REP6
#define REP6 1
#endif
#ifndef REP8
#define REP8 1
#endif
#ifndef REP9
#define REP9 1
#endif
#define GAS __attribute__((address_space(1)))
#define LAS __attribute__((address_space(3)))
typedef unsigned short bf16_t;
typedef short bf16x8 __attribute__((ext_vector_type(8)));
typedef float f32x4 __attribute__((ext_vector_type(4)));
typedef float f32x16 __attribute__((ext_vector_type(16)));
typedef unsigned u32x4 __attribute__((ext_vector_type(4)));
typedef unsigned u32x2 __attribute__((ext_vector_type(2)));

constexpr int NWAVES = 8, NTHR = 512;
constexpr int D = 2048, NB = 8, SEQ = 2048, M = NB * SEQ, CTXL = 256, MC = NB * CTXL, MT = M + MC;
constexpr int DIN = 4096, S5W = 1024, HYW = 1024, NG = 64;
constexpr int NE = 32, DFF = 2048;
constexpr int NPHASE = 11;
constexpr float WSCALE = 64.0f;
constexpr int SEG = 288;

constexpr size_t MiB = 1u << 20;
constexpr size_t WS_CTL = 0, CTL_ZERO_BYTES = 1024 * 1024;
constexpr int CW_TMO = 0, CW_BAR = 4096, CW_CNT = 8192, CW_HNORM = 12288, CW_MOD = 16384;
constexpr size_t WS_LAM = 1 * MiB, WS_LAML = WS_LAM + 64 * 1024, WS_S5B = WS_LAM + 128 * 1024, WS_S5C = WS_LAM + 640 * 1024;
constexpr size_t WS_HRAW = 4 * MiB, WS_RG = 20 * MiB, WS_WIN = 28 * MiB, WS_WGLU = 44 * MiB, WS_WOUT = 46 * MiB;
constexpr size_t WS_PK = 54 * MiB, WS_GATE = WS_PK + 256 * 1024, WS_ROWL = 55 * MiB, WS_MODF = 58 * MiB, WS_WRF = 59 * MiB;
constexpr size_t WS_A1 = 64 * MiB, WS_P = 136 * MiB, WS_YS5 = 280 * MiB, WS_VT = 344 * MiB, WS_LCT = 376 * MiB, WS_YG = 408 * MiB;
constexpr size_t WS_YCAT = 440 * MiB, WS_X1 = 504 * MiB, WS_A2 = 632 * MiB, WS_WGU = 704 * MiB, WS_WDN = 1216 * MiB;
constexpr size_t WS_H = 1472 * MiB, WS_YD = 1760 * MiB, WS_END = 2048 * MiB;
constexpr int HROWS = 73728;

constexpr int RING_BYTES = 131072, LDSCTL_OFF = RING_BYTES, LDS_BYTES = 147456;
constexpr int LW_BAR = 8, LW_TST = 64, LW_CNT = 128, LW_TE = 256;

typedef __bf16 bf16v2 __attribute__((ext_vector_type(2)));
typedef float f32v2 __attribute__((ext_vector_type(2)));
__device__ __forceinline__ unsigned f2bf(float f) { return (unsigned)__builtin_bit_cast(unsigned short, (__bf16)f); }
__device__ __forceinline__ unsigned pk2(float lo, float hi) { const f32v2 v = {lo, hi}; return __builtin_bit_cast(unsigned, __builtin_convertvector(v, bf16v2)); }
__device__ __forceinline__ float bflo(unsigned w) { return __builtin_bit_cast(float, w << 16); }
__device__ __forceinline__ float bfhi(unsigned w) { return __builtin_bit_cast(float, w & 0xffff0000u); }
__device__ __forceinline__ float bf1(bf16_t b) { return __builtin_bit_cast(float, (unsigned)b << 16); }
__device__ __forceinline__ unsigned pk4_fp8(float a, float b, float c, float d) { int w = __builtin_amdgcn_cvt_pk_fp8_f32(a, b, 0, false); w = __builtin_amdgcn_cvt_pk_fp8_f32(c, d, w, true); return (unsigned)w; }
constexpr float FIX_SCALE = 4294967296.0f;
__device__ __forceinline__ void fix_add(unsigned long long* p, float v) { atomicAdd(p, (unsigned long long)__float2ll_rn(v * FIX_SCALE)); }
__device__ __forceinline__ float fix_get(const unsigned long long* p) { const unsigned long long v = *p; return (float)(int)(unsigned)(v >> 32) + (float)(unsigned)v * (1.0f / 4294967296.0f); }
__device__ __forceinline__ float sigm(float v) { return __builtin_amdgcn_rcpf(1.0f + __builtin_amdgcn_exp2f(-1.44269504f * v)); }
__device__ __forceinline__ float wave_sum(float v) {
#pragma unroll
    for (int o = 1; o < 64; o <<= 1) v += __shfl_xor(v, o);
    return v;
}
#define LDS_WAIT() asm volatile("s_waitcnt lgkmcnt(0)" ::: "memory")
#define VM_WAIT() asm volatile("s_waitcnt vmcnt(0)" ::: "memory")

#define XB_TMO      128
#define XB_XCNT(j)  (256  + 64 * (j))
#define XB_XSUB(j)  (1280 + 64 * (j))
#define XB_XGEN(j)  (2304 + 64 * (j))
#define XB_TOP      3328
#define XB_TOPGEN   3392
#define XCD_BAR_WORDS 3456
#define XB_SPIN_CAP (1u << 18)
__device__ __forceinline__ unsigned xb_ld(unsigned* p)              { return __hip_atomic_load(p, __ATOMIC_RELAXED, __HIP_MEMORY_SCOPE_AGENT); }
__device__ __forceinline__ unsigned xb_add(unsigned* p, unsigned v) { return __hip_atomic_fetch_add(p, v, __ATOMIC_RELAXED, __HIP_MEMORY_SCOPE_AGENT); }
__device__ __forceinline__ unsigned xb_xcc_id() { return (unsigned)__builtin_amdgcn_s_getreg((3 << 11) | 20) & 0xFu; }
#define XB_SPIN(cond, bar) do { unsigned _sp = 0; while (cond) { __builtin_amdgcn_s_sleep(1); \
    if ((++_sp & 255u) == 0u) { if (xb_ld(&(bar)[XB_TMO])) break; if (_sp > XB_SPIN_CAP) { atomicAdd(&(bar)[XB_TMO], 1u); break; } } } } while (0)
struct XcdBarrier { unsigned* bar; unsigned x; volatile LAS unsigned* st; };
__device__ __forceinline__ XcdBarrier xcd_barrier_post(unsigned* bar, volatile LAS unsigned* st) {
    XcdBarrier b; b.bar = bar; b.x = xb_xcc_id(); b.st = st;
    if (threadIdx.x == 0) (void)xb_add(&bar[XB_XCNT(b.x)], 1u);
    return b;
}
__device__ __forceinline__ void xcd_barrier_complete(unsigned* bar, unsigned x, unsigned& nloc, unsigned& nx) {
    const unsigned G = gridDim.x * gridDim.y * gridDim.z;
    unsigned sum, cnt, mine, sp = 0u;
    for (;;) {
        sum = 0u; cnt = 0u; mine = 0u;
#pragma unroll
        for (unsigned j = 0; j < 16; ++j) { const unsigned c = xb_ld(&bar[XB_XCNT(j)]); sum += c; cnt += (c > 0u) ? 1u : 0u; mine = (j == x) ? c : mine; }
        if (sum == G) break;
        __builtin_amdgcn_s_sleep(1);
        if ((++sp & 255u) == 0u) { if (xb_ld(&bar[XB_TMO])) break; if (sp > XB_SPIN_CAP) { atomicAdd(&bar[XB_TMO], 1u); break; } }
    }
    nloc = mine > 0u ? mine : 1u; nx = cnt > 0u ? cnt : 1u;
}
__device__ __forceinline__ void xcd_barrier(const XcdBarrier& b) {
    asm volatile("s_waitcnt vmcnt(0)" ::: "memory");
    __syncthreads();
    if (threadIdx.x == 0) {
        unsigned* bar = b.bar;
        __builtin_amdgcn_s_waitcnt(0);
        unsigned nloc = b.st[0], nx = b.st[1];
        if (nloc == 0u) { xcd_barrier_complete(bar, b.x, nloc, nx); b.st[0] = nloc; b.st[1] = nx; }
        const unsigned old = xb_add(&bar[XB_XSUB(b.x)], 1u);
        const unsigned gen = old / nloc;
        if (old + 1u == (gen + 1u) * nloc) {
            __builtin_amdgcn_fence(__ATOMIC_RELEASE, "agent");
            asm volatile("s_waitcnt vmcnt(0)" ::: "memory");
            const unsigned og = xb_add(&bar[XB_TOP], 1u);
            const unsigned tg = og / nx;
            if (og + 1u == (tg + 1u) * nx) xb_add(&bar[XB_TOPGEN], 1u);
            else XB_SPIN(xb_ld(&bar[XB_TOPGEN]) == tg, bar);
            __builtin_amdgcn_fence(__ATOMIC_ACQUIRE, "agent");
            xb_add(&bar[XB_XGEN(b.x)], 1u);
            asm volatile("s_waitcnt vmcnt(0)" ::: "memory");
        } else {
            XB_SPIN(xb_ld(&bar[XB_XGEN(b.x)]) == gen, bar);
            __builtin_amdgcn_fence(__ATOMIC_ACQUIRE, "agent");
            asm volatile("s_waitcnt vmcnt(0)" ::: "memory");
        }
    }
    __syncthreads();
}

struct Args { const float* in[39]; float* out; unsigned char* ws; int ph_lo, ph_hi; };

namespace pg8 {
constexpr int BM = 256, BK = 64, HALF = 128, HTB = HALF * BK * 2, STAGE_BYTES = 8 * HTB, NXCD = 8, WGM = 8;
__device__ __forceinline__ int lds_byte(int r, int c) { const int st = (r >> 4) * 2 + (c >> 5), rr = r & 15, cc = c & 31, ob = rr * 64 + cc * 2; return st * 1024 + (ob ^ (((ob >> 9) & 1) << 5)); }
__device__ __forceinline__ void stage_rc(int b, int& R, int& C) { const int st = b / 1024, sb = b % 1024, swz = sb ^ (((sb >> 9) & 1) << 5); R = (st >> 1) * 16 + swz / 64; C = (st & 1) * 32 + (swz % 64) / 2; }
__device__ __forceinline__ int perm32(int rho) { const int n = rho >> 4, i = rho & 15; return 8 * (i >> 2) + 4 * n + (i & 3); }
struct Unit { int pm, pn, e; };
__device__ __forceinline__ unsigned cvt_pk_bf16(float lo, float hi) { unsigned r; asm volatile("v_cvt_pk_bf16_f32 %0, %1, %2" : "=v"(r) : "v"(lo), "v"(hi)); return r; }

__device__ __forceinline__ void tile_of(long L, int nM, int nN, int& pm, int& pn) {
    const int nwg = nM * nN; int wgid = (int)L;
    { const int q = nwg / NXCD, r = nwg % NXCD, xcd = wgid % NXCD, off = wgid / NXCD; wgid = (xcd < r ? xcd * (q + 1) : r * (q + 1) + (xcd - r) * q) + off; }
    const int nig = WGM * nN, gid = wgid / nig, fm = gid * WGM, gsz = (nM - fm) < WGM ? (nM - fm) : WGM;
    pm = fm + ((wgid % nig) % gsz); pn = (wgid % nig) / gsz;
}

struct DenseSched {
    const bf16_t* A; const bf16_t* Bt; int RB, nM, nN, G, c, xM0, xnM, xnN, xN0;
    __device__ __forceinline__ bool next(int i, Unit& u) const {
        const long L = (long)i * G + c; const int nwg = nM * nN;
        if (L < nwg) { tile_of(L, nM, nN, u.pm, u.pn); u.e = 0; return true; }
        const long r = L - nwg; if (r >= (long)xnM * xnN) return false;
        u.pm = xM0 + (int)(r % xnM); u.pn = xN0 + (int)(r / xnM); u.e = 0; return true;
    }
    __device__ __forceinline__ const char* abase(const Unit& u) const { return (const char*)A + (size_t)u.pm * BM * RB; }
    __device__ __forceinline__ const char* bbase(const Unit& u) const { return (const char*)Bt + (size_t)u.pn * BM * RB; }
    __device__ __forceinline__ void rows(const Unit&, unsigned (&va)[2][2], const int (&R)[2], const int (&C)[2]) const {
#pragma unroll
        for (int h = 0; h < 2; ++h)
#pragma unroll
            for (int i = 0; i < 2; ++i) va[h][i] = (unsigned)((h * HALF + R[i]) * RB + 2 * C[i]);
    }
};
template <bool GATHER> struct MoeSched {
    const unsigned char* A; const unsigned char* Bt; int RB, nN, G, c; size_t estride;
    const LAS int* tst; const LAS int* cnts; const int* rowlist;
    __device__ __forceinline__ bool next(int i, Unit& u) const {
        const int TM = __builtin_amdgcn_readfirstlane(tst[NE]); const long L = (long)i * G + c; if (L >= (long)TM * nN) return false;
        tile_of(L, TM, nN, u.pm, u.pn);
        u.e = __builtin_amdgcn_readfirstlane(tst[(LW_TE - LW_TST) + u.pm]); return true;
    }
    __device__ __forceinline__ const char* abase(const Unit& u) const { return GATHER ? (const char*)A : (const char*)A + (size_t)u.pm * BM * RB; }
    __device__ __forceinline__ const char* bbase(const Unit& u) const { return (const char*)Bt + (size_t)u.e * estride + (size_t)u.pn * BM * RB; }
    __device__ __forceinline__ void rows(const Unit& u, unsigned (&va)[2][2], const int (&R)[2], const int (&C)[2]) const {
        if (GATHER) {
            const int n = __builtin_amdgcn_readfirstlane(cnts[u.e]), lt = u.pm - __builtin_amdgcn_readfirstlane(tst[u.e]);
#pragma unroll
            for (int h = 0; h < 2; ++h)
#pragma unroll
                for (int i = 0; i < 2; ++i) { int slot = lt * BM + h * HALF + R[i]; slot = slot < n ? slot : 0; const int tok = rowlist[u.e * M + slot]; va[h][i] = (unsigned)(tok * RB + 2 * C[i]); }
        } else {
#pragma unroll
            for (int h = 0; h < 2; ++h)
#pragma unroll
                for (int i = 0; i < 2; ++i) va[h][i] = (unsigned)((h * HALF + R[i]) * RB + 2 * C[i]);
        }
    }
};

typedef int i32x4 __attribute__((ext_vector_type(4)));
typedef int i32x8 __attribute__((ext_vector_type(8)));
template <bool FP8, class Epi, class Sched>
__device__ __forceinline__ void gemm_phase(LAS unsigned char* lds, const int RB, const Sched& S, const Epi& E) {
    const int tid = threadIdx.x, wid = __builtin_amdgcn_readfirstlane(tid >> 6), lane = tid & 63, wr = wid >> 2, wc = wid & 3, fr = lane & 15, fq = lane >> 4;
    const int nt = RB / 128;
    unsigned voffB[2]; int Rr[2], Cc[2];
#pragma unroll
    for (int i = 0; i < 2; ++i) { int R, C; stage_rc(tid * 16 + i * 8192, R, C); Rr[i] = R; Cc[i] = C; const int Rb = Epi::PERM ? ((R & ~31) + perm32(R & 31)) : R; voffB[i] = (unsigned)(Rb * RB + 2 * C); }
    const size_t kstep = (size_t)(BK * 2);
    const size_t hstep = (size_t)HALF * RB;
    const unsigned ldsw = (unsigned)wid * 1024u;
    const int aoff = lds_byte(wr * 64 + fr, fq * 8), boff = lds_byte(wc * 32 + fr, fq * 8);
#define PG8_SA(b, h) (((b) * 2 + (h)) * HTB)
#define PG8_SB(b, h) ((4 + (b) * 2 + (h)) * HTB)
#define PG8_STAGE(bufoff, gbase, voff) do { _Pragma("unroll") for (int _i = 0; _i < 2; ++_i) \
        __builtin_amdgcn_global_load_lds((const unsigned*)((const char*)(gbase) + (voff)[_i]), (LAS unsigned*)(lds + (bufoff) + ldsw + _i * 8192), 16, 0, 0); } while (0)
#define PG8_LDA(dst, b, h) do { _Pragma("unroll") for (int m = 0; m < 4; ++m) _Pragma("unroll") for (int k = 0; k < 2; ++k) dst[m][k] = *(const LAS bf16x8*)(lds + PG8_SA(b, h) + aoff + m * 2048 + k * 1024); } while (0)
#define PG8_LDB(dst, b, h) do { _Pragma("unroll") for (int n = 0; n < 2; ++n) _Pragma("unroll") for (int k = 0; k < 2; ++k) dst[n][k] = *(const LAS bf16x8*)(lds + PG8_SB(b, h) + boff + n * 2048 + k * 1024); } while (0)
#define PG8_MMA(ai, bj, At, Bt) do { __builtin_amdgcn_s_setprio(1); _Pragma("unroll") for (int m = 0; m < 4; ++m) _Pragma("unroll") for (int n = 0; n < 2; ++n) { \
        if constexpr (FP8) { const i32x8 bb_ = __builtin_shufflevector(__builtin_bit_cast(i32x4, Bt[n][0]), __builtin_bit_cast(i32x4, Bt[n][1]), 0, 1, 2, 3, 4, 5, 6, 7); \
            const i32x8 aa_ = __builtin_shufflevector(__builtin_bit_cast(i32x4, At[m][0]), __builtin_bit_cast(i32x4, At[m][1]), 0, 1, 2, 3, 4, 5, 6, 7); \
            asm volatile("v_mfma_scale_f32_16x16x128_f8f6f4 %0, %1, %2, %0, %3, %3 op_sel_hi:[0,0,0]" : "+v"(acc[ai][bj][m][n]) : "v"(bb_), "v"(aa_), "v"(one_scale)); } \
        else { _Pragma("unroll") for (int k = 0; k < 2; ++k) acc[ai][bj][m][n] = __builtin_amdgcn_mfma_f32_16x16x32_bf16(Bt[n][k], At[m][k], acc[ai][bj][m][n], 0, 0, 0); } } \
        __builtin_amdgcn_s_setprio(0); } while (0)
#define PG8_WAIT_V(n) asm volatile("s_waitcnt vmcnt(" #n ")" ::: "memory")
#define PG8_WAIT_L(n) asm volatile("s_waitcnt lgkmcnt(" #n ")" ::: "memory")
#define PG8_BAR __builtin_amdgcn_s_barrier()
#define PG8_SCHED __builtin_amdgcn_sched_barrier(0)
    Unit cur, nxt; int ui = 0;
    if (!S.next(0, cur)) return;
    f32x4 acc[2][2][4][2];
#pragma unroll
    for (int a = 0; a < 2; ++a)
#pragma unroll
        for (int b = 0; b < 2; ++b)
#pragma unroll
            for (int m = 0; m < 4; ++m)
#pragma unroll
                for (int n = 0; n < 2; ++n) acc[a][b][m][n] = (f32x4){0.f, 0.f, 0.f, 0.f};
    bf16x8 At[4][2], B0[2][2], B1[2][2];
    unsigned one_scale = 0x7F7F7F7Fu; asm volatile("" : "+v"(one_scale));
    unsigned vaC[2][2], vaN[2][2];
    S.rows(cur, vaC, Rr, Cc);
    const char* cA = S.abase(cur); const char* cB = S.bbase(cur);
    PG8_STAGE(PG8_SB(0, 0), cB, voffB); PG8_STAGE(PG8_SA(0, 0), cA, vaC[0]); PG8_STAGE(PG8_SB(0, 1), cB + hstep, voffB); PG8_STAGE(PG8_SA(0, 1), cA, vaC[1]);
    if (wr == 1) PG8_BAR;
    PG8_WAIT_V(4); PG8_BAR;
    PG8_STAGE(PG8_SB(1, 0), cB + kstep, voffB); PG8_STAGE(PG8_SA(1, 0), cA + kstep, vaC[0]); PG8_STAGE(PG8_SB(1, 1), cB + hstep + kstep, voffB);
    PG8_WAIT_V(6); PG8_BAR;
    for (;;) {
        const bool has_next = S.next(ui + 1, nxt);
        const char* nA = has_next ? S.abase(nxt) : cA; const char* nB = has_next ? S.bbase(nxt) : cB;
#pragma unroll
        for (int h = 0; h < 2; ++h)
#pragma unroll
            for (int i = 0; i < 2; ++i) vaN[h][i] = vaC[h][i];
        for (int t = 0; t < nt; t += 2) {
            const bool last = (t == nt - 2);
            const char* a1 = cA + (size_t)(t + 1) * kstep;
            const char* a2 = last ? nA : cA + (size_t)(t + 2) * kstep; const char* b2 = last ? nB : cB + (size_t)(t + 2) * kstep;
            const char* a3 = a2 + kstep; const char* b3 = b2 + kstep;
            if (last && has_next) S.rows(nxt, vaN, Rr, Cc);
            unsigned v2[2][2];
#pragma unroll
            for (int h = 0; h < 2; ++h)
#pragma unroll
                for (int i = 0; i < 2; ++i) v2[h][i] = last ? vaN[h][i] : vaC[h][i];
            PG8_LDB(B0, 0, 0); PG8_SCHED; PG8_LDA(At, 0, 0); PG8_STAGE(PG8_SA(1, 1), a1, vaC[1]);
            PG8_WAIT_L(8); PG8_BAR; PG8_WAIT_L(0); PG8_MMA(0, 0, At, B0); PG8_BAR; PG8_SCHED;
            PG8_LDB(B1, 0, 1); PG8_STAGE(PG8_SB(0, 0), b2, voffB);
            PG8_BAR; PG8_WAIT_L(0); PG8_MMA(0, 1, At, B1); PG8_BAR;
            PG8_LDA(At, 0, 1); PG8_STAGE(PG8_SA(0, 0), a2, v2[0]);
            PG8_BAR; PG8_WAIT_L(0); PG8_MMA(1, 0, At, B0); PG8_BAR; PG8_SCHED;
            PG8_STAGE(PG8_SB(0, 1), b2 + hstep, voffB);
            PG8_WAIT_V(6); PG8_BAR; PG8_MMA(1, 1, At, B1); PG8_BAR;
            PG8_LDB(B0, 1, 0); PG8_SCHED; PG8_LDA(At, 1, 0); PG8_STAGE(PG8_SA(0, 1), a2, v2[1]);
            PG8_WAIT_L(8); PG8_BAR; PG8_WAIT_L(0); PG8_MMA(0, 0, At, B0); PG8_BAR; PG8_SCHED;
            PG8_LDB(B1, 1, 1); PG8_STAGE(PG8_SB(1, 0), b3, voffB);
            PG8_BAR; PG8_WAIT_L(0); PG8_MMA(0, 1, At, B1); PG8_BAR;
            PG8_LDA(At, 1, 1); PG8_STAGE(PG8_SA(1, 0), a3, v2[0]);
            PG8_BAR; PG8_WAIT_L(0); PG8_MMA(1, 0, At, B0); PG8_BAR; PG8_SCHED;
            PG8_STAGE(PG8_SB(1, 1), b3 + hstep, voffB);
            PG8_WAIT_V(6); PG8_BAR; PG8_MMA(1, 1, At, B1); PG8_BAR;
        }
        if constexpr (FP8) asm volatile("s_nop 15\n\ts_nop 15" ::: "memory");
        E(acc, cur, wr, wc, fr, fq);
        if (!has_next) break;
#pragma unroll
        for (int a = 0; a < 2; ++a)
#pragma unroll
            for (int b = 0; b < 2; ++b)
#pragma unroll
                for (int m = 0; m < 4; ++m)
#pragma unroll
                    for (int n = 0; n < 2; ++n) acc[a][b][m][n] = (f32x4){0.f, 0.f, 0.f, 0.f};
        cur = nxt; cA = nA; cB = nB; ++ui;
#pragma unroll
        for (int h = 0; h < 2; ++h)
#pragma unroll
            for (int i = 0; i < 2; ++i) vaC[h][i] = vaN[h][i];
    }
    PG8_WAIT_V(0);
    if (wr == 0) PG8_BAR;
    PG8_BAR;
#undef PG8_SA
#undef PG8_SB
#undef PG8_STAGE
#undef PG8_LDA
#undef PG8_LDB
#undef PG8_MMA
#undef PG8_WAIT_V
#undef PG8_WAIT_L
#undef PG8_BAR
#undef PG8_SCHED
}

template <bool HAS_BIAS> struct EpiStoreBf16 {
    static constexpr bool PERM = true;
    bf16_t* O; int ldc; const float* bias; int bias_estride; float sc;
    __device__ __forceinline__ void operator()(const f32x4 (&acc)[2][2][4][2], const Unit& u, int wr, int wc, int fr, int fq) const {
        const int row0 = u.pm * BM + wr * 64 + fr, col0 = u.pn * BM + wc * 32 + 8 * fq;
        f32x4 bv[2][2];
#pragma unroll
        for (int bj = 0; bj < 2; ++bj)
#pragma unroll
            for (int n = 0; n < 2; ++n) { if constexpr (HAS_BIAS) bv[bj][n] = *(const f32x4*)(bias + (size_t)u.e * bias_estride + col0 + bj * HALF + 4 * n); else bv[bj][n] = (f32x4){0.f, 0.f, 0.f, 0.f}; }
#pragma unroll
        for (int ai = 0; ai < 2; ++ai)
#pragma unroll
            for (int m = 0; m < 4; ++m) { bf16_t* rowp = O + (size_t)(row0 + ai * HALF + m * 16) * ldc + col0;
#pragma unroll
                for (int bj = 0; bj < 2; ++bj) { const f32x4 v0 = acc[ai][bj][m][0] * sc + bv[bj][0], v1 = acc[ai][bj][m][1] * sc + bv[bj][1];
                    u32x4 w; w.x = cvt_pk_bf16(v0[0], v0[1]); w.y = cvt_pk_bf16(v0[2], v0[3]); w.z = cvt_pk_bf16(v1[0], v1[1]); w.w = cvt_pk_bf16(v1[2], v1[3]);
                    *(u32x4*)(rowp + bj * HALF) = w; } }
    }
};
struct EpiStoreFp8 {
    static constexpr bool PERM = true;
    unsigned char* O; int ldc; float sc;
    __device__ __forceinline__ void operator()(const f32x4 (&acc)[2][2][4][2], const Unit& u, int wr, int wc, int fr, int fq) const {
        const int row0 = u.pm * BM + wr * 64 + fr, col0 = u.pn * BM + wc * 32 + 8 * fq;
#pragma unroll
        for (int ai = 0; ai < 2; ++ai)
#pragma unroll
            for (int m = 0; m < 4; ++m) { unsigned char* rowp = O + (size_t)(row0 + ai * HALF + m * 16) * ldc + col0;
#pragma unroll
                for (int bj = 0; bj < 2; ++bj) { const f32x4 v0 = acc[ai][bj][m][0] * sc, v1 = acc[ai][bj][m][1] * sc;
                    u32x2 w; w.x = pk4_fp8(v0[0], v0[1], v0[2], v0[3]); w.y = pk4_fp8(v1[0], v1[1], v1[2], v1[3]);
                    *(u32x2*)(rowp + bj * HALF) = w; } }
    }
};
struct EpiGlu {
    static constexpr bool PERM = true;
    const bf16_t* Yg; bf16_t* O; const float* bias;
    __device__ __forceinline__ void operator()(const f32x4 (&acc)[2][2][4][2], const Unit& u, int wr, int wc, int fr, int fq) const {
        const int row0 = u.pm * BM + wr * 64 + fr, col0 = u.pn * BM + wc * 32 + 8 * fq;
        f32x4 bv[2][2];
#pragma unroll
        for (int bj = 0; bj < 2; ++bj)
#pragma unroll
            for (int n = 0; n < 2; ++n) bv[bj][n] = *(const f32x4*)(bias + col0 + bj * HALF + 4 * n);
#pragma unroll
        for (int ai = 0; ai < 2; ++ai)
#pragma unroll
            for (int m = 0; m < 4; ++m) { const size_t r = (size_t)(row0 + ai * HALF + m * 16);
#pragma unroll
                for (int bj = 0; bj < 2; ++bj) { const f32x4 v0 = acc[ai][bj][m][0] + bv[bj][0], v1 = acc[ai][bj][m][1] + bv[bj][1];
                    const u32x4 y = *(const u32x4*)(Yg + r * S5W + col0 + bj * HALF);
                    float o[8];
                    o[0] = bflo(y.x) * sigm(v0[0]); o[1] = bfhi(y.x) * sigm(v0[1]); o[2] = bflo(y.y) * sigm(v0[2]); o[3] = bfhi(y.y) * sigm(v0[3]);
                    o[4] = bflo(y.z) * sigm(v1[0]); o[5] = bfhi(y.z) * sigm(v1[1]); o[6] = bflo(y.w) * sigm(v1[2]); o[7] = bfhi(y.w) * sigm(v1[3]);
                    u32x4 w; w.x = cvt_pk_bf16(o[0], o[1]); w.y = cvt_pk_bf16(o[2], o[3]); w.z = cvt_pk_bf16(o[4], o[5]); w.w = cvt_pk_bf16(o[6], o[7]);
                    *(u32x4*)(O + r * D + col0 + bj * HALF) = w; } }
    }
};
struct EpiResid {
    static constexpr bool PERM = false;
    const float* X; float* O; const float* mod;
    __device__ __forceinline__ void operator()(const f32x4 (&acc)[2][2][4][2], const Unit& u, int wr, int wc, int fr, int fq) const {
        const int row0 = u.pm * BM + wr * 64 + fr, col0 = u.pn * BM + wc * 32 + 4 * fq, b = u.pm >> 3;
        f32x4 gv[2][2];
#pragma unroll
        for (int bj = 0; bj < 2; ++bj)
#pragma unroll
            for (int n = 0; n < 2; ++n) { const int c = col0 + bj * HALF + n * 16; gv[bj][n] = *(const f32x4*)(mod + (size_t)b * 12288 + 2 * D + c); }
#pragma unroll
        for (int ai = 0; ai < 2; ++ai) {
            f32x4 xv[4][2][2];
#pragma unroll
            for (int m = 0; m < 4; ++m) { const size_t off = (size_t)(row0 + ai * HALF + m * 16) * D + col0;
#pragma unroll
                for (int bj = 0; bj < 2; ++bj)
#pragma unroll
                    for (int n = 0; n < 2; ++n) xv[m][bj][n] = *(const f32x4*)(X + off + bj * HALF + n * 16); }
            asm volatile("" ::: "memory");
#pragma unroll
            for (int m = 0; m < 4; ++m) { const size_t off = (size_t)(row0 + ai * HALF + m * 16) * D + col0;
#pragma unroll
                for (int bj = 0; bj < 2; ++bj)
#pragma unroll
                    for (int n = 0; n < 2; ++n) *(f32x4*)(O + off + bj * HALF + n * 16) = xv[m][bj][n] + gv[bj][n] * acc[ai][bj][m][n]; }
            asm volatile("" ::: "memory");
        }
    }
};
struct EpiSwiglu {
    static constexpr bool PERM = true;
    unsigned char* O; const float* bias; float sc;
    __device__ __forceinline__ void operator()(const f32x4 (&acc)[2][2][4][2], const Unit& u, int wr, int wc, int fr, int fq) const {
        const int row0 = u.pm * BM + wr * 64 + fr, j0 = wc * 32 + 8 * fq, cb = u.pn * HALF + j0;
        f32x4 bg[2], bu[2];
#pragma unroll
        for (int n = 0; n < 2; ++n) { bg[n] = *(const f32x4*)(bias + (size_t)u.e * 4096 + cb + 4 * n); bu[n] = *(const f32x4*)(bias + (size_t)u.e * 4096 + 2048 + cb + 4 * n); }
#pragma unroll
        for (int ai = 0; ai < 2; ++ai)
#pragma unroll
            for (int m = 0; m < 4; ++m) { float o[8];
#pragma unroll
                for (int n = 0; n < 2; ++n)
#pragma unroll
                    for (int e = 0; e < 4; ++e) { float g = acc[ai][0][m][n][e] * sc + bg[n][e], uu = acc[ai][1][m][n][e] * sc + bu[n][e];
                        g = fminf(g, 7.0f); uu = fminf(fmaxf(uu, -7.0f), 7.0f);
                        o[4 * n + e] = (uu + 1.0f) * (g * sigm(1.702f * g)); }
                u32x2 w; w.x = pk4_fp8(o[0], o[1], o[2], o[3]); w.y = pk4_fp8(o[4], o[5], o[6], o[7]);
                *(u32x2*)(O + (size_t)(row0 + ai * HALF + m * 16) * DFF + cb) = w; }
    }
};
}

#define FI __device__ __forceinline__

FI void transpose_item(const float* W, int K, int N, bf16_t* WT, int row_off, LAS float* scr, int kb, int nb, int lane) {
    const int k0 = 64 * kb, n0 = 32 * nb;
#pragma unroll 8
    for (int i = 0; i < 32; ++i) { const int kk = 2 * i + (lane >> 5); scr[kk * 33 + (lane & 31)] = W[(size_t)(k0 + kk) * N + n0 + (lane & 31)]; }
    LDS_WAIT(); asm volatile("" ::: "memory");
    const int c = lane & 7;
#pragma unroll
    for (int j = 0; j < 4; ++j) { const int n = (lane >> 3) + 8 * j; const LAS float* s = scr + (8 * c) * 33 + n;
        u32x4 o; o.x = pk2(s[0 * 33], s[1 * 33]); o.y = pk2(s[2 * 33], s[3 * 33]); o.z = pk2(s[4 * 33], s[5 * 33]); o.w = pk2(s[6 * 33], s[7 * 33]);
        *(u32x4*)(WT + (size_t)(row_off + n0 + n) * K + k0 + 8 * c) = o; }
    LDS_WAIT(); asm volatile("" ::: "memory");
}

FI void transpose_item_fp8(const float* W, int K, int N, unsigned char* WT, int row_off, LAS float* scr, int kb, int nb, int lane, float scale) {
    const int k0 = 64 * kb, n0 = 32 * nb;
#pragma unroll 8
    for (int i = 0; i < 32; ++i) { const int kk = 2 * i + (lane >> 5); scr[kk * 33 + (lane & 31)] = W[(size_t)(k0 + kk) * N + n0 + (lane & 31)]; }
    LDS_WAIT(); asm volatile("" ::: "memory");
    const int n = lane & 31, hf = lane >> 5; const LAS float* s = scr + (32 * hf) * 33 + n;
    u32x4 o0, o1;
    o0.x = pk4_fp8(s[0 * 33] * scale, s[1 * 33] * scale, s[2 * 33] * scale, s[3 * 33] * scale); o0.y = pk4_fp8(s[4 * 33] * scale, s[5 * 33] * scale, s[6 * 33] * scale, s[7 * 33] * scale);
    o0.z = pk4_fp8(s[8 * 33] * scale, s[9 * 33] * scale, s[10 * 33] * scale, s[11 * 33] * scale); o0.w = pk4_fp8(s[12 * 33] * scale, s[13 * 33] * scale, s[14 * 33] * scale, s[15 * 33] * scale);
    o1.x = pk4_fp8(s[16 * 33] * scale, s[17 * 33] * scale, s[18 * 33] * scale, s[19 * 33] * scale); o1.y = pk4_fp8(s[20 * 33] * scale, s[21 * 33] * scale, s[22 * 33] * scale, s[23 * 33] * scale);
    o1.z = pk4_fp8(s[24 * 33] * scale, s[25 * 33] * scale, s[26 * 33] * scale, s[27 * 33] * scale); o1.w = pk4_fp8(s[28 * 33] * scale, s[29 * 33] * scale, s[30 * 33] * scale, s[31 * 33] * scale);
    unsigned char* dst = WT + (size_t)(row_off + n0 + n) * K + k0 + 32 * hf;
    *(u32x4*)dst = o0; *(u32x4*)(dst + 16) = o1;
    LDS_WAIT(); asm volatile("" ::: "memory");
}

FI void tr8_item(const float* W, int N, int K, unsigned char* WT, int row_off, LAS unsigned char* T, int k0, int n0, int lane, float scale) {
    const int nq = lane & 15, kr = lane >> 4;
    const float* src = W + (size_t)(k0 + 4 * kr) * N + n0 + 4 * nq;
#pragma unroll
    for (int rg = 0; rg < 8; ++rg) {
        f32x4 v[4];
#pragma unroll
        for (int j = 0; j < 4; ++j) v[j] = *(const f32x4*)(src + (size_t)(rg * 16 + j) * N) * scale;
#pragma unroll
        for (int i = 0; i < 4; ++i) *(LAS unsigned*)(T + (4 * nq + i) * 128 + ((rg ^ (nq & 7)) << 4) + kr * 4) = pk4_fp8(v[0][i], v[1][i], v[2][i], v[3][i]);
    }
    LDS_WAIT(); asm volatile("" ::: "memory");
#pragma unroll
    for (int t = 0; t < 8; ++t) { const int n = 8 * t + (lane >> 3), p = lane & 7;
        const u32x4 o = *(const LAS u32x4*)(T + n * 128 + ((p ^ ((n >> 2) & 7)) << 4));
        *(u32x4*)(WT + (size_t)(row_off + n0 + n) * K + k0 + 16 * p) = o; }
    LDS_WAIT(); asm volatile("" ::: "memory");
}
FI void moe_weight_item(const Args& A, LAS unsigned char* T, int q, int lane) {
    unsigned char* ws = A.ws;
    if (q < 32768) { const int e = q >> 10, r = q & 1023, kb = r >> 6, nb = r & 63, n0 = 64 * nb;
        const int isU = n0 / 2048, pn = (n0 % 2048) / 128, j = n0 % 128, rowmap = 256 * pn + 128 * isU + j;
        tr8_item(A.in[34] + (size_t)e * D * 4096, 4096, D, ws + WS_WGU + (size_t)e * 4096 * D, rowmap - n0, T, 128 * kb, n0, lane, WSCALE); }
    else { const int q2 = q - 32768, e = q2 >> 9, r = q2 & 511, kb = r >> 5, nb = r & 31;
        tr8_item(A.in[36] + (size_t)e * DFF * D, D, DFF, ws + WS_WDN + (size_t)e * D * DFF, 0, T, 128 * kb, 64 * nb, lane, WSCALE); }
}

FI void p0_run(const Args& A, LAS unsigned char* lds, int tid, int lane, int wave, int vcu, int G) {
    unsigned char* ws = A.ws;
    unsigned long long* mod = (unsigned long long*)((unsigned*)(ws + WS_CTL) + CW_MOD); unsigned long long* hnorm = (unsigned long long*)((unsigned*)(ws + WS_CTL) + CW_HNORM);
    {
        LAS float* sl = (LAS float*)lds;
        LAS float* part = (LAS float*)(lds + 9 * 512 * 4);
        const float* c = A.in[1]; const float* cc = A.in[3]; const float* wada = A.in[4];
        _Pragma("unroll 1") for (int rep = 0; rep < REP0A; ++rep)
        for (int it = vcu; it < 192; it += G) {
            const int cg = it % 48, kq = it / 48, n0 = cg * 256 + 4 * lane, k0 = kq * 512;
            for (int i = tid; i < 9 * 512; i += NTHR) { const int r = i >> 9, k = k0 + (i & 511); const float v = r < 8 ? c[r * D + k] : cc[k]; sl[i] = v / (1.f + __expf(-v)); }
            __syncthreads();
            f32x4 acc[9];
#pragma unroll
            for (int r = 0; r < 9; ++r) acc[r] = (f32x4){0.f, 0.f, 0.f, 0.f};
#pragma unroll 8
            for (int kk = 0; kk < 64; ++kk) { const int kl = wave * 64 + kk; const f32x4 w = *(const f32x4*)(wada + (size_t)(k0 + kl) * 12288 + n0);
#pragma unroll
                for (int r = 0; r < 9; ++r) { const float sv = sl[r * 512 + kl]; acc[r] += w * sv; } }
#pragma unroll
            for (int r = 0; r < 9; ++r) *(LAS f32x4*)(part + (wave * 9 + r) * 256 + 4 * lane) = acc[r];
            __syncthreads();
            for (int i = tid; i < 9 * 256; i += NTHR) { const int r = i >> 8, col = i & 255; float sum = 0.f;
#pragma unroll
                for (int w = 0; w < 8; ++w) sum += part[(w * 9 + r) * 256 + col];
                fix_add(mod + r * 12288 + cg * 256 + col, rep == REP0A - 1 ? sum : 0.0f); }
            __syncthreads();
        }
    }
    {
        LAS float* L = (LAS float*)lds;
        LAS float *w1s = L, *w2s = L + 2112, *w3s = L + 6208, *b1s = L + 10304, *b2s = L + 10368, *b3s = L + 10432, *fqs = L + 10496, *zs = L + 10560, *h1 = L + 10824, *h2 = L + 11336, *h3 = L + 11848;
        for (int i = tid; i < 33 * 64; i += NTHR) w1s[i] = A.in[21][i];
        for (int i = tid; i < 4096; i += NTHR) { w2s[i] = A.in[23][i]; w3s[i] = A.in[25][i]; }
        if (tid < 64) { b1s[tid] = A.in[22][tid]; b2s[tid] = A.in[24][tid]; b3s[tid] = A.in[26][tid]; fqs[tid] = A.in[28][tid]; }
        __syncthreads();
        const float* w4 = A.in[27]; const float* dl = A.in[29]; float* hraw = (float*)(ws + WS_HRAW);
        for (int item = vcu; item < 256; item += G) {
            const int l0 = item * 8;
            if (tid < 264) { const int r = tid / 33, i = tid % 33, l = l0 + r; float z;
                if (i == 0) z = (float)l / 2047.0f;
                else { const int j = (i - 1) & 15; const float band = 1e-4f + (float)j * ((15.0f - 1e-4f) / 15.0f); const float ang = (6.283185307179586f / 2048.0f) * (float)l * band; z = (i <= 16) ? cosf(ang) : -sinf(ang); }
                zs[tid] = z; }
            __syncthreads();
            const int r = tid >> 6, o = tid & 63;
            { float s = b1s[o]; for (int i = 0; i < 33; ++i) s += zs[r * 33 + i] * w1s[i * 64 + o]; h1[r * 64 + o] = sinf(fqs[o] * s); }
            __syncthreads();
            { float s = b2s[o]; for (int i = 0; i < 64; ++i) s += h1[r * 64 + i] * w2s[i * 64 + o]; h2[r * 64 + o] = sinf(fqs[o] * s); }
            __syncthreads();
            { float s = b3s[o]; for (int i = 0; i < 64; ++i) s += h2[r * 64 + i] * w3s[i * 64 + o]; h3[r * 64 + o] = sinf(fqs[o] * s); }
            __syncthreads();
            f32x4 acc[8];
#pragma unroll
            for (int q = 0; q < 8; ++q) acc[q] = (f32x4){0.f, 0.f, 0.f, 0.f};
#pragma unroll 4
            for (int i = 0; i < 64; ++i) { const f32x4 w = *(const f32x4*)(w4 + (size_t)i * 2048 + 4 * tid);
#pragma unroll
                for (int q = 0; q < 8; ++q) acc[q] += w * h3[q * 64 + i]; }
            const f32x4 dv = *(const f32x4*)(dl + 4 * tid);
            f32x4 asum = (f32x4){0.f, 0.f, 0.f, 0.f};
#pragma unroll
            for (int q = 0; q < 8; ++q) { const int l = l0 + q; const float t = (float)l / 2047.0f; f32x4 v;
#pragma unroll
                for (int e = 0; e < 4; ++e) v[e] = acc[q][e] * expf(-t * fabsf(dv[e]));
                *(f32x4*)(hraw + (size_t)l * 2048 + 4 * tid) = v;
                if (!(l == 2047 && 4 * tid >= 1024)) {
#pragma unroll
                    for (int e = 0; e < 4; ++e) asum[e] += fabsf(v[e]); } }
#pragma unroll
            for (int e = 0; e < 4; ++e) fix_add(hnorm + 4 * tid + e, asum[e]);
            __syncthreads();
        }
    }
    {
        const float *lre = A.in[9], *lim = A.in[10], *lst = A.in[11], *bre = A.in[12], *bim = A.in[13], *cre = A.in[14], *cim = A.in[15];
        float* LAM = (float*)(ws + WS_LAM); float* LAML = (float*)(ws + WS_LAML); bf16_t* SB = (bf16_t*)(ws + WS_S5B); bf16_t* SC = (bf16_t*)(ws + WS_S5C);
        for (int idx = vcu * NTHR + tid; idx < 2 * 64 * 4 * 64; idx += G * NTHR) {
            const int ln = idx & 63, T = (idx >> 6) & 3, g = (idx >> 8) & 63, d = idx >> 14;
            {
                const int n = ln & 31, hq = ln >> 5, p = n + 32 * (T >> 1), part = T & 1;
                const int q = (d * 64 + g) * 64 + p;
                const float lr = fminf(lre[q], -1e-4f), li = lim[q], dt = expf(lst[q]), zr = lr * dt, zi = li * dt, er = expf(zr), br = er * cosf(zi), bi = er * sinf(zi);
                const float den = lr * lr + li * li, cr = ((br - 1.f) * lr + bi * li) / den, ci = (bi * lr - (br - 1.f) * li) / den;
                float v[8];
#pragma unroll
                for (int j = 0; j < 8; ++j) { const int h = 8 * hq + j; const float xr = bre[(size_t)q * 16 + h], xi = bim[(size_t)q * 16 + h]; v[j] = part ? (cr * xi + ci * xr) : (cr * xr - ci * xi); }
                u32x4 w; w.x = pk2(v[0], v[1]); w.y = pk2(v[2], v[3]); w.z = pk2(v[4], v[5]); w.w = pk2(v[6], v[7]);
                *(u32x4*)(SB + (size_t)idx * 8) = w;
                if (part == 0 && hq == 0) { LAM[q * 2] = br; LAM[q * 2 + 1] = bi; const float eL = expf((float)SEG * zr), aL = (float)SEG * zi; LAML[q * 2] = eL * cosf(aL); LAML[q * 2 + 1] = eL * sinf(aL); }
            }
            {
                const int hc = ln & 15, qq = ln >> 4; float v[8];
#pragma unroll
                for (int j = 0; j < 8; ++j) { const int k = 32 * T + 8 * qq + j, n = k >> 2, TT = k & 3, p = n + 32 * (TT >> 1), part = TT & 1; const size_t ci = ((size_t)(d * 64 + g) * 16 + hc) * 64 + p; v[j] = part ? -cim[ci] : cre[ci]; }
                u32x4 w; w.x = pk2(v[0], v[1]); w.y = pk2(v[2], v[3]); w.z = pk2(v[4], v[5]); w.w = pk2(v[6], v[7]);
                *(u32x4*)(SC + (size_t)idx * 8) = w;
            }
        }
    }
    {
        const float* wrt = A.in[32]; bf16_t* WRF = (bf16_t*)(ws + WS_WRF);
        for (int idx = vcu * NTHR + tid; idx < 64 * 2 * 64; idx += G * NTHR) {
            const int ln = idx & 63, nt = (idx >> 6) & 1, ks = idx >> 7, ex = 16 * nt + (ln & 15), k0 = 32 * ks + 8 * (ln >> 4);
            float v[8], rsd[8];
#pragma unroll
            for (int j = 0; j < 8; ++j) { v[j] = wrt[(size_t)(k0 + j) * NE + ex]; rsd[j] = v[j] - bf1((bf16_t)f2bf(v[j])); }
            u32x4 hi, lo; hi.x = pk2(v[0], v[1]); hi.y = pk2(v[2], v[3]); hi.z = pk2(v[4], v[5]); hi.w = pk2(v[6], v[7]);
            lo.x = pk2(rsd[0], rsd[1]); lo.y = pk2(rsd[2], rsd[3]); lo.z = pk2(rsd[4], rsd[5]); lo.w = pk2(rsd[6], rsd[7]);
            *(u32x4*)(WRF + ((size_t)((ks * 2 + nt) * 2 + 0) * 64 + ln) * 8) = hi;
            *(u32x4*)(WRF + ((size_t)((ks * 2 + nt) * 2 + 1) * 64 + ln) * 8) = lo;
        }
    }
    {
        __syncthreads();
        LAS float* scr = (LAS float*)(lds + wave * 16384);
        const int gw = vcu * NWAVES + wave, NGW = G * NWAVES;
        constexpr int I_IN = 32 * 128, I_GLU = 16 * 32, I_OUT = 32 * 64;
        constexpr int NITEMS = I_IN + I_GLU + I_OUT;
        for (int it = gw; it < NITEMS; it += NGW) {
            int r = it;
            if (r < I_IN) { transpose_item(A.in[8], D, DIN, (bf16_t*)(ws + WS_WIN), 0, scr, r / 128, r % 128, lane); continue; } r -= I_IN;
            if (r < I_GLU) { transpose_item(A.in[17], S5W, S5W, (bf16_t*)(ws + WS_WGLU), 0, scr, r / 32, r % 32, lane); continue; } r -= I_GLU;
            transpose_item(A.in[31], D, D, (bf16_t*)(ws + WS_WOUT), 0, scr, r / 64, r % 64, lane);
        }
    }
}
#ifndef P0_SPLIT_ITEMS
#define P0_SPLIT_ITEMS 28000
#endif
FI void p0d_run(const Args& A, LAS unsigned char* lds, int lane, int wave, int q0, int q1, int vcu, int G) {
    const int gw = vcu * NWAVES + wave, NGW = G * NWAVES;
    _Pragma("unroll 1") for (int rep = 0; rep < REP0D; ++rep)
    for (int q = q0 + gw; q < q1; q += NGW) moe_weight_item(A, lds + wave * 16384, q, lane);
}

FI void p1_run(const Args& A, int tid, int lane, int wave, int vcu, int G, int m0, int m1, bool extras) {
    unsigned char* ws = A.ws;
    const unsigned long long* mod = (const unsigned long long*)((const unsigned*)(ws + WS_CTL) + CW_MOD); const unsigned long long* hnorm = (const unsigned long long*)((const unsigned*)(ws + WS_CTL) + CW_HNORM);
    const float* bada = A.in[5]; const float* g1 = A.in[6];
    bf16_t* A1 = (bf16_t*)(ws + WS_A1);
    const int gw = vcu * NWAVES + wave, NGW = G * NWAVES;
    if (extras) { float* modf = (float*)(ws + WS_MODF); for (int i = vcu * NTHR + tid; i < 9 * 12288; i += G * NTHR) modf[i] = fix_get(mod + i) + bada[i % 12288]; }
    {
        const int nrows = m1 - m0, per = (nrows + NGW - 1) / NGW, r0 = m0 + gw * per, r1 = (r0 + per) < m1 ? (r0 + per) : m1;
        int cur_mr = -1; f32x4 gsc[8], shv[8];
        for (int m = r0; m < r1; ++m) {
            const float* src = m < M ? A.in[0] + (size_t)m * D : A.in[2] + (size_t)(m - M) * D;
            const int mr = m < M ? m / SEQ : 8;
            f32x4 v[8]; float ss = 0.f;
#pragma unroll
            for (int j = 0; j < 8; ++j) { v[j] = *(const f32x4*)(src + 4 * lane + 256 * j); ss += (v[j].x * v[j].x + v[j].y * v[j].y) + (v[j].z * v[j].z + v[j].w * v[j].w); }
            if (mr != cur_mr) { cur_mr = mr;
#pragma unroll
                for (int j = 0; j < 8; ++j) { const int c = 4 * lane + 256 * j; const unsigned long long* mp = mod + (size_t)mr * 12288 + c;
                    shv[j] = (f32x4){fix_get(mp), fix_get(mp + 1), fix_get(mp + 2), fix_get(mp + 3)} + *(const f32x4*)(bada + c);
                    const f32x4 sc = (f32x4){fix_get(mp + D), fix_get(mp + D + 1), fix_get(mp + D + 2), fix_get(mp + D + 3)} + *(const f32x4*)(bada + D + c);
                    gsc[j] = *(const f32x4*)(g1 + c) * (sc + 1.0f); } }
            const float rstd = rsqrtf(wave_sum(ss) * (1.0f / D) + 1e-6f);
#pragma unroll
            for (int j = 0; j < 8; ++j) { const int c = 4 * lane + 256 * j;
                const f32x4 h = v[j] * rstd * gsc[j] + shv[j];
                u32x2 w; w.x = pk2(h.x, h.y); w.y = pk2(h.z, h.w);
                *(u32x2*)(A1 + (size_t)m * D + c) = w; }
        }
    }
    const float* hraw = (const float*)(ws + WS_HRAW); bf16_t* Rg = (bf16_t*)(ws + WS_RG);
    if (extras)
    for (int it = gw; it < 512 * 16; it += NGW) {
        const int ib = it >> 4, c = (it & 15) * 64 + lane;
        const float inv = 1.0f / (fix_get(hnorm + c) + fix_get(hnorm + HYW + c));
        float v[8];
#pragma unroll
        for (int jj = 0; jj < 8; ++jj) { const int i = 8 * ib + jj; float x;
            if (i <= 2047) x = hraw[(size_t)(2047 - i) * 2048 + c]; else if (i <= 4094) x = hraw[(size_t)(i - 2048) * 2048 + HYW + c]; else x = 0.f;
            v[jj] = x * inv; }
        u32x4 w; w.x = pk2(v[0], v[1]); w.y = pk2(v[2], v[3]); w.z = pk2(v[4], v[5]); w.w = pk2(v[6], v[7]);
        *(u32x4*)(Rg + (size_t)c * 4096 + 8 * ib) = w;
    }
}

FI void s5_unit(const Args& A, LAS unsigned char* lds, int unit, int lane, int wave) {
    unsigned char* ws = A.ws;
    const int d = unit & 1, g = (unit >> 1) & 63, bp = unit >> 7, dg = d * 64 + g;
    const bf16_t* P = (const bf16_t*)(ws + WS_P); bf16_t* Ys = (bf16_t*)(ws + WS_YS5);
    bf16x8 Bf[4], Cf[4];
#pragma unroll
    for (int T = 0; T < 4; ++T) { Bf[T] = *(const bf16x8*)((const bf16_t*)(ws + WS_S5B) + ((size_t)(dg * 4 + T) * 64 + lane) * 8); Cf[T] = *(const bf16x8*)((const bf16_t*)(ws + WS_S5C) + ((size_t)(dg * 4 + T) * 64 + lane) * 8); }
    const int n = lane & 31, hh = lane >> 5;
    const float* LAM = (const float*)(ws + WS_LAM) + (size_t)dg * 128; const float* LAML = (const float*)(ws + WS_LAML) + (size_t)dg * 128;
    const float lr0 = LAM[n * 2], li0 = LAM[n * 2 + 1], lr1 = LAM[(n + 32) * 2], li1 = LAM[(n + 32) * 2 + 1];
    const int r = lane & 31, bsel = (r >> 2) & 1, tau = (r & 3) + 4 * (r >> 3), b = 2 * bp + bsel, kofs = g * 16 + 8 * (lane >> 5);
    const int seg0 = wave * SEG;
    auto rowp = [&](int pos) -> const bf16_t* {
        int row; if (pos < CTXL) { const int tc = d ? (CTXL - 1 - pos) : pos; row = M + b * CTXL + tc; } else { const int q = pos - CTXL; const int tl = d ? (SEQ - 1 - q) : q; row = b * SEQ + tl; }
        return P + (size_t)row * DIN + kofs; };
    const f32x16 z16 = {0.f, 0.f, 0.f, 0.f, 0.f, 0.f, 0.f, 0.f, 0.f, 0.f, 0.f, 0.f, 0.f, 0.f, 0.f, 0.f};
    float xr0 = 0.f, xi0 = 0.f, xr1 = 0.f, xi1 = 0.f;
#define S5_FMA(dst, a, b, c) asm volatile("v_fma_f32 %0, %1, %2, %3" : "=v"(dst) : "v"(a), "v"(b), "v"(c))
#define S5_SETTLE(c0, c1, c2, c3) asm volatile("s_nop 15\n\ts_nop 7" : "+v"(c0), "+v"(c1), "+v"(c2), "+v"(c3))
#define S5_TOKEN(tt, R0, I0, R1, I1) do { float t0_, t1_, s0_, s1_; \
        S5_FMA(t0_, nli0, xi0, c0[tt]); S5_FMA(t1_, nli1, xi1, c2[tt]); S5_FMA(s0_, li0, xr0, c1[tt]); S5_FMA(s1_, li1, xr1, c3[tt]); \
        S5_FMA(R0, lr0, xr0, t0_); S5_FMA(R1, lr1, xr1, t1_); S5_FMA(I0, lr0, xi0, s0_); S5_FMA(I1, lr1, xi1, s1_); \
        xr0 = R0; xi0 = I0; xr1 = R1; xi1 = I1; } while (0)
    const float nli0 = -li0, nli1 = -li1;
    {
        bf16x8 uc[3], un[3];
#pragma unroll
        for (int q = 0; q < 3; ++q) { uc[q] = *(const bf16x8*)rowp(seg0 + 16 * q + tau); un[q] = uc[q]; }
#pragma unroll 1
        for (int ch = 0; ch < 6; ++ch) {
            if (ch < 5) {
#pragma unroll
                for (int q = 0; q < 3; ++q) un[q] = *(const bf16x8*)rowp(seg0 + 16 * (3 * (ch + 1) + q) + tau); }
#pragma unroll
            for (int q = 0; q < 3; ++q) {
                f32x16 c0 = __builtin_amdgcn_mfma_f32_32x32x16_bf16(uc[q], Bf[0], z16, 0, 0, 0), c1 = __builtin_amdgcn_mfma_f32_32x32x16_bf16(uc[q], Bf[1], z16, 0, 0, 0);
                f32x16 c2 = __builtin_amdgcn_mfma_f32_32x32x16_bf16(uc[q], Bf[2], z16, 0, 0, 0), c3 = __builtin_amdgcn_mfma_f32_32x32x16_bf16(uc[q], Bf[3], z16, 0, 0, 0);
                S5_SETTLE(c0, c1, c2, c3);
#pragma unroll
                for (int tt = 0; tt < 16; ++tt) { float r0_, i0_, r1_, i1_; S5_TOKEN(tt, r0_, i0_, r1_, i1_); }
            }
#pragma unroll
            for (int q = 0; q < 3; ++q) uc[q] = un[q];
        }
    }
    LAS float* Es = (LAS float*)(lds + 8 * 8704);
    *(LAS f32x4*)(Es + (wave * 64 + lane) * 4) = (f32x4){xr0, xi0, xr1, xi1};
    __syncthreads();
    {
        const float Lr0 = LAML[n * 2], Li0 = LAML[n * 2 + 1], Lr1 = LAML[(n + 32) * 2], Li1 = LAML[(n + 32) * 2 + 1];
        xr0 = 0.f; xi0 = 0.f; xr1 = 0.f; xi1 = 0.f;
#pragma unroll 1
        for (int w = 0; w < wave; ++w) { const f32x4 e = *(LAS f32x4*)(Es + (w * 64 + lane) * 4);
            const float nr0 = Lr0 * xr0 - Li0 * xi0 + e.x, ni0 = Lr0 * xi0 + Li0 * xr0 + e.y; xr0 = nr0; xi0 = ni0;
            const float nr1 = Lr1 * xr1 - Li1 * xi1 + e.z, ni1 = Lr1 * xi1 + Li1 * xr1 + e.w; xr1 = nr1; xi1 = ni1; }
    }
    {
        LAS unsigned char* Xs = lds + wave * 8704;
        bf16x8 uc[3], un[3];
#pragma unroll
        for (int q = 0; q < 3; ++q) { uc[q] = *(const bf16x8*)rowp(seg0 + 16 * q + tau); un[q] = uc[q]; }
#pragma unroll 1
        for (int ch = 0; ch < 6; ++ch) {
            if (ch < 5) {
#pragma unroll
                for (int q = 0; q < 3; ++q) un[q] = *(const bf16x8*)rowp(seg0 + 16 * (3 * (ch + 1) + q) + tau); }
#pragma unroll
            for (int q = 0; q < 3; ++q) {
                const int pos0 = seg0 + 16 * (3 * ch + q);
                f32x16 c0 = __builtin_amdgcn_mfma_f32_32x32x16_bf16(uc[q], Bf[0], z16, 0, 0, 0), c1 = __builtin_amdgcn_mfma_f32_32x32x16_bf16(uc[q], Bf[1], z16, 0, 0, 0);
                f32x16 c2 = __builtin_amdgcn_mfma_f32_32x32x16_bf16(uc[q], Bf[2], z16, 0, 0, 0), c3 = __builtin_amdgcn_mfma_f32_32x32x16_bf16(uc[q], Bf[3], z16, 0, 0, 0);
                S5_SETTLE(c0, c1, c2, c3);
                float R0[16], I0[16], R1[16], I1[16];
#pragma unroll
                for (int tt = 0; tt < 16; ++tt) S5_TOKEN(tt, R0[tt], I0[tt], R1[tt], I1[tt]);
                if (pos0 >= CTXL) {
#pragma unroll
                    for (int tt = 0; tt < 16; ++tt) { u32x2 w; w.x = pk2(R0[tt], I0[tt]); w.y = pk2(R1[tt], I1[tt]); *(LAS u32x2*)(Xs + (hh * 16 + tt) * 272 + 8 * n) = w; }
                    LDS_WAIT();
#pragma unroll
                    for (int bt = 0; bt < 2; ++bt) {
                        f32x4 y = (f32x4){0.f, 0.f, 0.f, 0.f};
#pragma unroll
                        for (int ks = 0; ks < 4; ++ks) { const bf16x8 xf = *(const LAS bf16x8*)(Xs + (bt * 16 + (lane & 15)) * 272 + (32 * ks + 8 * (lane >> 4)) * 2); y = __builtin_amdgcn_mfma_f32_16x16x32_bf16(Cf[ks], xf, y, 0, 0, 0); }
                        const int qq = pos0 + (lane & 15) - CTXL, tl = d ? (SEQ - 1 - qq) : qq, bb = 2 * bp + bt;
                        u32x2 w; w.x = pk2(y[0], y[1]); w.y = pk2(y[2], y[3]);
                        *(u32x2*)(Ys + ((size_t)(d * M + bb * SEQ + tl)) * S5W + g * 16 + 4 * (lane >> 4)) = w;
                    }
                    LDS_WAIT();
                }
            }
#pragma unroll
            for (int q = 0; q < 3; ++q) uc[q] = un[q];
        }
    }
    __syncthreads();
#undef S5_FMA
#undef S5_SETTLE
#undef S5_TOKEN
}

FI void h1_item(const Args& A, LAS unsigned char* lds, int item, int tid) {
    unsigned char* ws = A.ws;
    const bf16_t* P = (const bf16_t*)(ws + WS_P); bf16_t* Vt = (bf16_t*)(ws + WS_VT);
    const int gr = item >> 3, cg = item & 7, b = gr >> 5, t0 = (gr & 31) * 64, c0 = cg * 128;
    for (int idx = tid; idx < 2 * 64 * 16; idx += NTHR) { const int ch = idx >> 10, rem = idx & 1023, row = rem >> 4, sg = rem & 15;
        const u32x4 v = *(const u32x4*)(P + (size_t)(b * SEQ + t0 + row) * DIN + S5W + ch * HYW + c0 + sg * 8);
        *(LAS u32x4*)(lds + ch * 16896 + (row + 1) * 256 + sg * 16) = v; }
    if (tid < 64) { const int ch = tid >> 5, rr = (tid >> 4) & 1, sg = tid & 15; *(LAS u32x4*)(lds + ch * 16896 + (rr ? 65 : 0) * 256 + sg * 16) = (u32x4){0u, 0u, 0u, 0u}; }
    __syncthreads();
    const int c = tid & 127, tq = tid >> 7, cc = c0 + c;
    const float* cw = A.in[19]; const float* cb = A.in[20];
    const float w0v = cw[cc], w1v = cw[3072 + cc], w2v = cw[6144 + cc], bv = cb[cc];
    const float w0x = cw[HYW + cc], w1x = cw[3072 + HYW + cc], w2x = cw[6144 + HYW + cc], bx = cb[HYW + cc];
    const LAS bf16_t* Vs = (const LAS bf16_t*)lds; const LAS bf16_t* Xs = (const LAS bf16_t*)(lds + 16896);
    float o[16];
#pragma unroll
    for (int i = 0; i < 16; ++i) { const int t = tq * 16 + i;
        const float v = w0v * bf1(Vs[t * 128 + c]) + w1v * bf1(Vs[(t + 1) * 128 + c]) + w2v * bf1(Vs[(t + 2) * 128 + c]) + bv;
        const float x = w0x * bf1(Xs[t * 128 + c]) + w1x * bf1(Xs[(t + 1) * 128 + c]) + w2x * bf1(Xs[(t + 2) * 128 + c]) + bx;
        o[i] = v * x; }
    bf16_t* dst = Vt + ((size_t)(cc * NB + b) * SEQ + t0 + tq * 16);
    u32x4 w0; w0.x = pk2(o[0], o[1]); w0.y = pk2(o[2], o[3]); w0.z = pk2(o[4], o[5]); w0.w = pk2(o[6], o[7]);
    u32x4 w1; w1.x = pk2(o[8], o[9]); w1.y = pk2(o[10], o[11]); w1.z = pk2(o[12], o[13]); w1.w = pk2(o[14], o[15]);
    *(u32x4*)dst = w0; *(u32x4*)(dst + 8) = w1;
    __syncthreads();
}

constexpr int RT_STRIDE = 8208, VS_OFF = 8 * RT_STRIDE, VS_STRIDE = 4112;
FI void longconv_channel(const Args& A, LAS unsigned char* lds, int c, int tid, int lane, int wave) {
    unsigned char* ws = A.ws;
    const bf16_t* Rg = (const bf16_t*)(ws + WS_RG) + (size_t)c * 4096; const bf16_t* Vt = (const bf16_t*)(ws + WS_VT) + (size_t)c * NB * SEQ; bf16_t* LC = (bf16_t*)(ws + WS_LCT) + (size_t)c * NB * SEQ;
    for (int i = tid; i < VS_OFF / 16; i += NTHR) *(LAS u32x4*)(lds + i * 16) = (u32x4){0u, 0u, 0u, 0u};
    for (int i = tid; i < NB * SEQ / 8; i += NTHR) { const int bb = i >> 8, s8 = i & 255; *(LAS u32x4*)(lds + VS_OFF + bb * VS_STRIDE + s8 * 16) = *(const u32x4*)(Vt + (size_t)bb * SEQ + s8 * 8); }
    __syncthreads();
    for (int i = tid; i < 4096; i += NTHR) { const bf16_t v = Rg[i];
#pragma unroll
        for (int r = 0; r < 8; ++r) *(LAS bf16_t*)(lds + r * RT_STRIDE + (i + r) * 2) = v; }
    __syncthreads();
    const int a = lane & 15, q = lane >> 4, r = (a + 1) & 7;
    const LAS unsigned char* vb = lds + VS_OFF + (lane & 7) * VS_STRIDE + 16 * q;
#pragma unroll 1
    for (int grp = 0; grp < 2; ++grp) {
        const int i0 = wave * 16 + grp * 8;
        const LAS unsigned char* rb = lds + r * RT_STRIDE + 2 * (2047 - 16 * (i0 + 7) - a + 8 * q + r);
        f32x4 acc[8];
#pragma unroll
        for (int ii = 0; ii < 8; ++ii) acc[ii] = (f32x4){0.f, 0.f, 0.f, 0.f};
        bf16x8 S[8];
#pragma unroll
        for (int ii = 2; ii < 8; ++ii) S[ii] = *(const LAS bf16x8*)(rb + 32 * (7 - ii));
#pragma unroll 1
        for (int j4 = 0; j4 < 64; j4 += 4) {
#pragma unroll
            for (int jj = 0; jj < 4; ++jj) {
                const int j = j4 + jj;
                const bf16x8 bfr = *(const LAS bf16x8*)(vb + 64 * j);
                S[(0 - 2 * jj) & 7] = *(const LAS bf16x8*)(rb + 32 * 7 + 64 * j);
                S[(1 - 2 * jj) & 7] = *(const LAS bf16x8*)(rb + 32 * 6 + 64 * j);
#pragma unroll
                for (int ii = 0; ii < 8; ++ii) acc[ii] = __builtin_amdgcn_mfma_f32_16x16x32_bf16(S[(ii - 2 * jj) & 7], bfr, acc[ii], 0, 0, 0);
            }
        }
        if (a < 8) {
#pragma unroll
            for (int ii = 0; ii < 8; ++ii) { u32x2 w; w.x = pk2(acc[ii][0], acc[ii][1]); w.y = pk2(acc[ii][2], acc[ii][3]); *(u32x2*)(LC + (size_t)a * SEQ + 16 * (i0 + ii) + 4 * q) = w; }
        }
    }
    __syncthreads();
}

FI void s5_combine(const Args& A, int gtid, int gthreads) {
    unsigned char* ws = A.ws;
    const bf16_t* P = (const bf16_t*)(ws + WS_P); const bf16_t* Ys = (const bf16_t*)(ws + WS_YS5); bf16_t* Yg = (bf16_t*)(ws + WS_YG); const float* dsk = A.in[16];
    for (int idx = gtid; idx < M * 128; idx += gthreads) {
        const int row = idx >> 7, c8 = (idx & 127) * 8;
        const u32x4 u = *(const u32x4*)(P + (size_t)row * DIN + c8), yf = *(const u32x4*)(Ys + (size_t)row * S5W + c8), yb = *(const u32x4*)(Ys + (size_t)(M + row) * S5W + c8);
        const f32x4 d0 = *(const f32x4*)(dsk + c8), d1 = *(const f32x4*)(dsk + c8 + 4);
        float y[8];
        y[0] = bflo(u.x) * d0.x + bflo(yf.x) + bflo(yb.x); y[1] = bfhi(u.x) * d0.y + bfhi(yf.x) + bfhi(yb.x);
        y[2] = bflo(u.y) * d0.z + bflo(yf.y) + bflo(yb.y); y[3] = bfhi(u.y) * d0.w + bfhi(yf.y) + bfhi(yb.y);
        y[4] = bflo(u.z) * d1.x + bflo(yf.z) + bflo(yb.z); y[5] = bfhi(u.z) * d1.y + bfhi(yf.z) + bfhi(yb.z);
        y[6] = bflo(u.w) * d1.z + bflo(yf.w) + bflo(yb.w); y[7] = bfhi(u.w) * d1.w + bfhi(yf.w) + bfhi(yb.w);
#pragma unroll
        for (int e = 0; e < 8; ++e) y[e] = 0.5f * y[e] * (1.0f + erff(y[e] * 0.70710678118654752f));
        u32x4 w; w.x = pk2(y[0], y[1]); w.y = pk2(y[2], y[3]); w.z = pk2(y[4], y[5]); w.w = pk2(y[6], y[7]);
        *(u32x4*)(Yg + (size_t)row * S5W + c8) = w;
    }
}

FI void h3_run(const Args& A, LAS unsigned char* lds, int tid, int vcu, int G) {
    unsigned char* ws = A.ws;
    const bf16_t* P = (const bf16_t*)(ws + WS_P); const bf16_t* LC = (const bf16_t*)(ws + WS_LCT); bf16_t* Yc = (bf16_t*)(ws + WS_YCAT);
    const float* cw = A.in[19]; const float* cb = A.in[20];
    u32x4 rp[6], rl[2];
    auto fetch = [&](int item) {
        const int gr = item >> 3, cg = item & 7, b = gr >> 5, t0 = (gr & 31) * 64, c0 = cg * 128;
#pragma unroll
        for (int k = 0; k < 6; ++k) { const int idx = tid + k * NTHR, ch = idx >> 10, rem = idx & 1023, row = rem >> 4, sg = rem & 15;
            rp[k] = *(const u32x4*)(P + (size_t)(b * SEQ + t0 + row) * DIN + S5W + ch * HYW + c0 + sg * 8); }
#pragma unroll
        for (int k = 0; k < 2; ++k) { const int idx = tid + k * NTHR, c = idx >> 3, pc = idx & 7;
            rl[k] = *(const u32x4*)(LC + (size_t)((c0 + c) * NB + b) * SEQ + t0 + pc * 8); }
    };
    int item = vcu;
    if (item < 2048) fetch(item);
    for (; item < 2048; item += G) {
        const int gr = item >> 3, cg = item & 7, b = gr >> 5, t0 = (gr & 31) * 64, c0 = cg * 128;
#pragma unroll
        for (int k = 0; k < 6; ++k) { const int idx = tid + k * NTHR, ch = idx >> 10, rem = idx & 1023, row = rem >> 4, sg = rem & 15;
            *(LAS u32x4*)(lds + ch * 16896 + (row + 1) * 256 + sg * 16) = rp[k]; }
        if (tid < 96) { const int ch = tid >> 5, rr = (tid >> 4) & 1, sg = tid & 15; *(LAS u32x4*)(lds + ch * 16896 + (rr ? 65 : 0) * 256 + sg * 16) = (u32x4){0u, 0u, 0u, 0u}; }
        LAS bf16_t* Ls = (LAS bf16_t*)(lds + 3 * 16896);
#pragma unroll
        for (int k = 0; k < 2; ++k) { const int idx = tid + k * NTHR, c = idx >> 3, pc = idx & 7;
            const unsigned wv[4] = {rl[k].x, rl[k].y, rl[k].z, rl[k].w};
#pragma unroll
            for (int e = 0; e < 4; ++e) { Ls[(pc * 8 + 2 * e) * 128 + c] = (bf16_t)(wv[e] & 0xffffu); Ls[(pc * 8 + 2 * e + 1) * 128 + c] = (bf16_t)(wv[e] >> 16); } }
        __syncthreads();
        if (item + G < 2048) fetch(item + G);
        const int c2 = tid & 63, tq = tid >> 6, cc = c0 + 2 * c2;
        const float2 w0v = *(const float2*)(cw + cc), w1v = *(const float2*)(cw + 3072 + cc), w2v = *(const float2*)(cw + 6144 + cc), bv = *(const float2*)(cb + cc);
        const float2 w0x = *(const float2*)(cw + HYW + cc), w1x = *(const float2*)(cw + 3072 + HYW + cc), w2x = *(const float2*)(cw + 6144 + HYW + cc), bx = *(const float2*)(cb + HYW + cc);
        const float2 w0z = *(const float2*)(cw + 2 * HYW + cc), w1z = *(const float2*)(cw + 3072 + 2 * HYW + cc), w2z = *(const float2*)(cw + 6144 + 2 * HYW + cc), bz = *(const float2*)(cb + 2 * HYW + cc);
        const float2 dd = *(const float2*)(A.in[30] + cc);
        const LAS unsigned* Vs = (const LAS unsigned*)lds; const LAS unsigned* Xs = (const LAS unsigned*)(lds + 16896); const LAS unsigned* Zs = (const LAS unsigned*)(lds + 2 * 16896); const LAS unsigned* Lw = (const LAS unsigned*)Ls;
        unsigned vm = Vs[(tq * 8) * 64 + c2], v0 = Vs[(tq * 8 + 1) * 64 + c2], xm = Xs[(tq * 8) * 64 + c2], x0 = Xs[(tq * 8 + 1) * 64 + c2], zm = Zs[(tq * 8) * 64 + c2], z0 = Zs[(tq * 8 + 1) * 64 + c2];
#pragma unroll
        for (int i = 0; i < 8; ++i) { const int t = tq * 8 + i;
            const unsigned vp = Vs[(t + 2) * 64 + c2], xp = Xs[(t + 2) * 64 + c2], zp = Zs[(t + 2) * 64 + c2], lw = Lw[t * 64 + c2];
            const float va = w0v.x * bflo(vm) + w1v.x * bflo(v0) + w2v.x * bflo(vp) + bv.x, vb = w0v.y * bfhi(vm) + w1v.y * bfhi(v0) + w2v.y * bfhi(vp) + bv.y;
            const float xa = w0x.x * bflo(xm) + w1x.x * bflo(x0) + w2x.x * bflo(xp) + bx.x, xb = w0x.y * bfhi(xm) + w1x.y * bfhi(x0) + w2x.y * bfhi(xp) + bx.y;
            const float za = w0z.x * bflo(zm) + w1z.x * bflo(z0) + w2z.x * bflo(zp) + bz.x, zb = w0z.y * bfhi(zm) + w1z.y * bfhi(z0) + w2z.y * bfhi(zp) + bz.y;
            const float ya = (bflo(lw) + va * xa * dd.x) * za, yb = (bfhi(lw) + vb * xb * dd.y) * zb;
            *(unsigned*)(Yc + (size_t)(b * SEQ + t0 + t) * D + S5W + cc) = pk2(ya, yb);
            vm = v0; v0 = vp; xm = x0; x0 = xp; zm = z0; z0 = zp; }
        __syncthreads();
    }
}

FI void p7_run(const Args& A, LAS unsigned char* lds, int lane, int wave, int vcu, int G, bool commit) {
    unsigned char* ws = A.ws;
    const float* x1 = (const float*)(ws + WS_X1); unsigned char* A2 = ws + WS_A2;
    const float* mod = (const float*)(ws + WS_MODF); const float* g2 = A.in[7]; const float* brt = A.in[33];
    const bf16x8* WRF = (const bf16x8*)(ws + WS_WRF);
    int* cnt = (int*)(ws + WS_CTL) + CW_CNT; int* rowl = (int*)(ws + WS_ROWL); int* pk = (int*)(ws + WS_PK); float* gate = (float*)(ws + WS_GATE);
    const int t = lane & 15, q = lane >> 4, pair = wave >> 1, kh = wave & 1;
    LAS float* xch = (LAS float*)(lds + 32768);
    LAS float* part = (LAS float*)(lds + 34816);
    LAS int* lcnt = (LAS int*)(lds + 65536);
    for (int it = vcu; it < M / 64; it += G) {
        const int row = it * 64 + pair * 16 + t, b = (it * 64) / SEQ;
        const float* xr = x1 + (size_t)row * D + kh * 1024 + 8 * q;
        if (threadIdx.x < 64) lcnt[threadIdx.x] = 0;
        float ss = 0.f;
#pragma unroll 8
        for (int ks = 0; ks < 32; ++ks) { const f32x4 a = *(const f32x4*)(xr + 32 * ks), c = *(const f32x4*)(xr + 32 * ks + 4);
            ss += ((a.x * a.x + a.y * a.y) + (a.z * a.z + a.w * a.w)) + ((c.x * c.x + c.y * c.y) + (c.z * c.z + c.w * c.w)); }
        ss += __shfl_xor(ss, 16); ss += __shfl_xor(ss, 32);
        if (q == 0) xch[wave * 16 + t] = ss;
        __syncthreads();
        const float rstd = rsqrtf((xch[(pair * 2) * 16 + t] + xch[(pair * 2 + 1) * 16 + t]) * (1.0f / D) + 1e-6f);
        f32x4 acc0 = (f32x4){0.f, 0.f, 0.f, 0.f}, acc1 = (f32x4){0.f, 0.f, 0.f, 0.f};
        const float* gp = g2 + kh * 1024 + 8 * q; const float* shp = mod + (size_t)b * 12288 + 3 * D + kh * 1024 + 8 * q; const float* scp = mod + (size_t)b * 12288 + 4 * D + kh * 1024 + 8 * q;
        unsigned char* a2p = A2 + (size_t)row * D + kh * 1024 + 8 * q;
#pragma unroll 4
        for (int ks = 0; ks < 32; ++ks) {
            const f32x4 xa = *(const f32x4*)(xr + 32 * ks), xb = *(const f32x4*)(xr + 32 * ks + 4);
            const f32x4 ha = xa * rstd * *(const f32x4*)(gp + 32 * ks) * (*(const f32x4*)(scp + 32 * ks) + 1.0f) + *(const f32x4*)(shp + 32 * ks);
            const f32x4 hb = xb * rstd * *(const f32x4*)(gp + 32 * ks + 4) * (*(const f32x4*)(scp + 32 * ks + 4) + 1.0f) + *(const f32x4*)(shp + 32 * ks + 4);
            u32x2 w8; w8.x = pk4_fp8(ha.x, ha.y, ha.z, ha.w); w8.y = pk4_fp8(hb.x, hb.y, hb.z, hb.w); *(u32x2*)(a2p + 32 * ks) = w8;
            u32x4 hi; hi.x = pk2(ha.x, ha.y); hi.y = pk2(ha.z, ha.w); hi.z = pk2(hb.x, hb.y); hi.w = pk2(hb.z, hb.w);
            u32x4 lo; lo.x = pk2(ha.x - bflo(hi.x), ha.y - bfhi(hi.x)); lo.y = pk2(ha.z - bflo(hi.y), ha.w - bfhi(hi.y)); lo.z = pk2(hb.x - bflo(hi.z), hb.y - bfhi(hi.z)); lo.w = pk2(hb.z - bflo(hi.w), hb.w - bfhi(hi.w));
            const bf16x8 Hh = __builtin_bit_cast(bf16x8, hi), Hl = __builtin_bit_cast(bf16x8, lo);
            const bf16x8* wf = WRF + (size_t)((kh * 32 + ks) * 4) * 64 + lane;
            const bf16x8 wh0 = wf[0], wl0 = wf[64], wh1 = wf[128], wl1 = wf[192];
            acc0 = __builtin_amdgcn_mfma_f32_16x16x32_bf16(wh0, Hh, acc0, 0, 0, 0); acc1 = __builtin_amdgcn_mfma_f32_16x16x32_bf16(wh1, Hh, acc1, 0, 0, 0);
            acc0 = __builtin_amdgcn_mfma_f32_16x16x32_bf16(wl0, Hh, acc0, 0, 0, 0); acc1 = __builtin_amdgcn_mfma_f32_16x16x32_bf16(wl1, Hh, acc1, 0, 0, 0);
            acc0 = __builtin_amdgcn_mfma_f32_16x16x32_bf16(wh0, Hl, acc0, 0, 0, 0); acc1 = __builtin_amdgcn_mfma_f32_16x16x32_bf16(wh1, Hl, acc1, 0, 0, 0);
        }
        if (kh == 1) { *(LAS f32x4*)(part + (pair * 64 + lane) * 8) = acc0; *(LAS f32x4*)(part + (pair * 64 + lane) * 8 + 4) = acc1; }
        __syncthreads();
        int myex = 0, myrank = 0; float mygate = 0.f;
        if (kh == 0) {
            acc0 += *(const LAS f32x4*)(part + (pair * 64 + lane) * 8); acc1 += *(const LAS f32x4*)(part + (pair * 64 + lane) * 8 + 4);
            float v[8]; int ix[8];
#pragma unroll
            for (int r = 0; r < 4; ++r) { ix[r] = 4 * q + r; ix[4 + r] = 16 + 4 * q + r; v[r] = acc0[r] + brt[4 * q + r]; v[4 + r] = acc1[r] + brt[16 + 4 * q + r]; }
            float tv[4]; int ti[4];
#pragma unroll
            for (int k = 0; k < 4; ++k) { float bv = v[0]; int bi = ix[0];
#pragma unroll
                for (int r = 1; r < 8; ++r) if (v[r] > bv) { bv = v[r]; bi = ix[r]; }
#pragma unroll
                for (int o = 16; o <= 32; o <<= 1) { const float ov = __shfl_xor(bv, o); const int oi = __shfl_xor(bi, o); if (ov > bv || (ov == bv && oi < bi)) { bv = ov; bi = oi; } }
                tv[k] = bv; ti[k] = bi;
#pragma unroll
                for (int r = 0; r < 8; ++r) if (ix[r] == bi) v[r] = -3.0e38f; }
            const float e1 = __expf(tv[1] - tv[0]), e2 = __expf(tv[2] - tv[0]), e3 = __expf(tv[3] - tv[0]), inv = 1.0f / (1.0f + e1 + e2 + e3);
            myex = q == 0 ? ti[0] : q == 1 ? ti[1] : q == 2 ? ti[2] : ti[3];
            mygate = (q == 0 ? 1.0f : q == 1 ? e1 : q == 2 ? e2 : e3) * inv;
            myrank = __hip_atomic_fetch_add(lcnt + myex, 1, __ATOMIC_RELAXED, __HIP_MEMORY_SCOPE_WORKGROUP);
        }
        __syncthreads();
        if (threadIdx.x < NE) { const int n = lcnt[threadIdx.x]; lcnt[32 + threadIdx.x] = (n > 0 && commit) ? atomicAdd(cnt + threadIdx.x, n) : 0; }
        __syncthreads();
        if (kh == 0 && commit) { const int slot = lcnt[32 + myex] + myrank;
            rowl[myex * M + slot] = row; pk[row * 4 + q] = myex * M + slot; gate[row * 4 + q] = mygate; }
        __syncthreads();
    }
}

FI void moe_table(const Args& A, LAS unsigned char* lds, int tid) {
    const int* cnt = (const int*)(A.ws + WS_CTL) + CW_CNT;
    LAS int* tw = (LAS int*)(lds + LDSCTL_OFF);
    if (tid < 64) { const int n = tid < NE ? cnt[tid] : 0; int p = (n + 255) >> 8;
#pragma unroll
        for (int o = 1; o < 32; o <<= 1) { const int q = __shfl_up(p, o); if ((tid & 63) >= o) p += q; }
        if (tid < NE) { tw[LW_TST + tid + 1] = p; tw[LW_CNT + tid] = n; } if (tid == 0) tw[LW_TST] = 0; }
    __syncthreads();
    if (tid < 320) { int e = 0;
#pragma unroll 1
        for (int j = 1; j < NE; ++j) e += (tw[LW_TST + j] <= tid) ? 1 : 0;
        tw[LW_TE + tid] = e; }
    __syncthreads();
}

FI void p10_run(const Args& A, LAS unsigned char* lds, int lane, int wave, int vcu, int G) {
    unsigned char* ws = A.ws;
    const float* x1 = (const float*)(ws + WS_X1); const unsigned char* Yd = ws + WS_YD; const float* bdn = A.in[37];
    const float* mod = (const float*)(ws + WS_MODF); const float* gf = A.in[38];
    const int* pk = (const int*)(ws + WS_PK); const float* gate = (const float*)(ws + WS_GATE);
    const LAS int* tst = (const LAS int*)(lds + LDSCTL_OFF) + LW_TST;
    const int gw = vcu * NWAVES + wave, NGW = G * NWAVES;
    for (int row = gw; row < M; row += NGW) {
        const int b = row / SEQ; unsigned hr[4], bo[4]; float gk[4];
#pragma unroll
        for (int k = 0; k < 4; ++k) { const int p = __builtin_amdgcn_readfirstlane(pk[row * 4 + k]), ex = p / M, slot = p % M;
            hr[k] = (unsigned)(__builtin_amdgcn_readfirstlane(tst[ex]) * 256 + slot) * (unsigned)D; gk[k] = __builtin_bit_cast(float, __builtin_amdgcn_readfirstlane(__builtin_bit_cast(int, gate[row * 4 + k]))); bo[k] = (unsigned)ex * (unsigned)D; }
        f32x4 x2[8]; float ss = 0.f;
#pragma unroll
        for (int j = 0; j < 8; ++j) { const int col = 4 * lane + 256 * j;
            f32x4 s = (f32x4){0.f, 0.f, 0.f, 0.f};
#pragma unroll
            for (int k = 0; k < 4; ++k) { const int y = *(const int*)(Yd + hr[k] + col); const f32v2 lo = __builtin_amdgcn_cvt_pk_f32_fp8(y, false), hi = __builtin_amdgcn_cvt_pk_f32_fp8(y, true);
                s += ((f32x4){lo.x, lo.y, hi.x, hi.y} + *(const f32x4*)(bdn + bo[k] + col)) * gk[k]; }
            const f32x4 ga = *(const f32x4*)(mod + (size_t)b * 12288 + 5 * D + col);
            x2[j] = *(const f32x4*)(x1 + (size_t)row * D + col) + ga * s;
            ss += (x2[j].x * x2[j].x + x2[j].y * x2[j].y) + (x2[j].z * x2[j].z + x2[j].w * x2[j].w); }
        const float rstd = rsqrtf(wave_sum(ss) * (1.0f / D) + 1e-6f);
#pragma unroll
        for (int j = 0; j < 8; ++j) { const int col = 4 * lane + 256 * j; *(f32x4*)(A.out + (size_t)row * D + col) = x2[j] * rstd * *(const f32x4*)(gf + col); }
    }
}

__global__ void __launch_bounds__(NTHR, 2) fwd_kernel(Args args) {
    extern __shared__ __attribute__((aligned(16))) unsigned char lds_raw[];
    LAS unsigned char* lds = (LAS unsigned char*)lds_raw;
    const int tid = threadIdx.x, lane = tid & 63, wave = __builtin_amdgcn_readfirstlane(tid >> 6);
    const int G = gridDim.x; const int bx = blockIdx.x; const int vcu = (G % 8 == 0) ? (bx % 8) * (G / 8) + bx / 8 : bx;
    unsigned char* ws = args.ws;
    for (int u = tid; u < (LDS_BYTES - LDSCTL_OFF) / 4; u += NTHR) ((LAS unsigned*)(lds + LDSCTL_OFF))[u] = 0u;
    __syncthreads();
    XcdBarrier bar; bar.bar = (unsigned*)(ws + WS_CTL) + CW_BAR; bar.x = 0; bar.st = nullptr;
#if !MK_SPLIT
    bar = xcd_barrier_post((unsigned*)(ws + WS_CTL) + CW_BAR, (volatile LAS unsigned*)(lds + LDSCTL_OFF) + LW_BAR);
#endif
    const int lo = args.ph_lo, hi = args.ph_hi;
#ifndef PHASE_MASK
#define PHASE_MASK 0x7ff
#endif
#define IN(k) (((PHASE_MASK >> (k)) & 1) && lo <= (k) && (k) < hi)
#if MK_SPLIT
#define SEAM(k) do { } while (0)
#else
#define SEAM(k) do { if (IN(k) && IN((k) + 1)) xcd_barrier(bar); } while (0)
#endif
    const float* modp = (const float*)(ws + WS_MODF);
    volatile LAS unsigned long long* amp_w = (volatile LAS unsigned long long*)(lds + LDSCTL_OFF + 8192);
#ifndef AMP_CLK
#define AMP_CLK 0
#endif
#define AMP_NOW() (AMP_CLK ? (unsigned long long)__builtin_amdgcn_s_memtime() / 128ull : (unsigned long long)__builtin_amdgcn_s_memrealtime())
#define AMP_BEGIN(k) do { if (AMP_PHASE == (k) && bx == 0 && tid == 0) amp_w[0] = AMP_NOW(); } while (0)
#define AMP_END(k) do { if (AMP_PHASE == (k) && bx == 0 && tid == 0) amp_w[1] = AMP_NOW() - amp_w[0]; } while (0)

    AMP_BEGIN(0);
    AMP_BEGIN(11);
    if (IN(0)) {
        if ((G & 1) == 0 && G >= 64) {
            if ((bx & 1) == 0) { p0_run(args, lds, tid, lane, wave, bx >> 1, G >> 1); __syncthreads(); p0d_run(args, lds, lane, wave, P0_SPLIT_ITEMS, 49152, bx >> 1, G >> 1); }
            else p0d_run(args, lds, lane, wave, 0, P0_SPLIT_ITEMS, bx >> 1, G >> 1);
        } else { p0_run(args, lds, tid, lane, wave, vcu, G); __syncthreads(); p0d_run(args, lds, lane, wave, 0, 49152, vcu, G); }
    }
    AMP_END(11);
    SEAM(0); AMP_END(0);
    AMP_BEGIN(1);
    if (IN(1)) { _Pragma("unroll 1") for (int rep = 0; rep < REP1; ++rep) p1_run(args, tid, lane, wave, vcu, G, 0, MT, true); } SEAM(1); AMP_END(1);
    AMP_BEGIN(2);
    if (IN(2)) {
        pg8::DenseSched S{(const bf16_t*)(ws + WS_A1), (const bf16_t*)(ws + WS_WIN), 2 * D, M / 256, DIN / 256, G, bx, M / 256, MC / 256, S5W / 256, 0};
        pg8::EpiStoreBf16<false> E{(bf16_t*)(ws + WS_P), DIN, nullptr, 0, 1.0f};
        _Pragma("unroll 1") for (int rep = 0; rep < REP2; ++rep)
        pg8::gemm_phase<false>(lds, 2 * D, S, E);
    } SEAM(2); AMP_END(2);
    AMP_BEGIN(3);
    if (IN(3)) {
        _Pragma("unroll 1") for (int rep = 0; rep < REP3; ++rep) {
        _Pragma("unroll 1") for (int r2 = 0; r2 < REP3A; ++r2) for (int u = vcu; u < 512; u += G) s5_unit(args, lds, u, lane, wave);
        _Pragma("unroll 1") for (int r2 = 0; r2 < REP3B; ++r2) for (int it = vcu; it < 2048; it += G) h1_item(args, lds, it, tid); }
    } SEAM(3); AMP_END(3);
    AMP_BEGIN(4);
    if (IN(4)) {
        _Pragma("unroll 1") for (int rep = 0; rep < REP4; ++rep) {
        _Pragma("unroll 1") for (int r2 = 0; r2 < REP4A; ++r2) s5_combine(args, vcu * NTHR + tid, G * NTHR);
        _Pragma("unroll 1") for (int r2 = 0; r2 < REP4B; ++r2) for (int c = vcu; c < HYW; c += G) longconv_channel(args, lds, c, tid, lane, wave); }
    } SEAM(4); AMP_END(4);
    AMP_BEGIN(5);
    if (IN(5)) {
        _Pragma("unroll 1") for (int rep = 0; rep < REP5; ++rep) h3_run(args, lds, tid, vcu, G);
        pg8::DenseSched S{(const bf16_t*)(ws + WS_YG), (const bf16_t*)(ws + WS_WGLU), 2 * S5W, M / 256, S5W / 256, G, bx, 0, 0, 0, 0};
        pg8::EpiGlu E{(const bf16_t*)(ws + WS_YG), (bf16_t*)(ws + WS_YCAT), args.in[18]};
        pg8::gemm_phase<false>(lds, 2 * S5W, S, E);
    } SEAM(5); AMP_END(5);
    AMP_BEGIN(6);
    if (IN(6)) {
        pg8::DenseSched S{(const bf16_t*)(ws + WS_YCAT), (const bf16_t*)(ws + WS_WOUT), 2 * D, M / 256, D / 256, G, bx, 0, 0, 0, 0};
        pg8::EpiResid E{args.in[0], (float*)(ws + WS_X1), modp};
#ifndef P6_STAGGER_TICKS
#define P6_STAGGER_TICKS 0
#endif
        if ((bx & 1) && P6_STAGGER_TICKS > 0) { const unsigned long long t0 = __builtin_amdgcn_s_memrealtime(); while (__builtin_amdgcn_s_memrealtime() - t0 < (unsigned long long)P6_STAGGER_TICKS) __builtin_amdgcn_s_sleep(8); }
        _Pragma("unroll 1") for (int rep = 0; rep < REP6; ++rep)
        pg8::gemm_phase<false>(lds, 2 * D, S, E);
    } SEAM(6); AMP_END(6);
    AMP_BEGIN(7);
    if (IN(7)) { _Pragma("unroll 1") for (int rep = 0; rep < REP7; ++rep) p7_run(args, lds, lane, wave, vcu, G, rep == REP7 - 1); } SEAM(7); AMP_END(7);
    AMP_BEGIN(8);
    if (IN(8)) {
        moe_table(args, lds, tid);
        pg8::MoeSched<true> S{ws + WS_A2, ws + WS_WGU, D, 16, G, bx, (size_t)4096 * D,
                              (const LAS int*)(lds + LDSCTL_OFF) + LW_TST, (const LAS int*)(lds + LDSCTL_OFF) + LW_CNT, (const int*)(ws + WS_ROWL)};
        pg8::EpiSwiglu E{ws + WS_H, args.in[35], 1.0f / WSCALE};
        _Pragma("unroll 1") for (int rep = 0; rep < REP8; ++rep)
        pg8::gemm_phase<true>(lds, D, S, E);
    } SEAM(8); AMP_END(8);
    AMP_BEGIN(9);
    if (IN(9)) {
        moe_table(args, lds, tid);
        pg8::MoeSched<false> S{ws + WS_H, ws + WS_WDN, DFF, 8, G, bx, (size_t)D * DFF,
                               (const LAS int*)(lds + LDSCTL_OFF) + LW_TST, (const LAS int*)(lds + LDSCTL_OFF) + LW_CNT, (const int*)(ws + WS_ROWL)};
        pg8::EpiStoreFp8 E{ws + WS_YD, D, 1.0f / WSCALE};
        _Pragma("unroll 1") for (int rep = 0; rep < REP9; ++rep)
        pg8::gemm_phase<true>(lds, DFF, S, E);
    } SEAM(9); AMP_END(9);
    AMP_BEGIN(10);
    if (IN(10)) { moe_table(args, lds, tid); _Pragma("unroll 1") for (int rep = 0; rep < REP10; ++rep) p10_run(args, lds, lane, wave, vcu, G); }
    AMP_END(10);
    if (AMP_PHASE >= 0 && bx == 0 && tid == 0) { const unsigned long long t0 = __builtin_amdgcn_s_memrealtime(); const unsigned long long amp_dt = amp_w[1]; while (__builtin_amdgcn_s_memrealtime() - t0 < 4ull * amp_dt) __builtin_amdgcn_s_sleep(16); }
#undef IN
#undef SEAM
}

extern "C" void kernel_launch(void* const* d_in, const int* in_sizes, int n_in, void* d_out, int out_size, void* d_ws, size_t ws_size, hipStream_t stream) {
    static int grid = 0;
    if (grid == 0) {
        if (n_in != 39 || out_size != M * D || ws_size < WS_END) { fprintf(stderr, "kernel_launch: unexpected problem (n_in %d, out %d, ws %zu)\n", n_in, out_size, ws_size); grid = -1; return; }
        int dev = 0, cus = 0, per_cu = 0;
        if (hipGetDevice(&dev) != hipSuccess || hipDeviceGetAttribute(&cus, hipDeviceAttributeMultiprocessorCount, dev) != hipSuccess) { grid = -1; return; }
        if (hipFuncSetAttribute((const void*)fwd_kernel, hipFuncAttributeMaxDynamicSharedMemorySize, LDS_BYTES) != hipSuccess) { fprintf(stderr, "kernel_launch: hipFuncSetAttribute failed\n"); grid = -1; return; }
        if (hipOccupancyMaxActiveBlocksPerMultiprocessor(&per_cu, (const void*)fwd_kernel, NTHR, LDS_BYTES) != hipSuccess || per_cu < 1) fprintf(stderr, "kernel_launch: occupancy query says %d\n", per_cu);
        (void)hipGetLastError();
        grid = cus;
    }
    if (grid < 0) return;
    (void)in_sizes;
    if (hipMemsetAsync((char*)d_ws + WS_CTL, 0, CTL_ZERO_BYTES, stream) != hipSuccess) { fprintf(stderr, "kernel_launch: memset failed\n"); return; }
    Args a{};
    for (int i = 0; i < 39; ++i) a.in[i] = (const float*)d_in[i];
    a.out = (float*)d_out; a.ws = (unsigned char*)d_ws;
#if MK_SPLIT
    for (int p = 0; p < NPHASE; ++p) { a.ph_lo = p; a.ph_hi = p + 1; hipLaunchKernelGGL(fwd_kernel, dim3(grid), dim3(NTHR), LDS_BYTES, stream, a); }
#else
    a.ph_lo = 0; a.ph_hi = NPHASE;
    hipLaunchKernelGGL(fwd_kernel, dim3(grid), dim3(NTHR), LDS_BYTES, stream, a);
#endif
    const hipError_t le = hipPeekAtLastError();
    if (le != hipSuccess) fprintf(stderr, "kernel_launch: launch failed: %s\n", hipGetErrorName(le));
}
```

```cpp
#include <hip/hip_runtime.h>
#include <cstdio>
#include <cstdint>

#ifndef MK_SPLIT
#define MK_SPLIT 0
#endif

#ifndef REP0D
#define REP0D 1
#endif
#ifndef REP2
#define REP2 1
#endif
#ifndef AMP_PHASE
#define AMP_PHASE -1
#endif
#ifndef REP1
#define REP1 1
#endif
#ifndef REP5
#define REP5 1
#endif
#ifndef REP7
#define REP7 1
#endif
#ifndef REP10
#define REP10 1
#endif
#ifndef REP0A
#define REP0A 1
#endif
#ifndef REP3
#define REP3 1
#endif
#ifndef REP3A
#define REP3A 1
#endif
#ifndef REP3B
#define REP3B 1
#endif
#ifndef REP4A
#define REP4A 1
#endif
#ifndef REP4B
#define REP4B 1
#endif
#ifndef REP4
#define REP4 1
#endif
#ifndef REP6
#define REP6 1
#endif
#ifndef REP8
#define REP8 1
#endif
#ifndef REP9
#define REP9 1
#endif
#define GAS __attribute__((address_space(1)))
#define LAS __attribute__((address_space(3)))
typedef unsigned short bf16_t;
typedef short bf16x8 __attribute__((ext_vector_type(8)));
typedef float f32x4 __attribute__((ext_vector_type(4)));
typedef float f32x16 __attribute__((ext_vector_type(16)));
typedef unsigned u32x4 __attribute__((ext_vector_type(4)));
typedef unsigned u32x2 __attribute__((ext_vector_type(2)));

constexpr int NWAVES = 8, NTHR = 512;
constexpr int D = 2048, NB = 8, SEQ = 2048, M = NB * SEQ, CTXL = 256, MC = NB * CTXL, MT = M + MC;
constexpr int DIN = 4096, S5W = 1024, HYW = 1024, NG = 64;
constexpr int NE = 32, DFF = 2048;
constexpr int NPHASE = 11;
constexpr float WSCALE = 64.0f;
constexpr int SEG = 288;

constexpr size_t MiB = 1u << 20;
constexpr size_t WS_CTL = 0, CTL_ZERO_BYTES = 1024 * 1024;
constexpr int CW_TMO = 0, CW_BAR = 4096, CW_CNT = 8192, CW_HNORM = 12288, CW_MOD = 16384;
constexpr size_t WS_LAM = 1 * MiB, WS_LAML = WS_LAM + 64 * 1024, WS_S5B = WS_LAM + 128 * 1024, WS_S5C = WS_LAM + 640 * 1024;
constexpr size_t WS_HRAW = 4 * MiB, WS_RG = 20 * MiB, WS_WIN = 28 * MiB, WS_WGLU = 44 * MiB, WS_WOUT = 46 * MiB;
constexpr size_t WS_PK = 54 * MiB, WS_GATE = WS_PK + 256 * 1024, WS_ROWL = 55 * MiB, WS_MODF = 58 * MiB, WS_WRF = 59 * MiB;
constexpr size_t WS_A1 = 64 * MiB, WS_P = 136 * MiB, WS_YS5 = 280 * MiB, WS_VT = 344 * MiB, WS_LCT = 376 * MiB, WS_YG = 408 * MiB;
constexpr size_t WS_YCAT = 440 * MiB, WS_X1 = 504 * MiB, WS_A2 = 632 * MiB, WS_WGU = 704 * MiB, WS_WDN = 1216 * MiB;
constexpr size_t WS_H = 1472 * MiB, WS_YD = 1760 * MiB, WS_END = 2048 * MiB;
constexpr int HROWS = 73728;

constexpr int RING_BYTES = 131072, LDSCTL_OFF = RING_BYTES, LDS_BYTES = 147456;
constexpr int LW_BAR = 8, LW_TST = 64, LW_CNT = 128, LW_TE = 256;

typedef __bf16 bf16v2 __attribute__((ext_vector_type(2)));
typedef float f32v2 __attribute__((ext_vector_type(2)));
__device__ __forceinline__ unsigned f2bf(float f) { return (unsigned)__builtin_bit_cast(unsigned short, (__bf16)f); }
__device__ __forceinline__ unsigned pk2(float lo, float hi) { const f32v2 v = {lo, hi}; return __builtin_bit_cast(unsigned, __builtin_convertvector(v, bf16v2)); }
__device__ __forceinline__ float bflo(unsigned w) { return __builtin_bit_cast(float, w << 16); }
__device__ __forceinline__ float bfhi(unsigned w) { return __builtin_bit_cast(float, w & 0xffff0000u); }
__device__ __forceinline__ float bf1(bf16_t b) { return __builtin_bit_cast(float, (unsigned)b << 16); }
__device__ __forceinline__ unsigned pk4_fp8(float a, float b, float c, float d) { int w = __builtin_amdgcn_cvt_pk_fp8_f32(a, b, 0, false); w = __builtin_amdgcn_cvt_pk_fp8_f32(c, d, w, true); return (unsigned)w; }
constexpr float FIX_SCALE = 4294967296.0f;
__device__ __forceinline__ void fix_add(unsigned long long* p, float v) { atomicAdd(p, (unsigned long long)__float2ll_rn(v * FIX_SCALE)); }
__device__ __forceinline__ float fix_get(const unsigned long long* p) { const unsigned long long v = *p; return (float)(int)(unsigned)(v >> 32) + (float)(unsigned)v * (1.0f / 4294967296.0f); }
__device__ __forceinline__ float sigm(float v) { return __builtin_amdgcn_rcpf(1.0f + __builtin_amdgcn_exp2f(-1.44269504f * v)); }
__device__ __forceinline__ float wave_sum(float v) {
#pragma unroll
    for (int o = 1; o < 64; o <<= 1) v += __shfl_xor(v, o);
    return v;
}
#define LDS_WAIT() asm volatile("s_waitcnt lgkmcnt(0)" ::: "memory")
#define VM_WAIT() asm volatile("s_waitcnt vmcnt(0)" ::: "memory")

#define XB_TMO      128
#define XB_XCNT(j)  (256  + 64 * (j))
#define XB_XSUB(j)  (1280 + 64 * (j))
#define XB_XGEN(j)  (2304 + 64 * (j))
#define XB_TOP      3328
#define XB_TOPGEN   3392
#define XCD_BAR_WORDS 3456
#define XB_SPIN_CAP (1u << 18)
__device__ __forceinline__ unsigned xb_ld(unsigned* p)              { return __hip_atomic_load(p, __ATOMIC_RELAXED, __HIP_MEMORY_SCOPE_AGENT); }
__device__ __forceinline__ unsigned xb_add(unsigned* p, unsigned v) { return __hip_atomic_fetch_add(p, v, __ATOMIC_RELAXED, __HIP_MEMORY_SCOPE_AGENT); }
__device__ __forceinline__ unsigned xb_xcc_id() { return (unsigned)__builtin_amdgcn_s_getreg((3 << 11) | 20) & 0xFu; }
#define XB_SPIN(cond, bar) do { unsigned _sp = 0; while (cond) { __builtin_amdgcn_s_sleep(1); \
    if ((++_sp & 255u) == 0u) { if (xb_ld(&(bar)[XB_TMO])) break; if (_sp > XB_SPIN_CAP) { atomicAdd(&(bar)[XB_TMO], 1u); break; } } } } while (0)
struct XcdBarrier { unsigned* bar; unsigned x; volatile LAS unsigned* st; };
__device__ __forceinline__ XcdBarrier xcd_barrier_post(unsigned* bar, volatile LAS unsigned* st) {
    XcdBarrier b; b.bar = bar; b.x = xb_xcc_id(); b.st = st;
    if (threadIdx.x == 0) (void)xb_add(&bar[XB_XCNT(b.x)], 1u);
    return b;
}
__device__ __forceinline__ void xcd_barrier_complete(unsigned* bar, unsigned x, unsigned& nloc, unsigned& nx) {
    const unsigned G = gridDim.x * gridDim.y * gridDim.z;
    unsigned sum, cnt, mine, sp = 0u;
    for (;;) {
        sum = 0u; cnt = 0u; mine = 0u;
#pragma unroll
        for (unsigned j = 0; j < 16; ++j) { const unsigned c = xb_ld(&bar[XB_XCNT(j)]); sum += c; cnt += (c > 0u) ? 1u : 0u; mine = (j == x) ? c : mine; }
        if (sum == G) break;
        __builtin_amdgcn_s_sleep(1);
        if ((++sp & 255u) == 0u) { if (xb_ld(&bar[XB_TMO])) break; if (sp > XB_SPIN_CAP) { atomicAdd(&bar[XB_TMO], 1u); break; } }
    }
    nloc = mine > 0u ? mine : 1u; nx = cnt > 0u ? cnt : 1u;
}
__device__ __forceinline__ void xcd_barrier(const XcdBarrier& b) {
    asm volatile("s_waitcnt vmcnt(0)" ::: "memory");
    __syncthreads();
    if (threadIdx.x == 0) {
        unsigned* bar = b.bar;
        __builtin_amdgcn_s_waitcnt(0);
        unsigned nloc = b.st[0], nx = b.st[1];
        if (nloc == 0u) { xcd_barrier_complete(bar, b.x, nloc, nx); b.st[0] = nloc; b.st[1] = nx; }
        const unsigned old = xb_add(&bar[XB_XSUB(b.x)], 1u);
        const unsigned gen = old / nloc;
        if (old + 1u == (gen + 1u) * nloc) {
            __builtin_amdgcn_fence(__ATOMIC_RELEASE, "agent");
            asm volatile("s_waitcnt vmcnt(0)" ::: "memory");
            const unsigned og = xb_add(&bar[XB_TOP], 1u);
            const unsigned tg = og / nx;
            if (og + 1u == (tg + 1u) * nx) xb_add(&bar[XB_TOPGEN], 1u);
            else XB_SPIN(xb_ld(&bar[XB_TOPGEN]) == tg, bar);
            __builtin_amdgcn_fence(__ATOMIC_ACQUIRE, "agent");
            xb_add(&bar[XB_XGEN(b.x)], 1u);
            asm volatile("s_waitcnt vmcnt(0)" ::: "memory");
        } else {
            XB_SPIN(xb_ld(&bar[XB_XGEN(b.x)]) == gen, bar);
            __builtin_amdgcn_fence(__ATOMIC_ACQUIRE, "agent");
            asm volatile("s_waitcnt vmcnt(0)" ::: "memory");
        }
    }
    __syncthreads();
}

struct Args { const float* in[39]; float* out; unsigned char* ws; int ph_lo, ph_hi; };

namespace pg8 {
constexpr int BM = 256, BK = 64, HALF = 128, HTB = HALF * BK * 2, STAGE_BYTES = 8 * HTB, NXCD = 8, WGM = 8;
__device__ __forceinline__ int lds_byte(int r, int c) { const int st = (r >> 4) * 2 + (c >> 5), rr = r & 15, cc = c & 31, ob = rr * 64 + cc * 2; return st * 1024 + (ob ^ (((ob >> 9) & 1) << 5)); }
__device__ __forceinline__ void stage_rc(int b, int& R, int& C) { const int st = b / 1024, sb = b % 1024, swz = sb ^ (((sb >> 9) & 1) << 5); R = (st >> 1) * 16 + swz / 64; C = (st & 1) * 32 + (swz % 64) / 2; }
__device__ __forceinline__ int perm32(int rho) { const int n = rho >> 4, i = rho & 15; return 8 * (i >> 2) + 4 * n + (i & 3); }
struct Unit { int pm, pn, e; };
__device__ __forceinline__ unsigned cvt_pk_bf16(float lo, float hi) { unsigned r; asm volatile("v_cvt_pk_bf16_f32 %0, %1, %2" : "=v"(r) : "v"(lo), "v"(hi)); return r; }

__device__ __forceinline__ void tile_of(long L, int nM, int nN, int& pm, int& pn) {
    const int nwg = nM * nN; int wgid = (int)L;
    { const int q = nwg / NXCD, r = nwg % NXCD, xcd = wgid % NXCD, off = wgid / NXCD; wgid = (xcd < r ? xcd * (q + 1) : r * (q + 1) + (xcd - r) * q) + off; }
    const int nig = WGM * nN, gid = wgid / nig, fm = gid * WGM, gsz = (nM - fm) < WGM ? (nM - fm) : WGM;
    pm = fm + ((wgid % nig) % gsz); pn = (wgid % nig) / gsz;
}

struct DenseSched {
    const bf16_t* A; const bf16_t* Bt; int RB, nM, nN, G, c, xM0, xnM, xnN, xN0;
    __device__ __forceinline__ bool next(int i, Unit& u) const {
        const long L = (long)i * G + c; const int nwg = nM * nN;
        if (L < nwg) { tile_of(L, nM, nN, u.pm, u.pn); u.e = 0; return true; }
        const long r = L - nwg; if (r >= (long)xnM * xnN) return false;
        u.pm = xM0 + (int)(r % xnM); u.pn = xN0 + (int)(r / xnM); u.e = 0; return true;
    }
    __device__ __forceinline__ const char* abase(const Unit& u) const { return (const char*)A + (size_t)u.pm * BM * RB; }
    __device__ __forceinline__ const char* bbase(const Unit& u) const { return (const char*)Bt + (size_t)u.pn * BM * RB; }
    __device__ __forceinline__ void rows(const Unit&, unsigned (&va)[2][2], const int (&R)[2], const int (&C)[2]) const {
#pragma unroll
        for (int h = 0; h < 2; ++h)
#pragma unroll
            for (int i = 0; i < 2; ++i) va[h][i] = (unsigned)((h * HALF + R[i]) * RB + 2 * C[i]);
    }
};
template <bool GATHER> struct MoeSched {
    const unsigned char* A; const unsigned char* Bt; int RB, nN, G, c; size_t estride;
    const LAS int* tst; const LAS int* cnts; const int* rowlist;
    __device__ __forceinline__ bool next(int i, Unit& u) const {
        const int TM = __builtin_amdgcn_readfirstlane(tst[NE]); const long L = (long)i * G + c; if (L >= (long)TM * nN) return false;
        tile_of(L, TM, nN, u.pm, u.pn);
        u.e = __builtin_amdgcn_readfirstlane(tst[(LW_TE - LW_TST) + u.pm]); return true;
    }
    __device__ __forceinline__ const char* abase(const Unit& u) const { return GATHER ? (const char*)A : (const char*)A + (size_t)u.pm * BM * RB; }
    __device__ __forceinline__ const char* bbase(const Unit& u) const { return (const char*)Bt + (size_t)u.e * estride + (size_t)u.pn * BM * RB; }
    __device__ __forceinline__ void rows(const Unit& u, unsigned (&va)[2][2], const int (&R)[2], const int (&C)[2]) const {
        if (GATHER) {
            const int n = __builtin_amdgcn_readfirstlane(cnts[u.e]), lt = u.pm - __builtin_amdgcn_readfirstlane(tst[u.e]);
#pragma unroll
            for (int h = 0; h < 2; ++h)
#pragma unroll
                for (int i = 0; i < 2; ++i) { int slot = lt * BM + h * HALF + R[i]; slot = slot < n ? slot : 0; const int tok = rowlist[u.e * M + slot]; va[h][i] = (unsigned)(tok * RB + 2 * C[i]); }
        } else {
#pragma unroll
            for (int h = 0; h < 2; ++h)
#pragma unroll
                for (int i = 0; i < 2; ++i) va[h][i] = (unsigned)((h * HALF + R[i]) * RB + 2 * C[i]);
        }
    }
};

typedef int i32x4 __attribute__((ext_vector_type(4)));
typedef int i32x8 __attribute__((ext_vector_type(8)));
template <bool FP8, class Epi, class Sched>
__device__ __forceinline__ void gemm_phase(LAS unsigned char* lds, const int RB, const Sched& S, const Epi& E) {
    const int tid = threadIdx.x, wid = __builtin_amdgcn_readfirstlane(tid >> 6), lane = tid & 63, wr = wid >> 2, wc = wid & 3, fr = lane & 15, fq = lane >> 4;
    const int nt = RB / 128;
    unsigned voffB[2]; int Rr[2], Cc[2];
#pragma unroll
    for (int i = 0; i < 2; ++i) { int R, C; stage_rc(tid * 16 + i * 8192, R, C); Rr[i] = R; Cc[i] = C; const int Rb = Epi::PERM ? ((R & ~31) + perm32(R & 31)) : R; voffB[i] = (unsigned)(Rb * RB + 2 * C); }
    const size_t kstep = (size_t)(BK * 2);
    const size_t hstep = (size_t)HALF * RB;
    const unsigned ldsw = (unsigned)wid * 1024u;
    const int aoff = lds_byte(wr * 64 + fr, fq * 8), boff = lds_byte(wc * 32 + fr, fq * 8);
#define PG8_SA(b, h) (((b) * 2 + (h)) * HTB)
#define PG8_SB(b, h) ((4 + (b) * 2 + (h)) * HTB)
#define PG8_STAGE(bufoff, gbase, voff) do { _Pragma("unroll") for (int _i = 0; _i < 2; ++_i) \
        __builtin_amdgcn_global_load_lds((const unsigned*)((const char*)(gbase) + (voff)[_i]), (LAS unsigned*)(lds + (bufoff) + ldsw + _i * 8192), 16, 0, 0); } while (0)
#define PG8_LDA(dst, b, h) do { _Pragma("unroll") for (int m = 0; m < 4; ++m) _Pragma("unroll") for (int k = 0; k < 2; ++k) dst[m][k] = *(const LAS bf16x8*)(lds + PG8_SA(b, h) + aoff + m * 2048 + k * 1024); } while (0)
#define PG8_LDB(dst, b, h) do { _Pragma("unroll") for (int n = 0; n < 2; ++n) _Pragma("unroll") for (int k = 0; k < 2; ++k) dst[n][k] = *(const LAS bf16x8*)(lds + PG8_SB(b, h) + boff + n * 2048 + k * 1024); } while (0)
#define PG8_MMA(ai, bj, At, Bt) do { __builtin_amdgcn_s_setprio(1); _Pragma("unroll") for (int m = 0; m < 4; ++m) _Pragma("unroll") for (int n = 0; n < 2; ++n) { \
        if constexpr (FP8) { const i32x8 bb_ = __builtin_shufflevector(__builtin_bit_cast(i32x4, Bt[n][0]), __builtin_bit_cast(i32x4, Bt[n][1]), 0, 1, 2, 3, 4, 5, 6, 7); \
            const i32x8 aa_ = __builtin_shufflevector(__builtin_bit_cast(i32x4, At[m][0]), __builtin_bit_cast(i32x4, At[m][1]), 0, 1, 2, 3, 4, 5, 6, 7); \
            asm volatile("v_mfma_scale_f32_16x16x128_f8f6f4 %0, %1, %2, %0, %3, %3 op_sel_hi:[0,0,0]" : "+v"(acc[ai][bj][m][n]) : "v"(bb_), "v"(aa_), "v"(one_scale)); } \
        else { _Pragma("unroll") for (int k = 0; k < 2; ++k) acc[ai][bj][m][n] = __builtin_amdgcn_mfma_f32_16x16x32_bf16(Bt[n][k], At[m][k], acc[ai][bj][m][n], 0, 0, 0); } } \
        __builtin_amdgcn_s_setprio(0); } while (0)
#define PG8_WAIT_V(n) asm volatile("s_waitcnt vmcnt(" #n ")" ::: "memory")
#define PG8_WAIT_L(n) asm volatile("s_waitcnt lgkmcnt(" #n ")" ::: "memory")
#define PG8_BAR __builtin_amdgcn_s_barrier()
#define PG8_SCHED __builtin_amdgcn_sched_barrier(0)
    Unit cur, nxt; int ui = 0;
    if (!S.next(0, cur)) return;
    f32x4 acc[2][2][4][2];
#pragma unroll
    for (int a = 0; a < 2; ++a)
#pragma unroll
        for (int b = 0; b < 2; ++b)
#pragma unroll
            for (int m = 0; m < 4; ++m)
#pragma unroll
                for (int n = 0; n < 2; ++n) acc[a][b][m][n] = (f32x4){0.f, 0.f, 0.f, 0.f};
    bf16x8 At[4][2], B0[2][2], B1[2][2];
    unsigned one_scale = 0x7F7F7F7Fu; asm volatile("" : "+v"(one_scale));
    unsigned vaC[2][2], vaN[2][2];
    S.rows(cur, vaC, Rr, Cc);
    const char* cA = S.abase(cur); const char* cB = S.bbase(cur);
    PG8_STAGE(PG8_SB(0, 0), cB, voffB); PG8_STAGE(PG8_SA(0, 0), cA, vaC[0]); PG8_STAGE(PG8_SB(0, 1), cB + hstep, voffB); PG8_STAGE(PG8_SA(0, 1), cA, vaC[1]);
    if (wr == 1) PG8_BAR;
    PG8_WAIT_V(4); PG8_BAR;
    PG8_STAGE(PG8_SB(1, 0), cB + kstep, voffB); PG8_STAGE(PG8_SA(1, 0), cA + kstep, vaC[0]); PG8_STAGE(PG8_SB(1, 1), cB + hstep + kstep, voffB);
    PG8_WAIT_V(6); PG8_BAR;
    for (;;) {
        const bool has_next = S.next(ui + 1, nxt);
        const char* nA = has_next ? S.abase(nxt) : cA; const char* nB = has_next ? S.bbase(nxt) : cB;
#pragma unroll
        for (int h = 0; h < 2; ++h)
#pragma unroll
            for (int i = 0; i < 2; ++i) vaN[h][i] = vaC[h][i];
        for (int t = 0; t < nt; t += 2) {
            const bool last = (t == nt - 2);
            const char* a1 = cA + (size_t)(t + 1) * kstep;
            const char* a2 = last ? nA : cA + (size_t)(t + 2) * kstep; const char* b2 = last ? nB : cB + (size_t)(t + 2) * kstep;
            const char* a3 = a2 + kstep; const char* b3 = b2 + kstep;
            if (last && has_next) S.rows(nxt, vaN, Rr, Cc);
            unsigned v2[2][2];
#pragma unroll
            for (int h = 0; h < 2; ++h)
#pragma unroll
                for (int i = 0; i < 2; ++i) v2[h][i] = last ? vaN[h][i] : vaC[h][i];
            PG8_LDB(B0, 0, 0); PG8_SCHED; PG8_LDA(At, 0, 0); PG8_STAGE(PG8_SA(1, 1), a1, vaC[1]);
            PG8_WAIT_L(8); PG8_BAR; PG8_WAIT_L(0); PG8_MMA(0, 0, At, B0); PG8_BAR; PG8_SCHED;
            PG8_LDB(B1, 0, 1); PG8_STAGE(PG8_SB(0, 0), b2, voffB);
            PG8_BAR; PG8_WAIT_L(0); PG8_MMA(0, 1, At, B1); PG8_BAR;
            PG8_LDA(At, 0, 1); PG8_STAGE(PG8_SA(0, 0), a2, v2[0]);
            PG8_BAR; PG8_WAIT_L(0); PG8_MMA(1, 0, At, B0); PG8_BAR; PG8_SCHED;
            PG8_STAGE(PG8_SB(0, 1), b2 + hstep, voffB);
            PG8_WAIT_V(6); PG8_BAR; PG8_MMA(1, 1, At, B1); PG8_BAR;
            PG8_LDB(B0, 1, 0); PG8_SCHED; PG8_LDA(At, 1, 0); PG8_STAGE(PG8_SA(0, 1), a2, v2[1]);
            PG8_WAIT_L(8); PG8_BAR; PG8_WAIT_L(0); PG8_MMA(0, 0, At, B0); PG8_BAR; PG8_SCHED;
            PG8_LDB(B1, 1, 1); PG8_STAGE(PG8_SB(1, 0), b3, voffB);
            PG8_BAR; PG8_WAIT_L(0); PG8_MMA(0, 1, At, B1); PG8_BAR;
            PG8_LDA(At, 1, 1); PG8_STAGE(PG8_SA(1, 0), a3, v2[0]);
            PG8_BAR; PG8_WAIT_L(0); PG8_MMA(1, 0, At, B0); PG8_BAR; PG8_SCHED;
            PG8_STAGE(PG8_SB(1, 1), b3 + hstep, voffB);
            PG8_WAIT_V(6); PG8_BAR; PG8_MMA(1, 1, At, B1); PG8_BAR;
        }
        if constexpr (FP8) asm volatile("s_nop 15\n\ts_nop 15" ::: "memory");
        E(acc, cur, wr, wc, fr, fq);
        if (!has_next) break;
#pragma unroll
        for (int a = 0; a < 2; ++a)
#pragma unroll
            for (int b = 0; b < 2; ++b)
#pragma unroll
                for (int m = 0; m < 4; ++m)
#pragma unroll
                    for (int n = 0; n < 2; ++n) acc[a][b][m][n] = (f32x4){0.f, 0.f, 0.f, 0.f};
        cur = nxt; cA = nA; cB = nB; ++ui;
#pragma unroll
        for (int h = 0; h < 2; ++h)
#pragma unroll
            for (int i = 0; i < 2; ++i) vaC[h][i] = vaN[h][i];
    }
    PG8_WAIT_V(0);
    if (wr == 0) PG8_BAR;
    PG8_BAR;
#undef PG8_SA
#undef PG8_SB
#undef PG8_STAGE
#undef PG8_LDA
#undef PG8_LDB
#undef PG8_MMA
#undef PG8_WAIT_V
#undef PG8_WAIT_L
#undef PG8_BAR
#undef PG8_SCHED
}

template <bool HAS_BIAS> struct EpiStoreBf16 {
    static constexpr bool PERM = true;
    bf16_t* O; int ldc; const float* bias; int bias_estride; float sc;
    __device__ __forceinline__ void operator()(const f32x4 (&acc)[2][2][4][2], const Unit& u, int wr, int wc, int fr, int fq) const {
        const int row0 = u.pm * BM + wr * 64 + fr, col0 = u.pn * BM + wc * 32 + 8 * fq;
        f32x4 bv[2][2];
#pragma unroll
        for (int bj = 0; bj < 2; ++bj)
#pragma unroll
            for (int n = 0; n < 2; ++n) { if constexpr (HAS_BIAS) bv[bj][n] = *(const f32x4*)(bias + (size_t)u.e * bias_estride + col0 + bj * HALF + 4 * n); else bv[bj][n] = (f32x4){0.f, 0.f, 0.f, 0.f}; }
#pragma unroll
        for (int ai = 0; ai < 2; ++ai)
#pragma unroll
            for (int m = 0; m < 4; ++m) { bf16_t* rowp = O + (size_t)(row0 + ai * HALF + m * 16) * ldc + col0;
#pragma unroll
                for (int bj = 0; bj < 2; ++bj) { const f32x4 v0 = acc[ai][bj][m][0] * sc + bv[bj][0], v1 = acc[ai][bj][m][1] * sc + bv[bj][1];
                    u32x4 w; w.x = cvt_pk_bf16(v0[0], v0[1]); w.y = cvt_pk_bf16(v0[2], v0[3]); w.z = cvt_pk_bf16(v1[0], v1[1]); w.w = cvt_pk_bf16(v1[2], v1[3]);
                    *(u32x4*)(rowp + bj * HALF) = w; } }
    }
};
struct EpiStoreFp8 {
    static constexpr bool PERM = true;
    unsigned char* O; int ldc; float sc;
    __device__ __forceinline__ void operator()(const f32x4 (&acc)[2][2][4][2], const Unit& u, int wr, int wc, int fr, int fq) const {
        const int row0 = u.pm * BM + wr * 64 + fr, col0 = u.pn * BM + wc * 32 + 8 * fq;
#pragma unroll
        for (int ai = 0; ai < 2; ++ai)
#pragma unroll
            for (int m = 0; m < 4; ++m) { unsigned char* rowp = O + (size_t)(row0 + ai * HALF + m * 16) * ldc + col0;
#pragma unroll
                for (int bj = 0; bj < 2; ++bj) { const f32x4 v0 = acc[ai][bj][m][0] * sc, v1 = acc[ai][bj][m][1] * sc;
                    u32x2 w; w.x = pk4_fp8(v0[0], v0[1], v0[2], v0[3]); w.y = pk4_fp8(v1[0], v1[1], v1[2], v1[3]);
                    *(u32x2*)(rowp + bj * HALF) = w; } }
    }
};
struct EpiGlu {
    static constexpr bool PERM = true;
    const bf16_t* Yg; bf16_t* O; const float* bias;
    __device__ __forceinline__ void operator()(const f32x4 (&acc)[2][2][4][2], const Unit& u, int wr, int wc, int fr, int fq) const {
        const int row0 = u.pm * BM + wr * 64 + fr, col0 = u.pn * BM + wc * 32 + 8 * fq;
        f32x4 bv[2][2];
#pragma unroll
        for (int bj = 0; bj < 2; ++bj)
#pragma unroll
            for (int n = 0; n < 2; ++n) bv[bj][n] = *(const f32x4*)(bias + col0 + bj * HALF + 4 * n);
#pragma unroll
        for (int ai = 0; ai < 2; ++ai)
#pragma unroll
            for (int m = 0; m < 4; ++m) { const size_t r = (size_t)(row0 + ai * HALF + m * 16);
#pragma unroll
                for (int bj = 0; bj < 2; ++bj) { const f32x4 v0 = acc[ai][bj][m][0] + bv[bj][0], v1 = acc[ai][bj][m][1] + bv[bj][1];
                    const u32x4 y = *(const u32x4*)(Yg + r * S5W + col0 + bj * HALF);
                    float o[8];
                    o[0] = bflo(y.x) * sigm(v0[0]); o[1] = bfhi(y.x) * sigm(v0[1]); o[2] = bflo(y.y) * sigm(v0[2]); o[3] = bfhi(y.y) * sigm(v0[3]);
                    o[4] = bflo(y.z) * sigm(v1[0]); o[5] = bfhi(y.z) * sigm(v1[1]); o[6] = bflo(y.w) * sigm(v1[2]); o[7] = bfhi(y.w) * sigm(v1[3]);
                    u32x4 w; w.x = cvt_pk_bf16(o[0], o[1]); w.y = cvt_pk_bf16(o[2], o[3]); w.z = cvt_pk_bf16(o[4], o[5]); w.w = cvt_pk_bf16(o[6], o[7]);
                    *(u32x4*)(O + r * D + col0 + bj * HALF) = w; } }
    }
};
struct EpiResid {
    static constexpr bool PERM = false;
    const float* X; float* O; const float* mod;
    __device__ __forceinline__ void operator()(const f32x4 (&acc)[2][2][4][2], const Unit& u, int wr, int wc, int fr, int fq) const {
        const int row0 = u.pm * BM + wr * 64 + fr, col0 = u.pn * BM + wc * 32 + 4 * fq, b = u.pm >> 3;
        f32x4 gv[2][2];
#pragma unroll
        for (int bj = 0; bj < 2; ++bj)
#pragma unroll
            for (int n = 0; n < 2; ++n) { const int c = col0 + bj * HALF + n * 16; gv[bj][n] = *(const f32x4*)(mod + (size_t)b * 12288 + 2 * D + c); }
#pragma unroll
        for (int ai = 0; ai < 2; ++ai) {
            f32x4 xv[4][2][2];
#pragma unroll
            for (int m = 0; m < 4; ++m) { const size_t off = (size_t)(row0 + ai * HALF + m * 16) * D + col0;
#pragma unroll
                for (int bj = 0; bj < 2; ++bj)
#pragma unroll
                    for (int n = 0; n < 2; ++n) xv[m][bj][n] = *(const f32x4*)(X + off + bj * HALF + n * 16); }
            asm volatile("" ::: "memory");
#pragma unroll
            for (int m = 0; m < 4; ++m) { const size_t off = (size_t)(row0 + ai * HALF + m * 16) * D + col0;
#pragma unroll
                for (int bj = 0; bj < 2; ++bj)
#pragma unroll
                    for (int n = 0; n < 2; ++n) *(f32x4*)(O + off + bj * HALF + n * 16) = xv[m][bj][n] + gv[bj][n] * acc[ai][bj][m][n]; }
            asm volatile("" ::: "memory");
        }
    }
};
struct EpiSwiglu {
    static constexpr bool PERM = true;
    unsigned char* O; const float* bias; float sc;
    __device__ __forceinline__ void operator()(const f32x4 (&acc)[2][2][4][2], const Unit& u, int wr, int wc, int fr, int fq) const {
        const int row0 = u.pm * BM + wr * 64 + fr, j0 = wc * 32 + 8 * fq, cb = u.pn * HALF + j0;
        f32x4 bg[2], bu[2];
#pragma unroll
        for (int n = 0; n < 2; ++n) { bg[n] = *(const f32x4*)(bias + (size_t)u.e * 4096 + cb + 4 * n); bu[n] = *(const f32x4*)(bias + (size_t)u.e * 4096 + 2048 + cb + 4 * n); }
#pragma unroll
        for (int ai = 0; ai < 2; ++ai)
#pragma unroll
            for (int m = 0; m < 4; ++m) { float o[8];
#pragma unroll
                for (int n = 0; n < 2; ++n)
#pragma unroll
                    for (int e = 0; e < 4; ++e) { float g = acc[ai][0][m][n][e] * sc + bg[n][e], uu = acc[ai][1][m][n][e] * sc + bu[n][e];
                        g = fminf(g, 7.0f); uu = fminf(fmaxf(uu, -7.0f), 7.0f);
                        o[4 * n + e] = (uu + 1.0f) * (g * sigm(1.702f * g)); }
                u32x2 w; w.x = pk4_fp8(o[0], o[1], o[2], o[3]); w.y = pk4_fp8(o[4], o[5], o[6], o[7]);
                *(u32x2*)(O + (size_t)(row0 + ai * HALF + m * 16) * DFF + cb) = w; }
    }
};
}

#define FI __device__ __forceinline__

FI void transpose_item(const float* W, int K, int N, bf16_t* WT, int row_off, LAS float* scr, int kb, int nb, int lane) {
    const int k0 = 64 * kb, n0 = 32 * nb;
#pragma unroll 8
    for (int i = 0; i < 32; ++i) { const int kk = 2 * i + (lane >> 5); scr[kk * 33 + (lane & 31)] = W[(size_t)(k0 + kk) * N + n0 + (lane & 31)]; }
    LDS_WAIT(); asm volatile("" ::: "memory");
    const int c = lane & 7;
#pragma unroll
    for (int j = 0; j < 4; ++j) { const int n = (lane >> 3) + 8 * j; const LAS float* s = scr + (8 * c) * 33 + n;
        u32x4 o; o.x = pk2(s[0 * 33], s[1 * 33]); o.y = pk2(s[2 * 33], s[3 * 33]); o.z = pk2(s[4 * 33], s[5 * 33]); o.w = pk2(s[6 * 33], s[7 * 33]);
        *(u32x4*)(WT + (size_t)(row_off + n0 + n) * K + k0 + 8 * c) = o; }
    LDS_WAIT(); asm volatile("" ::: "memory");
}

FI void transpose_item_fp8(const float* W, int K, int N, unsigned char* WT, int row_off, LAS float* scr, int kb, int nb, int lane, float scale) {
    const int k0 = 64 * kb, n0 = 32 * nb;
#pragma unroll 8
    for (int i = 0; i < 32; ++i) { const int kk = 2 * i + (lane >> 5); scr[kk * 33 + (lane & 31)] = W[(size_t)(k0 + kk) * N + n0 + (lane & 31)]; }
    LDS_WAIT(); asm volatile("" ::: "memory");
    const int n = lane & 31, hf = lane >> 5; const LAS float* s = scr + (32 * hf) * 33 + n;
    u32x4 o0, o1;
    o0.x = pk4_fp8(s[0 * 33] * scale, s[1 * 33] * scale, s[2 * 33] * scale, s[3 * 33] * scale); o0.y = pk4_fp8(s[4 * 33] * scale, s[5 * 33] * scale, s[6 * 33] * scale, s[7 * 33] * scale);
    o0.z = pk4_fp8(s[8 * 33] * scale, s[9 * 33] * scale, s[10 * 33] * scale, s[11 * 33] * scale); o0.w = pk4_fp8(s[12 * 33] * scale, s[13 * 33] * scale, s[14 * 33] * scale, s[15 * 33] * scale);
    o1.x = pk4_fp8(s[16 * 33] * scale, s[17 * 33] * scale, s[18 * 33] * scale, s[19 * 33] * scale); o1.y = pk4_fp8(s[20 * 33] * scale, s[21 * 33] * scale, s[22 * 33] * scale, s[23 * 33] * scale);
    o1.z = pk4_fp8(s[24 * 33] * scale, s[25 * 33] * scale, s[26 * 33] * scale, s[27 * 33] * scale); o1.w = pk4_fp8(s[28 * 33] * scale, s[29 * 33] * scale, s[30 * 33] * scale, s[31 * 33] * scale);
    unsigned char* dst = WT + (size_t)(row_off + n0 + n) * K + k0 + 32 * hf;
    *(u32x4*)dst = o0; *(u32x4*)(dst + 16) = o1;
    LDS_WAIT(); asm volatile("" ::: "memory");
}

FI void tr8_item(const float* W, int N, int K, unsigned char* WT, int row_off, LAS unsigned char* T, int k0, int n0, int lane, float scale) {
    const int nq = lane & 15, kr = lane >> 4;
    const float* src = W + (size_t)(k0 + 4 * kr) * N + n0 + 4 * nq;
#pragma unroll
    for (int rg = 0; rg < 8; ++rg) {
        f32x4 v[4];
#pragma unroll
        for (int j = 0; j < 4; ++j) v[j] = *(const f32x4*)(src + (size_t)(rg * 16 + j) * N) * scale;
#pragma unroll
        for (int i = 0; i < 4; ++i) *(LAS unsigned*)(T + (4 * nq + i) * 128 + ((rg ^ (nq & 7)) << 4) + kr * 4) = pk4_fp8(v[0][i], v[1][i], v[2][i], v[3][i]);
    }
    LDS_WAIT(); asm volatile("" ::: "memory");
#pragma unroll
    for (int t = 0; t < 8; ++t) { const int n = 8 * t + (lane >> 3), p = lane & 7;
        const u32x4 o = *(const LAS u32x4*)(T + n * 128 + ((p ^ ((n >> 2) & 7)) << 4));
        *(u32x4*)(WT + (size_t)(row_off + n0 + n) * K + k0 + 16 * p) = o; }
    LDS_WAIT(); asm volatile("" ::: "memory");
}
FI void moe_weight_item(const Args& A, LAS unsigned char* T, int q, int lane) {
    unsigned char* ws = A.ws;
    if (q < 32768) { const int e = q >> 10, r = q & 1023, kb = r >> 6, nb = r & 63, n0 = 64 * nb;
        const int isU = n0 / 2048, pn = (n0 % 2048) / 128, j = n0 % 128, rowmap = 256 * pn + 128 * isU + j;
        tr8_item(A.in[34] + (size_t)e * D * 4096, 4096, D, ws + WS_WGU + (size_t)e * 4096 * D, rowmap - n0, T, 128 * kb, n0, lane, WSCALE); }
    else { const int q2 = q - 32768, e = q2 >> 9, r = q2 & 511, kb = r >> 5, nb = r & 31;
        tr8_item(A.in[36] + (size_t)e * DFF * D, D, DFF, ws + WS_WDN + (size_t)e * D * DFF, 0, T, 128 * kb, 64 * nb, lane, WSCALE); }
}

FI void p0_run(const Args& A, LAS unsigned char* lds, int tid, int lane, int wave, int vcu, int G) {
    unsigned char* ws = A.ws;
    unsigned long long* mod = (unsigned long long*)((unsigned*)(ws + WS_CTL) + CW_MOD); unsigned long long* hnorm = (unsigned long long*)((unsigned*)(ws + WS_CTL) + CW_HNORM);
    {
        LAS float* sl = (LAS float*)lds;
        LAS float* part = (LAS float*)(lds + 9 * 512 * 4);
        const float* c = A.in[1]; const float* cc = A.in[3]; const float* wada = A.in[4];
        _Pragma("unroll 1") for (int rep = 0; rep < REP0A; ++rep)
        for (int it = vcu; it < 192; it += G) {
            const int cg = it % 48, kq = it / 48, n0 = cg * 256 + 4 * lane, k0 = kq * 512;
            for (int i = tid; i < 9 * 512; i += NTHR) { const int r = i >> 9, k = k0 + (i & 511); const float v = r < 8 ? c[r * D + k] : cc[k]; sl[i] = v / (1.f + __expf(-v)); }
            __syncthreads();
            f32x4 acc[9];
#pragma unroll
            for (int r = 0; r < 9; ++r) acc[r] = (f32x4){0.f, 0.f, 0.f, 0.f};
#pragma unroll 8
            for (int kk = 0; kk < 64; ++kk) { const int kl = wave * 64 + kk; const f32x4 w = *(const f32x4*)(wada + (size_t)(k0 + kl) * 12288 + n0);
#pragma unroll
                for (int r = 0; r < 9; ++r) { const float sv = sl[r * 512 + kl]; acc[r] += w * sv; } }
#pragma unroll
            for (int r = 0; r < 9; ++r) *(LAS f32x4*)(part + (wave * 9 + r) * 256 + 4 * lane) = acc[r];
            __syncthreads();
            for (int i = tid; i < 9 * 256; i += NTHR) { const int r = i >> 8, col = i & 255; float sum = 0.f;
#pragma unroll
                for (int w = 0; w < 8; ++w) sum += part[(w * 9 + r) * 256 + col];
                fix_add(mod + r * 12288 + cg * 256 + col, rep == REP0A - 1 ? sum : 0.0f); }
            __syncthreads();
        }
    }
    {
        LAS float* L = (LAS float*)lds;
        LAS float *w1s = L, *w2s = L + 2112, *w3s = L + 6208, *b1s = L + 10304, *b2s = L + 10368, *b3s = L + 10432, *fqs = L + 10496, *zs = L + 10560, *h1 = L + 10824, *h2 = L + 11336, *h3 = L + 11848;
        for (int i = tid; i < 33 * 64; i += NTHR) w1s[i] = A.in[21][i];
        for (int i = tid; i < 4096; i += NTHR) { w2s[i] = A.in[23][i]; w3s[i] = A.in[25][i]; }
        if (tid < 64) { b1s[tid] = A.in[22][tid]; b2s[tid] = A.in[24][tid]; b3s[tid] = A.in[26][tid]; fqs[tid] = A.in[28][tid]; }
        __syncthreads();
        const float* w4 = A.in[27]; const float* dl = A.in[29]; float* hraw = (float*)(ws + WS_HRAW);
        for (int item = vcu; item < 256; item += G) {
            const int l0 = item * 8;
            if (tid < 264) { const int r = tid / 33, i = tid % 33, l = l0 + r; float z;
                if (i == 0) z = (float)l / 2047.0f;
                else { const int j = (i - 1) & 15; const float band = 1e-4f + (float)j * ((15.0f - 1e-4f) / 15.0f); const float ang = (6.283185307179586f / 2048.0f) * (float)l * band; z = (i <= 16) ? cosf(ang) : -sinf(ang); }
                zs[tid] = z; }
            __syncthreads();
            const int r = tid >> 6, o = tid & 63;
            { float s = b1s[o]; for (int i = 0; i < 33; ++i) s += zs[r * 33 + i] * w1s[i * 64 + o]; h1[r * 64 + o] = sinf(fqs[o] * s); }
            __syncthreads();
            { float s = b2s[o]; for (int i = 0; i < 64; ++i) s += h1[r * 64 + i] * w2s[i * 64 + o]; h2[r * 64 + o] = sinf(fqs[o] * s); }
            __syncthreads();
            { float s = b3s[o]; for (int i = 0; i < 64; ++i) s += h2[r * 64 + i] * w3s[i * 64 + o]; h3[r * 64 + o] = sinf(fqs[o] * s); }
            __syncthreads();
            f32x4 acc[8];
#pragma unroll
            for (int q = 0; q < 8; ++q) acc[q] = (f32x4){0.f, 0.f, 0.f, 0.f};
#pragma unroll 4
            for (int i = 0; i < 64; ++i) { const f32x4 w = *(const f32x4*)(w4 + (size_t)i * 2048 + 4 * tid);
#pragma unroll
                for (int q = 0; q < 8; ++q) acc[q] += w * h3[q * 64 + i]; }
            const f32x4 dv = *(const f32x4*)(dl + 4 * tid);
            f32x4 asum = (f32x4){0.f, 0.f, 0.f, 0.f};
#pragma unroll
            for (int q = 0; q < 8; ++q) { const int l = l0 + q; const float t = (float)l / 2047.0f; f32x4 v;
#pragma unroll
                for (int e = 0; e < 4; ++e) v[e] = acc[q][e] * expf(-t * fabsf(dv[e]));
                *(f32x4*)(hraw + (size_t)l * 2048 + 4 * tid) = v;
                if (!(l == 2047 && 4 * tid >= 1024)) {
#pragma unroll
                    for (int e = 0; e < 4; ++e) asum[e] += fabsf(v[e]); } }
#pragma unroll
            for (int e = 0; e < 4; ++e) fix_add(hnorm + 4 * tid + e, asum[e]);
            __syncthreads();
        }
    }
    {
        __syncthreads();
        LAS float* scr = (LAS float*)(lds + wave * 16384);
        const int gw = vcu * NWAVES + wave, NGW = G * NWAVES;
        constexpr int I_IN = 32 * 128;
        for (int it = gw; it < I_IN; it += NGW) transpose_item(A.in[8], D, DIN, (bf16_t*)(ws + WS_WIN), 0, scr, it / 128, it % 128, lane);
    }
}
#ifndef P0_SPLIT_ITEMS
#define P0_SPLIT_ITEMS 28000
#endif
FI void p0d_run(const Args& A, LAS unsigned char* lds, int lane, int wave, int q0, int q1, int vcu, int G) {
    const int gw = vcu * NWAVES + wave, NGW = G * NWAVES;
    _Pragma("unroll 1") for (int rep = 0; rep < REP0D; ++rep)
    for (int q = q0 + gw; q < q1; q += NGW) moe_weight_item(A, lds + wave * 16384, q, lane);
}

FI void p1_run(const Args& A, int tid, int lane, int wave, int vcu, int G, int m0, int m1, bool extras) {
    unsigned char* ws = A.ws;
    const unsigned long long* mod = (const unsigned long long*)((const unsigned*)(ws + WS_CTL) + CW_MOD); const unsigned long long* hnorm = (const unsigned long long*)((const unsigned*)(ws + WS_CTL) + CW_HNORM);
    const float* bada = A.in[5]; const float* g1 = A.in[6];
    bf16_t* A1 = (bf16_t*)(ws + WS_A1);
    const int gw = vcu * NWAVES + wave, NGW = G * NWAVES;
    if (extras) { float* modf = (float*)(ws + WS_MODF); for (int i = vcu * NTHR + tid; i < 9 * 12288; i += G * NTHR) modf[i] = fix_get(mod + i) + bada[i % 12288]; }
    {
        const int nrows = m1 - m0, per = (nrows + NGW - 1) / NGW, r0 = m0 + gw * per, r1 = (r0 + per) < m1 ? (r0 + per) : m1;
        int cur_mr = -1; f32x4 gsc[8], shv[8];
        for (int m = r0; m < r1; ++m) {
            const float* src = m < M ? A.in[0] + (size_t)m * D : A.in[2] + (size_t)(m - M) * D;
            const int mr = m < M ? m / SEQ : 8;
            f32x4 v[8]; float ss = 0.f;
#pragma unroll
            for (int j = 0; j < 8; ++j) { v[j] = *(const f32x4*)(src + 4 * lane + 256 * j); ss += (v[j].x * v[j].x + v[j].y * v[j].y) + (v[j].z * v[j].z + v[j].w * v[j].w); }
            if (mr != cur_mr) { cur_mr = mr;
#pragma unroll
                for (int j = 0; j < 8; ++j) { const int c = 4 * lane + 256 * j; const unsigned long long* mp = mod + (size_t)mr * 12288 + c;
                    shv[j] = (f32x4){fix_get(mp), fix_get(mp + 1), fix_get(mp + 2), fix_get(mp + 3)} + *(const f32x4*)(bada + c);
                    const f32x4 sc = (f32x4){fix_get(mp + D), fix_get(mp + D + 1), fix_get(mp + D + 2), fix_get(mp + D + 3)} + *(const f32x4*)(bada + D + c);
                    gsc[j] = *(const f32x4*)(g1 + c) * (sc + 1.0f); } }
            const float rstd = rsqrtf(wave_sum(ss) * (1.0f / D) + 1e-6f);
#pragma unroll
            for (int j = 0; j < 8; ++j) { const int c = 4 * lane + 256 * j;
                const f32x4 h = v[j] * rstd * gsc[j] + shv[j];
                u32x2 w; w.x = pk2(h.x, h.y); w.y = pk2(h.z, h.w);
                *(u32x2*)(A1 + (size_t)m * D + c) = w; }
        }
    }
}

FI void p2_slack_run(const Args& A, LAS unsigned char* lds, int tid, int lane, int wave, int vcu, int G) {
    unsigned char* ws = A.ws;
    const unsigned long long* hnorm = (const unsigned long long*)((const unsigned*)(ws + WS_CTL) + CW_HNORM);
    const int gw = vcu * NWAVES + wave, NGW = G * NWAVES;
    {
        const float *lre = A.in[9], *lim = A.in[10], *lst = A.in[11], *bre = A.in[12], *bim = A.in[13], *cre = A.in[14], *cim = A.in[15];
        float* LAM = (float*)(ws + WS_LAM); float* LAML = (float*)(ws + WS_LAML); bf16_t* SB = (bf16_t*)(ws + WS_S5B); bf16_t* SC = (bf16_t*)(ws + WS_S5C);
        for (int idx = vcu * NTHR + tid; idx < 2 * 64 * 4 * 64; idx += G * NTHR) {
            const int ln = idx & 63, T = (idx >> 6) & 3, g = (idx >> 8) & 63, d = idx >> 14;
            {
                const int n = ln & 31, hq = ln >> 5, p = n + 32 * (T >> 1), part = T & 1;
                const int q = (d * 64 + g) * 64 + p;
                const float lr = fminf(lre[q], -1e-4f), li = lim[q], dt = expf(lst[q]), zr = lr * dt, zi = li * dt, er = expf(zr), br = er * cosf(zi), bi = er * sinf(zi);
                const float den = lr * lr + li * li, cr = ((br - 1.f) * lr + bi * li) / den, ci = (bi * lr - (br - 1.f) * li) / den;
                float v[8];
#pragma unroll
                for (int j = 0; j < 8; ++j) { const int h = 8 * hq + j; const float xr = bre[(size_t)q * 16 + h], xi = bim[(size_t)q * 16 + h]; v[j] = part ? (cr * xi + ci * xr) : (cr * xr - ci * xi); }
                u32x4 w; w.x = pk2(v[0], v[1]); w.y = pk2(v[2], v[3]); w.z = pk2(v[4], v[5]); w.w = pk2(v[6], v[7]);
                *(u32x4*)(SB + (size_t)idx * 8) = w;
                if (part == 0 && hq == 0) { LAM[q * 2] = br; LAM[q * 2 + 1] = bi; const float eL = expf((float)SEG * zr), aL = (float)SEG * zi; LAML[q * 2] = eL * cosf(aL); LAML[q * 2 + 1] = eL * sinf(aL); }
            }
            {
                const int hc = ln & 15, qq = ln >> 4; float v[8];
#pragma unroll
                for (int j = 0; j < 8; ++j) { const int k = 32 * T + 8 * qq + j, n = k >> 2, TT = k & 3, p = n + 32 * (TT >> 1), part = TT & 1; const size_t ci = ((size_t)(d * 64 + g) * 16 + hc) * 64 + p; v[j] = part ? -cim[ci] : cre[ci]; }
                u32x4 w; w.x = pk2(v[0], v[1]); w.y = pk2(v[2], v[3]); w.z = pk2(v[4], v[5]); w.w = pk2(v[6], v[7]);
                *(u32x4*)(SC + (size_t)idx * 8) = w;
            }
        }
    }
    {
        const float* wrt = A.in[32]; bf16_t* WRF = (bf16_t*)(ws + WS_WRF);
        for (int idx = vcu * NTHR + tid; idx < 64 * 2 * 64; idx += G * NTHR) {
            const int ln = idx & 63, nt = (idx >> 6) & 1, ks = idx >> 7, ex = 16 * nt + (ln & 15), k0 = 32 * ks + 8 * (ln >> 4);
            float v[8], rsd[8];
#pragma unroll
            for (int j = 0; j < 8; ++j) { v[j] = wrt[(size_t)(k0 + j) * NE + ex]; rsd[j] = v[j] - bf1((bf16_t)f2bf(v[j])); }
            u32x4 hi, lo; hi.x = pk2(v[0], v[1]); hi.y = pk2(v[2], v[3]); hi.z = pk2(v[4], v[5]); hi.w = pk2(v[6], v[7]);
            lo.x = pk2(rsd[0], rsd[1]); lo.y = pk2(rsd[2], rsd[3]); lo.z = pk2(rsd[4], rsd[5]); lo.w = pk2(rsd[6], rsd[7]);
            *(u32x4*)(WRF + ((size_t)((ks * 2 + nt) * 2 + 0) * 64 + ln) * 8) = hi;
            *(u32x4*)(WRF + ((size_t)((ks * 2 + nt) * 2 + 1) * 64 + ln) * 8) = lo;
        }
    }
    {
        LAS float* scr = (LAS float*)(lds + wave * 16384);
        constexpr int I_GLU = 16 * 32, I_OUT = 32 * 64;
        for (int it = gw; it < I_GLU + I_OUT; it += NGW) {
            if (it < I_GLU) transpose_item(A.in[17], S5W, S5W, (bf16_t*)(ws + WS_WGLU), 0, scr, it / 32, it % 32, lane);
            else { const int r = it - I_GLU; transpose_item(A.in[31], D, D, (bf16_t*)(ws + WS_WOUT), 0, scr, r / 64, r % 64, lane); }
        }
    }
    const float* hraw = (const float*)(ws + WS_HRAW); bf16_t* Rg = (bf16_t*)(ws + WS_RG);
    for (int it = gw; it < 512 * 16; it += NGW) {
        const int ib = it >> 4, c = (it & 15) * 64 + lane;
        const float inv = 1.0f / (fix_get(hnorm + c) + fix_get(hnorm + HYW + c));
        float v[8];
#pragma unroll
        for (int jj = 0; jj < 8; ++jj) { const int i = 8 * ib + jj; float x;
            if (i <= 2047) x = hraw[(size_t)(2047 - i) * 2048 + c]; else if (i <= 4094) x = hraw[(size_t)(i - 2048) * 2048 + HYW + c]; else x = 0.f;
            v[jj] = x * inv; }
        u32x4 w; w.x = pk2(v[0], v[1]); w.y = pk2(v[2], v[3]); w.z = pk2(v[4], v[5]); w.w = pk2(v[6], v[7]);
        *(u32x4*)(Rg + (size_t)c * 4096 + 8 * ib) = w;
    }
}

FI void s5_unit(const Args& A, LAS unsigned char* lds, int unit, int lane, int wave) {
    unsigned char* ws = A.ws;
    const int d = unit & 1, g = (unit >> 1) & 63, bp = unit >> 7, dg = d * 64 + g;
    const bf16_t* P = (const bf16_t*)(ws + WS_P); bf16_t* Ys = (bf16_t*)(ws + WS_YS5);
    bf16x8 Bf[4], Cf[4];
#pragma unroll
    for (int T = 0; T < 4; ++T) { Bf[T] = *(const bf16x8*)((const bf16_t*)(ws + WS_S5B) + ((size_t)(dg * 4 + T) * 64 + lane) * 8); Cf[T] = *(const bf16x8*)((const bf16_t*)(ws + WS_S5C) + ((size_t)(dg * 4 + T) * 64 + lane) * 8); }
    const int n = lane & 31, hh = lane >> 5;
    const float* LAM = (const float*)(ws + WS_LAM) + (size_t)dg * 128; const float* LAML = (const float*)(ws + WS_LAML) + (size_t)dg * 128;
    const float lr0 = LAM[n * 2], li0 = LAM[n * 2 + 1], lr1 = LAM[(n + 32) * 2], li1 = LAM[(n + 32) * 2 + 1];
    const int r = lane & 31, bsel = (r >> 2) & 1, tau = (r & 3) + 4 * (r >> 3), b = 2 * bp + bsel, kofs = g * 16 + 8 * (lane >> 5);
    const int seg0 = wave * SEG;
    auto rowp = [&](int pos) -> const bf16_t* {
        int row; if (pos < CTXL) { const int tc = d ? (CTXL - 1 - pos) : pos; row = M + b * CTXL + tc; } else { const int q = pos - CTXL; const int tl = d ? (SEQ - 1 - q) : q; row = b * SEQ + tl; }
        return P + (size_t)row * DIN + kofs; };
    const f32x16 z16 = {0.f, 0.f, 0.f, 0.f, 0.f, 0.f, 0.f, 0.f, 0.f, 0.f, 0.f, 0.f, 0.f, 0.f, 0.f, 0.f};
    float xr0 = 0.f, xi0 = 0.f, xr1 = 0.f, xi1 = 0.f;
#define S5_FMA(dst, a, b, c) asm volatile("v_fma_f32 %0, %1, %2, %3" : "=v"(dst) : "v"(a), "v"(b), "v"(c))
#define S5_SETTLE(c0, c1, c2, c3) asm volatile("s_nop 15\n\ts_nop 7" : "+v"(c0), "+v"(c1), "+v"(c2), "+v"(c3))
#define S5_TOKEN(tt, R0, I0, R1, I1) do { float t0_, t1_, s0_, s1_; \
        S5_FMA(t0_, nli0, xi0, c0[tt]); S5_FMA(t1_, nli1, xi1, c2[tt]); S5_FMA(s0_, li0, xr0, c1[tt]); S5_FMA(s1_, li1, xr1, c3[tt]); \
        S5_FMA(R0, lr0, xr0, t0_); S5_FMA(R1, lr1, xr1, t1_); S5_FMA(I0, lr0, xi0, s0_); S5_FMA(I1, lr1, xi1, s1_); \
        xr0 = R0; xi0 = I0; xr1 = R1; xi1 = I1; } while (0)
    const float nli0 = -li0, nli1 = -li1;
    {
        bf16x8 uc[3], un[3];
#pragma unroll
        for (int q = 0; q < 3; ++q) { uc[q] = *(const bf16x8*)rowp(seg0 + 16 * q + tau); un[q] = uc[q]; }
#pragma unroll 1
        for (int ch = 0; ch < 6; ++ch) {
            if (ch < 5) {
#pragma unroll
                for (int q = 0; q < 3; ++q) un[q] = *(const bf16x8*)rowp(seg0 + 16 * (3 * (ch + 1) + q) + tau); }
#pragma unroll
            for (int q = 0; q < 3; ++q) {
                f32x16 c0 = __builtin_amdgcn_mfma_f32_32x32x16_bf16(uc[q], Bf[0], z16, 0, 0, 0), c1 = __builtin_amdgcn_mfma_f32_32x32x16_bf16(uc[q], Bf[1], z16, 0, 0, 0);
                f32x16 c2 = __builtin_amdgcn_mfma_f32_32x32x16_bf16(uc[q], Bf[2], z16, 0, 0, 0), c3 = __builtin_amdgcn_mfma_f32_32x32x16_bf16(uc[q], Bf[3], z16, 0, 0, 0);
                S5_SETTLE(c0, c1, c2, c3);
#pragma unroll
                for (int tt = 0; tt < 16; ++tt) { float r0_, i0_, r1_, i1_; S5_TOKEN(tt, r0_, i0_, r1_, i1_); }
            }
#pragma unroll
            for (int q = 0; q < 3; ++q) uc[q] = un[q];
        }
    }
    LAS float* Es = (LAS float*)(lds + 8 * 8704);
    *(LAS f32x4*)(Es + (wave * 64 + lane) * 4) = (f32x4){xr0, xi0, xr1, xi1};
    __syncthreads();
    {
        const float Lr0 = LAML[n * 2], Li0 = LAML[n * 2 + 1], Lr1 = LAML[(n + 32) * 2], Li1 = LAML[(n + 32) * 2 + 1];
        xr0 = 0.f; xi0 = 0.f; xr1 = 0.f; xi1 = 0.f;
#pragma unroll 1
        for (int w = 0; w < wave; ++w) { const f32x4 e = *(LAS f32x4*)(Es + (w * 64 + lane) * 4);
            const float nr0 = Lr0 * xr0 - Li0 * xi0 + e.x, ni0 = Lr0 * xi0 + Li0 * xr0 + e.y; xr0 = nr0; xi0 = ni0;
            const float nr1 = Lr1 * xr1 - Li1 * xi1 + e.z, ni1 = Lr1 * xi1 + Li1 * xr1 + e.w; xr1 = nr1; xi1 = ni1; }
    }
    {
        LAS unsigned char* Xs = lds + wave * 8704;
        bf16x8 uc[3], un[3];
#pragma unroll
        for (int q = 0; q < 3; ++q) { uc[q] = *(const bf16x8*)rowp(seg0 + 16 * q + tau); un[q] = uc[q]; }
#pragma unroll 1
        for (int ch = 0; ch < 6; ++ch) {
            if (ch < 5) {
#pragma unroll
                for (int q = 0; q < 3; ++q) un[q] = *(const bf16x8*)rowp(seg0 + 16 * (3 * (ch + 1) + q) + tau); }
#pragma unroll
            for (int q = 0; q < 3; ++q) {
                const int pos0 = seg0 + 16 * (3 * ch + q);
                f32x16 c0 = __builtin_amdgcn_mfma_f32_32x32x16_bf16(uc[q], Bf[0], z16, 0, 0, 0), c1 = __builtin_amdgcn_mfma_f32_32x32x16_bf16(uc[q], Bf[1], z16, 0, 0, 0);
                f32x16 c2 = __builtin_amdgcn_mfma_f32_32x32x16_bf16(uc[q], Bf[2], z16, 0, 0, 0), c3 = __builtin_amdgcn_mfma_f32_32x32x16_bf16(uc[q], Bf[3], z16, 0, 0, 0);
                S5_SETTLE(c0, c1, c2, c3);
                float R0[16], I0[16], R1[16], I1[16];
#pragma unroll
                for (int tt = 0; tt < 16; ++tt) S5_TOKEN(tt, R0[tt], I0[tt], R1[tt], I1[tt]);
                if (pos0 >= CTXL) {
#pragma unroll
                    for (int tt = 0; tt < 16; ++tt) { u32x2 w; w.x = pk2(R0[tt], I0[tt]); w.y = pk2(R1[tt], I1[tt]); *(LAS u32x2*)(Xs + (hh * 16 + tt) * 272 + 8 * n) = w; }
                    LDS_WAIT();
#pragma unroll
                    for (int bt = 0; bt < 2; ++bt) {
                        f32x4 y = (f32x4){0.f, 0.f, 0.f, 0.f};
#pragma unroll
                        for (int ks = 0; ks < 4; ++ks) { const bf16x8 xf = *(const LAS bf16x8*)(Xs + (bt * 16 + (lane & 15)) * 272 + (32 * ks + 8 * (lane >> 4)) * 2); y = __builtin_amdgcn_mfma_f32_16x16x32_bf16(Cf[ks], xf, y, 0, 0, 0); }
                        const int qq = pos0 + (lane & 15) - CTXL, tl = d ? (SEQ - 1 - qq) : qq, bb = 2 * bp + bt;
                        u32x2 w; w.x = pk2(y[0], y[1]); w.y = pk2(y[2], y[3]);
                        *(u32x2*)(Ys + ((size_t)(d * M + bb * SEQ + tl)) * S5W + g * 16 + 4 * (lane >> 4)) = w;
                    }
                    LDS_WAIT();
                }
            }
#pragma unroll
            for (int q = 0; q < 3; ++q) uc[q] = un[q];
        }
    }
    __syncthreads();
#undef S5_FMA
#undef S5_SETTLE
#undef S5_TOKEN
}

FI void h1_item(const Args& A, LAS unsigned char* lds, int item, int tid) {
    unsigned char* ws = A.ws;
    const bf16_t* P = (const bf16_t*)(ws + WS_P); bf16_t* Vt = (bf16_t*)(ws + WS_VT);
    const int gr = item >> 3, cg = item & 7, b = gr >> 5, t0 = (gr & 31) * 64, c0 = cg * 128;
    for (int idx = tid; idx < 2 * 64 * 16; idx += NTHR) { const int ch = idx >> 10, rem = idx & 1023, row = rem >> 4, sg = rem & 15;
        const u32x4 v = *(const u32x4*)(P + (size_t)(b * SEQ + t0 + row) * DIN + S5W + ch * HYW + c0 + sg * 8);
        *(LAS u32x4*)(lds + ch * 16896 + (row + 1) * 256 + sg * 16) = v; }
    if (tid < 64) { const int ch = tid >> 5, rr = (tid >> 4) & 1, sg = tid & 15; *(LAS u32x4*)(lds + ch * 16896 + (rr ? 65 : 0) * 256 + sg * 16) = (u32x4){0u, 0u, 0u, 0u}; }
    __syncthreads();
    const int c2 = tid & 63, tq = tid >> 6, cc = c0 + 2 * c2;
    const float* cw = A.in[19]; const float* cb = A.in[20];
    const float2 w0v = *(const float2*)(cw + cc), w1v = *(const float2*)(cw + 3072 + cc), w2v = *(const float2*)(cw + 6144 + cc), bv = *(const float2*)(cb + cc);
    const float2 w0x = *(const float2*)(cw + HYW + cc), w1x = *(const float2*)(cw + 3072 + HYW + cc), w2x = *(const float2*)(cw + 6144 + HYW + cc), bx = *(const float2*)(cb + HYW + cc);
    const LAS unsigned* Vs = (const LAS unsigned*)lds; const LAS unsigned* Xs = (const LAS unsigned*)(lds + 16896);
    unsigned vm = Vs[(tq * 8) * 64 + c2], v0 = Vs[(tq * 8 + 1) * 64 + c2], xm = Xs[(tq * 8) * 64 + c2], x0 = Xs[(tq * 8 + 1) * 64 + c2];
    float oa[8], ob[8];
#pragma unroll
    for (int i = 0; i < 8; ++i) { const int t = tq * 8 + i;
        const unsigned vp = Vs[(t + 2) * 64 + c2], xp = Xs[(t + 2) * 64 + c2];
        const float va = w0v.x * bflo(vm) + w1v.x * bflo(v0) + w2v.x * bflo(vp) + bv.x, vb = w0v.y * bfhi(vm) + w1v.y * bfhi(v0) + w2v.y * bfhi(vp) + bv.y;
        const float xa = w0x.x * bflo(xm) + w1x.x * bflo(x0) + w2x.x * bflo(xp) + bx.x, xb = w0x.y * bfhi(xm) + w1x.y * bfhi(x0) + w2x.y * bfhi(xp) + bx.y;
        oa[i] = va * xa; ob[i] = vb * xb; vm = v0; v0 = vp; xm = x0; x0 = xp; }
    bf16_t* dst = Vt + ((size_t)(cc * NB + b) * SEQ + t0 + tq * 8);
    u32x4 wa; wa.x = pk2(oa[0], oa[1]); wa.y = pk2(oa[2], oa[3]); wa.z = pk2(oa[4], oa[5]); wa.w = pk2(oa[6], oa[7]);
    u32x4 wb; wb.x = pk2(ob[0], ob[1]); wb.y = pk2(ob[2], ob[3]); wb.z = pk2(ob[4], ob[5]); wb.w = pk2(ob[6], ob[7]);
    *(u32x4*)dst = wa; *(u32x4*)(dst + (size_t)NB * SEQ) = wb;
    __syncthreads();
}

constexpr int RT_STRIDE = 8208, VS_OFF = 8 * RT_STRIDE, VS_STRIDE = 4112;
FI void longconv_run(const Args& A, LAS unsigned char* lds, int tid, int lane, int wave, int vcu, int G) {
    unsigned char* ws = A.ws;
    for (int i = tid; i < VS_OFF / 16; i += NTHR) *(LAS u32x4*)(lds + i * 16) = (u32x4){0u, 0u, 0u, 0u};
    for (int i = tid; i < VS_STRIDE / 16; i += NTHR) *(LAS u32x4*)(lds + VS_OFF + NB * VS_STRIDE + i * 16) = (u32x4){0u, 0u, 0u, 0u};
    u32x4 pr, pv[4];
    auto fetch = [&](int c) { const bf16_t* Rg = (const bf16_t*)(ws + WS_RG) + (size_t)c * 4096; const bf16_t* Vt = (const bf16_t*)(ws + WS_VT) + (size_t)c * NB * SEQ;
        pr = *(const u32x4*)(Rg + 8 * tid);
#pragma unroll
        for (int k = 0; k < 4; ++k) { const int i = tid + k * NTHR; pv[k] = *(const u32x4*)(Vt + (size_t)(i >> 8) * SEQ + (i & 255) * 8); } };
    int c = vcu;
    if (c < HYW) fetch(c);
    __syncthreads();
  for (; c < HYW; c += G) {
    bf16_t* LC = (bf16_t*)(ws + WS_LCT) + (size_t)c * NB * SEQ;
#pragma unroll
    for (int k = 0; k < 4; ++k) { const int i = tid + k * NTHR; *(LAS u32x4*)(lds + VS_OFF + (i >> 8) * VS_STRIDE + (i & 255) * 16) = pv[k]; }
    { const unsigned wv[4] = {pr.x, pr.y, pr.z, pr.w};
#pragma unroll
      for (int e = 0; e < 8; ++e) { const bf16_t v = (bf16_t)((e & 1) ? (wv[e >> 1] >> 16) : (wv[e >> 1] & 0xffffu)); const int i = 8 * tid + e;
#pragma unroll
        for (int r = 0; r < 8; ++r) *(LAS bf16_t*)(lds + r * RT_STRIDE + (i + r) * 2) = v; } }
    __syncthreads();
    if (c + G < HYW) fetch(c + G);
    const int a = lane & 15, q = lane >> 4, r = (a + 1) & 7, nb = a & 7, hi = a >> 3, i0 = wave * 8;
    const int ZOFF = VS_OFF + NB * VS_STRIDE;
    f32x4 acc[8];
#pragma unroll
    for (int ii = 0; ii < 8; ++ii) acc[ii] = (f32x4){0.f, 0.f, 0.f, 0.f};
    auto run = [&](const LAS unsigned char* rb, const LAS unsigned char* vb) {
        bf16x8 S[8];
#pragma unroll
        for (int ii = 0; ii < 8; ++ii) S[ii] = *(const LAS bf16x8*)(rb + 32 * (7 - ii));
        bf16x8 bfr = *(const LAS bf16x8*)vb;
#pragma unroll 1
        for (int j4 = 0; j4 < 32; j4 += 4) {
#pragma unroll
            for (int jj = 0; jj < 4; ++jj) {
                const int j = j4 + jj, jn = (j + 1) & 31;
                const bf16x8 nb_ = *(const LAS bf16x8*)(vb + 64 * jn);
                const bf16x8 n0_ = *(const LAS bf16x8*)(rb + 32 * 7 + 64 * jn), n1_ = *(const LAS bf16x8*)(rb + 32 * 6 + 64 * jn);
#pragma unroll
                for (int ii = 0; ii < 8; ++ii) acc[ii] = __builtin_amdgcn_mfma_f32_16x16x32_bf16(S[(ii - 2 * jj) & 7], bfr, acc[ii], 0, 0, 0);
                S[(0 - 2 * (jj + 1)) & 7] = n0_; S[(1 - 2 * (jj + 1)) & 7] = n1_; bfr = nb_;
            }
        }
    };
    const int ebase = 2047 - 16 * (i0 + 7) - a + 8 * q + r;
    const LAS unsigned char* rt = lds + r * RT_STRIDE;
    const LAS unsigned char* vrow = lds + VS_OFF + nb * VS_STRIDE + 16 * q; const LAS unsigned char* zrow = lds + ZOFF + 16 * q;
    run(rt + 2 * ebase, vrow + (hi ? 64 * 32 : 0));
    run(rt + 2 * (ebase + 32 * 32), hi ? zrow : vrow + 64 * 32);
    run(rt + 2 * (ebase - 16 * 64), hi ? vrow : zrow);
#pragma unroll
    for (int ii = 0; ii < 8; ++ii) { u32x2 w; w.x = pk2(acc[ii][0], acc[ii][1]); w.y = pk2(acc[ii][2], acc[ii][3]); *(u32x2*)(LC + (size_t)nb * SEQ + 16 * (i0 + ii + 64 * hi) + 4 * q) = w; }
    __syncthreads();
  }
}

FI void s5_combine(const Args& A, int gtid, int gthreads) {
    unsigned char* ws = A.ws;
    const bf16_t* P = (const bf16_t*)(ws + WS_P); const bf16_t* Ys = (const bf16_t*)(ws + WS_YS5); bf16_t* Yg = (bf16_t*)(ws + WS_YG); const float* dsk = A.in[16];
    for (int idx = gtid; idx < M * 128; idx += gthreads) {
        const int row = idx >> 7, c8 = (idx & 127) * 8;
        const u32x4 u = *(const u32x4*)(P + (size_t)row * DIN + c8), yf = *(const u32x4*)(Ys + (size_t)row * S5W + c8), yb = *(const u32x4*)(Ys + (size_t)(M + row) * S5W + c8);
        const f32x4 d0 = *(const f32x4*)(dsk + c8), d1 = *(const f32x4*)(dsk + c8 + 4);
        float y[8];
        y[0] = bflo(u.x) * d0.x + bflo(yf.x) + bflo(yb.x); y[1] = bfhi(u.x) * d0.y + bfhi(yf.x) + bfhi(yb.x);
        y[2] = bflo(u.y) * d0.z + bflo(yf.y) + bflo(yb.y); y[3] = bfhi(u.y) * d0.w + bfhi(yf.y) + bfhi(yb.y);
        y[4] = bflo(u.z) * d1.x + bflo(yf.z) + bflo(yb.z); y[5] = bfhi(u.z) * d1.y + bfhi(yf.z) + bfhi(yb.z);
        y[6] = bflo(u.w) * d1.z + bflo(yf.w) + bflo(yb.w); y[7] = bfhi(u.w) * d1.w + bfhi(yf.w) + bfhi(yb.w);
#pragma unroll
        for (int e = 0; e < 8; ++e) y[e] = 0.5f * y[e] * (1.0f + erff(y[e] * 0.70710678118654752f));
        u32x4 w; w.x = pk2(y[0], y[1]); w.y = pk2(y[2], y[3]); w.z = pk2(y[4], y[5]); w.w = pk2(y[6], y[7]);
        *(u32x4*)(Yg + (size_t)row * S5W + c8) = w;
    }
}

FI void h3_run(const Args& A, LAS unsigned char* lds, int tid, int vcu, int G) {
    unsigned char* ws = A.ws;
    const bf16_t* P = (const bf16_t*)(ws + WS_P); const bf16_t* LC = (const bf16_t*)(ws + WS_LCT); bf16_t* Yc = (bf16_t*)(ws + WS_YCAT);
    const float* cw = A.in[19]; const float* cb = A.in[20];
    u32x4 rp[6], rl[2];
    auto fetch = [&](int item) {
        const int gr = item >> 3, cg = item & 7, b = gr >> 5, t0 = (gr & 31) * 64, c0 = cg * 128;
#pragma unroll
        for (int k = 0; k < 6; ++k) { const int idx = tid + k * NTHR, ch = idx >> 10, rem = idx & 1023, row = rem >> 4, sg = rem & 15;
            rp[k] = *(const u32x4*)(P + (size_t)(b * SEQ + t0 + row) * DIN + S5W + ch * HYW + c0 + sg * 8); }
#pragma unroll
        for (int k = 0; k < 2; ++k) { const int idx = tid + k * NTHR, c = idx >> 3, pc = idx & 7;
            rl[k] = *(const u32x4*)(LC + (size_t)((c0 + c) * NB + b) * SEQ + t0 + pc * 8); }
    };
    int item = vcu;
    if (item < 2048) fetch(item);
    for (; item < 2048; item += G) {
        const int gr = item >> 3, cg = item & 7, b = gr >> 5, t0 = (gr & 31) * 64, c0 = cg * 128;
#pragma unroll
        for (int k = 0; k < 6; ++k) { const int idx = tid + k * NTHR, ch = idx >> 10, rem = idx & 1023, row = rem >> 4, sg = rem & 15;
            *(LAS u32x4*)(lds + ch * 16896 + (row + 1) * 256 + sg * 16) = rp[k]; }
        if (tid < 96) { const int ch = tid >> 5, rr = (tid >> 4) & 1, sg = tid & 15; *(LAS u32x4*)(lds + ch * 16896 + (rr ? 65 : 0) * 256 + sg * 16) = (u32x4){0u, 0u, 0u, 0u}; }
        LAS bf16_t* Ls = (LAS bf16_t*)(lds + 3 * 16896);
#pragma unroll
        for (int k = 0; k < 2; ++k) { const int idx = tid + k * NTHR, c = idx >> 3, pc = idx & 7;
            const unsigned wv[4] = {rl[k].x, rl[k].y, rl[k].z, rl[k].w};
#pragma unroll
            for (int e = 0; e < 4; ++e) { Ls[(pc * 8 + 2 * e) * 128 + c] = (bf16_t)(wv[e] & 0xffffu); Ls[(pc * 8 + 2 * e + 1) * 128 + c] = (bf16_t)(wv[e] >> 16); } }
        __syncthreads();
        if (item + G < 2048) fetch(item + G);
        const int c2 = tid & 63, tq = tid >> 6, cc = c0 + 2 * c2;
        const float2 w0v = *(const float2*)(cw + cc), w1v = *(const float2*)(cw + 3072 + cc), w2v = *(const float2*)(cw + 6144 + cc), bv = *(const float2*)(cb + cc);
        const float2 w0x = *(const float2*)(cw + HYW + cc), w1x = *(const float2*)(cw + 3072 + HYW + cc), w2x = *(const float2*)(cw + 6144 + HYW + cc), bx = *(const float2*)(cb + HYW + cc);
        const float2 w0z = *(const float2*)(cw + 2 * HYW + cc), w1z = *(const float2*)(cw + 3072 + 2 * HYW + cc), w2z = *(const float2*)(cw + 6144 + 2 * HYW + cc), bz = *(const float2*)(cb + 2 * HYW + cc);
        const float2 dd = *(const float2*)(A.in[30] + cc);
        const LAS unsigned* Vs = (const LAS unsigned*)lds; const LAS unsigned* Xs = (const LAS unsigned*)(lds + 16896); const LAS unsigned* Zs = (const LAS unsigned*)(lds + 2 * 16896); const LAS unsigned* Lw = (const LAS unsigned*)Ls;
        unsigned vm = Vs[(tq * 8) * 64 + c2], v0 = Vs[(tq * 8 + 1) * 64 + c2], xm = Xs[(tq * 8) * 64 + c2], x0 = Xs[(tq * 8 + 1) * 64 + c2], zm = Zs[(tq * 8) * 64 + c2], z0 = Zs[(tq * 8 + 1) * 64 + c2];
#pragma unroll
        for (int i = 0; i < 8; ++i) { const int t = tq * 8 + i;
            const unsigned vp = Vs[(t + 2) * 64 + c2], xp = Xs[(t + 2) * 64 + c2], zp = Zs[(t + 2) * 64 + c2], lw = Lw[t * 64 + c2];
            const float va = w0v.x * bflo(vm) + w1v.x * bflo(v0) + w2v.x * bflo(vp) + bv.x, vb = w0v.y * bfhi(vm) + w1v.y * bfhi(v0) + w2v.y * bfhi(vp) + bv.y;
            const float xa = w0x.x * bflo(xm) + w1x.x * bflo(x0) + w2x.x * bflo(xp) + bx.x, xb = w0x.y * bfhi(xm) + w1x.y * bfhi(x0) + w2x.y * bfhi(xp) + bx.y;
            const float za = w0z.x * bflo(zm) + w1z.x * bflo(z0) + w2z.x * bflo(zp) + bz.x, zb = w0z.y * bfhi(zm) + w1z.y * bfhi(z0) + w2z.y * bfhi(zp) + bz.y;
            const float ya = (bflo(lw) + va * xa * dd.x) * za, yb = (bfhi(lw) + vb * xb * dd.y) * zb;
            *(unsigned*)(Yc + (size_t)(b * SEQ + t0 + t) * D + S5W + cc) = pk2(ya, yb);
            vm = v0; v0 = vp; xm = x0; x0 = xp; zm = z0; z0 = zp; }
        __syncthreads();
    }
}

FI void p7_run(const Args& A, LAS unsigned char* lds, int lane, int wave, int vcu, int G, bool commit) {
    unsigned char* ws = A.ws;
    const float* x1 = (const float*)(ws + WS_X1); unsigned char* A2 = ws + WS_A2;
    const float* mod = (const float*)(ws + WS_MODF); const float* g2 = A.in[7]; const float* brt = A.in[33];
    const bf16x8* WRF = (const bf16x8*)(ws + WS_WRF);
    int* cnt = (int*)(ws + WS_CTL) + CW_CNT; int* rowl = (int*)(ws + WS_ROWL); int* pk = (int*)(ws + WS_PK); float* gate = (float*)(ws + WS_GATE);
    const int t = lane & 15, q = lane >> 4, pair = wave >> 1, kh = wave & 1;
    LAS float* xch = (LAS float*)(lds + 32768);
    LAS float* part = (LAS float*)(lds + 34816);
    LAS int* lcnt = (LAS int*)(lds + 65536);
    for (int it = vcu; it < M / 64; it += G) {
        const int row = it * 64 + pair * 16 + t, b = (it * 64) / SEQ;
        const float* xr = x1 + (size_t)row * D + kh * 1024 + 8 * q;
        if (threadIdx.x < 64) lcnt[threadIdx.x] = 0;
        float ss = 0.f;
#pragma unroll 8
        for (int ks = 0; ks < 32; ++ks) { const f32x4 a = *(const f32x4*)(xr + 32 * ks), c = *(const f32x4*)(xr + 32 * ks + 4);
            ss += ((a.x * a.x + a.y * a.y) + (a.z * a.z + a.w * a.w)) + ((c.x * c.x + c.y * c.y) + (c.z * c.z + c.w * c.w)); }
        ss += __shfl_xor(ss, 16); ss += __shfl_xor(ss, 32);
        if (q == 0) xch[wave * 16 + t] = ss;
        __syncthreads();
        const float rstd = rsqrtf((xch[(pair * 2) * 16 + t] + xch[(pair * 2 + 1) * 16 + t]) * (1.0f / D) + 1e-6f);
        f32x4 acc0 = (f32x4){0.f, 0.f, 0.f, 0.f}, acc1 = (f32x4){0.f, 0.f, 0.f, 0.f};
        const float* gp = g2 + kh * 1024 + 8 * q; const float* shp = mod + (size_t)b * 12288 + 3 * D + kh * 1024 + 8 * q; const float* scp = mod + (size_t)b * 12288 + 4 * D + kh * 1024 + 8 * q;
        unsigned char* a2p = A2 + (size_t)row * D + kh * 1024 + 8 * q;
#pragma unroll 4
        for (int ks = 0; ks < 32; ++ks) {
            const f32x4 xa = *(const f32x4*)(xr + 32 * ks), xb = *(const f32x4*)(xr + 32 * ks + 4);
            const f32x4 ha = xa * rstd * *(const f32x4*)(gp + 32 * ks) * (*(const f32x4*)(scp + 32 * ks) + 1.0f) + *(const f32x4*)(shp + 32 * ks);
            const f32x4 hb = xb * rstd * *(const f32x4*)(gp + 32 * ks + 4) * (*(const f32x4*)(scp + 32 * ks + 4) + 1.0f) + *(const f32x4*)(shp + 32 * ks + 4);
            u32x2 w8; w8.x = pk4_fp8(ha.x, ha.y, ha.z, ha.w); w8.y = pk4_fp8(hb.x, hb.y, hb.z, hb.w); *(u32x2*)(a2p + 32 * ks) = w8;
            u32x4 hi; hi.x = pk2(ha.x, ha.y); hi.y = pk2(ha.z, ha.w); hi.z = pk2(hb.x, hb.y); hi.w = pk2(hb.z, hb.w);
            u32x4 lo; lo.x = pk2(ha.x - bflo(hi.x), ha.y - bfhi(hi.x)); lo.y = pk2(ha.z - bflo(hi.y), ha.w - bfhi(hi.y)); lo.z = pk2(hb.x - bflo(hi.z), hb.y - bfhi(hi.z)); lo.w = pk2(hb.z - bflo(hi.w), hb.w - bfhi(hi.w));
            const bf16x8 Hh = __builtin_bit_cast(bf16x8, hi), Hl = __builtin_bit_cast(bf16x8, lo);
            const bf16x8* wf = WRF + (size_t)((kh * 32 + ks) * 4) * 64 + lane;
            const bf16x8 wh0 = wf[0], wl0 = wf[64], wh1 = wf[128], wl1 = wf[192];
            acc0 = __builtin_amdgcn_mfma_f32_16x16x32_bf16(wh0, Hh, acc0, 0, 0, 0); acc1 = __builtin_amdgcn_mfma_f32_16x16x32_bf16(wh1, Hh, acc1, 0, 0, 0);
            acc0 = __builtin_amdgcn_mfma_f32_16x16x32_bf16(wl0, Hh, acc0, 0, 0, 0); acc1 = __builtin_amdgcn_mfma_f32_16x16x32_bf16(wl1, Hh, acc1, 0, 0, 0);
            acc0 = __builtin_amdgcn_mfma_f32_16x16x32_bf16(wh0, Hl, acc0, 0, 0, 0); acc1 = __builtin_amdgcn_mfma_f32_16x16x32_bf16(wh1, Hl, acc1, 0, 0, 0);
        }
        if (kh == 1) { *(LAS f32x4*)(part + (pair * 64 + lane) * 8) = acc0; *(LAS f32x4*)(part + (pair * 64 + lane) * 8 + 4) = acc1; }
        __syncthreads();
        int myex = 0, myrank = 0; float mygate = 0.f;
        if (kh == 0) {
            acc0 += *(const LAS f32x4*)(part + (pair * 64 + lane) * 8); acc1 += *(const LAS f32x4*)(part + (pair * 64 + lane) * 8 + 4);
            float v[8]; int ix[8];
#pragma unroll
            for (int r = 0; r < 4; ++r) { ix[r] = 4 * q + r; ix[4 + r] = 16 + 4 * q + r; v[r] = acc0[r] + brt[4 * q + r]; v[4 + r] = acc1[r] + brt[16 + 4 * q + r]; }
            float tv[4]; int ti[4];
#pragma unroll
            for (int k = 0; k < 4; ++k) { float bv = v[0]; int bi = ix[0];
#pragma unroll
                for (int r = 1; r < 8; ++r) if (v[r] > bv) { bv = v[r]; bi = ix[r]; }
#pragma unroll
                for (int o = 16; o <= 32; o <<= 1) { const float ov = __shfl_xor(bv, o); const int oi = __shfl_xor(bi, o); if (ov > bv || (ov == bv && oi < bi)) { bv = ov; bi = oi; } }
                tv[k] = bv; ti[k] = bi;
#pragma unroll
                for (int r = 0; r < 8; ++r) if (ix[r] == bi) v[r] = -3.0e38f; }
            const float e1 = __expf(tv[1] - tv[0]), e2 = __expf(tv[2] - tv[0]), e3 = __expf(tv[3] - tv[0]), inv = 1.0f / (1.0f + e1 + e2 + e3);
            myex = q == 0 ? ti[0] : q == 1 ? ti[1] : q == 2 ? ti[2] : ti[3];
            mygate = (q == 0 ? 1.0f : q == 1 ? e1 : q == 2 ? e2 : e3) * inv;
            myrank = __hip_atomic_fetch_add(lcnt + myex, 1, __ATOMIC_RELAXED, __HIP_MEMORY_SCOPE_WORKGROUP);
        }
        __syncthreads();
        if (threadIdx.x < NE) { const int n = lcnt[threadIdx.x]; lcnt[32 + threadIdx.x] = (n > 0 && commit) ? atomicAdd(cnt + threadIdx.x, n) : 0; }
        __syncthreads();
        if (kh == 0 && commit) { const int slot = lcnt[32 + myex] + myrank;
            rowl[myex * M + slot] = row; pk[row * 4 + q] = myex * M + slot; gate[row * 4 + q] = mygate; }
        __syncthreads();
    }
}

FI void moe_table(const Args& A, LAS unsigned char* lds, int tid) {
    const int* cnt = (const int*)(A.ws + WS_CTL) + CW_CNT;
    LAS int* tw = (LAS int*)(lds + LDSCTL_OFF);
    if (tid < 64) { const int n = tid < NE ? cnt[tid] : 0; int p = (n + 255) >> 8;
#pragma unroll
        for (int o = 1; o < 32; o <<= 1) { const int q = __shfl_up(p, o); if ((tid & 63) >= o) p += q; }
        if (tid < NE) { tw[LW_TST + tid + 1] = p; tw[LW_CNT + tid] = n; } if (tid == 0) tw[LW_TST] = 0; }
    __syncthreads();
    if (tid < 320) { int e = 0;
#pragma unroll 1
        for (int j = 1; j < NE; ++j) e += (tw[LW_TST + j] <= tid) ? 1 : 0;
        tw[LW_TE + tid] = e; }
    __syncthreads();
}

FI void p10_run(const Args& A, LAS unsigned char* lds, int lane, int wave, int vcu, int G) {
    unsigned char* ws = A.ws;
    const float* x1 = (const float*)(ws + WS_X1); const unsigned char* Yd = ws + WS_YD; const float* bdn = A.in[37];
    const float* mod = (const float*)(ws + WS_MODF); const float* gf = A.in[38];
    const int* pk = (const int*)(ws + WS_PK); const float* gate = (const float*)(ws + WS_GATE);
    const LAS int* tst = (const LAS int*)(lds + LDSCTL_OFF) + LW_TST;
    const int gw = vcu * NWAVES + wave, NGW = G * NWAVES;
    for (int row = gw; row < M; row += NGW) {
        const int b = row / SEQ; unsigned hr[4], bo[4]; float gk[4];
#pragma unroll
        for (int k = 0; k < 4; ++k) { const int p = __builtin_amdgcn_readfirstlane(pk[row * 4 + k]), ex = p / M, slot = p % M;
            hr[k] = (unsigned)(__builtin_amdgcn_readfirstlane(tst[ex]) * 256 + slot) * (unsigned)D; gk[k] = __builtin_bit_cast(float, __builtin_amdgcn_readfirstlane(__builtin_bit_cast(int, gate[row * 4 + k]))); bo[k] = (unsigned)ex * (unsigned)D; }
        f32x4 x2[8]; float ss = 0.f;
        const int rowu = __builtin_amdgcn_readfirstlane(row);
        const float* x1r = x1 + (size_t)rowu * D; const float* gar = mod + (size_t)(rowu / SEQ) * 12288 + 5 * D; float* outr = A.out + (size_t)rowu * D;
#pragma unroll
        for (int hb = 0; hb < 2; ++hb) {
            const float* x1h = x1r + hb * 1024; const float* gah = gar + hb * 1024;
            const unsigned char* y0 = Yd + hr[0] + hb * 1024; const unsigned char* y1 = Yd + hr[1] + hb * 1024; const unsigned char* y2 = Yd + hr[2] + hb * 1024; const unsigned char* y3 = Yd + hr[3] + hb * 1024;
            const float* b0 = bdn + bo[0] + hb * 1024; const float* b1 = bdn + bo[1] + hb * 1024; const float* b2 = bdn + bo[2] + hb * 1024; const float* b3 = bdn + bo[3] + hb * 1024;
#pragma unroll
            for (int jj = 0; jj < 4; ++jj) { const int col = 4 * lane + 256 * jj, j = hb * 4 + jj;
                f32x4 s = (f32x4){0.f, 0.f, 0.f, 0.f};
                { const int y = *(const int*)(y0 + col); const f32v2 lo = __builtin_amdgcn_cvt_pk_f32_fp8(y, false), hi = __builtin_amdgcn_cvt_pk_f32_fp8(y, true); s += ((f32x4){lo.x, lo.y, hi.x, hi.y} + *(const f32x4*)(b0 + col)) * gk[0]; }
                { const int y = *(const int*)(y1 + col); const f32v2 lo = __builtin_amdgcn_cvt_pk_f32_fp8(y, false), hi = __builtin_amdgcn_cvt_pk_f32_fp8(y, true); s += ((f32x4){lo.x, lo.y, hi.x, hi.y} + *(const f32x4*)(b1 + col)) * gk[1]; }
                { const int y = *(const int*)(y2 + col); const f32v2 lo = __builtin_amdgcn_cvt_pk_f32_fp8(y, false), hi = __builtin_amdgcn_cvt_pk_f32_fp8(y, true); s += ((f32x4){lo.x, lo.y, hi.x, hi.y} + *(const f32x4*)(b2 + col)) * gk[2]; }
                { const int y = *(const int*)(y3 + col); const f32v2 lo = __builtin_amdgcn_cvt_pk_f32_fp8(y, false), hi = __builtin_amdgcn_cvt_pk_f32_fp8(y, true); s += ((f32x4){lo.x, lo.y, hi.x, hi.y} + *(const f32x4*)(b3 + col)) * gk[3]; }
                x2[j] = *(const f32x4*)(x1h + col) + *(const f32x4*)(gah + col) * s;
                ss += (x2[j].x * x2[j].x + x2[j].y * x2[j].y) + (x2[j].z * x2[j].z + x2[j].w * x2[j].w); }
        }
        const float rstd = rsqrtf(wave_sum(ss) * (1.0f / D) + 1e-6f);
#pragma unroll
        for (int hb = 0; hb < 2; ++hb) { float* oh = outr + hb * 1024; const float* gh = gf + hb * 1024;
#pragma unroll
            for (int jj = 0; jj < 4; ++jj) { const int col = 4 * lane + 256 * jj; *(f32x4*)(oh + col) = x2[hb * 4 + jj] * rstd * *(const f32x4*)(gh + col); } }
    }
}

__global__ void __launch_bounds__(NTHR, 2) fwd_kernel(Args args) {
    extern __shared__ __attribute__((aligned(16))) unsigned char lds_raw[];
    LAS unsigned char* lds = (LAS unsigned char*)lds_raw;
    const int tid = threadIdx.x, lane = tid & 63, wave = __builtin_amdgcn_readfirstlane(tid >> 6);
    const int G = gridDim.x; const int bx = blockIdx.x; const int vcu = (G % 8 == 0) ? (bx % 8) * (G / 8) + bx / 8 : bx;
    unsigned char* ws = args.ws;
    for (int u = tid; u < (LDS_BYTES - LDSCTL_OFF) / 4; u += NTHR) ((LAS unsigned*)(lds + LDSCTL_OFF))[u] = 0u;
    __syncthreads();
    XcdBarrier bar; bar.bar = (unsigned*)(ws + WS_CTL) + CW_BAR; bar.x = 0; bar.st = nullptr;
#if !MK_SPLIT
    bar = xcd_barrier_post((unsigned*)(ws + WS_CTL) + CW_BAR, (volatile LAS unsigned*)(lds + LDSCTL_OFF) + LW_BAR);
#endif
    const int lo = args.ph_lo, hi = args.ph_hi;
#ifndef PHASE_MASK
#define PHASE_MASK 0x7ff
#endif
#define IN(k) (((PHASE_MASK >> (k)) & 1) && lo <= (k) && (k) < hi)
#if MK_SPLIT
#define SEAM(k) do { } while (0)
#else
#define SEAM(k) do { if (IN(k) && IN((k) + 1)) xcd_barrier(bar); } while (0)
#endif
    const float* modp = (const float*)(ws + WS_MODF);
    volatile LAS unsigned long long* amp_w = (volatile LAS unsigned long long*)(lds + LDSCTL_OFF + 8192);
#ifndef AMP_CLK
#define AMP_CLK 0
#endif
#define AMP_NOW() (AMP_CLK ? (unsigned long long)__builtin_amdgcn_s_memtime() / 128ull : (unsigned long long)__builtin_amdgcn_s_memrealtime())
#define AMP_BEGIN(k) do { if (AMP_PHASE == (k) && bx == 0 && tid == 0) amp_w[0] = AMP_NOW(); } while (0)
#define AMP_END(k) do { if (AMP_PHASE == (k) && bx == 0 && tid == 0) amp_w[1] = AMP_NOW() - amp_w[0]; } while (0)

    AMP_BEGIN(0);
    AMP_BEGIN(11);
    if (IN(0)) {
        if ((G & 1) == 0 && G >= 64) {
            if ((bx & 1) == 0) { p0_run(args, lds, tid, lane, wave, bx >> 1, G >> 1); __syncthreads(); p0d_run(args, lds, lane, wave, P0_SPLIT_ITEMS, 49152, bx >> 1, G >> 1); }
            else p0d_run(args, lds, lane, wave, 0, P0_SPLIT_ITEMS, bx >> 1, G >> 1);
        } else { p0_run(args, lds, tid, lane, wave, vcu, G); __syncthreads(); p0d_run(args, lds, lane, wave, 0, 49152, vcu, G); }
    }
    AMP_END(11);
    SEAM(0); AMP_END(0);
    AMP_BEGIN(1);
    if (IN(1)) { _Pragma("unroll 1") for (int rep = 0; rep < REP1; ++rep) p1_run(args, tid, lane, wave, vcu, G, 0, MT, true); } SEAM(1); AMP_END(1);
    AMP_BEGIN(2);
    if (IN(2)) {
        pg8::DenseSched S{(const bf16_t*)(ws + WS_A1), (const bf16_t*)(ws + WS_WIN), 2 * D, M / 256, DIN / 256, G, bx, M / 256, MC / 256, S5W / 256, 0};
        pg8::EpiStoreBf16<false> E{(bf16_t*)(ws + WS_P), DIN, nullptr, 0, 1.0f};
        _Pragma("unroll 1") for (int rep = 0; rep < REP2; ++rep)
        pg8::gemm_phase<false>(lds, 2 * D, S, E);
        if (G >= 64) { if (bx >= 32) p2_slack_run(args, lds, tid, lane, wave, bx - 32, G - 32); } else p2_slack_run(args, lds, tid, lane, wave, vcu, G);
    } SEAM(2); AMP_END(2);
    AMP_BEGIN(3);
    if (IN(3)) {
        _Pragma("unroll 1") for (int rep = 0; rep < REP3; ++rep) {
        _Pragma("unroll 1") for (int r2 = 0; r2 < REP3A; ++r2) for (int u = vcu; u < 512; u += G) s5_unit(args, lds, u, lane, wave);
        _Pragma("unroll 1") for (int r2 = 0; r2 < REP3B; ++r2) for (int it = vcu; it < 2048; it += G) h1_item(args, lds, it, tid); }
    } SEAM(3); AMP_END(3);
    AMP_BEGIN(4);
    if (IN(4)) {
        _Pragma("unroll 1") for (int rep = 0; rep < REP4; ++rep) {
        _Pragma("unroll 1") for (int r2 = 0; r2 < REP4A; ++r2) s5_combine(args, vcu * NTHR + tid, G * NTHR);
        _Pragma("unroll 1") for (int r2 = 0; r2 < REP4B; ++r2) longconv_run(args, lds, tid, lane, wave, vcu, G); }
    } SEAM(4); AMP_END(4);
    AMP_BEGIN(5);
    if (IN(5)) {
        _Pragma("unroll 1") for (int rep = 0; rep < REP5; ++rep) h3_run(args, lds, tid, vcu, G);
        pg8::DenseSched S{(const bf16_t*)(ws + WS_YG), (const bf16_t*)(ws + WS_WGLU), 2 * S5W, M / 256, S5W / 256, G, bx, 0, 0, 0, 0};
        pg8::EpiGlu E{(const bf16_t*)(ws + WS_YG), (bf16_t*)(ws + WS_YCAT), args.in[18]};
        pg8::gemm_phase<false>(lds, 2 * S5W, S, E);
    } SEAM(5); AMP_END(5);
    AMP_BEGIN(6);
    if (IN(6)) {
        pg8::DenseSched S{(const bf16_t*)(ws + WS_YCAT), (const bf16_t*)(ws + WS_WOUT), 2 * D, M / 256, D / 256, G, bx, 0, 0, 0, 0};
        pg8::EpiResid E{args.in[0], (float*)(ws + WS_X1), modp};
#ifndef P6_STAGGER_TICKS
#define P6_STAGGER_TICKS 0
#endif
        if ((bx & 1) && P6_STAGGER_TICKS > 0) { const unsigned long long t0 = __builtin_amdgcn_s_memrealtime(); while (__builtin_amdgcn_s_memrealtime() - t0 < (unsigned long long)P6_STAGGER_TICKS) __builtin_amdgcn_s_sleep(8); }
        _Pragma("unroll 1") for (int rep = 0; rep < REP6; ++rep)
        pg8::gemm_phase<false>(lds, 2 * D, S, E);
    } SEAM(6); AMP_END(6);
    AMP_BEGIN(7);
    if (IN(7)) { _Pragma("unroll 1") for (int rep = 0; rep < REP7; ++rep) p7_run(args, lds, lane, wave, vcu, G, rep == REP7 - 1); } SEAM(7); AMP_END(7);
    AMP_BEGIN(8);
    if (IN(8)) {
        moe_table(args, lds, tid);
        pg8::MoeSched<true> S{ws + WS_A2, ws + WS_WGU, D, 16, G, bx, (size_t)4096 * D,
                              (const LAS int*)(lds + LDSCTL_OFF) + LW_TST, (const LAS int*)(lds + LDSCTL_OFF) + LW_CNT, (const int*)(ws + WS_ROWL)};
        pg8::EpiSwiglu E{ws + WS_H, args.in[35], 1.0f / WSCALE};
        _Pragma("unroll 1") for (int rep = 0; rep < REP8; ++rep)
        pg8::gemm_phase<true>(lds, D, S, E);
    } SEAM(8); AMP_END(8);
    AMP_BEGIN(9);
    if (IN(9)) {
        moe_table(args, lds, tid);
        pg8::MoeSched<false> S{ws + WS_H, ws + WS_WDN, DFF, 8, G, bx, (size_t)D * DFF,
                               (const LAS int*)(lds + LDSCTL_OFF) + LW_TST, (const LAS int*)(lds + LDSCTL_OFF) + LW_CNT, (const int*)(ws + WS_ROWL)};
        pg8::EpiStoreFp8 E{ws + WS_YD, D, 1.0f / WSCALE};
        _Pragma("unroll 1") for (int rep = 0; rep < REP9; ++rep)
        pg8::gemm_phase<true>(lds, DFF, S, E);
    } SEAM(9); AMP_END(9);
    AMP_BEGIN(10);
    if (IN(10)) { moe_table(args, lds, tid); _Pragma("unroll 1") for (int rep = 0; rep < REP10; ++rep) p10_run(args, lds, lane, wave, vcu, G); }
    AMP_END(10);
    if (AMP_PHASE >= 0 && bx == 0 && tid == 0) { const unsigned long long t0 = __builtin_amdgcn_s_memrealtime(); const unsigned long long amp_dt = amp_w[1]; while (__builtin_amdgcn_s_memrealtime() - t0 < 4ull * amp_dt) __builtin_amdgcn_s_sleep(16); }
#undef IN
#undef SEAM
}

extern "C" void kernel_launch(void* const* d_in, const int* in_sizes, int n_in, void* d_out, int out_size, void* d_ws, size_t ws_size, hipStream_t stream) {
    static int grid = 0;
    if (grid == 0) {
        if (n_in != 39 || out_size != M * D || ws_size < WS_END) { fprintf(stderr, "kernel_launch: unexpected problem (n_in %d, out %d, ws %zu)\n", n_in, out_size, ws_size); grid = -1; return; }
        int dev = 0, cus = 0, per_cu = 0;
        if (hipGetDevice(&dev) != hipSuccess || hipDeviceGetAttribute(&cus, hipDeviceAttributeMultiprocessorCount, dev) != hipSuccess) { grid = -1; return; }
        if (hipFuncSetAttribute((const void*)fwd_kernel, hipFuncAttributeMaxDynamicSharedMemorySize, LDS_BYTES) != hipSuccess) { fprintf(stderr, "kernel_launch: hipFuncSetAttribute failed\n"); grid = -1; return; }
        if (hipOccupancyMaxActiveBlocksPerMultiprocessor(&per_cu, (const void*)fwd_kernel, NTHR, LDS_BYTES) != hipSuccess || per_cu < 1) fprintf(stderr, "kernel_launch: occupancy query says %d\n", per_cu);
        (void)hipGetLastError();
        grid = cus;
    }
    if (grid < 0) return;
    (void)in_sizes;
    if (hipMemsetAsync((char*)d_ws + WS_CTL, 0, CTL_ZERO_BYTES, stream) != hipSuccess) { fprintf(stderr, "kernel_launch: memset failed\n"); return; }
    Args a{};
    for (int i = 0; i < 39; ++i) a.in[i] = (const float*)d_in[i];
    a.out = (float*)d_out; a.ws = (unsigned char*)d_ws;
#if MK_SPLIT
    for (int p = 0; p < NPHASE; ++p) { a.ph_lo = p; a.ph_hi = p + 1; hipLaunchKernelGGL(fwd_kernel, dim3(grid), dim3(NTHR), LDS_BYTES, stream, a); }
#else
    a.ph_lo = 0; a.ph_hi = NPHASE;
    hipLaunchKernelGGL(fwd_kernel, dim3(grid), dim3(NTHR), LDS_BYTES, stream, a);
#endif
    const hipError_t le = hipPeekAtLastError();
    if (le != hipSuccess) fprintf(stderr, "kernel_launch: launch failed: %s\n", hipGetErrorName(le));
}
```

```cpp
#include <hip/hip_runtime.h>
#include <cstdio>
#include <cstdint>

#ifndef MK_SPLIT
#define MK_SPLIT 0
#endif

#ifndef REP0D
#define REP0D 1
#endif
#ifndef REP2
#define REP2 1
#endif
#ifndef AMP_PHASE
#define AMP_PHASE -1
#endif
#ifndef REP1
#define REP1 1
#endif
#ifndef REP5
#define REP5 1
#endif
#ifndef REP7
#define REP7 1
#endif
#ifndef REP10
#define REP10 1
#endif
#ifndef REP0A
#define REP0A 1
#endif
#ifndef REP3
#define REP3 1
#endif
#ifndef REP3A
#define REP3A 1
#endif
#ifndef REP3B
#define REP3B 1
#endif
#ifndef REP4A
#define REP4A 1
#endif
#ifndef REP4B
#define REP4B 1
#endif
#ifndef REP4
#define REP4 1
#endif
#ifndef REP6
#define REP6 1
#endif
#ifndef REP8
#define REP8 1
#endif
#ifndef REP9
#define REP9 1
#endif
#define GAS __attribute__((address_space(1)))
#define LAS __attribute__((address_space(3)))
typedef unsigned short bf16_t;
typedef short bf16x8 __attribute__((ext_vector_type(8)));
typedef float f32x4 __attribute__((ext_vector_type(4)));
typedef float f32x16 __attribute__((ext_vector_type(16)));
typedef unsigned u32x4 __attribute__((ext_vector_type(4)));
typedef unsigned u32x2 __attribute__((ext_vector_type(2)));

constexpr int NWAVES = 8, NTHR = 512;
constexpr int D = 2048, NB = 8, SEQ = 2048, M = NB * SEQ, CTXL = 256, MC = NB * CTXL, MT = M + MC;
constexpr int DIN = 4096, S5W = 1024, HYW = 1024, NG = 64;
constexpr int NE = 32, DFF = 2048;
constexpr int NPHASE = 11;
constexpr float WSCALE = 64.0f;
constexpr int SEG = 288;

constexpr size_t MiB = 1u << 20;
constexpr size_t WS_CTL = 0, CTL_ZERO_BYTES = 1024 * 1024;
constexpr int CW_TMO = 0, CW_BAR = 4096, CW_CNT = 8192, CW_HNORM = 12288, CW_MOD = 16384;
constexpr size_t WS_LAM = 1 * MiB, WS_LAML = WS_LAM + 64 * 1024, WS_S5B = WS_LAM + 128 * 1024, WS_S5C = WS_LAM + 640 * 1024;
constexpr size_t WS_HRAW = 4 * MiB, WS_RG = 20 * MiB, WS_WIN = 28 * MiB, WS_WGLU = 44 * MiB, WS_WOUT = 46 * MiB;
constexpr size_t WS_PK = 54 * MiB, WS_GATE = WS_PK + 256 * 1024, WS_ROWL = 55 * MiB, WS_MODF = 58 * MiB, WS_WRF = 59 * MiB;
constexpr size_t WS_A1 = 64 * MiB, WS_P = 136 * MiB, WS_YS5 = 280 * MiB, WS_VT = 344 * MiB, WS_LCT = 376 * MiB, WS_YG = 408 * MiB;
constexpr size_t WS_YCAT = 440 * MiB, WS_X1 = 504 * MiB, WS_A2 = 632 * MiB, WS_WGU = 704 * MiB, WS_WDN = 1216 * MiB;
constexpr size_t WS_H = 1472 * MiB, WS_YD = 1760 * MiB, WS_WIN8 = 1904 * MiB, WS_A1C8 = 1908 * MiB, WS_END = 2048 * MiB;
constexpr int HROWS = 73728;

constexpr int RING_BYTES = 131072, LDSCTL_OFF = RING_BYTES, LDS_BYTES = 147456;
constexpr int LW_BAR = 8, LW_TST = 64, LW_CNT = 128, LW_TE = 256;

typedef __bf16 bf16v2 __attribute__((ext_vector_type(2)));
typedef float f32v2 __attribute__((ext_vector_type(2)));
__device__ __forceinline__ unsigned f2bf(float f) { return (unsigned)__builtin_bit_cast(unsigned short, (__bf16)f); }
__device__ __forceinline__ unsigned pk2(float lo, float hi) { const f32v2 v = {lo, hi}; return __builtin_bit_cast(unsigned, __builtin_convertvector(v, bf16v2)); }
__device__ __forceinline__ float bflo(unsigned w) { return __builtin_bit_cast(float, w << 16); }
__device__ __forceinline__ float bfhi(unsigned w) { return __builtin_bit_cast(float, w & 0xffff0000u); }
__device__ __forceinline__ float bf1(bf16_t b) { return __builtin_bit_cast(float, (unsigned)b << 16); }
__device__ __forceinline__ unsigned pk4_fp8(float a, float b, float c, float d) { int w = __builtin_amdgcn_cvt_pk_fp8_f32(a, b, 0, false); w = __builtin_amdgcn_cvt_pk_fp8_f32(c, d, w, true); return (unsigned)w; }
constexpr float FIX_SCALE = 4294967296.0f;
__device__ __forceinline__ void fix_add(unsigned long long* p, float v) { atomicAdd(p, (unsigned long long)__float2ll_rn(v * FIX_SCALE)); }
__device__ __forceinline__ float fix_get(const unsigned long long* p) { const unsigned long long v = *p; return (float)(int)(unsigned)(v >> 32) + (float)(unsigned)v * (1.0f / 4294967296.0f); }
__device__ __forceinline__ float sigm(float v) { return __builtin_amdgcn_rcpf(1.0f + __builtin_amdgcn_exp2f(-1.44269504f * v)); }
__device__ __forceinline__ float wave_sum(float v) {
#pragma unroll
    for (int o = 1; o < 64; o <<= 1) v += __shfl_xor(v, o);
    return v;
}
__device__ __forceinline__ float gelu_erf(float x) {
    const float ax = __builtin_fabsf(x);
    const float t = __builtin_amdgcn_rcpf(__builtin_fmaf(ax, 0.3275911f * 0.70710678118654752f, 1.0f));
    float p = __builtin_fmaf(t, 1.061405429f, -1.453152027f); p = __builtin_fmaf(t, p, 1.421413741f); p = __builtin_fmaf(t, p, -0.284496736f); p = __builtin_fmaf(t, p, 0.254829592f); p *= t;
    const float w = ax * 0.84932180028801904f;
    const float e = __builtin_amdgcn_exp2f(-(w * w));
    return __builtin_fmaf(-0.5f * ax, p * e, __builtin_fmaxf(x, 0.0f));
}
#define LDS_WAIT() asm volatile("s_waitcnt lgkmcnt(0)" ::: "memory")
#define VM_WAIT() asm volatile("s_waitcnt vmcnt(0)" ::: "memory")

#define XB_TMO      128
#define XB_XCNT(j)  (256  + 64 * (j))
#define XB_XSUB(j)  (1280 + 64 * (j))
#define XB_XGEN(j)  (2304 + 64 * (j))
#define XB_TOP      3328
#define XB_TOPGEN   3392
#define XCD_BAR_WORDS 3456
#define XB_SPIN_CAP (1u << 18)
__device__ __forceinline__ unsigned xb_ld(unsigned* p)              { return __hip_atomic_load(p, __ATOMIC_RELAXED, __HIP_MEMORY_SCOPE_AGENT); }
__device__ __forceinline__ unsigned xb_add(unsigned* p, unsigned v) { return __hip_atomic_fetch_add(p, v, __ATOMIC_RELAXED, __HIP_MEMORY_SCOPE_AGENT); }
__device__ __forceinline__ unsigned xb_xcc_id() { return (unsigned)__builtin_amdgcn_s_getreg((3 << 11) | 20) & 0xFu; }
#define XB_SPIN(cond, bar) do { unsigned _sp = 0; while (cond) { __builtin_amdgcn_s_sleep(1); \
    if ((++_sp & 255u) == 0u) { if (xb_ld(&(bar)[XB_TMO])) break; if (_sp > XB_SPIN_CAP) { atomicAdd(&(bar)[XB_TMO], 1u); break; } } } } while (0)
struct XcdBarrier { unsigned* bar; unsigned x; volatile LAS unsigned* st; };
__device__ __forceinline__ XcdBarrier xcd_barrier_post(unsigned* bar, volatile LAS unsigned* st) {
    XcdBarrier b; b.bar = bar; b.x = xb_xcc_id(); b.st = st;
    if (threadIdx.x == 0) (void)xb_add(&bar[XB_XCNT(b.x)], 1u);
    return b;
}
__device__ __forceinline__ void xcd_barrier_complete(unsigned* bar, unsigned x, unsigned& nloc, unsigned& nx) {
    const unsigned G = gridDim.x * gridDim.y * gridDim.z;
    unsigned sum, cnt, mine, sp = 0u;
    for (;;) {
        sum = 0u; cnt = 0u; mine = 0u;
#pragma unroll
        for (unsigned j = 0; j < 16; ++j) { const unsigned c = xb_ld(&bar[XB_XCNT(j)]); sum += c; cnt += (c > 0u) ? 1u : 0u; mine = (j == x) ? c : mine; }
        if (sum == G) break;
        __builtin_amdgcn_s_sleep(1);
        if ((++sp & 255u) == 0u) { if (xb_ld(&bar[XB_TMO])) break; if (sp > XB_SPIN_CAP) { atomicAdd(&bar[XB_TMO], 1u); break; } }
    }
    nloc = mine > 0u ? mine : 1u; nx = cnt > 0u ? cnt : 1u;
}
__device__ __forceinline__ void xcd_barrier(const XcdBarrier& b) {
    asm volatile("s_waitcnt vmcnt(0)" ::: "memory");
    __syncthreads();
    if (threadIdx.x == 0) {
        unsigned* bar = b.bar;
        __builtin_amdgcn_s_waitcnt(0);
        unsigned nloc = b.st[0], nx = b.st[1];
        if (nloc == 0u) { xcd_barrier_complete(bar, b.x, nloc, nx); b.st[0] = nloc; b.st[1] = nx; }
        const unsigned old = xb_add(&bar[XB_XSUB(b.x)], 1u);
        const unsigned gen = old / nloc;
        if (old + 1u == (gen + 1u) * nloc) {
            __builtin_amdgcn_fence(__ATOMIC_RELEASE, "agent");
            asm volatile("s_waitcnt vmcnt(0)" ::: "memory");
            const unsigned og = xb_add(&bar[XB_TOP], 1u);
            const unsigned tg = og / nx;
            if (og + 1u == (tg + 1u) * nx) xb_add(&bar[XB_TOPGEN], 1u);
            else XB_SPIN(xb_ld(&bar[XB_TOPGEN]) == tg, bar);
            __builtin_amdgcn_fence(__ATOMIC_ACQUIRE, "agent");
            xb_add(&bar[XB_XGEN(b.x)], 1u);
            asm volatile("s_waitcnt vmcnt(0)" ::: "memory");
        } else {
            XB_SPIN(xb_ld(&bar[XB_XGEN(b.x)]) == gen, bar);
            __builtin_amdgcn_fence(__ATOMIC_ACQUIRE, "agent");
            asm volatile("s_waitcnt vmcnt(0)" ::: "memory");
        }
    }
    __syncthreads();
}

struct Args { const float* in[39]; float* out; unsigned char* ws; int ph_lo, ph_hi; };

namespace pg8 {
constexpr int BM = 256, BK = 64, HALF = 128, HTB = HALF * BK * 2, STAGE_BYTES = 8 * HTB, NXCD = 8, WGM = 8;
__device__ __forceinline__ int lds_byte(int r, int c) { const int st = (r >> 4) * 2 + (c >> 5), rr = r & 15, cc = c & 31, ob = rr * 64 + cc * 2; return st * 1024 + (ob ^ (((ob >> 9) & 1) << 5)); }
__device__ __forceinline__ void stage_rc(int b, int& R, int& C) { const int st = b / 1024, sb = b % 1024, swz = sb ^ (((sb >> 9) & 1) << 5); R = (st >> 1) * 16 + swz / 64; C = (st & 1) * 32 + (swz % 64) / 2; }
__device__ __forceinline__ int perm32(int rho) { const int n = rho >> 4, i = rho & 15; return 8 * (i >> 2) + 4 * n + (i & 3); }
struct Unit { int pm, pn, e; };
__device__ __forceinline__ unsigned cvt_pk_bf16(float lo, float hi) { unsigned r; asm volatile("v_cvt_pk_bf16_f32 %0, %1, %2" : "=v"(r) : "v"(lo), "v"(hi)); return r; }

__device__ __forceinline__ void tile_of(long L, int nM, int nN, int& pm, int& pn) {
    const int nwg = nM * nN; int wgid = (int)L;
    { const int q = nwg / NXCD, r = nwg % NXCD, xcd = wgid % NXCD, off = wgid / NXCD; wgid = (xcd < r ? xcd * (q + 1) : r * (q + 1) + (xcd - r) * q) + off; }
    const int nig = WGM * nN, gid = wgid / nig, fm = gid * WGM, gsz = (nM - fm) < WGM ? (nM - fm) : WGM;
    pm = fm + ((wgid % nig) % gsz); pn = (wgid % nig) / gsz;
}

struct DenseSched {
    static constexpr bool ROWS_LDS = false;
    const bf16_t* A; const bf16_t* Bt; int RB, nM, nN, G, c, xM0, xnM, xnN, xN0;
    __device__ __forceinline__ bool next(int i, Unit& u) const {
        const long L = (long)i * G + c; const int nwg = nM * nN;
        if (L < nwg) { tile_of(L, nM, nN, u.pm, u.pn); u.e = 0; return true; }
        const long r = L - nwg; if (r >= (long)xnM * xnN) return false;
        u.pm = xM0 + (int)(r % xnM); u.pn = xN0 + (int)(r / xnM); u.e = 0; return true;
    }
    __device__ __forceinline__ const char* abase(const Unit& u) const { return (const char*)A + (size_t)u.pm * BM * RB; }
    __device__ __forceinline__ const char* bbase(const Unit& u) const { return (const char*)Bt + (size_t)u.pn * BM * RB; }
    __device__ __forceinline__ void rows(const Unit&, unsigned (&va)[2][2], const int (&R)[2], const int (&C)[2]) const {
#pragma unroll
        for (int h = 0; h < 2; ++h)
#pragma unroll
            for (int i = 0; i < 2; ++i) va[h][i] = (unsigned)((h * HALF + R[i]) * RB + 2 * C[i]);
    }
};
template <bool GATHER> struct MoeSched {
    static constexpr bool ROWS_LDS = GATHER;
    const unsigned char* A; const unsigned char* Bt; int RB, nN, G, c; size_t estride;
    const LAS int* tst; const LAS int* cnts; const int* rowlist;
    __device__ __forceinline__ bool next(int i, Unit& u) const {
        const int TM = __builtin_amdgcn_readfirstlane(tst[NE]); const long L = (long)i * G + c; if (L >= (long)TM * nN) return false;
        tile_of(L, TM, nN, u.pm, u.pn);
        u.e = __builtin_amdgcn_readfirstlane(tst[(LW_TE - LW_TST) + u.pm]); return true;
    }
    __device__ __forceinline__ void prefetch_rows(LAS unsigned char* lds, const Unit& u, int ui, int lane) const {
        const int lt = u.pm - __builtin_amdgcn_readfirstlane(tst[u.e]);
        __builtin_amdgcn_global_load_lds((const unsigned*)(rowlist + (size_t)u.e * M + lt * BM + 4 * lane), (LAS unsigned*)(lds + LDSCTL_OFF + 6144 + (ui & 1) * 1024), 16, 0, 0);
    }
    __device__ __forceinline__ void rows_lds(const Unit& u, unsigned (&va)[2][2], const int (&R)[2], const int (&C)[2], const LAS unsigned char* lds, int ui) const {
        const int n = __builtin_amdgcn_readfirstlane(cnts[u.e]), lt = u.pm - __builtin_amdgcn_readfirstlane(tst[u.e]), nloc = n - lt * BM;
        const LAS int* rl = (const LAS int*)(lds + LDSCTL_OFF + 6144 + (ui & 1) * 1024);
#pragma unroll
        for (int h = 0; h < 2; ++h)
#pragma unroll
            for (int i = 0; i < 2; ++i) { int sl = h * HALF + R[i]; sl = sl < nloc ? sl : 0; va[h][i] = (unsigned)(rl[sl] * RB + 2 * C[i]); }
    }
    __device__ __forceinline__ const char* abase(const Unit& u) const { return GATHER ? (const char*)A : (const char*)A + (size_t)u.pm * BM * RB; }
    __device__ __forceinline__ const char* bbase(const Unit& u) const { return (const char*)Bt + (size_t)u.e * estride + (size_t)u.pn * BM * RB; }
    __device__ __forceinline__ void rows(const Unit& u, unsigned (&va)[2][2], const int (&R)[2], const int (&C)[2]) const {
        if (GATHER) {
            const int n = __builtin_amdgcn_readfirstlane(cnts[u.e]), lt = u.pm - __builtin_amdgcn_readfirstlane(tst[u.e]);
#pragma unroll
            for (int h = 0; h < 2; ++h)
#pragma unroll
                for (int i = 0; i < 2; ++i) { int slot = lt * BM + h * HALF + R[i]; slot = slot < n ? slot : 0; const int tok = rowlist[u.e * M + slot]; va[h][i] = (unsigned)(tok * RB + 2 * C[i]); }
        } else {
#pragma unroll
            for (int h = 0; h < 2; ++h)
#pragma unroll
                for (int i = 0; i < 2; ++i) va[h][i] = (unsigned)((h * HALF + R[i]) * RB + 2 * C[i]);
        }
    }
};

typedef int i32x4 __attribute__((ext_vector_type(4)));
typedef int i32x8 __attribute__((ext_vector_type(8)));
template <bool FP8, class Epi, class Sched>
__device__ __forceinline__ void gemm_phase(LAS unsigned char* lds, const int RB, const Sched& S, const Epi& E) {
    const int tid = threadIdx.x, wid = __builtin_amdgcn_readfirstlane(tid >> 6), lane = tid & 63, wr = wid >> 2, wc = wid & 3, fr = lane & 15, fq = lane >> 4;
    const int nt = RB / 128;
    unsigned voffB[2]; int Rr[2], Cc[2];
#pragma unroll
    for (int i = 0; i < 2; ++i) { int R, C; stage_rc(tid * 16 + i * 8192, R, C); Rr[i] = R; Cc[i] = C; const int Rb = Epi::PERM ? ((R & ~31) + perm32(R & 31)) : R; voffB[i] = (unsigned)(Rb * RB + 2 * C); }
    const size_t kstep = (size_t)(BK * 2);
    const size_t hstep = (size_t)HALF * RB;
    const unsigned ldsw = (unsigned)wid * 1024u;
    const int aoff = lds_byte(wr * 64 + fr, fq * 8), boff = lds_byte(wc * 32 + fr, fq * 8);
#define PG8_SA(b, h) (((b) * 2 + (h)) * HTB)
#define PG8_SB(b, h) ((4 + (b) * 2 + (h)) * HTB)
#define PG8_STAGE(bufoff, gbase, voff) do { _Pragma("unroll") for (int _i = 0; _i < 2; ++_i) \
        __builtin_amdgcn_global_load_lds((const unsigned*)((const char*)(gbase) + (voff)[_i]), (LAS unsigned*)(lds + (bufoff) + ldsw + _i * 8192), 16, 0, 0); } while (0)
#define PG8_LDA(dst, b, h) do { _Pragma("unroll") for (int m = 0; m < 4; ++m) _Pragma("unroll") for (int k = 0; k < 2; ++k) dst[m][k] = *(const LAS bf16x8*)(lds + PG8_SA(b, h) + aoff + m * 2048 + k * 1024); } while (0)
#define PG8_LDB(dst, b, h) do { _Pragma("unroll") for (int n = 0; n < 2; ++n) _Pragma("unroll") for (int k = 0; k < 2; ++k) dst[n][k] = *(const LAS bf16x8*)(lds + PG8_SB(b, h) + boff + n * 2048 + k * 1024); } while (0)
#define PG8_MMA(ai, bj, At, Bt) do { __builtin_amdgcn_s_setprio(1); _Pragma("unroll") for (int m = 0; m < 4; ++m) _Pragma("unroll") for (int n = 0; n < 2; ++n) { \
        if constexpr (FP8) { const i32x8 bb_ = __builtin_shufflevector(__builtin_bit_cast(i32x4, Bt[n][0]), __builtin_bit_cast(i32x4, Bt[n][1]), 0, 1, 2, 3, 4, 5, 6, 7); \
            const i32x8 aa_ = __builtin_shufflevector(__builtin_bit_cast(i32x4, At[m][0]), __builtin_bit_cast(i32x4, At[m][1]), 0, 1, 2, 3, 4, 5, 6, 7); \
            asm volatile("v_mfma_scale_f32_16x16x128_f8f6f4 %0, %1, %2, %0, %3, %3 op_sel_hi:[0,0,0]" : "+v"(acc[ai][bj][m][n]) : "v"(bb_), "v"(aa_), "v"(one_scale)); } \
        else { _Pragma("unroll") for (int k = 0; k < 2; ++k) acc[ai][bj][m][n] = __builtin_amdgcn_mfma_f32_16x16x32_bf16(Bt[n][k], At[m][k], acc[ai][bj][m][n], 0, 0, 0); } } \
        __builtin_amdgcn_s_setprio(0); } while (0)
#define PG8_WAIT_V(n) asm volatile("s_waitcnt vmcnt(" #n ")" ::: "memory")
#define PG8_WAIT_L(n) asm volatile("s_waitcnt lgkmcnt(" #n ")" ::: "memory")
#define PG8_BAR __builtin_amdgcn_s_barrier()
#define PG8_SCHED __builtin_amdgcn_sched_barrier(0)
    Unit cur, nxt; int ui = 0;
    if (!S.next(0, cur)) return;
    f32x4 acc[2][2][4][2];
#pragma unroll
    for (int a = 0; a < 2; ++a)
#pragma unroll
        for (int b = 0; b < 2; ++b)
#pragma unroll
            for (int m = 0; m < 4; ++m)
#pragma unroll
                for (int n = 0; n < 2; ++n) acc[a][b][m][n] = (f32x4){0.f, 0.f, 0.f, 0.f};
    bf16x8 At[4][2], B0[2][2], B1[2][2];
    unsigned one_scale = 0x7F7F7F7Fu; asm volatile("" : "+v"(one_scale));
    unsigned vaC[2][2], vaN[2][2];
    S.rows(cur, vaC, Rr, Cc);
    const char* cA = S.abase(cur); const char* cB = S.bbase(cur);
    PG8_STAGE(PG8_SB(0, 0), cB, voffB); PG8_STAGE(PG8_SA(0, 0), cA, vaC[0]); PG8_STAGE(PG8_SB(0, 1), cB + hstep, voffB); PG8_STAGE(PG8_SA(0, 1), cA, vaC[1]);
    if (wr == 1) PG8_BAR;
    PG8_WAIT_V(4); PG8_BAR;
    PG8_STAGE(PG8_SB(1, 0), cB + kstep, voffB); PG8_STAGE(PG8_SA(1, 0), cA + kstep, vaC[0]); PG8_STAGE(PG8_SB(1, 1), cB + hstep + kstep, voffB);
    PG8_WAIT_V(6); PG8_BAR;
    for (;;) {
        const bool has_next = S.next(ui + 1, nxt);
        const char* nA = has_next ? S.abase(nxt) : cA; const char* nB = has_next ? S.bbase(nxt) : cB;
#pragma unroll
        for (int h = 0; h < 2; ++h)
#pragma unroll
            for (int i = 0; i < 2; ++i) vaN[h][i] = vaC[h][i];
        if constexpr (Epi::BIAS_LDS) { if (wid == 0) E.prefetch(lds, cur, ui, lane); }
        if constexpr (Sched::ROWS_LDS) { if (wid == 1 && has_next) S.prefetch_rows(lds, nxt, ui, lane); }
        for (int t = 0; t < nt; t += 2) {
            const bool last = (t == nt - 2);
            const char* a1 = cA + (size_t)(t + 1) * kstep;
            const char* a2 = last ? nA : cA + (size_t)(t + 2) * kstep; const char* b2 = last ? nB : cB + (size_t)(t + 2) * kstep;
            const char* a3 = a2 + kstep; const char* b3 = b2 + kstep;
            if (last && has_next) { if constexpr (Sched::ROWS_LDS) S.rows_lds(nxt, vaN, Rr, Cc, lds, ui); else S.rows(nxt, vaN, Rr, Cc); }
            unsigned v2[2][2];
#pragma unroll
            for (int h = 0; h < 2; ++h)
#pragma unroll
                for (int i = 0; i < 2; ++i) v2[h][i] = last ? vaN[h][i] : vaC[h][i];
            PG8_LDB(B0, 0, 0); PG8_SCHED; PG8_LDA(At, 0, 0); PG8_STAGE(PG8_SA(1, 1), a1, vaC[1]);
            PG8_WAIT_L(8); PG8_BAR; PG8_WAIT_L(0); PG8_MMA(0, 0, At, B0); PG8_BAR; PG8_SCHED;
            PG8_LDB(B1, 0, 1); PG8_STAGE(PG8_SB(0, 0), b2, voffB);
            PG8_BAR; PG8_WAIT_L(0); PG8_MMA(0, 1, At, B1); PG8_BAR;
            PG8_LDA(At, 0, 1); PG8_STAGE(PG8_SA(0, 0), a2, v2[0]);
            PG8_BAR; PG8_WAIT_L(0); PG8_MMA(1, 0, At, B0); PG8_BAR; PG8_SCHED;
            PG8_STAGE(PG8_SB(0, 1), b2 + hstep, voffB);
            PG8_WAIT_V(6); PG8_BAR; PG8_MMA(1, 1, At, B1); PG8_BAR;
            PG8_LDB(B0, 1, 0); PG8_SCHED; PG8_LDA(At, 1, 0); PG8_STAGE(PG8_SA(0, 1), a2, v2[1]);
            PG8_WAIT_L(8); PG8_BAR; PG8_WAIT_L(0); PG8_MMA(0, 0, At, B0); PG8_BAR; PG8_SCHED;
            PG8_LDB(B1, 1, 1); PG8_STAGE(PG8_SB(1, 0), b3, voffB);
            PG8_BAR; PG8_WAIT_L(0); PG8_MMA(0, 1, At, B1); PG8_BAR;
            PG8_LDA(At, 1, 1); PG8_STAGE(PG8_SA(1, 0), a3, v2[0]);
            PG8_BAR; PG8_WAIT_L(0); PG8_MMA(1, 0, At, B0); PG8_BAR; PG8_SCHED;
            PG8_STAGE(PG8_SB(1, 1), b3 + hstep, voffB);
            PG8_WAIT_V(6); PG8_BAR; PG8_MMA(1, 1, At, B1); PG8_BAR;
        }
        if constexpr (FP8) asm volatile("s_nop 15\n\ts_nop 15" ::: "memory");
        if constexpr (Epi::BIAS_LDS) E(acc, cur, wr, wc, fr, fq, lds, ui); else E(acc, cur, wr, wc, fr, fq);
        if (!has_next) break;
#pragma unroll
        for (int a = 0; a < 2; ++a)
#pragma unroll
            for (int b = 0; b < 2; ++b)
#pragma unroll
                for (int m = 0; m < 4; ++m)
#pragma unroll
                    for (int n = 0; n < 2; ++n) acc[a][b][m][n] = (f32x4){0.f, 0.f, 0.f, 0.f};
        cur = nxt; cA = nA; cB = nB; ++ui;
#pragma unroll
        for (int h = 0; h < 2; ++h)
#pragma unroll
            for (int i = 0; i < 2; ++i) vaC[h][i] = vaN[h][i];
    }
    PG8_WAIT_V(0);
    if (wr == 0) PG8_BAR;
    PG8_BAR;
#undef PG8_SA
#undef PG8_SB
#undef PG8_STAGE
#undef PG8_LDA
#undef PG8_LDB
#undef PG8_MMA
#undef PG8_WAIT_V
#undef PG8_WAIT_L
#undef PG8_BAR
#undef PG8_SCHED
}

template <bool HAS_BIAS> struct EpiStoreBf16 {
    static constexpr bool PERM = true; static constexpr bool BIAS_LDS = false;
    bf16_t* O; int ldc; const float* bias; int bias_estride; float sc;
    __device__ __forceinline__ void operator()(const f32x4 (&acc)[2][2][4][2], const Unit& u, int wr, int wc, int fr, int fq) const {
        const int row0 = u.pm * BM + wr * 64 + fr, col0 = u.pn * BM + wc * 32 + 8 * fq;
        f32x4 bv[2][2];
#pragma unroll
        for (int bj = 0; bj < 2; ++bj)
#pragma unroll
            for (int n = 0; n < 2; ++n) { if constexpr (HAS_BIAS) bv[bj][n] = *(const f32x4*)(bias + (size_t)u.e * bias_estride + col0 + bj * HALF + 4 * n); else bv[bj][n] = (f32x4){0.f, 0.f, 0.f, 0.f}; }
#pragma unroll
        for (int ai = 0; ai < 2; ++ai)
#pragma unroll
            for (int m = 0; m < 4; ++m) { bf16_t* rowp = O + (size_t)(row0 + ai * HALF + m * 16) * ldc + col0;
#pragma unroll
                for (int bj = 0; bj < 2; ++bj) { const f32x4 v0 = acc[ai][bj][m][0] * sc + bv[bj][0], v1 = acc[ai][bj][m][1] * sc + bv[bj][1];
                    u32x4 w; w.x = cvt_pk_bf16(v0[0], v0[1]); w.y = cvt_pk_bf16(v0[2], v0[3]); w.z = cvt_pk_bf16(v1[0], v1[1]); w.w = cvt_pk_bf16(v1[2], v1[3]);
                    *(u32x4*)(rowp + bj * HALF) = w; } }
    }
};
struct EpiStoreFp8 {
    static constexpr bool PERM = true; static constexpr bool BIAS_LDS = false;
    unsigned char* O; int ldc; float sc;
    __device__ __forceinline__ void operator()(const f32x4 (&acc)[2][2][4][2], const Unit& u, int wr, int wc, int fr, int fq) const {
        const int row0 = u.pm * BM + wr * 64 + fr, col0 = u.pn * BM + wc * 32 + 8 * fq;
#pragma unroll
        for (int ai = 0; ai < 2; ++ai)
#pragma unroll
            for (int m = 0; m < 4; ++m) { unsigned char* rowp = O + (size_t)(row0 + ai * HALF + m * 16) * ldc + col0;
#pragma unroll
                for (int bj = 0; bj < 2; ++bj) { const f32x4 v0 = acc[ai][bj][m][0] * sc, v1 = acc[ai][bj][m][1] * sc;
                    u32x2 w; w.x = pk4_fp8(v0[0], v0[1], v0[2], v0[3]); w.y = pk4_fp8(v1[0], v1[1], v1[2], v1[3]);
                    *(u32x2*)(rowp + bj * HALF) = w; } }
    }
};
struct EpiGlu {
    static constexpr bool PERM = true; static constexpr bool BIAS_LDS = false;
    const bf16_t* Yg; bf16_t* O; const float* bias;
    __device__ __forceinline__ void operator()(const f32x4 (&acc)[2][2][4][2], const Unit& u, int wr, int wc, int fr, int fq) const {
        const int row0 = u.pm * BM + wr * 64 + fr, col0 = u.pn * BM + wc * 32 + 8 * fq;
        f32x4 bv[2][2];
#pragma unroll
        for (int bj = 0; bj < 2; ++bj)
#pragma unroll
            for (int n = 0; n < 2; ++n) bv[bj][n] = *(const f32x4*)(bias + col0 + bj * HALF + 4 * n);
#pragma unroll
        for (int ai = 0; ai < 2; ++ai) {
            u32x4 yv[4][2];
#pragma unroll
            for (int m = 0; m < 4; ++m)
#pragma unroll
                for (int bj = 0; bj < 2; ++bj) yv[m][bj] = *(const u32x4*)(Yg + (size_t)(row0 + ai * HALF + m * 16) * S5W + col0 + bj * HALF);
            asm volatile("" ::: "memory");
#pragma unroll
            for (int m = 0; m < 4; ++m) { const size_t r = (size_t)(row0 + ai * HALF + m * 16);
#pragma unroll
                for (int bj = 0; bj < 2; ++bj) { const f32x4 v0 = acc[ai][bj][m][0] + bv[bj][0], v1 = acc[ai][bj][m][1] + bv[bj][1];
                    const u32x4 y = yv[m][bj];
                    float o[8];
                    o[0] = bflo(y.x) * sigm(v0[0]); o[1] = bfhi(y.x) * sigm(v0[1]); o[2] = bflo(y.y) * sigm(v0[2]); o[3] = bfhi(y.y) * sigm(v0[3]);
                    o[4] = bflo(y.z) * sigm(v1[0]); o[5] = bfhi(y.z) * sigm(v1[1]); o[6] = bflo(y.w) * sigm(v1[2]); o[7] = bfhi(y.w) * sigm(v1[3]);
                    u32x4 w; w.x = cvt_pk_bf16(o[0], o[1]); w.y = cvt_pk_bf16(o[2], o[3]); w.z = cvt_pk_bf16(o[4], o[5]); w.w = cvt_pk_bf16(o[6], o[7]);
                    *(u32x4*)(O + r * D + col0 + bj * HALF) = w; } }
            asm volatile("" ::: "memory");
        }
    }
};
struct EpiResid {
    static constexpr bool PERM = false; static constexpr bool BIAS_LDS = false;
    const float* X; float* O; const float* mod;
    __device__ __forceinline__ void operator()(const f32x4 (&acc)[2][2][4][2], const Unit& u, int wr, int wc, int fr, int fq) const {
        const int row0 = u.pm * BM + wr * 64 + fr, col0 = u.pn * BM + wc * 32 + 4 * fq, b = u.pm >> 3;
        f32x4 gv[2][2];
#pragma unroll
        for (int bj = 0; bj < 2; ++bj)
#pragma unroll
            for (int n = 0; n < 2; ++n) { const int c = col0 + bj * HALF + n * 16; gv[bj][n] = *(const f32x4*)(mod + (size_t)b * 12288 + 2 * D + c); }
#pragma unroll
        for (int ai = 0; ai < 2; ++ai) {
            f32x4 xv[4][2][2];
#pragma unroll
            for (int m = 0; m < 4; ++m) { const size_t off = (size_t)(row0 + ai * HALF + m * 16) * D + col0;
#pragma unroll
                for (int bj = 0; bj < 2; ++bj)
#pragma unroll
                    for (int n = 0; n < 2; ++n) xv[m][bj][n] = *(const f32x4*)(X + off + bj * HALF + n * 16); }
            asm volatile("" ::: "memory");
#pragma unroll
            for (int m = 0; m < 4; ++m) { const size_t off = (size_t)(row0 + ai * HALF + m * 16) * D + col0;
#pragma unroll
                for (int bj = 0; bj < 2; ++bj)
#pragma unroll
                    for (int n = 0; n < 2; ++n) *(f32x4*)(O + off + bj * HALF + n * 16) = xv[m][bj][n] + gv[bj][n] * acc[ai][bj][m][n]; }
            asm volatile("" ::: "memory");
        }
    }
};
struct EpiSwiglu {
    static constexpr bool PERM = true; static constexpr bool BIAS_LDS = true;
    unsigned char* O; const float* bias; float sc;
    __device__ __forceinline__ void prefetch(LAS unsigned char* lds, const Unit& u, int ui, int lane) const {
        const float* src = bias + (size_t)u.e * 4096 + (lane < 32 ? 0 : 2048) + u.pn * HALF + 4 * (lane & 31);
        __builtin_amdgcn_global_load_lds((const unsigned*)src, (LAS unsigned*)(lds + LDSCTL_OFF + 4096 + (ui & 1) * 1024), 16, 0, 0);
    }
    __device__ __forceinline__ void operator()(const f32x4 (&acc)[2][2][4][2], const Unit& u, int wr, int wc, int fr, int fq, const LAS unsigned char* lds, int ui) const {
        const int row0 = u.pm * BM + wr * 64 + fr, j0 = wc * 32 + 8 * fq, cb = u.pn * HALF + j0;
        const LAS float* bl = (const LAS float*)(lds + LDSCTL_OFF + 4096 + (ui & 1) * 1024);
        f32v2 bg[2][2], bu[2][2];
#pragma unroll
        for (int n = 0; n < 2; ++n) { const f32x4 g4 = *(const LAS f32x4*)(bl + j0 + 4 * n), u4 = *(const LAS f32x4*)(bl + 128 + j0 + 4 * n);
            bg[n][0] = (f32v2){g4[0], g4[1]}; bg[n][1] = (f32v2){g4[2], g4[3]}; bu[n][0] = (f32v2){u4[0] + 1.0f, u4[1] + 1.0f}; bu[n][1] = (f32v2){u4[2] + 1.0f, u4[3] + 1.0f}; }
        const f32v2 sc2 = {sc, sc}, kx = {-2.45546696f, -2.45546696f}, one2 = {1.0f, 1.0f};
#pragma unroll
        for (int ai = 0; ai < 2; ++ai)
#pragma unroll
            for (int m = 0; m < 4; ++m) { f32v2 o[4];
#pragma unroll
                for (int n = 0; n < 2; ++n)
#pragma unroll
                    for (int h = 0; h < 2; ++h) {
                        f32v2 g = (f32v2){acc[ai][0][m][n][2 * h], acc[ai][0][m][n][2 * h + 1]} * sc2 + bg[n][h];
                        f32v2 up = (f32v2){acc[ai][1][m][n][2 * h], acc[ai][1][m][n][2 * h + 1]} * sc2 + bu[n][h];
                        g = (f32v2){fminf(g[0], 7.0f), fminf(g[1], 7.0f)};
                        up = (f32v2){fminf(fmaxf(up[0], -6.0f), 8.0f), fminf(fmaxf(up[1], -6.0f), 8.0f)};
                        const f32v2 t = g * kx;
                        const f32v2 den = (f32v2){__builtin_amdgcn_exp2f(t[0]), __builtin_amdgcn_exp2f(t[1])} + one2;
                        const f32v2 r = {__builtin_amdgcn_rcpf(den[0]), __builtin_amdgcn_rcpf(den[1])};
                        o[2 * n + h] = up * (g * r); }
                u32x2 w; w.x = pk4_fp8(o[0][0], o[0][1], o[1][0], o[1][1]); w.y = pk4_fp8(o[2][0], o[2][1], o[3][0], o[3][1]);
                *(u32x2*)(O + (size_t)(row0 + ai * HALF + m * 16) * DFF + cb) = w; }
    }
};
}

#define FI __device__ __forceinline__

FI void transpose_item(const float* W, int K, int N, bf16_t* WT, int row_off, LAS float* scr, int kb, int nb, int lane) {
    const int k0 = 64 * kb, n0 = 32 * nb;
#pragma unroll 8
    for (int i = 0; i < 32; ++i) { const int kk = 2 * i + (lane >> 5); scr[kk * 33 + (lane & 31)] = W[(size_t)(k0 + kk) * N + n0 + (lane & 31)]; }
    LDS_WAIT(); asm volatile("" ::: "memory");
    const int c = lane & 7;
#pragma unroll
    for (int j = 0; j < 4; ++j) { const int n = (lane >> 3) + 8 * j; const LAS float* s = scr + (8 * c) * 33 + n;
        u32x4 o; o.x = pk2(s[0 * 33], s[1 * 33]); o.y = pk2(s[2 * 33], s[3 * 33]); o.z = pk2(s[4 * 33], s[5 * 33]); o.w = pk2(s[6 * 33], s[7 * 33]);
        *(u32x4*)(WT + (size_t)(row_off + n0 + n) * K + k0 + 8 * c) = o; }
    LDS_WAIT(); asm volatile("" ::: "memory");
}

FI void transpose_item_fp8(const float* W, int K, int N, unsigned char* WT, int row_off, LAS float* scr, int kb, int nb, int lane, float scale) {
    const int k0 = 64 * kb, n0 = 32 * nb;
#pragma unroll 8
    for (int i = 0; i < 32; ++i) { const int kk = 2 * i + (lane >> 5); scr[kk * 33 + (lane & 31)] = W[(size_t)(k0 + kk) * N + n0 + (lane & 31)]; }
    LDS_WAIT(); asm volatile("" ::: "memory");
    const int n = lane & 31, hf = lane >> 5; const LAS float* s = scr + (32 * hf) * 33 + n;
    u32x4 o0, o1;
    o0.x = pk4_fp8(s[0 * 33] * scale, s[1 * 33] * scale, s[2 * 33] * scale, s[3 * 33] * scale); o0.y = pk4_fp8(s[4 * 33] * scale, s[5 * 33] * scale, s[6 * 33] * scale, s[7 * 33] * scale);
    o0.z = pk4_fp8(s[8 * 33] * scale, s[9 * 33] * scale, s[10 * 33] * scale, s[11 * 33] * scale); o0.w = pk4_fp8(s[12 * 33] * scale, s[13 * 33] * scale, s[14 * 33] * scale, s[15 * 33] * scale);
    o1.x = pk4_fp8(s[16 * 33] * scale, s[17 * 33] * scale, s[18 * 33] * scale, s[19 * 33] * scale); o1.y = pk4_fp8(s[20 * 33] * scale, s[21 * 33] * scale, s[22 * 33] * scale, s[23 * 33] * scale);
    o1.z = pk4_fp8(s[24 * 33] * scale, s[25 * 33] * scale, s[26 * 33] * scale, s[27 * 33] * scale); o1.w = pk4_fp8(s[28 * 33] * scale, s[29 * 33] * scale, s[30 * 33] * scale, s[31 * 33] * scale);
    unsigned char* dst = WT + (size_t)(row_off + n0 + n) * K + k0 + 32 * hf;
    *(u32x4*)dst = o0; *(u32x4*)(dst + 16) = o1;
    LDS_WAIT(); asm volatile("" ::: "memory");
}

FI void tr8_item(const float* W, int N, int K, unsigned char* WT, int row_off, LAS unsigned char* T, int k0, int n0, int lane, float scale) {
    const int nq = lane & 15, kr = lane >> 4;
    const float* src = W + (size_t)(k0 + 4 * kr) * N + n0 + 4 * nq;
#pragma unroll
    for (int rg = 0; rg < 8; ++rg) {
        f32x4 v[4];
#pragma unroll
        for (int j = 0; j < 4; ++j) v[j] = *(const f32x4*)(src + (size_t)(rg * 16 + j) * N) * scale;
#pragma unroll
        for (int i = 0; i < 4; ++i) *(LAS unsigned*)(T + (4 * nq + i) * 128 + ((rg ^ (nq & 7)) << 4) + kr * 4) = pk4_fp8(v[0][i], v[1][i], v[2][i], v[3][i]);
    }
    LDS_WAIT(); asm volatile("" ::: "memory");
#pragma unroll
    for (int t = 0; t < 8; ++t) { const int n = 8 * t + (lane >> 3), p = lane & 7;
        const u32x4 o = *(const LAS u32x4*)(T + n * 128 + ((p ^ ((n >> 2) & 7)) << 4));
        *(u32x4*)(WT + (size_t)(row_off + n0 + n) * K + k0 + 16 * p) = o; }
    LDS_WAIT(); asm volatile("" ::: "memory");
}
FI void moe_weight_item(const Args& A, LAS unsigned char* T, int q, int lane) {
    unsigned char* ws = A.ws;
    if (q < 32768) { const int e = q >> 10, r = q & 1023, kb = r >> 6, nb = r & 63, n0 = 64 * nb;
        const int isU = n0 / 2048, pn = (n0 % 2048) / 128, j = n0 % 128, rowmap = 256 * pn + 128 * isU + j;
        tr8_item(A.in[34] + (size_t)e * D * 4096, 4096, D, ws + WS_WGU + (size_t)e * 4096 * D, rowmap - n0, T, 128 * kb, n0, lane, WSCALE); }
    else { const int q2 = q - 32768, e = q2 >> 9, r = q2 & 511, kb = r >> 5, nb = r & 31;
        tr8_item(A.in[36] + (size_t)e * DFF * D, D, DFF, ws + WS_WDN + (size_t)e * D * DFF, 0, T, 128 * kb, 64 * nb, lane, WSCALE); }
}

FI void p0_run(const Args& A, LAS unsigned char* lds, int tid, int lane, int wave, int vcu, int G) {
    unsigned char* ws = A.ws;
    unsigned long long* mod = (unsigned long long*)((unsigned*)(ws + WS_CTL) + CW_MOD); unsigned long long* hnorm = (unsigned long long*)((unsigned*)(ws + WS_CTL) + CW_HNORM);
    {
        LAS float* sl = (LAS float*)lds;
        LAS float* part = (LAS float*)(lds + 9 * 256 * 4);
        const float* c = A.in[1]; const float* cc = A.in[3]; const float* wada = A.in[4];
        _Pragma("unroll 1") for (int rep = 0; rep < REP0A; ++rep)
        for (int it = vcu; it < 384; it += G) {
            const int cg = it % 48, kq = it / 48, n0 = cg * 256 + 4 * lane, k0 = kq * 256;
            for (int i = tid; i < 9 * 256; i += NTHR) { const int r = i >> 8, k = k0 + (i & 255); const float v = r < 8 ? c[r * D + k] : cc[k]; sl[i] = v / (1.f + __expf(-v)); }
            __syncthreads();
            f32x4 acc[9];
#pragma unroll
            for (int r = 0; r < 9; ++r) acc[r] = (f32x4){0.f, 0.f, 0.f, 0.f};
#pragma unroll 8
            for (int kk = 0; kk < 32; ++kk) { const int kl = wave * 32 + kk; const f32x4 w = *(const f32x4*)(wada + (size_t)(k0 + kl) * 12288 + n0);
#pragma unroll
                for (int r = 0; r < 9; ++r) { const float sv = sl[r * 256 + kl]; acc[r] += w * sv; } }
#pragma unroll
            for (int r = 0; r < 9; ++r) *(LAS f32x4*)(part + (wave * 9 + r) * 256 + 4 * lane) = acc[r];
            __syncthreads();
            for (int i = tid; i < 9 * 256; i += NTHR) { const int r = i >> 8, col = i & 255; float sum = 0.f;
#pragma unroll
                for (int w = 0; w < 8; ++w) sum += part[(w * 9 + r) * 256 + col];
                fix_add(mod + r * 12288 + cg * 256 + col, rep == REP0A - 1 ? sum : 0.0f); }
            __syncthreads();
        }
    }
    {
        LAS float* L = (LAS float*)lds;
        LAS float *w1s = L, *w2s = L + 2112, *w3s = L + 6208, *b1s = L + 10304, *b2s = L + 10368, *b3s = L + 10432, *fqs = L + 10496, *zs = L + 10560, *h1 = L + 10824, *h2 = L + 11336, *h3 = L + 11848;
        for (int i = tid; i < 33 * 64; i += NTHR) w1s[i] = A.in[21][i];
        for (int i = tid; i < 4096; i += NTHR) { w2s[i] = A.in[23][i]; w3s[i] = A.in[25][i]; }
        if (tid < 64) { b1s[tid] = A.in[22][tid]; b2s[tid] = A.in[24][tid]; b3s[tid] = A.in[26][tid]; fqs[tid] = A.in[28][tid]; }
        __syncthreads();
        const float* w4 = A.in[27]; const float* dl = A.in[29]; float* hraw = (float*)(ws + WS_HRAW);
        for (int item = vcu; item < 256; item += G) {
            const int l0 = item * 8;
            if (tid < 264) { const int r = tid / 33, i = tid % 33, l = l0 + r; float z;
                if (i == 0) z = (float)l / 2047.0f;
                else { const int j = (i - 1) & 15; const float band = 1e-4f + (float)j * ((15.0f - 1e-4f) / 15.0f); const float ang = (6.283185307179586f / 2048.0f) * (float)l * band; z = (i <= 16) ? cosf(ang) : -sinf(ang); }
                zs[tid] = z; }
            __syncthreads();
            const int r = tid >> 6, o = tid & 63;
            { float s = b1s[o]; for (int i = 0; i < 33; ++i) s += zs[r * 33 + i] * w1s[i * 64 + o]; h1[r * 64 + o] = sinf(fqs[o] * s); }
            __syncthreads();
            { float s = b2s[o]; for (int i = 0; i < 64; ++i) s += h1[r * 64 + i] * w2s[i * 64 + o]; h2[r * 64 + o] = sinf(fqs[o] * s); }
            __syncthreads();
            { float s = b3s[o]; for (int i = 0; i < 64; ++i) s += h2[r * 64 + i] * w3s[i * 64 + o]; h3[r * 64 + o] = sinf(fqs[o] * s); }
            __syncthreads();
            f32x4 acc[8];
#pragma unroll
            for (int q = 0; q < 8; ++q) acc[q] = (f32x4){0.f, 0.f, 0.f, 0.f};
#pragma unroll 4
            for (int i = 0; i < 64; ++i) { const f32x4 w = *(const f32x4*)(w4 + (size_t)i * 2048 + 4 * tid);
#pragma unroll
                for (int q = 0; q < 8; ++q) acc[q] += w * h3[q * 64 + i]; }
            const f32x4 dv = *(const f32x4*)(dl + 4 * tid);
            f32x4 asum = (f32x4){0.f, 0.f, 0.f, 0.f};
#pragma unroll
            for (int q = 0; q < 8; ++q) { const int l = l0 + q; const float t = (float)l / 2047.0f; f32x4 v;
#pragma unroll
                for (int e = 0; e < 4; ++e) v[e] = acc[q][e] * expf(-t * fabsf(dv[e]));
                *(f32x4*)(hraw + (size_t)l * 2048 + 4 * tid) = v;
                if (!(l == 2047 && 4 * tid >= 1024)) {
#pragma unroll
                    for (int e = 0; e < 4; ++e) asum[e] += fabsf(v[e]); } }
#pragma unroll
            for (int e = 0; e < 4; ++e) fix_add(hnorm + 4 * tid + e, asum[e]);
            __syncthreads();
        }
    }
    {
        __syncthreads();
        LAS float* scr = (LAS float*)(lds + wave * 16384);
        const int gw = vcu * NWAVES + wave, NGW = G * NWAVES;
        constexpr int I_IN = 32 * 128;
        for (int it = gw; it < I_IN; it += NGW) transpose_item(A.in[8], D, DIN, (bf16_t*)(ws + WS_WIN), 0, scr, it / 128, it % 128, lane);
        for (int it = gw; it < 256; it += NGW) tr8_item(A.in[8], DIN, D, ws + WS_WIN8, 0, lds + wave * 16384, 128 * (it >> 4), 64 * (it & 15), lane, WSCALE);
    }
}
#ifndef P0_SPLIT_ITEMS
#define P0_SPLIT_ITEMS 29500
#endif
FI void p0d_run(const Args& A, LAS unsigned char* lds, int lane, int wave, int q0, int q1, int vcu, int G) {
    const int gw = vcu * NWAVES + wave, NGW = G * NWAVES;
    _Pragma("unroll 1") for (int rep = 0; rep < REP0D; ++rep)
    for (int q = q0 + gw; q < q1; q += NGW) moe_weight_item(A, lds + wave * 16384, q, lane);
}

FI void p1_run(const Args& A, int tid, int lane, int wave, int vcu, int G, int m0, int m1, bool extras) {
    unsigned char* ws = A.ws;
    const unsigned long long* mod = (const unsigned long long*)((const unsigned*)(ws + WS_CTL) + CW_MOD); const unsigned long long* hnorm = (const unsigned long long*)((const unsigned*)(ws + WS_CTL) + CW_HNORM);
    const float* bada = A.in[5]; const float* g1 = A.in[6];
    bf16_t* A1 = (bf16_t*)(ws + WS_A1);
    const int gw = vcu * NWAVES + wave, NGW = G * NWAVES;
    if (extras) { float* modf = (float*)(ws + WS_MODF); for (int i = vcu * NTHR + tid; i < 9 * 12288; i += G * NTHR) modf[i] = fix_get(mod + i) + bada[i % 12288]; }
    {
        const int nrows = m1 - m0, per = (nrows + NGW - 1) / NGW, r0 = m0 + gw * per, r1 = (r0 + per) < m1 ? (r0 + per) : m1;
        int cur_mr = -1; f32x4 gsc[8], shv[8];
        for (int m = r0; m < r1; ++m) {
            const float* src = m < M ? A.in[0] + (size_t)m * D : A.in[2] + (size_t)(m - M) * D;
            const int mr = m < M ? m / SEQ : 8;
            f32x4 v[8]; float ss = 0.f;
#pragma unroll
            for (int j = 0; j < 8; ++j) { v[j] = *(const f32x4*)(src + 4 * lane + 256 * j); ss += (v[j].x * v[j].x + v[j].y * v[j].y) + (v[j].z * v[j].z + v[j].w * v[j].w); }
            if (mr != cur_mr) { cur_mr = mr;
#pragma unroll
                for (int j = 0; j < 8; ++j) { const int c = 4 * lane + 256 * j; const unsigned long long* mp = mod + (size_t)mr * 12288 + c;
                    shv[j] = (f32x4){fix_get(mp), fix_get(mp + 1), fix_get(mp + 2), fix_get(mp + 3)} + *(const f32x4*)(bada + c);
                    const f32x4 sc = (f32x4){fix_get(mp + D), fix_get(mp + D + 1), fix_get(mp + D + 2), fix_get(mp + D + 3)} + *(const f32x4*)(bada + D + c);
                    gsc[j] = *(const f32x4*)(g1 + c) * (sc + 1.0f); } }
            const float rstd = rsqrtf(wave_sum(ss) * (1.0f / D) + 1e-6f);
#pragma unroll
            for (int j = 0; j < 8; ++j) { const int c = 4 * lane + 256 * j;
                const f32x4 h = v[j] * rstd * gsc[j] + shv[j];
                if (m < M) { u32x2 w; w.x = pk2(h.x, h.y); w.y = pk2(h.z, h.w); *(u32x2*)(A1 + (size_t)m * D + c) = w; }
                else *(unsigned*)(ws + WS_A1C8 + (size_t)(m - M) * D + c) = pk4_fp8(h.x, h.y, h.z, h.w); }
        }
    }
}

FI void p2_slack_run(const Args& A, LAS unsigned char* lds, int tid, int lane, int wave, int vcu, int G) {
    unsigned char* ws = A.ws;
    const unsigned long long* hnorm = (const unsigned long long*)((const unsigned*)(ws + WS_CTL) + CW_HNORM);
    const int gw = vcu * NWAVES + wave, NGW = G * NWAVES;
    {
        const float *lre = A.in[9], *lim = A.in[10], *lst = A.in[11], *bre = A.in[12], *bim = A.in[13], *cre = A.in[14], *cim = A.in[15];
        float* LAM = (float*)(ws + WS_LAM); float* LAML = (float*)(ws + WS_LAML); bf16_t* SB = (bf16_t*)(ws + WS_S5B); bf16_t* SC = (bf16_t*)(ws + WS_S5C);
        for (int idx = vcu * NTHR + tid; idx < 2 * 64 * 4 * 64; idx += G * NTHR) {
            const int ln = idx & 63, T = (idx >> 6) & 3, g = (idx >> 8) & 63, d = idx >> 14;
            {
                const int n = ln & 31, hq = ln >> 5, p = n + 32 * (T >> 1), part = T & 1;
                const int q = (d * 64 + g) * 64 + p;
                const float lr = fminf(lre[q], -1e-4f), li = lim[q], dt = expf(lst[q]), zr = lr * dt, zi = li * dt, er = expf(zr), br = er * cosf(zi), bi = er * sinf(zi);
                const float den = lr * lr + li * li, cr = ((br - 1.f) * lr + bi * li) / den, ci = (bi * lr - (br - 1.f) * li) / den;
                float v[8];
#pragma unroll
                for (int j = 0; j < 8; ++j) { const int h = 8 * hq + j; const float xr = bre[(size_t)q * 16 + h], xi = bim[(size_t)q * 16 + h]; v[j] = part ? (cr * xi + ci * xr) : (cr * xr - ci * xi); }
                u32x4 w; w.x = pk2(v[0], v[1]); w.y = pk2(v[2], v[3]); w.z = pk2(v[4], v[5]); w.w = pk2(v[6], v[7]);
                *(u32x4*)(SB + (size_t)idx * 8) = w;
                if (part == 0 && hq == 0) { LAM[q * 2] = br; LAM[q * 2 + 1] = bi; const float eL = expf((float)SEG * zr), aL = (float)SEG * zi; LAML[q * 2] = eL * cosf(aL); LAML[q * 2 + 1] = eL * sinf(aL); }
            }
            {
                const int hc = ln & 15, qq = ln >> 4; float v[8];
#pragma unroll
                for (int j = 0; j < 8; ++j) { const int k = 32 * T + 8 * qq + j, n = k >> 2, TT = k & 3, p = n + 32 * (TT >> 1), part = TT & 1; const size_t ci = ((size_t)(d * 64 + g) * 16 + hc) * 64 + p; v[j] = part ? -cim[ci] : cre[ci]; }
                u32x4 w; w.x = pk2(v[0], v[1]); w.y = pk2(v[2], v[3]); w.z = pk2(v[4], v[5]); w.w = pk2(v[6], v[7]);
                *(u32x4*)(SC + (size_t)idx * 8) = w;
            }
        }
    }
    {
        const float* wrt = A.in[32]; bf16_t* WRF = (bf16_t*)(ws + WS_WRF);
        for (int idx = vcu * NTHR + tid; idx < 64 * 2 * 64; idx += G * NTHR) {
            const int ln = idx & 63, nt = (idx >> 6) & 1, ks = idx >> 7, ex = 16 * nt + (ln & 15), k0 = 32 * ks + 8 * (ln >> 4);
            float v[8], rsd[8];
#pragma unroll
            for (int j = 0; j < 8; ++j) { v[j] = wrt[(size_t)(k0 + j) * NE + ex]; rsd[j] = v[j] - bf1((bf16_t)f2bf(v[j])); }
            u32x4 hi, lo; hi.x = pk2(v[0], v[1]); hi.y = pk2(v[2], v[3]); hi.z = pk2(v[4], v[5]); hi.w = pk2(v[6], v[7]);
            lo.x = pk2(rsd[0], rsd[1]); lo.y = pk2(rsd[2], rsd[3]); lo.z = pk2(rsd[4], rsd[5]); lo.w = pk2(rsd[6], rsd[7]);
            *(u32x4*)(WRF + ((size_t)((ks * 2 + nt) * 2 + 0) * 64 + ln) * 8) = hi;
            *(u32x4*)(WRF + ((size_t)((ks * 2 + nt) * 2 + 1) * 64 + ln) * 8) = lo;
        }
    }
    {
        LAS float* scr = (LAS float*)(lds + wave * 16384);
        constexpr int I_GLU = 16 * 32, I_OUT = 32 * 64;
        for (int it = gw; it < I_GLU + I_OUT; it += NGW) {
            if (it < I_GLU) transpose_item(A.in[17], S5W, S5W, (bf16_t*)(ws + WS_WGLU), 0, scr, it / 32, it % 32, lane);
            else { const int r = it - I_GLU; transpose_item(A.in[31], D, D, (bf16_t*)(ws + WS_WOUT), 0, scr, r / 64, r % 64, lane); }
        }
    }
    const float* hraw = (const float*)(ws + WS_HRAW); bf16_t* Rg = (bf16_t*)(ws + WS_RG);
    for (int it = gw; it < 512 * 16; it += NGW) {
        const int ib = it >> 4, c = (it & 15) * 64 + lane;
        const float inv = 1.0f / (fix_get(hnorm + c) + fix_get(hnorm + HYW + c));
        float v[8];
#pragma unroll
        for (int jj = 0; jj < 8; ++jj) { const int i = 8 * ib + jj; float x;
            if (i <= 2047) x = hraw[(size_t)(2047 - i) * 2048 + c]; else if (i <= 4094) x = hraw[(size_t)(i - 2048) * 2048 + HYW + c]; else x = 0.f;
            v[jj] = x * inv; }
        u32x4 w; w.x = pk2(v[0], v[1]); w.y = pk2(v[2], v[3]); w.z = pk2(v[4], v[5]); w.w = pk2(v[6], v[7]);
        *(u32x4*)(Rg + (size_t)c * 4096 + 8 * ib) = w;
    }
}

FI void s5_unit(const Args& A, LAS unsigned char* lds, int unit, int lane, int wave) {
    unsigned char* ws = A.ws;
    const int d = unit & 1, g = (unit >> 1) & 63, bq = unit >> 7, dg = d * 64 + g;
    const bf16_t* P = (const bf16_t*)(ws + WS_P); bf16_t* Ys = (bf16_t*)(ws + WS_YS5);
    bf16x8 Bf[4], Cf[4];
#pragma unroll
    for (int T = 0; T < 4; ++T) { Bf[T] = *(const bf16x8*)((const bf16_t*)(ws + WS_S5B) + ((size_t)(dg * 4 + T) * 64 + lane) * 8); Cf[T] = *(const bf16x8*)((const bf16_t*)(ws + WS_S5C) + ((size_t)(dg * 4 + T) * 64 + lane) * 8); }
    const int n = lane & 31, hh = lane >> 5;
    const float* LAM = (const float*)(ws + WS_LAM) + (size_t)dg * 128; const float* LAML = (const float*)(ws + WS_LAML) + (size_t)dg * 128;
    f32v2 lr0, li0, lr1, li1, nli0, nli1;
    { const float a = LAM[n * 2], b_ = LAM[n * 2 + 1], c = LAM[(n + 32) * 2], e = LAM[(n + 32) * 2 + 1];
      lr0 = (f32v2){a, a}; li0 = (f32v2){b_, b_}; lr1 = (f32v2){c, c}; li1 = (f32v2){e, e}; nli0 = (f32v2){-b_, -b_}; nli1 = (f32v2){-e, -e}; }
    const int r = lane & 31, tau = 2 * (r >> 3) + ((r >> 1) & 1), b = 4 * bq + 2 * ((r >> 2) & 1) + (r & 1), kofs = g * 16 + 8 * (lane >> 5);
    const int seg0 = wave * SEG;
    auto rowp = [&](int pos) -> const bf16_t* {
        int row; if (pos < CTXL) { const int tc = d ? (CTXL - 1 - pos) : pos; row = M + b * CTXL + tc; } else { const int q = pos - CTXL; const int tl = d ? (SEQ - 1 - q) : q; row = b * SEQ + tl; }
        return P + (size_t)row * DIN + kofs; };
    const f32x16 z16 = {0.f, 0.f, 0.f, 0.f, 0.f, 0.f, 0.f, 0.f, 0.f, 0.f, 0.f, 0.f, 0.f, 0.f, 0.f, 0.f};
    f32v2 xr0 = {0.f, 0.f}, xi0 = {0.f, 0.f}, xr1 = {0.f, 0.f}, xi1 = {0.f, 0.f};
#define S5_FMA(dst, a, b, c) asm volatile("v_pk_fma_f32 %0, %1, %2, %3" : "=v"(dst) : "v"(a), "v"(b), "v"(c))
#define S5_SETTLE(c0, c1, c2, c3) asm volatile("s_nop 15\n\ts_nop 7" : "+v"(c0), "+v"(c1), "+v"(c2), "+v"(c3))
#define S5_PAIR(c, p) ((f32v2){c[2 * (p)], c[2 * (p) + 1]})
#define S5_TOKEN(p, R0, I0, R1, I1) do { f32v2 t0_, t1_, s0_, s1_; \
        S5_FMA(t0_, nli0, xi0, S5_PAIR(c0, p)); S5_FMA(t1_, nli1, xi1, S5_PAIR(c2, p)); S5_FMA(s0_, li0, xr0, S5_PAIR(c1, p)); S5_FMA(s1_, li1, xr1, S5_PAIR(c3, p)); \
        S5_FMA(R0, lr0, xr0, t0_); S5_FMA(R1, lr1, xr1, t1_); S5_FMA(I0, lr0, xi0, s0_); S5_FMA(I1, lr1, xi1, s1_); \
        xr0 = R0; xi0 = I0; xr1 = R1; xi1 = I1; } while (0)
    {
        bf16x8 uc[3], un[3];
#pragma unroll
        for (int q = 0; q < 3; ++q) { uc[q] = *(const bf16x8*)rowp(seg0 + 8 * q + tau); un[q] = uc[q]; }
#pragma unroll 1
        for (int ch = 0; ch < 12; ++ch) {
            if (ch < 11) {
#pragma unroll
                for (int q = 0; q < 3; ++q) un[q] = *(const bf16x8*)rowp(seg0 + 8 * (3 * (ch + 1) + q) + tau); }
#pragma unroll
            for (int q = 0; q < 3; ++q) {
                f32x16 c0 = __builtin_amdgcn_mfma_f32_32x32x16_bf16(uc[q], Bf[0], z16, 0, 0, 0), c1 = __builtin_amdgcn_mfma_f32_32x32x16_bf16(uc[q], Bf[1], z16, 0, 0, 0);
                f32x16 c2 = __builtin_amdgcn_mfma_f32_32x32x16_bf16(uc[q], Bf[2], z16, 0, 0, 0), c3 = __builtin_amdgcn_mfma_f32_32x32x16_bf16(uc[q], Bf[3], z16, 0, 0, 0);
                S5_SETTLE(c0, c1, c2, c3);
#pragma unroll
                for (int tt = 0; tt < 8; ++tt) { f32v2 r0_, i0_, r1_, i1_; S5_TOKEN(tt, r0_, i0_, r1_, i1_); }
            }
#pragma unroll
            for (int q = 0; q < 3; ++q) uc[q] = un[q];
        }
    }
    LAS float* Es = (LAS float*)(lds + 8 * 8704);
    *(LAS f32x4*)(Es + (wave * 64 + lane) * 8) = (f32x4){xr0[0], xr0[1], xi0[0], xi0[1]};
    *(LAS f32x4*)(Es + (wave * 64 + lane) * 8 + 4) = (f32x4){xr1[0], xr1[1], xi1[0], xi1[1]};
    __syncthreads();
    {
        const float Lr0 = LAML[n * 2], Li0 = LAML[n * 2 + 1], Lr1 = LAML[(n + 32) * 2], Li1 = LAML[(n + 32) * 2 + 1];
        xr0 = (f32v2){0.f, 0.f}; xi0 = (f32v2){0.f, 0.f}; xr1 = (f32v2){0.f, 0.f}; xi1 = (f32v2){0.f, 0.f};
#pragma unroll 1
        for (int w = 0; w < wave; ++w) { const f32x4 e0 = *(LAS f32x4*)(Es + (w * 64 + lane) * 8), e1 = *(LAS f32x4*)(Es + (w * 64 + lane) * 8 + 4);
            const f32v2 nr0 = Lr0 * xr0 - Li0 * xi0 + (f32v2){e0[0], e0[1]}, ni0 = Lr0 * xi0 + Li0 * xr0 + (f32v2){e0[2], e0[3]}; xr0 = nr0; xi0 = ni0;
            const f32v2 nr1 = Lr1 * xr1 - Li1 * xi1 + (f32v2){e1[0], e1[1]}, ni1 = Lr1 * xi1 + Li1 * xr1 + (f32v2){e1[2], e1[3]}; xr1 = nr1; xi1 = ni1; }
    }
    {
        LAS unsigned char* Xs = lds + wave * 8704;
        bf16x8 uc[3], un[3];
#pragma unroll
        for (int q = 0; q < 3; ++q) { uc[q] = *(const bf16x8*)rowp(seg0 + 8 * q + tau); un[q] = uc[q]; }
#pragma unroll 1
        for (int ch = 0; ch < 12; ++ch) {
            if (ch < 11) {
#pragma unroll
                for (int q = 0; q < 3; ++q) un[q] = *(const bf16x8*)rowp(seg0 + 8 * (3 * (ch + 1) + q) + tau); }
#pragma unroll
            for (int q = 0; q < 3; ++q) {
                const int pos0 = seg0 + 8 * (3 * ch + q);
                f32x16 c0 = __builtin_amdgcn_mfma_f32_32x32x16_bf16(uc[q], Bf[0], z16, 0, 0, 0), c1 = __builtin_amdgcn_mfma_f32_32x32x16_bf16(uc[q], Bf[1], z16, 0, 0, 0);
                f32x16 c2 = __builtin_amdgcn_mfma_f32_32x32x16_bf16(uc[q], Bf[2], z16, 0, 0, 0), c3 = __builtin_amdgcn_mfma_f32_32x32x16_bf16(uc[q], Bf[3], z16, 0, 0, 0);
                S5_SETTLE(c0, c1, c2, c3);
                f32v2 R0[8], I0[8], R1[8], I1[8];
#pragma unroll
                for (int tt = 0; tt < 8; ++tt) S5_TOKEN(tt, R0[tt], I0[tt], R1[tt], I1[tt]);
                if (pos0 >= CTXL) {
#pragma unroll
                    for (int tt = 0; tt < 8; ++tt)
#pragma unroll
                        for (int j = 0; j < 2; ++j) { u32x2 w; w.x = pk2(R0[tt][j], I0[tt][j]); w.y = pk2(R1[tt][j], I1[tt][j]); *(LAS u32x2*)(Xs + ((2 * hh + j) * 8 + tt) * 272 + 8 * n) = w; }
                    LDS_WAIT();
#pragma unroll
                    for (int bt = 0; bt < 2; ++bt) {
                        f32x4 y = (f32x4){0.f, 0.f, 0.f, 0.f};
#pragma unroll
                        for (int ks = 0; ks < 4; ++ks) { const bf16x8 xf = *(const LAS bf16x8*)(Xs + (bt * 16 + (lane & 15)) * 272 + (32 * ks + 8 * (lane >> 4)) * 2); y = __builtin_amdgcn_mfma_f32_16x16x32_bf16(Cf[ks], xf, y, 0, 0, 0); }
                        const int qq = pos0 + (lane & 7) - CTXL, tl = d ? (SEQ - 1 - qq) : qq, bb = 4 * bq + 2 * bt + ((lane >> 3) & 1);
                        u32x2 w; w.x = pk2(y[0], y[1]); w.y = pk2(y[2], y[3]);
                        *(u32x2*)(Ys + ((size_t)(d * M + bb * SEQ + tl)) * S5W + g * 16 + 4 * (lane >> 4)) = w;
                    }
                    LDS_WAIT();
                }
            }
#pragma unroll
            for (int q = 0; q < 3; ++q) uc[q] = un[q];
        }
    }
    __syncthreads();
#undef S5_FMA
#undef S5_SETTLE
#undef S5_PAIR
#undef S5_TOKEN
}

FI void h1_run(const Args& A, LAS unsigned char* lds, int tid, int vcu, int G) {
    unsigned char* ws = A.ws;
    const bf16_t* P = (const bf16_t*)(ws + WS_P); bf16_t* Vt = (bf16_t*)(ws + WS_VT);
    const float* cw = A.in[19]; const float* cb = A.in[20];
    u32x4 rp[4];
    auto fetch = [&](int item) {
        const int gr = item >> 3, cg = item & 7, b = gr >> 5, t0 = (gr & 31) * 64, c0 = cg * 128;
#pragma unroll
        for (int k = 0; k < 4; ++k) { const int idx = tid + k * NTHR, ch = idx >> 10, rem = idx & 1023, row = rem >> 4, sg = rem & 15;
            rp[k] = *(const u32x4*)(P + (size_t)(b * SEQ + t0 + row) * DIN + S5W + ch * HYW + c0 + sg * 8); } };
    int item = vcu;
    if (item < 2048) fetch(item);
    if (tid < 128) { const int bufz = tid >> 6, ch = (tid >> 5) & 1, rr = (tid >> 4) & 1, sg = tid & 15; *(LAS u32x4*)(lds + bufz * 33792 + ch * 16896 + (rr ? 65 : 0) * 256 + sg * 16) = (u32x4){0u, 0u, 0u, 0u}; }
    const int c2 = tid & 63, tq = tid >> 6;
    float2 w0v, w1v, w2v, bv, w0x, w1x, w2x, bx; int cur_cg = -1, buf = 0;
    w0v = w1v = w2v = bv = w0x = w1x = w2x = bx = make_float2(0.f, 0.f);
    for (; item < 2048; item += G) {
        const int gr = item >> 3, cg = item & 7, b = gr >> 5, t0 = (gr & 31) * 64, c0 = cg * 128, cc = c0 + 2 * c2;
        LAS unsigned char* L = lds + buf * 33792;
#pragma unroll
        for (int k = 0; k < 4; ++k) { const int idx = tid + k * NTHR, ch = idx >> 10, rem = idx & 1023, row = rem >> 4, sg = rem & 15; *(LAS u32x4*)(L + ch * 16896 + (row + 1) * 256 + sg * 16) = rp[k]; }
        if (cg != cur_cg) { cur_cg = cg;
            w0v = *(const float2*)(cw + cc); w1v = *(const float2*)(cw + 3072 + cc); w2v = *(const float2*)(cw + 6144 + cc); bv = *(const float2*)(cb + cc);
            w0x = *(const float2*)(cw + HYW + cc); w1x = *(const float2*)(cw + 3072 + HYW + cc); w2x = *(const float2*)(cw + 6144 + HYW + cc); bx = *(const float2*)(cb + HYW + cc); }
        __syncthreads();
        if (item + G < 2048) fetch(item + G);
        const LAS unsigned* Vs = (const LAS unsigned*)L; const LAS unsigned* Xs = (const LAS unsigned*)(L + 16896);
        unsigned vm = Vs[(tq * 8) * 64 + c2], v0 = Vs[(tq * 8 + 1) * 64 + c2], xm = Xs[(tq * 8) * 64 + c2], x0 = Xs[(tq * 8 + 1) * 64 + c2];
        float oa[8], ob[8];
#pragma unroll
        for (int i = 0; i < 8; ++i) { const int t = tq * 8 + i;
            const unsigned vp = Vs[(t + 2) * 64 + c2], xp = Xs[(t + 2) * 64 + c2];
            const float va = w0v.x * bflo(vm) + w1v.x * bflo(v0) + w2v.x * bflo(vp) + bv.x, vb = w0v.y * bfhi(vm) + w1v.y * bfhi(v0) + w2v.y * bfhi(vp) + bv.y;
            const float xa = w0x.x * bflo(xm) + w1x.x * bflo(x0) + w2x.x * bflo(xp) + bx.x, xb = w0x.y * bfhi(xm) + w1x.y * bfhi(x0) + w2x.y * bfhi(xp) + bx.y;
            oa[i] = va * xa; ob[i] = vb * xb; vm = v0; v0 = vp; xm = x0; x0 = xp; }
        bf16_t* dst = Vt + ((size_t)(cc * NB + b) * SEQ + t0 + tq * 8);
        u32x4 wa; wa.x = pk2(oa[0], oa[1]); wa.y = pk2(oa[2], oa[3]); wa.z = pk2(oa[4], oa[5]); wa.w = pk2(oa[6], oa[7]);
        u32x4 wb; wb.x = pk2(ob[0], ob[1]); wb.y = pk2(ob[2], ob[3]); wb.z = pk2(ob[4], ob[5]); wb.w = pk2(ob[6], ob[7]);
        *(u32x4*)dst = wa; *(u32x4*)(dst + (size_t)NB * SEQ) = wb;
        buf ^= 1;
    }
    __syncthreads();
}

constexpr int RT_STRIDE = 8208, VS_OFF = 8 * RT_STRIDE, VS_STRIDE = 4112;
FI void longconv_run(const Args& A, LAS unsigned char* lds, int tid, int lane, int wave, int vcu, int G) {
    unsigned char* ws = A.ws;
    const bf16_t* Pq = (const bf16_t*)(ws + WS_P); const bf16_t* Ysq = (const bf16_t*)(ws + WS_YS5); bf16_t* Ygq = (bf16_t*)(ws + WS_YG); const float* dsk = A.in[16];
    const int gthreads = G * NTHR; int sidx = vcu * NTHR + tid;
    const f32x4 dq0 = *(const f32x4*)(dsk + (sidx & 127) * 8), dq1 = *(const f32x4*)(dsk + (sidx & 127) * 8 + 4);
    u32x4 cu[4], cf[4], cbk[4];
    auto c_load = [&]() {
#pragma unroll
        for (int j = 0; j < 4; ++j) { const int idx = sidx + j * gthreads; if (idx < M * 128) { const int row = idx >> 7, c8 = (idx & 127) * 8;
            cu[j] = *(const u32x4*)(Pq + (size_t)row * DIN + c8); cf[j] = *(const u32x4*)(Ysq + (size_t)row * S5W + c8); cbk[j] = *(const u32x4*)(Ysq + (size_t)(M + row) * S5W + c8); } } };
    auto c_finish = [&]() {
#pragma unroll
        for (int j = 0; j < 4; ++j) { const int idx = sidx + j * gthreads; if (idx < M * 128) { const int row = idx >> 7, c8 = (idx & 127) * 8;
            const u32x4 u = cu[j], yf = cf[j], yb = cbk[j];
            const f32x4 d0 = dq0, d1 = dq1;
            float y[8];
            y[0] = bflo(u.x) * d0.x + bflo(yf.x) + bflo(yb.x); y[1] = bfhi(u.x) * d0.y + bfhi(yf.x) + bfhi(yb.x);
            y[2] = bflo(u.y) * d0.z + bflo(yf.y) + bflo(yb.y); y[3] = bfhi(u.y) * d0.w + bfhi(yf.y) + bfhi(yb.y);
            y[4] = bflo(u.z) * d1.x + bflo(yf.z) + bflo(yb.z); y[5] = bfhi(u.z) * d1.y + bfhi(yf.z) + bfhi(yb.z);
            y[6] = bflo(u.w) * d1.z + bflo(yf.w) + bflo(yb.w); y[7] = bfhi(u.w) * d1.w + bfhi(yf.w) + bfhi(yb.w);
#pragma unroll
            for (int e = 0; e < 8; ++e) y[e] = gelu_erf(y[e]);
            u32x4 w; w.x = pk2(y[0], y[1]); w.y = pk2(y[2], y[3]); w.z = pk2(y[4], y[5]); w.w = pk2(y[6], y[7]);
            *(u32x4*)(Ygq + (size_t)row * S5W + c8) = w; } }
        sidx += 4 * gthreads; };
    for (int i = tid; i < VS_OFF / 16; i += NTHR) *(LAS u32x4*)(lds + i * 16) = (u32x4){0u, 0u, 0u, 0u};
    for (int i = tid; i < VS_STRIDE / 16; i += NTHR) *(LAS u32x4*)(lds + VS_OFF + NB * VS_STRIDE + i * 16) = (u32x4){0u, 0u, 0u, 0u};
    u32x4 pr, pv[4];
    auto fetch = [&](int c) { const bf16_t* Rg = (const bf16_t*)(ws + WS_RG) + (size_t)c * 4096; const bf16_t* Vt = (const bf16_t*)(ws + WS_VT) + (size_t)c * NB * SEQ;
        pr = *(const u32x4*)(Rg + 8 * tid);
#pragma unroll
        for (int k = 0; k < 4; ++k) { const int i = tid + k * NTHR; pv[k] = *(const u32x4*)(Vt + (size_t)(i >> 8) * SEQ + (i & 255) * 8); } };
    int c = vcu;
    if (c < HYW) fetch(c);
    __syncthreads();
  for (; c < HYW; c += G) {
    bf16_t* LC = (bf16_t*)(ws + WS_LCT) + (size_t)c * NB * SEQ;
#pragma unroll
    for (int k = 0; k < 4; ++k) { const int i = tid + k * NTHR; *(LAS u32x4*)(lds + VS_OFF + (i >> 8) * VS_STRIDE + (i & 255) * 16) = pv[k]; }
    { const unsigned wv[4] = {pr.x, pr.y, pr.z, pr.w};
#pragma unroll
      for (int e = 0; e < 8; ++e) { const bf16_t v = (bf16_t)((e & 1) ? (wv[e >> 1] >> 16) : (wv[e >> 1] & 0xffffu)); const int i = 8 * tid + e;
#pragma unroll
        for (int r = 0; r < 8; ++r) *(LAS bf16_t*)(lds + r * RT_STRIDE + (i + r) * 2) = v; } }
    __syncthreads();
    if (c + G < HYW) fetch(c + G);
    c_load();
    const int a = lane & 15, q = lane >> 4, r = (a + 1) & 7, nb = a & 7, hi = a >> 3, i0 = wave * 8;
    const int ZOFF = VS_OFF + NB * VS_STRIDE;
    f32x4 acc[8];
#pragma unroll
    for (int ii = 0; ii < 8; ++ii) acc[ii] = (f32x4){0.f, 0.f, 0.f, 0.f};
    auto run = [&](const LAS unsigned char* rb, const LAS unsigned char* vb) {
        bf16x8 S[8];
#pragma unroll
        for (int ii = 0; ii < 8; ++ii) S[ii] = *(const LAS bf16x8*)(rb + 32 * (7 - ii));
        bf16x8 bfr = *(const LAS bf16x8*)vb;
#pragma unroll 1
        for (int j4 = 0; j4 < 32; j4 += 4) {
#pragma unroll
            for (int jj = 0; jj < 4; ++jj) {
                const int j = j4 + jj, jn = (j + 1) & 31;
                const bf16x8 nb_ = *(const LAS bf16x8*)(vb + 64 * jn);
                const bf16x8 n0_ = *(const LAS bf16x8*)(rb + 32 * 7 + 64 * jn), n1_ = *(const LAS bf16x8*)(rb + 32 * 6 + 64 * jn);
#pragma unroll
                for (int ii = 0; ii < 8; ++ii) acc[ii] = __builtin_amdgcn_mfma_f32_16x16x32_bf16(S[(ii - 2 * jj) & 7], bfr, acc[ii], 0, 0, 0);
                S[(0 - 2 * (jj + 1)) & 7] = n0_; S[(1 - 2 * (jj + 1)) & 7] = n1_; bfr = nb_;
            }
        }
    };
    const int ebase = 2047 - 16 * (i0 + 7) - a + 8 * q + r;
    const LAS unsigned char* rt = lds + r * RT_STRIDE;
    const LAS unsigned char* vrow = lds + VS_OFF + nb * VS_STRIDE + 16 * q; const LAS unsigned char* zrow = lds + ZOFF + 16 * q;
    run(rt + 2 * ebase, vrow + (hi ? 64 * 32 : 0));
    f32x4 acc2[4], acc3[4];
#pragma unroll
    for (int ii = 0; ii < 4; ++ii) { acc2[ii] = (f32x4){0.f, 0.f, 0.f, 0.f}; acc3[ii] = (f32x4){0.f, 0.f, 0.f, 0.f}; }
    auto run_off = [&](const LAS unsigned char* rb, const LAS unsigned char* vlo, const LAS unsigned char* vhi, f32x4 (&ac)[4]) {
        const LAS unsigned char* vbase = hi ? vhi : vlo;
        bf16x8 F0 = *(const LAS bf16x8*)(rb + 32 * 7 - 128), F1 = *(const LAS bf16x8*)(rb + 32 * 6 - 128), G0 = *(const LAS bf16x8*)(rb + 32 * 5 - 128), G1 = *(const LAS bf16x8*)(rb + 32 * 4 - 128);
        bf16x8 bfr = *(const LAS bf16x8*)(hi ? vbase - 128 : zrow);
#pragma unroll 2
        for (int jl = -2; jl < 32; ++jl) {
            const int jn = jl + 1; const bool okn = hi ? (jn <= 29) : (jn >= 0);
            const bf16x8 nb_ = *(const LAS bf16x8*)(okn ? vbase + 64 * jn : zrow);
            const bf16x8 n0_ = *(const LAS bf16x8*)(rb + 32 * 7 + 64 * jn), n1_ = *(const LAS bf16x8*)(rb + 32 * 6 + 64 * jn);
            ac[0] = __builtin_amdgcn_mfma_f32_16x16x32_bf16(F0, bfr, ac[0], 0, 0, 0); ac[1] = __builtin_amdgcn_mfma_f32_16x16x32_bf16(F1, bfr, ac[1], 0, 0, 0);
            ac[2] = __builtin_amdgcn_mfma_f32_16x16x32_bf16(G0, bfr, ac[2], 0, 0, 0); ac[3] = __builtin_amdgcn_mfma_f32_16x16x32_bf16(G1, bfr, ac[3], 0, 0, 0);
            G0 = F0; G1 = F1; F0 = n0_; F1 = n1_; bfr = nb_;
        }
    };
    run_off(rt + 2 * (ebase + 32 * 32), vrow + 64 * 32, vrow + 64 * 34, acc2);
    run_off(rt + 2 * (ebase - 16 * 64), vrow, vrow + 64 * 2, acc3);
#pragma unroll
    for (int k = 0; k < 4; ++k) {
        f32x4 x2, x3;
#pragma unroll
        for (int e = 0; e < 4; ++e) { x2[e] = __shfl_xor(acc2[k][e], 8); x3[e] = __shfl_xor(acc3[k][e], 8); }
        acc[k] += hi ? x3 : acc2[k];
        acc[k + 4] += hi ? acc3[k] : x2;
    }
#pragma unroll
    for (int ii = 0; ii < 8; ++ii) { u32x2 w; w.x = pk2(acc[ii][0], acc[ii][1]); w.y = pk2(acc[ii][2], acc[ii][3]); *(u32x2*)(LC + (size_t)nb * SEQ + 16 * (i0 + ii + 64 * hi) + 4 * q) = w; }
    c_finish();
    __syncthreads();
  }
  while (sidx < M * 128) { c_load(); c_finish(); }
}

FI void s5_combine(const Args& A, int gtid, int gthreads) {
    unsigned char* ws = A.ws;
    const bf16_t* P = (const bf16_t*)(ws + WS_P); const bf16_t* Ys = (const bf16_t*)(ws + WS_YS5); bf16_t* Yg = (bf16_t*)(ws + WS_YG); const float* dsk = A.in[16];
    for (int idx = gtid; idx < M * 128; idx += gthreads) {
        const int row = idx >> 7, c8 = (idx & 127) * 8;
        const u32x4 u = *(const u32x4*)(P + (size_t)row * DIN + c8), yf = *(const u32x4*)(Ys + (size_t)row * S5W + c8), yb = *(const u32x4*)(Ys + (size_t)(M + row) * S5W + c8);
        const f32x4 d0 = *(const f32x4*)(dsk + c8), d1 = *(const f32x4*)(dsk + c8 + 4);
        float y[8];
        y[0] = bflo(u.x) * d0.x + bflo(yf.x) + bflo(yb.x); y[1] = bfhi(u.x) * d0.y + bfhi(yf.x) + bfhi(yb.x);
        y[2] = bflo(u.y) * d0.z + bflo(yf.y) + bflo(yb.y); y[3] = bfhi(u.y) * d0.w + bfhi(yf.y) + bfhi(yb.y);
        y[4] = bflo(u.z) * d1.x + bflo(yf.z) + bflo(yb.z); y[5] = bfhi(u.z) * d1.y + bfhi(yf.z) + bfhi(yb.z);
        y[6] = bflo(u.w) * d1.z + bflo(yf.w) + bflo(yb.w); y[7] = bfhi(u.w) * d1.w + bfhi(yf.w) + bfhi(yb.w);
#pragma unroll
        for (int e = 0; e < 8; ++e) y[e] = gelu_erf(y[e]);
        u32x4 w; w.x = pk2(y[0], y[1]); w.y = pk2(y[2], y[3]); w.z = pk2(y[4], y[5]); w.w = pk2(y[6], y[7]);
        *(u32x4*)(Yg + (size_t)row * S5W + c8) = w;
    }
}

FI void h3_run(const Args& A, LAS unsigned char* lds, int tid, int vcu, int G) {
    unsigned char* ws = A.ws;
    const bf16_t* P = (const bf16_t*)(ws + WS_P); const bf16_t* LC = (const bf16_t*)(ws + WS_LCT); bf16_t* Yc = (bf16_t*)(ws + WS_YCAT);
    const float* cw = A.in[19]; const float* cb = A.in[20];
    u32x4 rp[6], rl[2];
    auto fetch = [&](int item) {
        const int gr = item >> 3, cg = item & 7, b = gr >> 5, t0 = (gr & 31) * 64, c0 = cg * 128;
#pragma unroll
        for (int k = 0; k < 6; ++k) { const int idx = tid + k * NTHR, ch = idx >> 10, rem = idx & 1023, row = rem >> 4, sg = rem & 15;
            rp[k] = *(const u32x4*)(P + (size_t)(b * SEQ + t0 + row) * DIN + S5W + ch * HYW + c0 + sg * 8); }
#pragma unroll
        for (int k = 0; k < 2; ++k) { const int idx = tid + k * NTHR, c = idx >> 3, pc = idx & 7;
            rl[k] = *(const u32x4*)(LC + (size_t)((c0 + c) * NB + b) * SEQ + t0 + pc * 8); }
    };
    int item = vcu;
    if (item < 2048) fetch(item);
    float2 w0v, w1v, w2v, bv, w0x, w1x, w2x, bx, w0z, w1z, w2z, bz, dd; int cur_cg = -1;
    w0v = w1v = w2v = bv = w0x = w1x = w2x = bx = w0z = w1z = w2z = bz = dd = make_float2(0.f, 0.f);
    for (; item < 2048; item += G) {
        const int gr = item >> 3, cg = item & 7, b = gr >> 5, t0 = (gr & 31) * 64, c0 = cg * 128;
#pragma unroll
        for (int k = 0; k < 6; ++k) { const int idx = tid + k * NTHR, ch = idx >> 10, rem = idx & 1023, row = rem >> 4, sg = rem & 15;
            *(LAS u32x4*)(lds + ch * 16896 + (row + 1) * 256 + sg * 16) = rp[k]; }
        if (tid < 96) { const int ch = tid >> 5, rr = (tid >> 4) & 1, sg = tid & 15; *(LAS u32x4*)(lds + ch * 16896 + (rr ? 65 : 0) * 256 + sg * 16) = (u32x4){0u, 0u, 0u, 0u}; }
        LAS bf16_t* Ls = (LAS bf16_t*)(lds + 3 * 16896);
#pragma unroll
        for (int k = 0; k < 2; ++k) { const int idx = tid + k * NTHR, c = idx >> 3, pc = idx & 7;
            const unsigned wv[4] = {rl[k].x, rl[k].y, rl[k].z, rl[k].w};
#pragma unroll
            for (int e = 0; e < 4; ++e) { Ls[(pc * 8 + 2 * e) * 128 + (c ^ (pc << 4))] = (bf16_t)(wv[e] & 0xffffu); Ls[(pc * 8 + 2 * e + 1) * 128 + (c ^ (pc << 4))] = (bf16_t)(wv[e] >> 16); } }
        __syncthreads();
        if (item + G < 2048) fetch(item + G);
        const int c2 = tid & 63, tq = tid >> 6, cc = c0 + 2 * c2;
        if (cg != cur_cg) { cur_cg = cg;
            w0v = *(const float2*)(cw + cc); w1v = *(const float2*)(cw + 3072 + cc); w2v = *(const float2*)(cw + 6144 + cc); bv = *(const float2*)(cb + cc);
            w0x = *(const float2*)(cw + HYW + cc); w1x = *(const float2*)(cw + 3072 + HYW + cc); w2x = *(const float2*)(cw + 6144 + HYW + cc); bx = *(const float2*)(cb + HYW + cc);
            w0z = *(const float2*)(cw + 2 * HYW + cc); w1z = *(const float2*)(cw + 3072 + 2 * HYW + cc); w2z = *(const float2*)(cw + 6144 + 2 * HYW + cc); bz = *(const float2*)(cb + 2 * HYW + cc);
            dd = *(const float2*)(A.in[30] + cc); }
        const LAS unsigned* Vs = (const LAS unsigned*)lds; const LAS unsigned* Xs = (const LAS unsigned*)(lds + 16896); const LAS unsigned* Zs = (const LAS unsigned*)(lds + 2 * 16896); const LAS unsigned* Lw = (const LAS unsigned*)Ls;
        unsigned vm = Vs[(tq * 8) * 64 + c2], v0 = Vs[(tq * 8 + 1) * 64 + c2], xm = Xs[(tq * 8) * 64 + c2], x0 = Xs[(tq * 8 + 1) * 64 + c2], zm = Zs[(tq * 8) * 64 + c2], z0 = Zs[(tq * 8 + 1) * 64 + c2];
#pragma unroll
        for (int i = 0; i < 8; ++i) { const int t = tq * 8 + i;
            const unsigned vp = Vs[(t + 2) * 64 + c2], xp = Xs[(t + 2) * 64 + c2], zp = Zs[(t + 2) * 64 + c2], lw = Lw[t * 64 + (c2 ^ (tq << 3))];
            const float va = w0v.x * bflo(vm) + w1v.x * bflo(v0) + w2v.x * bflo(vp) + bv.x, vb = w0v.y * bfhi(vm) + w1v.y * bfhi(v0) + w2v.y * bfhi(vp) + bv.y;
            const float xa = w0x.x * bflo(xm) + w1x.x * bflo(x0) + w2x.x * bflo(xp) + bx.x, xb = w0x.y * bfhi(xm) + w1x.y * bfhi(x0) + w2x.y * bfhi(xp) + bx.y;
            const float za = w0z.x * bflo(zm) + w1z.x * bflo(z0) + w2z.x * bflo(zp) + bz.x, zb = w0z.y * bfhi(zm) + w1z.y * bfhi(z0) + w2z.y * bfhi(zp) + bz.y;
            const float ya = (bflo(lw) + va * xa * dd.x) * za, yb = (bfhi(lw) + vb * xb * dd.y) * zb;
            *(unsigned*)(Yc + (size_t)(b * SEQ + t0 + t) * D + S5W + cc) = pk2(ya, yb);
            vm = v0; v0 = vp; xm = x0; x0 = xp; zm = z0; z0 = zp; }
        __syncthreads();
    }
}

FI void p7_run(const Args& A, LAS unsigned char* lds, int lane, int wave, int vcu, int G, bool commit) {
    unsigned char* ws = A.ws;
    const float* x1 = (const float*)(ws + WS_X1); unsigned char* A2 = ws + WS_A2;
    const float* mod = (const float*)(ws + WS_MODF); const float* g2 = A.in[7]; const float* brt = A.in[33];
    const bf16x8* WRF = (const bf16x8*)(ws + WS_WRF);
    int* cnt = (int*)(ws + WS_CTL) + CW_CNT; int* rowl = (int*)(ws + WS_ROWL); int* pk = (int*)(ws + WS_PK); float* gate = (float*)(ws + WS_GATE);
    const int t = lane & 15, q = lane >> 4, pair = wave >> 1, kh = wave & 1;
    LAS float* xch = (LAS float*)(lds + 32768);
    LAS float* part = (LAS float*)(lds + 34816);
    LAS int* lcnt = (LAS int*)(lds + 65536);
    for (int it = vcu; it < M / 64; it += G) {
        const int row = it * 64 + pair * 16 + t, b = (it * 64) / SEQ;
        const float* xr = x1 + (size_t)row * D + kh * 1024 + 8 * q;
        if (threadIdx.x < 64) lcnt[threadIdx.x] = 0;
        float ss = 0.f;
#pragma unroll 8
        for (int ks = 0; ks < 32; ++ks) { const f32x4 a = *(const f32x4*)(xr + 32 * ks), c = *(const f32x4*)(xr + 32 * ks + 4);
            ss += ((a.x * a.x + a.y * a.y) + (a.z * a.z + a.w * a.w)) + ((c.x * c.x + c.y * c.y) + (c.z * c.z + c.w * c.w)); }
        ss += __shfl_xor(ss, 16); ss += __shfl_xor(ss, 32);
        if (q == 0) xch[wave * 16 + t] = ss;
        __syncthreads();
        const float rstd = rsqrtf((xch[(pair * 2) * 16 + t] + xch[(pair * 2 + 1) * 16 + t]) * (1.0f / D) + 1e-6f);
        f32x4 acc0 = (f32x4){0.f, 0.f, 0.f, 0.f}, acc1 = (f32x4){0.f, 0.f, 0.f, 0.f};
        const float* gp = g2 + kh * 1024 + 8 * q; const float* shp = mod + (size_t)b * 12288 + 3 * D + kh * 1024 + 8 * q; const float* scp = mod + (size_t)b * 12288 + 4 * D + kh * 1024 + 8 * q;
        unsigned char* a2p = A2 + (size_t)row * D + kh * 1024 + 8 * q;
#pragma unroll 4
        for (int ks = 0; ks < 32; ++ks) {
            const f32x4 xa = *(const f32x4*)(xr + 32 * ks), xb = *(const f32x4*)(xr + 32 * ks + 4);
            const f32x4 ha = xa * rstd * *(const f32x4*)(gp + 32 * ks) * (*(const f32x4*)(scp + 32 * ks) + 1.0f) + *(const f32x4*)(shp + 32 * ks);
            const f32x4 hb = xb * rstd * *(const f32x4*)(gp + 32 * ks + 4) * (*(const f32x4*)(scp + 32 * ks + 4) + 1.0f) + *(const f32x4*)(shp + 32 * ks + 4);
            u32x2 w8; w8.x = pk4_fp8(ha.x, ha.y, ha.z, ha.w); w8.y = pk4_fp8(hb.x, hb.y, hb.z, hb.w); *(u32x2*)(a2p + 32 * ks) = w8;
            u32x4 hi; hi.x = pk2(ha.x, ha.y); hi.y = pk2(ha.z, ha.w); hi.z = pk2(hb.x, hb.y); hi.w = pk2(hb.z, hb.w);
            u32x4 lo; lo.x = pk2(ha.x - bflo(hi.x), ha.y - bfhi(hi.x)); lo.y = pk2(ha.z - bflo(hi.y), ha.w - bfhi(hi.y)); lo.z = pk2(hb.x - bflo(hi.z), hb.y - bfhi(hi.z)); lo.w = pk2(hb.z - bflo(hi.w), hb.w - bfhi(hi.w));
            const bf16x8 Hh = __builtin_bit_cast(bf16x8, hi), Hl = __builtin_bit_cast(bf16x8, lo);
            const bf16x8* wf = WRF + (size_t)((kh * 32 + ks) * 4) * 64 + lane;
            const bf16x8 wh0 = wf[0], wl0 = wf[64], wh1 = wf[128], wl1 = wf[192];
            acc0 = __builtin_amdgcn_mfma_f32_16x16x32_bf16(wh0, Hh, acc0, 0, 0, 0); acc1 = __builtin_amdgcn_mfma_f32_16x16x32_bf16(wh1, Hh, acc1, 0, 0, 0);
            acc0 = __builtin_amdgcn_mfma_f32_16x16x32_bf16(wl0, Hh, acc0, 0, 0, 0); acc1 = __builtin_amdgcn_mfma_f32_16x16x32_bf16(wl1, Hh, acc1, 0, 0, 0);
            acc0 = __builtin_amdgcn_mfma_f32_16x16x32_bf16(wh0, Hl, acc0, 0, 0, 0); acc1 = __builtin_amdgcn_mfma_f32_16x16x32_bf16(wh1, Hl, acc1, 0, 0, 0);
        }
        if (kh == 1) { *(LAS f32x4*)(part + (pair * 64 + lane) * 8) = acc0; *(LAS f32x4*)(part + (pair * 64 + lane) * 8 + 4) = acc1; }
        __syncthreads();
        int myex = 0, myrank = 0; float mygate = 0.f;
        if (kh == 0) {
            acc0 += *(const LAS f32x4*)(part + (pair * 64 + lane) * 8); acc1 += *(const LAS f32x4*)(part + (pair * 64 + lane) * 8 + 4);
            float v[8]; int ix[8];
#pragma unroll
            for (int r = 0; r < 4; ++r) { ix[r] = 4 * q + r; ix[4 + r] = 16 + 4 * q + r; v[r] = acc0[r] + brt[4 * q + r]; v[4 + r] = acc1[r] + brt[16 + 4 * q + r]; }
            float tv[4]; int ti[4];
#pragma unroll
            for (int k = 0; k < 4; ++k) { float bv = v[0]; int bi = ix[0];
#pragma unroll
                for (int r = 1; r < 8; ++r) if (v[r] > bv) { bv = v[r]; bi = ix[r]; }
#pragma unroll
                for (int o = 16; o <= 32; o <<= 1) { const float ov = __shfl_xor(bv, o); const int oi = __shfl_xor(bi, o); if (ov > bv || (ov == bv && oi < bi)) { bv = ov; bi = oi; } }
                tv[k] = bv; ti[k] = bi;
#pragma unroll
                for (int r = 0; r < 8; ++r) if (ix[r] == bi) v[r] = -3.0e38f; }
            const float e1 = __expf(tv[1] - tv[0]), e2 = __expf(tv[2] - tv[0]), e3 = __expf(tv[3] - tv[0]), inv = 1.0f / (1.0f + e1 + e2 + e3);
            myex = q == 0 ? ti[0] : q == 1 ? ti[1] : q == 2 ? ti[2] : ti[3];
            mygate = (q == 0 ? 1.0f : q == 1 ? e1 : q == 2 ? e2 : e3) * inv;
            myrank = __hip_atomic_fetch_add(lcnt + myex, 1, __ATOMIC_RELAXED, __HIP_MEMORY_SCOPE_WORKGROUP);
        }
        __syncthreads();
        if (threadIdx.x < NE) { const int n = lcnt[threadIdx.x]; lcnt[32 + threadIdx.x] = (n > 0 && commit) ? atomicAdd(cnt + threadIdx.x, n) : 0; }
        __syncthreads();
        if (kh == 0 && commit) { const int slot = lcnt[32 + myex] + myrank;
            rowl[myex * M + slot] = row; pk[row * 4 + q] = myex * M + slot; gate[row * 4 + q] = mygate; }
        __syncthreads();
    }
}

FI void moe_table(const Args& A, LAS unsigned char* lds, int tid) {
    const int* cnt = (const int*)(A.ws + WS_CTL) + CW_CNT;
    LAS int* tw = (LAS int*)(lds + LDSCTL_OFF);
    if (tid < 64) { const int n = tid < NE ? cnt[tid] : 0; int p = (n + 255) >> 8;
#pragma unroll
        for (int o = 1; o < 32; o <<= 1) { const int q = __shfl_up(p, o); if ((tid & 63) >= o) p += q; }
        if (tid < NE) { tw[LW_TST + tid + 1] = p; tw[LW_CNT + tid] = n; } if (tid == 0) tw[LW_TST] = 0; }
    __syncthreads();
    if (tid < 320) { int e = 0;
#pragma unroll 1
        for (int j = 1; j < NE; ++j) e += (tw[LW_TST + j] <= tid) ? 1 : 0;
        tw[LW_TE + tid] = e; }
    __syncthreads();
}

FI void p10_run(const Args& A, LAS unsigned char* lds, int lane, int wave, int vcu, int G) {
    unsigned char* ws = A.ws;
    const float* x1 = (const float*)(ws + WS_X1); const unsigned char* Yd = ws + WS_YD; const float* bdn = A.in[37];
    const float* mod = (const float*)(ws + WS_MODF); const float* gf = A.in[38];
    const int* pk = (const int*)(ws + WS_PK); const float* gate = (const float*)(ws + WS_GATE);
    const LAS int* tst = (const LAS int*)(lds + LDSCTL_OFF) + LW_TST;
    const int gw = vcu * NWAVES + wave, NGW = G * NWAVES;
    for (int row = gw; row < M; row += NGW) {
        const int b = row / SEQ; unsigned hr[4], bo[4]; float gk[4];
#pragma unroll
        for (int k = 0; k < 4; ++k) { const int p = __builtin_amdgcn_readfirstlane(pk[row * 4 + k]), ex = p / M, slot = p % M;
            hr[k] = (unsigned)(__builtin_amdgcn_readfirstlane(tst[ex]) * 256 + slot) * (unsigned)D; gk[k] = __builtin_bit_cast(float, __builtin_amdgcn_readfirstlane(__builtin_bit_cast(int, gate[row * 4 + k]))); bo[k] = (unsigned)ex * (unsigned)D; }
        f32x4 x2[8]; float ss = 0.f;
        const int rowu = __builtin_amdgcn_readfirstlane(row);
        const float* x1r = x1 + (size_t)rowu * D; const float* gar = mod + (size_t)(rowu / SEQ) * 12288 + 5 * D; float* outr = A.out + (size_t)rowu * D;
#pragma unroll
        for (int hb = 0; hb < 2; ++hb) {
            const float* x1h = x1r + hb * 1024; const float* gah = gar + hb * 1024;
            const unsigned char* y0 = Yd + hr[0] + hb * 1024; const unsigned char* y1 = Yd + hr[1] + hb * 1024; const unsigned char* y2 = Yd + hr[2] + hb * 1024; const unsigned char* y3 = Yd + hr[3] + hb * 1024;
            const float* b0 = bdn + bo[0] + hb * 1024; const float* b1 = bdn + bo[1] + hb * 1024; const float* b2 = bdn + bo[2] + hb * 1024; const float* b3 = bdn + bo[3] + hb * 1024;
#pragma unroll
            for (int jj = 0; jj < 4; ++jj) { const int col = 4 * lane + 256 * jj, j = hb * 4 + jj;
                f32x4 s = (f32x4){0.f, 0.f, 0.f, 0.f};
                { const int y = *(const int*)(y0 + col); const f32v2 lo = __builtin_amdgcn_cvt_pk_f32_fp8(y, false), hi = __builtin_amdgcn_cvt_pk_f32_fp8(y, true); s += ((f32x4){lo.x, lo.y, hi.x, hi.y} + *(const f32x4*)(b0 + col)) * gk[0]; }
                { const int y = *(const int*)(y1 + col); const f32v2 lo = __builtin_amdgcn_cvt_pk_f32_fp8(y, false), hi = __builtin_amdgcn_cvt_pk_f32_fp8(y, true); s += ((f32x4){lo.x, lo.y, hi.x, hi.y} + *(const f32x4*)(b1 + col)) * gk[1]; }
                { const int y = *(const int*)(y2 + col); const f32v2 lo = __builtin_amdgcn_cvt_pk_f32_fp8(y, false), hi = __builtin_amdgcn_cvt_pk_f32_fp8(y, true); s += ((f32x4){lo.x, lo.y, hi.x, hi.y} + *(const f32x4*)(b2 + col)) * gk[2]; }
                { const int y = *(const int*)(y3 + col); const f32v2 lo = __builtin_amdgcn_cvt_pk_f32_fp8(y, false), hi = __builtin_amdgcn_cvt_pk_f32_fp8(y, true); s += ((f32x4){lo.x, lo.y, hi.x, hi.y} + *(const f32x4*)(b3 + col)) * gk[3]; }
                x2[j] = *(const f32x4*)(x1h + col) + *(const f32x4*)(gah + col) * s;
                ss += (x2[j].x * x2[j].x + x2[j].y * x2[j].y) + (x2[j].z * x2[j].z + x2[j].w * x2[j].w); }
        }
        const float rstd = rsqrtf(wave_sum(ss) * (1.0f / D) + 1e-6f);
#pragma unroll
        for (int hb = 0; hb < 2; ++hb) { float* oh = outr + hb * 1024; const float* gh = gf + hb * 1024;
#pragma unroll
            for (int jj = 0; jj < 4; ++jj) { const int col = 4 * lane + 256 * jj; *(f32x4*)(oh + col) = x2[hb * 4 + jj] * rstd * *(const f32x4*)(gh + col); } }
    }
}

__global__ void __launch_bounds__(NTHR, 2) fwd_kernel(Args args) {
    extern __shared__ __attribute__((aligned(16))) unsigned char lds_raw[];
    LAS unsigned char* lds = (LAS unsigned char*)lds_raw;
    const int tid = threadIdx.x, lane = tid & 63, wave = __builtin_amdgcn_readfirstlane(tid >> 6);
    const int G = gridDim.x; const int bx = blockIdx.x; const int vcu = (G % 8 == 0) ? (bx % 8) * (G / 8) + bx / 8 : bx;
    unsigned char* ws = args.ws;
    for (int u = tid; u < (LDS_BYTES - LDSCTL_OFF) / 4; u += NTHR) ((LAS unsigned*)(lds + LDSCTL_OFF))[u] = 0u;
    __syncthreads();
    XcdBarrier bar; bar.bar = (unsigned*)(ws + WS_CTL) + CW_BAR; bar.x = 0; bar.st = nullptr;
#if !MK_SPLIT
    bar = xcd_barrier_post((unsigned*)(ws + WS_CTL) + CW_BAR, (volatile LAS unsigned*)(lds + LDSCTL_OFF) + LW_BAR);
#endif
    const int lo = args.ph_lo, hi = args.ph_hi;
#ifndef PHASE_MASK
#define PHASE_MASK 0x7ff
#endif
#define IN(k) (((PHASE_MASK >> (k)) & 1) && lo <= (k) && (k) < hi)
#if MK_SPLIT
#define SEAM(k) do { } while (0)
#else
#define SEAM(k) do { if (IN(k) && IN((k) + 1)) xcd_barrier(bar); } while (0)
#endif
    const float* modp = (const float*)(ws + WS_MODF);
    volatile LAS unsigned long long* amp_w = (volatile LAS unsigned long long*)(lds + LDSCTL_OFF + 8192);
#ifndef AMP_CLK
#define AMP_CLK 0
#endif
#define AMP_NOW() (AMP_CLK ? (unsigned long long)__builtin_amdgcn_s_memtime() / 128ull : (unsigned long long)__builtin_amdgcn_s_memrealtime())
#define AMP_BEGIN(k) do { if (AMP_PHASE == (k) && bx == 0 && tid == 0) amp_w[0] = AMP_NOW(); } while (0)
#define AMP_END(k) do { if (AMP_PHASE == (k) && bx == 0 && tid == 0) amp_w[1] = AMP_NOW() - amp_w[0]; } while (0)

    AMP_BEGIN(0);
    AMP_BEGIN(11);
    if (IN(0)) {
        if ((G & 1) == 0 && G >= 64) {
            if ((bx & 1) == 0) { p0_run(args, lds, tid, lane, wave, bx >> 1, G >> 1); __syncthreads(); p0d_run(args, lds, lane, wave, P0_SPLIT_ITEMS, 49152, bx >> 1, G >> 1); }
            else p0d_run(args, lds, lane, wave, 0, P0_SPLIT_ITEMS, bx >> 1, G >> 1);
        } else { p0_run(args, lds, tid, lane, wave, vcu, G); __syncthreads(); p0d_run(args, lds, lane, wave, 0, 49152, vcu, G); }
    }
    AMP_END(11);
    SEAM(0); AMP_END(0);
    AMP_BEGIN(1);
    if (IN(1)) { _Pragma("unroll 1") for (int rep = 0; rep < REP1; ++rep) p1_run(args, tid, lane, wave, vcu, G, 0, MT, true); } SEAM(1); AMP_END(1);
    AMP_BEGIN(2);
    if (IN(2)) {
        pg8::DenseSched S{(const bf16_t*)(ws + WS_A1), (const bf16_t*)(ws + WS_WIN), 2 * D, M / 256, DIN / 256, G, bx, 0, 0, 0, 0};
        pg8::EpiStoreBf16<false> E{(bf16_t*)(ws + WS_P), DIN, nullptr, 0, 1.0f};
        pg8::gemm_phase<false>(lds, 2 * D, S, E);
        if (G < 64 || bx < 32) {
            pg8::DenseSched S8{(const bf16_t*)(ws + WS_A1C8), (const bf16_t*)(ws + WS_WIN8), D, MC / 256, S5W / 256, G >= 64 ? 32 : G, bx, 0, 0, 0, 0};
            pg8::EpiStoreBf16<false> E8{(bf16_t*)(ws + WS_P) + (size_t)M * DIN, DIN, nullptr, 0, 1.0f / WSCALE};
            pg8::gemm_phase<true>(lds, D, S8, E8);
        }
        if (G >= 64) { if (bx >= 32) p2_slack_run(args, lds, tid, lane, wave, bx - 32, G - 32); } else p2_slack_run(args, lds, tid, lane, wave, vcu, G);
    } SEAM(2); AMP_END(2);
    AMP_BEGIN(3);
    if (IN(3)) {
        _Pragma("unroll 1") for (int rep = 0; rep < REP3; ++rep) {
        _Pragma("unroll 1") for (int r2 = 0; r2 < REP3A; ++r2) for (int u = vcu; u < 256; u += G) s5_unit(args, lds, u, lane, wave);
        _Pragma("unroll 1") for (int r2 = 0; r2 < REP3B; ++r2) h1_run(args, lds, tid, vcu, G); }
    } SEAM(3); AMP_END(3);
    AMP_BEGIN(4);
    if (IN(4)) {
        _Pragma("unroll 1") for (int rep = 0; rep < REP4; ++rep) {
        _Pragma("unroll 1") for (int r2 = 1; r2 < REP4A; ++r2) s5_combine(args, vcu * NTHR + tid, G * NTHR);
        _Pragma("unroll 1") for (int r2 = 0; r2 < REP4B; ++r2) longconv_run(args, lds, tid, lane, wave, vcu, G); }
    } SEAM(4); AMP_END(4);
    AMP_BEGIN(5);
    if (IN(5)) {
        _Pragma("unroll 1") for (int rep = 0; rep < REP5; ++rep) h3_run(args, lds, tid, vcu, G);
        pg8::DenseSched S{(const bf16_t*)(ws + WS_YG), (const bf16_t*)(ws + WS_WGLU), 2 * S5W, M / 256, S5W / 256, G, bx, 0, 0, 0, 0};
        pg8::EpiGlu E{(const bf16_t*)(ws + WS_YG), (bf16_t*)(ws + WS_YCAT), args.in[18]};
        pg8::gemm_phase<false>(lds, 2 * S5W, S, E);
    } SEAM(5); AMP_END(5);
    AMP_BEGIN(6);
    if (IN(6)) {
        pg8::DenseSched S{(const bf16_t*)(ws + WS_YCAT), (const bf16_t*)(ws + WS_WOUT), 2 * D, M / 256, D / 256, G, bx, 0, 0, 0, 0};
        pg8::EpiResid E{args.in[0], (float*)(ws + WS_X1), modp};
#ifndef P6_STAGGER_TICKS
#define P6_STAGGER_TICKS 0
#endif
        if ((bx & 1) && P6_STAGGER_TICKS > 0) { const unsigned long long t0 = __builtin_amdgcn_s_memrealtime(); while (__builtin_amdgcn_s_memrealtime() - t0 < (unsigned long long)P6_STAGGER_TICKS) __builtin_amdgcn_s_sleep(8); }
        pg8::gemm_phase<false>(lds, 2 * D, S, E);
    } SEAM(6); AMP_END(6);
    AMP_BEGIN(7);
    if (IN(7)) { _Pragma("unroll 1") for (int rep = 0; rep < REP7; ++rep) p7_run(args, lds, lane, wave, vcu, G, rep == REP7 - 1); } SEAM(7); AMP_END(7);
    AMP_BEGIN(8);
    if (IN(8)) {
        moe_table(args, lds, tid);
        pg8::MoeSched<true> S{ws + WS_A2, ws + WS_WGU, D, 16, G, bx, (size_t)4096 * D,
                              (const LAS int*)(lds + LDSCTL_OFF) + LW_TST, (const LAS int*)(lds + LDSCTL_OFF) + LW_CNT, (const int*)(ws + WS_ROWL)};
        pg8::EpiSwiglu E{ws + WS_H, args.in[35], 1.0f / WSCALE};
        pg8::gemm_phase<true>(lds, D, S, E);
    } SEAM(8); AMP_END(8);
    AMP_BEGIN(9);
    if (IN(9)) {
        if (!IN(8)) moe_table(args, lds, tid);
        pg8::MoeSched<false> S{ws + WS_H, ws + WS_WDN, DFF, 8, G, bx, (size_t)D * DFF,
                               (const LAS int*)(lds + LDSCTL_OFF) + LW_TST, (const LAS int*)(lds + LDSCTL_OFF) + LW_CNT, (const int*)(ws + WS_ROWL)};
        pg8::EpiStoreFp8 E{ws + WS_YD, D, 1.0f / WSCALE};
        pg8::gemm_phase<true>(lds, DFF, S, E);
    } SEAM(9); AMP_END(9);
    AMP_BEGIN(10);
    if (IN(10)) { if (!IN(8) && !IN(9)) moe_table(args, lds, tid); _Pragma("unroll 1") for (int rep = 0; rep < REP10; ++rep) p10_run(args, lds, lane, wave, vcu, G); }
    AMP_END(10);
    if (AMP_PHASE >= 0 && bx == 0 && tid == 0) { const unsigned long long t0 = __builtin_amdgcn_s_memrealtime(); const unsigned long long amp_dt = amp_w[1]; while (__builtin_amdgcn_s_memrealtime() - t0 < 4ull * amp_dt) __builtin_amdgcn_s_sleep(16); }
#undef IN
#undef SEAM
}

extern "C" void kernel_launch(void* const* d_in, const int* in_sizes, int n_in, void* d_out, int out_size, void* d_ws, size_t ws_size, hipStream_t stream) {
    static int grid = 0;
    if (grid == 0) {
        if (n_in != 39 || out_size != M * D || ws_size < WS_END) { fprintf(stderr, "kernel_launch: unexpected problem (n_in %d, out %d, ws %zu)\n", n_in, out_size, ws_size); grid = -1; return; }
        int dev = 0, cus = 0, per_cu = 0;
        if (hipGetDevice(&dev) != hipSuccess || hipDeviceGetAttribute(&cus, hipDeviceAttributeMultiprocessorCount, dev) != hipSuccess) { grid = -1; return; }
        if (hipFuncSetAttribute((const void*)fwd_kernel, hipFuncAttributeMaxDynamicSharedMemorySize, LDS_BYTES) != hipSuccess) { fprintf(stderr, "kernel_launch: hipFuncSetAttribute failed\n"); grid = -1; return; }
        if (hipOccupancyMaxActiveBlocksPerMultiprocessor(&per_cu, (const void*)fwd_kernel, NTHR, LDS_BYTES) != hipSuccess || per_cu < 1) fprintf(stderr, "kernel_launch: occupancy query says %d\n", per_cu);
        (void)hipGetLastError();
        grid = cus;
    }
    if (grid < 0) return;
    (void)in_sizes;
    if (hipMemsetAsync((char*)d_ws + WS_CTL, 0, CTL_ZERO_BYTES, stream) != hipSuccess) { fprintf(stderr, "kernel_launch: memset failed\n"); return; }
    Args a{};
    for (int i = 0; i < 39; ++i) a.in[i] = (const float*)d_in[i];
    a.out = (float*)d_out; a.ws = (unsigned char*)d_ws;
#if MK_SPLIT
    for (int p = 0; p < NPHASE; ++p) { a.ph_lo = p; a.ph_hi = p + 1; hipLaunchKernelGGL(fwd_kernel, dim3(grid), dim3(NTHR), LDS_BYTES, stream, a); }
#else
    a.ph_lo = 0; a.ph_hi = NPHASE;
    hipLaunchKernelGGL(fwd_kernel, dim3(grid), dim3(NTHR), LDS_BYTES, stream, a);
#endif
    const hipError_t le = hipPeekAtLastError();
    if (le != hipSuccess) fprintf(stderr, "kernel_launch: launch failed: %s\n", hipGetErrorName(le));
}
```
